# Optimizing an MI355X kernel written in HIP

```python
import jax
import jax.numpy as jnp
from jax import lax
import numpy as np

D_MODEL = 1024
BATCH = 16
SEQ = 256
DEPTH = 4
DEC_BATCH = 4
DEC_SEQ = 2048
PAST_LEN = 512

GRID_W = 64
HEAD_DIM = 64
BRANCH_W = 256
N_BRANCH = 4
NA_HEADS = 4
NA_WIN_H = 8
NA_WIN_W = 16
NA_QBW = 16
NA_KBW = 32
HG_HEADS = 4
HG_DK = 64
HG_DV = 64
HG_CHUNK = 64
F_FLOOR = 1e-30
MLA_HEADS = 4
MLA_Q_RANK = 256
MLA_KV_RANK = 128
MLA_NOPE = 64
MLA_ROPE = 32
MLA_V = 64
WG_HEADS = 4
WG_KV_HEADS = 2
WG_WINDOW = 128
WG_BLOCK = 128

Q_BLOCK = 128
ROPE_BASE = 10000.0
EPS = 1e-6
NEG_INF = -1e30

IN_LAYOUT = (
    ('na_q', NA_HEADS * HEAD_DIM), ('na_k', NA_HEADS * HEAD_DIM), ('na_v', NA_HEADS * HEAD_DIM), ('na_z', BRANCH_W),
    ('hg_q', HG_HEADS * HG_DK), ('hg_ff', HG_HEADS * HG_DK), ('hg_fb', HG_HEADS * HG_DK),
    ('hg_i', HG_HEADS * HG_DV), ('hg_og', HG_HEADS * HG_DV), ('hg_z', BRANCH_W),
    ('mla_qa', MLA_Q_RANK), ('mla_kva', MLA_KV_RANK + MLA_ROPE), ('mla_z', BRANCH_W),
    ('wg_q', WG_HEADS * HEAD_DIM), ('wg_k', WG_KV_HEADS * HEAD_DIM), ('wg_v', WG_KV_HEADS * HEAD_DIM), ('wg_z', BRANCH_W),
    ('merge', N_BRANCH * D_MODEL),
)
IN_WIDTH = sum(w for _, w in IN_LAYOUT)

kernel_name = 'hybrid_diffusion_prefix_step'

F32 = jnp.float32


def rms_norm(x, g):
    xf = x.astype(F32)
    y = xf * lax.rsqrt(jnp.mean(xf * xf, axis=-1, keepdims=True) + EPS)
    return (y * g.astype(F32)).astype(x.dtype)


def heads(a, n):
    return a.reshape(a.shape[:-1] + (n, a.shape[-1] // n))


def split_cols(p):
    out = {}
    off = 0
    for name, w in IN_LAYOUT:
        out[name] = p[..., off:off + w]
        off += w
    return out


def axial_rope(n_tok, rot_dim):
    t = jnp.arange(n_tok)
    row = (t // GRID_W).astype(F32)
    col = (t % GRID_W).astype(F32)
    nf = rot_dim // 4
    inv = ROPE_BASE ** (-jnp.arange(nf, dtype=F32) / nf)
    ang = jnp.concatenate([row[:, None] * inv, col[:, None] * inv], axis=-1)
    return jnp.cos(ang), jnp.sin(ang)


def apply_rope(x, cos, sin):
    x1, x2 = jnp.split(x.astype(F32), 2, axis=-1)
    c = cos[None, :, None, :]
    s = sin[None, :, None, :]
    return jnp.concatenate([x1 * c - x2 * s, x1 * s + x2 * c], axis=-1).astype(x.dtype)


def sink_softmax(s, sink=None):
    if sink is None:
        return jax.nn.softmax(s, axis=-1)
    sk = sink.astype(F32)
    m = jnp.maximum(jnp.max(s, axis=-1, keepdims=True), sk)
    e = jnp.exp(s - m)
    return e / (jnp.sum(e, axis=-1, keepdims=True) + jnp.exp(sk - m))


def block_attention(q, k, v, sink=None):
    B, Lq, H, dq = q.shape
    Hk = k.shape[2]
    G = H // Hk
    dv = v.shape[-1]
    nb = Lq // Q_BLOCK
    scale = dq ** -0.5
    qb = q.reshape(B, nb, Q_BLOCK, Hk, G, dq).transpose(1, 0, 2, 3, 4, 5)
    sk = None if sink is None else sink.reshape(1, Hk, G, 1, 1)

    def one(qblk):
        s = jnp.einsum('bqkgd,bskd->bkgqs', qblk, k).astype(F32) * scale
        p = sink_softmax(s, sk)
        return jnp.einsum('bkgqs,bskd->bqkgd', p.astype(v.dtype), v)

    o = lax.map(one, qb)
    return o.transpose(1, 0, 2, 3, 4, 5).reshape(B, Lq, H, dv)


def neighborhood_attention(q, k, v, kc, vc, rpb):
    B, T, H, d = q.shape
    rows = T // GRID_W
    wh = min(NA_WIN_H, rows)
    ncb = GRID_W // NA_QBW
    scale = d ** -0.5
    r = jnp.arange(rows)
    key_rows = jnp.clip(r - wh // 2, 0, rows - wh)[:, None] + jnp.arange(wh)[None, :]
    qcol = jnp.arange(GRID_W).reshape(ncb, NA_QBW)
    kcol = jnp.clip(jnp.arange(ncb) * NA_QBW - NA_WIN_W // 2, 0, GRID_W - NA_KBW)[:, None] + jnp.arange(NA_KBW)[None, :]
    qstart = jnp.clip(qcol - NA_WIN_W // 2, 0, GRID_W - NA_WIN_W)
    kc3 = kcol[:, None, :]
    col_ok = (kc3 >= qstart[..., None]) & (kc3 < qstart[..., None] + NA_WIN_W)
    drow = key_rows - r[:, None]
    dcol = jnp.clip(kc3 - qcol[:, :, None] + NA_WIN_W - 1, 0, 2 * NA_WIN_W - 2)
    bias = rpb[:, (drow + NA_WIN_H - 1)[:, None, None, :, None], dcol[None, :, :, None, :]]
    kg = k.reshape(B, rows, GRID_W, H, d)
    vg = v.reshape(B, rows, GRID_W, H, d)
    ri = key_rows[:, :, None, None]
    ci = kcol[None, None, :, :]
    kw = kg[:, ri, ci]
    vw = vg[:, ri, ci]
    qg = q.reshape(B, rows, ncb, NA_QBW, H, d)
    s_loc = jnp.einsum('brcqhd,brwckhd->bhrcqwk', qg, kw).astype(F32) * scale + bias[None].astype(F32)
    s_loc = jnp.where(col_ok[None, None, None, :, :, None, :], s_loc, NEG_INF)
    nloc = wh * NA_KBW
    s_loc = s_loc.reshape(B, H, rows, ncb, NA_QBW, nloc)
    s_ctx = jnp.einsum('brcqhd,blhd->bhrcql', qg, kc).astype(F32) * scale
    p = jax.nn.softmax(jnp.concatenate([s_loc, s_ctx], axis=-1), axis=-1)
    p_loc = p[..., :nloc].reshape(B, H, rows, ncb, NA_QBW, wh, NA_KBW).astype(v.dtype)
    o = (jnp.einsum('bhrcqwk,brwckhd->brcqhd', p_loc, vw)
         + jnp.einsum('bhrcql,blhd->brcqhd', p[..., nloc:].astype(vc.dtype), vc))
    return o.reshape(B, T, H, d)


def window_attention(q, k, v, kc, vc, sink):
    B, T, H, d = q.shape
    Hk = k.shape[2]
    G = H // Hk
    nb = T // WG_BLOCK
    scale = d ** -0.5
    qb = q.reshape(B, nb, WG_BLOCK, Hk, G, d)
    pad = ((0, 0), (WG_BLOCK, WG_BLOCK), (0, 0), (0, 0))
    kp = jnp.pad(k, pad).reshape(B, nb + 2, WG_BLOCK, Hk, d)
    vp = jnp.pad(v, pad).reshape(B, nb + 2, WG_BLOCK, Hk, d)
    kw = jnp.concatenate([kp[:, :-2], kp[:, 1:-1], kp[:, 2:]], axis=2)
    vw = jnp.concatenate([vp[:, :-2], vp[:, 1:-1], vp[:, 2:]], axis=2)
    a = jnp.arange(WG_BLOCK)
    m = jnp.arange(3 * WG_BLOCK)
    rel = m[None, :] - WG_BLOCK - a[:, None]
    kpos = jnp.arange(nb)[:, None] * WG_BLOCK - WG_BLOCK + m[None, :]
    valid = (jnp.abs(rel) <= WG_WINDOW)[None] & ((kpos >= 0) & (kpos < T))[:, None, :]
    s_loc = jnp.einsum('bnqkgd,bnmkd->bkgnqm', qb, kw).astype(F32) * scale
    s_loc = jnp.where(valid[None, None, None], s_loc, NEG_INF)
    s_ctx = jnp.einsum('bnqkgd,blkd->bkgnql', qb, kc).astype(F32) * scale
    p = sink_softmax(jnp.concatenate([s_loc, s_ctx], axis=-1), sink.reshape(1, Hk, G, 1, 1, 1))
    nloc = 3 * WG_BLOCK
    o = (jnp.einsum('bkgnqm,bnmkd->bnqkgd', p[..., :nloc].astype(v.dtype), vw)
         + jnp.einsum('bkgnql,blkd->bnqkgd', p[..., nloc:].astype(vc.dtype), vc))
    return o.reshape(B, T, H, d)


def chunk_scan(q, k, v, logf, s0):
    B, T, H, dk = q.shape
    dv = v.shape[-1]
    C = HG_CHUNK
    n = T // C
    causal = jnp.tril(jnp.ones((C, C), dtype=bool))

    def to_chunks(a):
        return a.reshape(B, n, C, H, a.shape[-1]).transpose(1, 0, 3, 2, 4)

    def step(S, inp):
        qc, kc, vc, gc = inp
        b = jnp.cumsum(gc, axis=2)
        dec = jnp.exp(jnp.where(causal[:, :, None], b[:, :, :, None, :] - b[:, :, None, :, :], NEG_INF))
        att = jnp.einsum('bhtd,bhsd,bhtsd->bhts', qc, kc, dec)
        o = jnp.einsum('bhts,bhsv->bhtv', att, vc) + jnp.einsum('bhtd,bhdv->bhtv', qc * jnp.exp(b), S)
        b_last = b[:, :, -1:, :]
        S = jnp.exp(b_last[:, :, 0, :, None]) * S + jnp.einsum('bhsd,bhsv->bhdv', kc * jnp.exp(b_last - b), vc)
        return S, o

    S, o = lax.scan(step, s0, (to_chunks(q), to_chunks(k), to_chunks(v), to_chunks(logf)))
    return o.transpose(1, 0, 3, 2, 4).reshape(B, T, H, dv), S


def hgrn_gates(fz, lb):
    fz = fz.astype(F32)
    lb = lb.astype(F32)
    f = lb + (1.0 - lb) * jax.nn.sigmoid(fz)
    logf = jnp.log(jnp.maximum(f, F_FLOOR))
    k = (1.0 - lb) * jax.nn.sigmoid(-fz)
    return heads(logf, HG_HEADS), heads(k, HG_HEADS)


def hgrn_branch(cols, lb_pair, norm_g, s0_f, s0_b):
    q = heads(jax.nn.silu(cols['hg_q']).astype(F32), HG_HEADS)
    i = heads(cols['hg_i'].astype(F32), HG_HEADS)
    outs = []
    finals = []
    for fz, lb, s0, rev in ((cols['hg_ff'], lb_pair[0], s0_f, False), (cols['hg_fb'], lb_pair[1], s0_b, True)):
        logf, k = hgrn_gates(fz, lb)
        seq = (q, k, i, logf)
        if rev:
            seq = tuple(jnp.flip(a, axis=1) for a in seq)
        o, s = chunk_scan(seq[0], seq[1], seq[2], seq[3], s0)
        outs.append(jnp.flip(o, axis=1) if rev else o)
        finals.append(s)
    o = rms_norm(outs[0] + outs[1], norm_g) * jax.nn.sigmoid(heads(cols['hg_og'], HG_HEADS).astype(F32))
    return o.astype(cols['hg_q'].dtype), finals[0], finals[1]


def mla_query(qa, g_qa, w_qb, rope):
    q = heads(rms_norm(qa, g_qa) @ w_qb, MLA_HEADS)
    if rope is not None:
        q = jnp.concatenate([q[..., :MLA_NOPE], apply_rope(q[..., MLA_NOPE:], rope[0], rope[1])], axis=-1)
    return q


def mla_compress(kva, g_kv, rope):
    ckv = rms_norm(kva[..., :MLA_KV_RANK], g_kv)
    kr = kva[..., MLA_KV_RANK:]
    if rope is not None:
        kr = apply_rope(kr[:, :, None, :], rope[0], rope[1])[:, :, 0, :]
    return ckv, kr


def mla_expand(ckv, kr, w_kvb):
    kv = heads(ckv @ w_kvb, MLA_HEADS)
    B, T, H, _ = kv.shape
    k = jnp.concatenate([kv[..., :MLA_NOPE], jnp.broadcast_to(kr[:, :, None, :], (B, T, H, MLA_ROPE))], axis=-1)
    return k, kv[..., MLA_NOPE:]


def layer_pre(x, cvec, W, l):
    mod = jax.nn.silu(cvec) @ W['w_mod'][l] + W['b_mod'][l]
    shift, scale, gate = jnp.split(mod[:, None, :], 3, axis=-1)
    h = rms_norm(x, W['norm_g'][l]) * (1 + scale) + shift
    return split_cols(h @ W['w_in'][l]), gate


def layer_post(x, cols, gate, branch_outs, W, l):
    B, T, _ = x.shape
    zs = (cols['na_z'], cols['hg_z'], cols['mla_z'], cols['wg_z'])
    y = jnp.stack([o.reshape(B, T, BRANCH_W) * jax.nn.silu(z) for o, z in zip(branch_outs, zs)], axis=2)
    proj = jnp.einsum('btnw,nwd->btnd', y, W['w_branch'][l])
    mg = jax.nn.sigmoid(cols['merge'].reshape(B, T, N_BRANCH, D_MODEL))
    merged = jnp.sum(mg * proj, axis=2)
    return x + gate * (merged @ W['w_out'][l])


def context_layer(x, cvec, lb, W, l):
    cols, gate = layer_pre(x, cvec, W, l)
    B = x.shape[0]
    na_k = heads(cols['na_k'], NA_HEADS)
    na_v = heads(cols['na_v'], NA_HEADS)
    o_na = block_attention(heads(cols['na_q'], NA_HEADS), na_k, na_v)
    zero = jnp.zeros((B, HG_HEADS, HG_DK, HG_DV), F32)
    o_hg, s_f, s_b = hgrn_branch(cols, lb, W['hg_norm_g'][l], zero, zero)
    q = mla_query(cols['mla_qa'], W['mla_q_norm_g'][l], W['mla_w_qb'][l], None)
    ckv, kr = mla_compress(cols['mla_kva'], W['mla_kv_norm_g'][l], None)
    k, v = mla_expand(ckv, kr, W['mla_w_kvb'][l])
    o_mla = block_attention(q, k, v)
    wk = heads(cols['wg_k'], WG_KV_HEADS)
    wv = heads(cols['wg_v'], WG_KV_HEADS)
    o_wg = block_attention(heads(cols['wg_q'], WG_HEADS), wk, wv, W['wg_sink'][l])
    x = layer_post(x, cols, gate, (o_na, o_hg, o_mla, o_wg), W, l)
    return x, (na_k, na_v, jnp.stack([s_f, s_b], axis=1), ckv, kr, wk, wv)


def latent_layer(x, c, cache, lb, rope_mla, rope_wg, W, l):
    kc_na, vc_na, st, ckv_c, kr_c, kc_wg, vc_wg = cache
    cols, gate = layer_pre(x, c, W, l)
    o_na = neighborhood_attention(heads(cols['na_q'], NA_HEADS), heads(cols['na_k'], NA_HEADS),
                                  heads(cols['na_v'], NA_HEADS), kc_na, vc_na, W['na_rpb'][l])
    o_hg, _, _ = hgrn_branch(cols, lb, W['hg_norm_g'][l], st[:, 0].astype(F32), st[:, 1].astype(F32))
    q = mla_query(cols['mla_qa'], W['mla_q_norm_g'][l], W['mla_w_qb'][l], rope_mla)
    ckv, kr = mla_compress(cols['mla_kva'], W['mla_kv_norm_g'][l], rope_mla)
    k_lat, v_lat = mla_expand(ckv, kr, W['mla_w_kvb'][l])
    k_ctx, v_ctx = mla_expand(ckv_c, kr_c, W['mla_w_kvb'][l])
    o_mla = block_attention(q, jnp.concatenate([k_lat, k_ctx], axis=1), jnp.concatenate([v_lat, v_ctx], axis=1))
    wq = apply_rope(heads(cols['wg_q'], WG_HEADS), rope_wg[0], rope_wg[1])
    wk = apply_rope(heads(cols['wg_k'], WG_KV_HEADS), rope_wg[0], rope_wg[1])
    o_wg = window_attention(wq, wk, heads(cols['wg_v'], WG_KV_HEADS), kc_wg, vc_wg, W['wg_sink'][l])
    return layer_post(x, cols, gate, (o_na, o_hg, o_mla, o_wg), W, l)


def setup_inputs(seed: int = 0) -> dict:
    key = jax.random.key(seed)
    ks = jax.random.split(key, 32)

    def nrm(k, shape, s=1.0):
        return jax.random.normal(k, shape, F32) * s

    L = PAST_LEN
    Bd = DEC_BATCH
    return {
        'x_prompt': nrm(ks[0], (BATCH, SEQ, D_MODEL)),
        'x_sample': nrm(ks[1], (DEC_BATCH, DEC_SEQ, D_MODEL)),
        'cache_na_k': nrm(ks[2], (Bd, DEPTH, L, NA_HEADS, HEAD_DIM)),
        'cache_na_v': nrm(ks[3], (Bd, DEPTH, L, NA_HEADS, HEAD_DIM)),
        'state_hgrn': nrm(ks[4], (Bd, DEPTH, 2, HG_HEADS, HG_DK, HG_DV)),
        'cache_mla_ckv': nrm(ks[5], (Bd, DEPTH, L, MLA_KV_RANK)),
        'cache_mla_krope': nrm(ks[6], (Bd, DEPTH, L, MLA_ROPE)),
        'cache_wg_k': nrm(ks[7], (Bd, DEPTH, L, WG_KV_HEADS, HEAD_DIM)),
        'cache_wg_v': nrm(ks[8], (Bd, DEPTH, L, WG_KV_HEADS, HEAD_DIM)),
        'c': nrm(ks[9], (DEC_BATCH, D_MODEL)),
        'c_ctx': nrm(ks[10], (D_MODEL,)),
        'norm_g': 1.0 + nrm(ks[11], (DEPTH, D_MODEL), 0.02),
        'w_mod': nrm(ks[12], (DEPTH, D_MODEL, 3 * D_MODEL), 0.5 * D_MODEL ** -0.5),
        'b_mod': nrm(ks[13], (DEPTH, 3 * D_MODEL), 0.01),
        'w_in': nrm(ks[14], (DEPTH, D_MODEL, IN_WIDTH), D_MODEL ** -0.5),
        'na_rpb': nrm(ks[15], (DEPTH, NA_HEADS, 2 * NA_WIN_H - 1, 2 * NA_WIN_W - 1), 0.1),
        'hg_lb_logits': nrm(ks[16], (DEPTH, 2, HG_HEADS * HG_DK), 0.5),
        'hg_norm_g': 1.0 + nrm(ks[17], (DEPTH, HG_DV), 0.02),
        'mla_q_norm_g': 1.0 + nrm(ks[18], (DEPTH, MLA_Q_RANK), 0.02),
        'mla_kv_norm_g': 1.0 + nrm(ks[19], (DEPTH, MLA_KV_RANK), 0.02),
        'mla_w_qb': nrm(ks[20], (DEPTH, MLA_Q_RANK, MLA_HEADS * (MLA_NOPE + MLA_ROPE)), MLA_Q_RANK ** -0.5),
        'mla_w_kvb': nrm(ks[21], (DEPTH, MLA_KV_RANK, MLA_HEADS * (MLA_NOPE + MLA_V)), MLA_KV_RANK ** -0.5),
        'wg_sink': nrm(ks[22], (DEPTH, WG_HEADS), 0.5),
        'w_branch': nrm(ks[23], (DEPTH, N_BRANCH, BRANCH_W, D_MODEL), BRANCH_W ** -0.5),
        'w_out': nrm(ks[24], (DEPTH, D_MODEL, D_MODEL), D_MODEL ** -0.5),
        'final_g': 1.0 + nrm(ks[25], (D_MODEL,), 0.02),
    }


def reference(x_prompt, x_sample, cache_na_k, cache_na_v, state_hgrn, cache_mla_ckv, cache_mla_krope,
              cache_wg_k, cache_wg_v, c, c_ctx, norm_g, w_mod, b_mod, w_in, na_rpb, hg_lb_logits, hg_norm_g,
              mla_q_norm_g, mla_kv_norm_g, mla_w_qb, mla_w_kvb, wg_sink, w_branch, w_out, final_g):
    W = {'norm_g': norm_g, 'w_mod': w_mod, 'b_mod': b_mod, 'w_in': w_in, 'na_rpb': na_rpb,
         'hg_norm_g': hg_norm_g, 'mla_q_norm_g': mla_q_norm_g, 'mla_kv_norm_g': mla_kv_norm_g,
         'mla_w_qb': mla_w_qb, 'mla_w_kvb': mla_w_kvb, 'wg_sink': wg_sink, 'w_branch': w_branch, 'w_out': w_out}
    p_lb = jax.nn.softmax(hg_lb_logits.astype(F32), axis=0)
    lbs = jnp.cumsum(p_lb, axis=0) - p_lb[0]

    Bp = x_prompt.shape[0]
    cvec = jnp.broadcast_to(c_ctx[None, :], (Bp, D_MODEL))
    h = x_prompt
    per_layer = []
    for l in range(DEPTH):
        h, st = context_layer(h, cvec, lbs[l], W, l)
        per_layer.append(st)
    y_prompt = rms_norm(h, final_g)
    new_na_k = jnp.stack([s[0] for s in per_layer], axis=1)
    new_na_v = jnp.stack([s[1] for s in per_layer], axis=1)
    new_state_hgrn = jnp.stack([s[2] for s in per_layer], axis=1)
    new_mla_ckv = jnp.stack([s[3] for s in per_layer], axis=1)
    new_mla_krope = jnp.stack([s[4] for s in per_layer], axis=1)
    new_wg_k = jnp.stack([s[5] for s in per_layer], axis=1)
    new_wg_v = jnp.stack([s[6] for s in per_layer], axis=1)

    T = x_sample.shape[1]
    rope_mla = axial_rope(T, MLA_ROPE)
    rope_wg = axial_rope(T, HEAD_DIM)
    h = x_sample
    for l in range(DEPTH):
        cache_l = (cache_na_k[:, l], cache_na_v[:, l], state_hgrn[:, l], cache_mla_ckv[:, l],
                   cache_mla_krope[:, l], cache_wg_k[:, l], cache_wg_v[:, l])
        h = latent_layer(h, c, cache_l, lbs[l], rope_mla, rope_wg, W, l)
    y_sample = rms_norm(h, final_g)
    return (y_prompt, y_sample, new_na_k, new_na_v, new_state_hgrn, new_mla_ckv, new_mla_krope, new_wg_k, new_wg_v)
```

```cpp
#ifndef CPU_EMU
#include <hip/hip_runtime.h>
#include <hip/hip_cooperative_groups.h>
#include <cstdio>
#define DEV __device__ __forceinline__
#else
#include <cmath>
#include <cstdio>
#include <cstring>
#define DEV inline
#endif
#include <cstdint>
#include <cstddef>

#ifndef CFG_BATCH
#define CFG_BATCH 16
#endif
#ifndef CFG_DEPTH
#define CFG_DEPTH 4
#endif
#ifndef CFG_DEC_BATCH
#define CFG_DEC_BATCH 4
#endif
constexpr int DM = 1024, BATCH = CFG_BATCH, SEQ = 256, DEPTH = CFG_DEPTH, DB = CFG_DEC_BATCH, DSEQ = 2048, PAST = 512;
constexpr int NCTX = BATCH * SEQ, NLAT = DB * DSEQ, NTOK = NCTX + NLAT;
constexpr int NCB = 1 + DB;
constexpr int INW = 8096, NC = 8192;
constexpr int GW = 64, GROWS = DSEQ / GW;
constexpr int C_NAQ = 0, C_NAK = 256, C_NAV = 512, C_NAZ = 768, C_HGQ = 1024, C_HGFF = 1280, C_HGFB = 1536, C_HGI = 1792, C_HGOG = 2048, C_HGZ = 2304,
              C_MQA = 2560, C_CKV = 2816, C_MZ = 2944, C_WQ = 3200, C_WK = 3456, C_WV = 3584, C_WZ = 3712, C_KR = 3968, C_PAD = 4000, C_MG = 4096;
DEV int orig_col(int c) {
    if (c < 2944) return c;
    if (c < 3968) return c + 32;
    if (c < 4000) return 2944 + (c - 3968);
    if (c < 4096) return -1;
    return c - 96;
}
enum { I_XP = 0, I_XS, I_CNAK, I_CNAV, I_ST, I_CCKV, I_CKR, I_CWK, I_CWV, I_C, I_CCTX, I_NG, I_WMOD, I_BMOD, I_WIN, I_RPB, I_LB, I_HGG, I_QG, I_KVG, I_WQB, I_WKVB, I_SINK, I_WBR, I_WOUT, I_FG, N_IN };
constexpr size_t O_Y = 0;
constexpr size_t O_NAK = (size_t)NTOK * DM;
constexpr size_t O_NAV = O_NAK + (size_t)BATCH * DEPTH * SEQ * 256;
constexpr size_t O_ST = O_NAV + (size_t)BATCH * DEPTH * SEQ * 256;
constexpr size_t O_CKV = O_ST + (size_t)BATCH * DEPTH * 2 * 4 * 64 * 64;
constexpr size_t O_KR = O_CKV + (size_t)BATCH * DEPTH * SEQ * 128;
constexpr size_t O_WK = O_KR + (size_t)BATCH * DEPTH * SEQ * 32;
constexpr size_t O_WV = O_WK + (size_t)BATCH * DEPTH * SEQ * 128;
constexpr size_t O_END = O_WV + (size_t)BATCH * DEPTH * SEQ * 128;

typedef unsigned short bf16_t;
constexpr size_t al256(size_t x) { return (x + 255) & ~(size_t)255; }
constexpr size_t WS_CTL = 0;
constexpr size_t WS_WTIN = 1u << 20;
constexpr size_t WS_WTBR = WS_WTIN + (size_t)DEPTH * NC * DM * 2;
constexpr size_t WS_WTOUT = WS_WTBR + (size_t)DEPTH * 4 * DM * 256 * 2;
constexpr size_t WS_WTQB = WS_WTOUT + (size_t)DEPTH * DM * DM * 2;
constexpr size_t WS_WTKVB = WS_WTQB + (size_t)DEPTH * 512 * 256 * 2;
constexpr size_t WS_MODV = WS_WTKVB + (size_t)DEPTH * 512 * 128 * 2;
constexpr size_t WS_LBS = al256(WS_MODV + (size_t)DEPTH * NCB * 3072 * 4);
constexpr size_t WS_ROPEM = al256(WS_LBS + (size_t)DEPTH * 2 * 256 * 4);
constexpr size_t WS_ROPEW = al256(WS_ROPEM + (size_t)DSEQ * 16 * 2 * 4);
constexpr size_t WS_X = al256(WS_ROPEW + (size_t)DSEQ * 32 * 2 * 4);
constexpr size_t WS_H = WS_X + (size_t)NTOK * DM * 4;
constexpr size_t WS_COLS = WS_H + (size_t)NTOK * DM * 2;
constexpr size_t WS_QN = WS_COLS + (size_t)NTOK * NC * 2;
constexpr size_t WS_CKVB = WS_QN + (size_t)NTOK * 256 * 2;
constexpr size_t WS_QMLA = WS_CKVB + (size_t)NTOK * 128 * 2;
constexpr size_t WS_KMLA = WS_QMLA + (size_t)NTOK * 384 * 2;
constexpr size_t WS_VMLA = WS_KMLA + (size_t)NTOK * 384 * 2;
constexpr size_t WS_KCM = WS_VMLA + (size_t)NTOK * 256 * 2;
constexpr size_t WS_VCM = WS_KCM + (size_t)DB * DEPTH * PAST * 384 * 2;
constexpr size_t WS_WQR = WS_VCM + (size_t)DB * DEPTH * PAST * 256 * 2;
constexpr size_t WS_WKR = WS_WQR + (size_t)NTOK * 256 * 2;
constexpr size_t WS_Y = WS_WKR + (size_t)NTOK * 128 * 2;
constexpr size_t WS_MRG = WS_Y + (size_t)NTOK * DM * 2;
constexpr size_t WS_OH = WS_MRG + (size_t)NTOK * DM * 2;
constexpr size_t WS_END = WS_OH + (size_t)2 * NTOK * 256 * 4;

struct P {
    const float* in[N_IN];
    float* out;
    unsigned char* ws;
};

DEV unsigned f2u(float f) { unsigned u; memcpy(&u, &f, 4); return u; }
DEV float u2f(unsigned u) { float f; memcpy(&f, &u, 4); return f; }
DEV bf16_t f2bf(float f) { unsigned u = f2u(f); return (bf16_t)((u + 0x7fffu + ((u >> 16) & 1u)) >> 16); }
DEV float bf2f(bf16_t b) { return u2f((unsigned)b << 16); }
DEV float rbf(float f) { return bf2f(f2bf(f)); }
DEV float sigm(float x) { return 1.f / (1.f + expf(-x)); }
DEV float siluf(float x) { return x * sigm(x); }
DEV int row_cb(int r) { return r < NCTX ? 0 : 1 + (r - NCTX) / DSEQ; }

struct U4 { unsigned x, y, z, w; };
DEV void unpack8(const bf16_t* p, float* f) {
    U4 v = *(const U4*)p;
    f[0] = u2f(v.x << 16); f[1] = u2f(v.x & 0xffff0000u); f[2] = u2f(v.y << 16); f[3] = u2f(v.y & 0xffff0000u);
    f[4] = u2f(v.z << 16); f[5] = u2f(v.z & 0xffff0000u); f[6] = u2f(v.w << 16); f[7] = u2f(v.w & 0xffff0000u);
}

#define WSP(T, off) ((T*)(p.ws + (off)))

DEV void nv_prep_w(const P& p, long gtid, long gsz) {
    bf16_t* wtin = WSP(bf16_t, WS_WTIN);
    const float* win = p.in[I_WIN];
    for (long i = gtid; i < (long)DEPTH * NC * DM; i += gsz) {
        int k = (int)(i % DM); long t = i / DM; int n = (int)(t % NC); int l = (int)(t / NC);
        int oc = orig_col(n);
        wtin[i] = oc < 0 ? (bf16_t)0 : f2bf(win[((size_t)l * DM + k) * INW + oc]);
    }
    bf16_t* wtbr = WSP(bf16_t, WS_WTBR);
    const float* wbr = p.in[I_WBR];
    for (long i = gtid; i < (long)DEPTH * 4 * DM * 256; i += gsz) {
        int w = (int)(i % 256); long t = i / 256; int d = (int)(t % DM); t /= DM; int b = (int)(t % 4); int l = (int)(t / 4);
        wtbr[i] = f2bf(wbr[(((size_t)l * 4 + b) * 256 + w) * DM + d]);
    }
    bf16_t* wtout = WSP(bf16_t, WS_WTOUT);
    const float* wout = p.in[I_WOUT];
    for (long i = gtid; i < (long)DEPTH * DM * DM; i += gsz) {
        int k = (int)(i % DM); long t = i / DM; int n = (int)(t % DM); int l = (int)(t / DM);
        wtout[i] = f2bf(wout[((size_t)l * DM + k) * DM + n]);
    }
    bf16_t* wtqb = WSP(bf16_t, WS_WTQB);
    const float* wqb = p.in[I_WQB];
    for (long i = gtid; i < (long)DEPTH * 512 * 256; i += gsz) {
        int k = (int)(i % 256); long t = i / 256; int n = (int)(t % 512); int l = (int)(t / 512);
        wtqb[i] = n < 384 ? f2bf(wqb[((size_t)l * 256 + k) * 384 + n]) : (bf16_t)0;
    }
    bf16_t* wtkvb = WSP(bf16_t, WS_WTKVB);
    const float* wkvb = p.in[I_WKVB];
    for (long i = gtid; i < (long)DEPTH * 512 * 128; i += gsz) {
        int k = (int)(i % 128); long t = i / 128; int n = (int)(t % 512); int l = (int)(t / 512);
        wtkvb[i] = f2bf(wkvb[((size_t)l * 128 + k) * 512 + n]);
    }
    float* modv = WSP(float, WS_MODV);
    for (long i = gtid; i < (long)DEPTH * NCB * 3072; i += gsz) {
        int j = (int)(i % 3072); long t = i / 3072; int cb = (int)(t % NCB); int l = (int)(t / NCB);
        const float* cv = cb == 0 ? p.in[I_CCTX] : p.in[I_C] + (size_t)(cb - 1) * DM;
        const float* w = p.in[I_WMOD] + (size_t)l * DM * 3072 + j;
        float acc = 0.f;
        for (int k = 0; k < DM; ++k) acc += siluf(cv[k]) * w[(size_t)k * 3072];
        modv[i] = acc + p.in[I_BMOD][(size_t)l * 3072 + j];
    }
    float* lbs = WSP(float, WS_LBS);
    for (long i = gtid; i < 2 * 256; i += gsz) {
        const float* lg = p.in[I_LB];
        float mx = -1e30f;
        for (int l = 0; l < DEPTH; ++l) mx = fmaxf(mx, lg[(size_t)l * 512 + i]);
        float s = 0.f;
        for (int l = 0; l < DEPTH; ++l) s += expf(lg[(size_t)l * 512 + i] - mx);
        float cum = 0.f, p0 = expf(lg[i] - mx) / s;
        for (int l = 0; l < DEPTH; ++l) { cum += expf(lg[(size_t)l * 512 + i] - mx) / s; lbs[(size_t)l * 512 + i] = cum - p0; }
    }
    float* rm = WSP(float, WS_ROPEM);
    for (long i = gtid; i < (long)DSEQ * 16; i += gsz) {
        int j = (int)(i % 16), t = (int)(i / 16);
        float pos = j < 8 ? (float)(t / GW) : (float)(t % GW);
        float inv = powf(10000.f, -(float)(j & 7) / 8.f);
        float a = pos * inv; rm[i * 2] = cosf(a); rm[i * 2 + 1] = sinf(a);
    }
    float* rw = WSP(float, WS_ROPEW);
    for (long i = gtid; i < (long)DSEQ * 32; i += gsz) {
        int j = (int)(i % 32), t = (int)(i / 32);
        float pos = j < 16 ? (float)(t / GW) : (float)(t % GW);
        float inv = powf(10000.f, -(float)(j & 15) / 16.f);
        float a = pos * inv; rw[i * 2] = cosf(a); rw[i * 2 + 1] = sinf(a);
    }
}

DEV void nv_prep_ctxmla(const P& p, long gtid, long gsz) {
    const bf16_t* wtkvb = WSP(bf16_t, WS_WTKVB);
    bf16_t* kcm = WSP(bf16_t, WS_KCM); bf16_t* vcm = WSP(bf16_t, WS_VCM);
    for (long i = gtid; i < (long)DB * DEPTH * PAST * 512; i += gsz) {
        int n = (int)(i % 512); long row = i / 512;
        int l = (int)((row / PAST) % DEPTH);
        const float* ck = p.in[I_CCKV] + (size_t)row * 128;
        const bf16_t* w = wtkvb + ((size_t)l * 512 + n) * 128;
        float acc = 0.f;
        for (int j = 0; j < 128; ++j) acc += rbf(ck[j]) * bf2f(w[j]);
        int h = n / 128, e = n % 128;
        if (e < 64) kcm[(size_t)row * 384 + h * 96 + e] = f2bf(acc);
        else vcm[(size_t)row * 256 + h * 64 + (e - 64)] = f2bf(acc);
    }
    for (long i = gtid; i < (long)DB * DEPTH * PAST * 128; i += gsz) {
        int e = (int)(i % 32); int h = (int)((i / 32) % 4); long row = i / 128;
        kcm[(size_t)row * 384 + h * 96 + 64 + e] = f2bf(p.in[I_CKR][(size_t)row * 32 + e]);
    }
}

DEV const float* x_row(const P& p, int l, int r) {
    if (l == 0) return r < NCTX ? p.in[I_XP] + (size_t)r * DM : p.in[I_XS] + (size_t)(r - NCTX) * DM;
    return WSP(float, WS_X) + (size_t)r * DM;
}

DEV void nv_normmod(const P& p, int l, long gtid, long gsz) {
    bf16_t* H = WSP(bf16_t, WS_H);
    const float* g = p.in[I_NG] + (size_t)l * DM;
    for (long r = gtid; r < NTOK; r += gsz) {
        const float* x = x_row(p, l, (int)r);
        const float* mv = WSP(float, WS_MODV) + ((size_t)l * NCB + row_cb((int)r)) * 3072;
        float ss = 0.f;
        for (int k = 0; k < DM; ++k) ss += x[k] * x[k];
        float rstd = 1.f / sqrtf(ss / DM + 1e-6f);
        for (int k = 0; k < DM; ++k) H[(size_t)r * DM + k] = f2bf(x[k] * rstd * g[k] * (1.f + mv[1024 + k]) + mv[k]);
    }
}

template <class Epi>
DEV void nv_gemm(const bf16_t* A, int lda, const bf16_t* Wt, int ldw, int M, int N, int K, long gtid, long gsz, Epi epi) {
    const long nItems = (long)(M / 4) * (N / 4);
    for (long it = gtid; it < nItems; it += gsz) {
        const int cb = (int)(it % (N / 4)), rb = (int)(it / (N / 4));
        float acc[4][4];
#pragma unroll
        for (int i = 0; i < 4; ++i)
#pragma unroll
            for (int j = 0; j < 4; ++j) acc[i][j] = 0.f;
        for (int k = 0; k < K; k += 8) {
            float a[4][8], w[4][8];
#pragma unroll
            for (int i = 0; i < 4; ++i) unpack8(A + (size_t)(rb * 4 + i) * lda + k, a[i]);
#pragma unroll
            for (int j = 0; j < 4; ++j) unpack8(Wt + (size_t)(cb * 4 + j) * ldw + k, w[j]);
#pragma unroll
            for (int i = 0; i < 4; ++i)
#pragma unroll
                for (int j = 0; j < 4; ++j)
#pragma unroll
                    for (int e = 0; e < 8; ++e) acc[i][j] += a[i][e] * w[j][e];
        }
#pragma unroll
        for (int i = 0; i < 4; ++i)
#pragma unroll
            for (int j = 0; j < 4; ++j) epi(rb * 4 + i, cb * 4 + j, acc[i][j]);
    }
}

DEV void nv_inproj(const P& p, int l, long gtid, long gsz) {
    bf16_t* cols = WSP(bf16_t, WS_COLS);
    float* out = p.out;
    nv_gemm(WSP(bf16_t, WS_H), DM, WSP(bf16_t, WS_WTIN) + (size_t)l * NC * DM, DM, NTOK, NC, DM, gtid, gsz,
        [=](int r, int n, float v) {
            cols[(size_t)r * NC + n] = f2bf(v);
            if (r < NCTX) {
                const int b = r / SEQ, t = r % SEQ; const size_t bl = ((size_t)b * DEPTH + l) * SEQ + t;
                if (n >= C_NAK && n < C_NAK + 256) out[O_NAK + bl * 256 + (n - C_NAK)] = v;
                else if (n >= C_NAV && n < C_NAV + 256) out[O_NAV + bl * 256 + (n - C_NAV)] = v;
                else if (n >= C_WK && n < C_WK + 128) out[O_WK + bl * 128 + (n - C_WK)] = v;
                else if (n >= C_WV && n < C_WV + 128) out[O_WV + bl * 128 + (n - C_WV)] = v;
            }
        });
}

DEV void nv_rowprep(const P& p, int l, long gtid, long gsz) {
    const bf16_t* cols = WSP(bf16_t, WS_COLS);
    for (long r = gtid; r < NTOK; r += gsz) {
        const bf16_t* c = cols + (size_t)r * NC;
        const bool lat = r >= NCTX; const int t = lat ? (int)((r - NCTX) % DSEQ) : 0;
        {
            float ss = 0.f;
            for (int j = 0; j < 128; ++j) { float v = bf2f(c[C_CKV + j]); ss += v * v; }
            float rstd = 1.f / sqrtf(ss / 128.f + 1e-6f);
            const float* g = p.in[I_KVG] + (size_t)l * 128;
            for (int j = 0; j < 128; ++j) {
                float v = bf2f(c[C_CKV + j]) * rstd * g[j];
                WSP(bf16_t, WS_CKVB)[(size_t)r * 128 + j] = f2bf(v);
                if (!lat) p.out[O_CKV + (((size_t)(r / SEQ) * DEPTH + l) * SEQ + (r % SEQ)) * 128 + j] = v;
            }
        }
        {
            const float* rm = WSP(float, WS_ROPEM) + (size_t)t * 32;
            for (int j = 0; j < 16; ++j) {
                float x1 = bf2f(c[C_KR + j]), x2 = bf2f(c[C_KR + 16 + j]);
                float o1 = x1, o2 = x2;
                if (lat) { float cs = rm[j * 2], sn = rm[j * 2 + 1]; o1 = x1 * cs - x2 * sn; o2 = x1 * sn + x2 * cs; }
                else {
                    size_t o = O_KR + (((size_t)(r / SEQ) * DEPTH + l) * SEQ + (r % SEQ)) * 32;
                    p.out[o + j] = x1; p.out[o + 16 + j] = x2;
                }
                for (int h = 0; h < 4; ++h) {
                    WSP(bf16_t, WS_KMLA)[(size_t)r * 384 + h * 96 + 64 + j] = f2bf(o1);
                    WSP(bf16_t, WS_KMLA)[(size_t)r * 384 + h * 96 + 80 + j] = f2bf(o2);
                }
            }
        }
        {
            float ss = 0.f;
            for (int j = 0; j < 256; ++j) { float v = bf2f(c[C_MQA + j]); ss += v * v; }
            float rstd = 1.f / sqrtf(ss / 256.f + 1e-6f);
            const float* g = p.in[I_QG] + (size_t)l * 256;
            for (int j = 0; j < 256; ++j) WSP(bf16_t, WS_QN)[(size_t)r * 256 + j] = f2bf(bf2f(c[C_MQA + j]) * rstd * g[j]);
        }
        {
            const float* rw = WSP(float, WS_ROPEW) + (size_t)t * 64;
            for (int hh = 0; hh < 6; ++hh) {
                const bf16_t* src = hh < 4 ? c + C_WQ + hh * 64 : c + C_WK + (hh - 4) * 64;
                bf16_t* dst = hh < 4 ? WSP(bf16_t, WS_WQR) + (size_t)r * 256 + hh * 64 : WSP(bf16_t, WS_WKR) + (size_t)r * 128 + (hh - 4) * 64;
                for (int j = 0; j < 32; ++j) {
                    float x1 = bf2f(src[j]), x2 = bf2f(src[32 + j]);
                    if (lat) { float cs = rw[j * 2], sn = rw[j * 2 + 1]; dst[j] = f2bf(x1 * cs - x2 * sn); dst[32 + j] = f2bf(x1 * sn + x2 * cs); }
                    else { dst[j] = src[j]; dst[32 + j] = src[32 + j]; }
                }
            }
        }
    }
}

DEV void nv_mlaproj(const P& p, int l, long gtid, long gsz) {
    bf16_t* qm = WSP(bf16_t, WS_QMLA); bf16_t* km = WSP(bf16_t, WS_KMLA); bf16_t* vm = WSP(bf16_t, WS_VMLA);
    nv_gemm(WSP(bf16_t, WS_QN), 256, WSP(bf16_t, WS_WTQB) + (size_t)l * 512 * 256, 256, NTOK, 384, 256, gtid, gsz,
        [=](int r, int n, float v) { qm[(size_t)r * 384 + n] = f2bf(v); });
    nv_gemm(WSP(bf16_t, WS_CKVB), 128, WSP(bf16_t, WS_WTKVB) + (size_t)l * 512 * 128, 128, NTOK, 512, 128, gtid, gsz,
        [=](int r, int n, float v) {
            int h = n / 128, e = n % 128;
            if (e < 64) km[(size_t)r * 384 + h * 96 + e] = f2bf(v); else vm[(size_t)r * 256 + h * 64 + (e - 64)] = f2bf(v);
        });
}

struct SoftAcc { float m, l; float o[64]; };
DEV void sa_init(SoftAcc& s) { s.m = -3e38f; s.l = 0.f;
#pragma unroll
    for (int d = 0; d < 64; ++d) s.o[d] = 0.f; }
DEV void sa_add(SoftAcc& s, float sc, const bf16_t* v) {
    float mn = fmaxf(s.m, sc);
    float corr = expf(s.m - mn), pe = expf(sc - mn);
    s.m = mn; s.l = s.l * corr + pe;
#pragma unroll
    for (int d8 = 0; d8 < 8; ++d8) {
        float f[8]; unpack8(v + d8 * 8, f);
#pragma unroll
        for (int e = 0; e < 8; ++e) s.o[d8 * 8 + e] = s.o[d8 * 8 + e] * corr + pe * f[e];
    }
}
DEV void sa_add_f32v(SoftAcc& s, float sc, const float* v) {
    float mn = fmaxf(s.m, sc);
    float corr = expf(s.m - mn), pe = expf(sc - mn);
    s.m = mn; s.l = s.l * corr + pe;
#pragma unroll
    for (int d = 0; d < 64; ++d) s.o[d] = s.o[d] * corr + pe * rbf(v[d]);
}
template <int DQ> DEV float dot_bf(const float* q, const bf16_t* k) {
    float acc = 0.f;
#pragma unroll
    for (int d8 = 0; d8 < DQ / 8; ++d8) {
        float f[8]; unpack8(k + d8 * 8, f);
#pragma unroll
        for (int e = 0; e < 8; ++e) acc += q[d8 * 8 + e] * f[e];
    }
    return acc;
}
DEV float dot64_f32k(const float* q, const float* k) {
    float acc = 0.f;
#pragma unroll
    for (int d = 0; d < 64; ++d) acc += q[d] * rbf(k[d]);
    return acc;
}
DEV void sa_store(const P& p, const SoftAcc& s, float extra_den, int r, int branch, int h, int zcol) {
    const bf16_t* c = WSP(bf16_t, WS_COLS) + (size_t)r * NC + zcol + h * 64;
    bf16_t* y = WSP(bf16_t, WS_Y) + (size_t)r * DM + branch * 256 + h * 64;
    float inv = 1.f / (s.l + extra_den);
#pragma unroll
    for (int d = 0; d < 64; ++d) y[d] = f2bf(s.o[d] * inv * siluf(bf2f(c[d])));
}

DEV void nv_attn(const P& p, int l, long gtid, long gsz) {
    const bf16_t* cols = WSP(bf16_t, WS_COLS);
    for (long it = gtid; it < (long)NTOK * 12; it += gsz) {
        const int kind = (int)(it % 3); const int h = (int)((it / 3) % 4); const int r = (int)(it / 12);
        const bool lat = r >= NCTX;
        const int b = lat ? (r - NCTX) / DSEQ : r / SEQ, t = lat ? (r - NCTX) % DSEQ : r % SEQ;
        const int seq0 = lat ? NCTX + b * DSEQ : b * SEQ;
        SoftAcc s; sa_init(s);
        if (kind == 0) {
            float q[64];
#pragma unroll
            for (int d8 = 0; d8 < 8; ++d8) unpack8(cols + (size_t)r * NC + C_NAQ + h * 64 + d8 * 8, q + d8 * 8);
            if (!lat) {
                for (int j = 0; j < SEQ; ++j) {
                    const bf16_t* kr = cols + (size_t)(seq0 + j) * NC;
                    sa_add(s, dot_bf<64>(q, kr + C_NAK + h * 64) * 0.125f, kr + C_NAV + h * 64);
                }
            } else {
                const int gi = t / GW, gj = t % GW;
                int rs = gi - 4; rs = rs < 0 ? 0 : (rs > GROWS - 8 ? GROWS - 8 : rs);
                int cs = gj - 8; cs = cs < 0 ? 0 : (cs > GW - 16 ? GW - 16 : cs);
                const float* rpb = p.in[I_RPB] + ((size_t)l * 4 + h) * 15 * 31;
                for (int kr_ = rs; kr_ < rs + 8; ++kr_)
                    for (int kc = cs; kc < cs + 16; ++kc) {
                        const bf16_t* kk = cols + (size_t)(seq0 + kr_ * GW + kc) * NC;
                        int dc = kc - gj + 15; dc = dc < 0 ? 0 : (dc > 30 ? 30 : dc);
                        float bias = rpb[(kr_ - gi + 7) * 31 + dc];
                        sa_add(s, dot_bf<64>(q, kk + C_NAK + h * 64) * 0.125f + bias, kk + C_NAV + h * 64);
                    }
                const float* ck = p.in[I_CNAK] + ((size_t)b * DEPTH + l) * PAST * 256 + h * 64;
                const float* cv = p.in[I_CNAV] + ((size_t)b * DEPTH + l) * PAST * 256 + h * 64;
                for (int j = 0; j < PAST; ++j) sa_add_f32v(s, dot64_f32k(q, ck + (size_t)j * 256) * 0.125f, cv + (size_t)j * 256);
            }
            sa_store(p, s, 0.f, r, 0, h, C_NAZ);
        } else if (kind == 1) {
            float q[96];
            const bf16_t* qp = WSP(bf16_t, WS_QMLA) + (size_t)r * 384 + h * 96;
#pragma unroll
            for (int d8 = 0; d8 < 12; ++d8) unpack8(qp + d8 * 8, q + d8 * 8);
            if (lat) {
                const float* rm = WSP(float, WS_ROPEM) + (size_t)t * 32;
#pragma unroll
                for (int j = 0; j < 16; ++j) {
                    float x1 = q[64 + j], x2 = q[80 + j], cs = rm[j * 2], sn = rm[j * 2 + 1];
                    q[64 + j] = rbf(x1 * cs - x2 * sn); q[80 + j] = rbf(x1 * sn + x2 * cs);
                }
            }
            const float scale = 0.10206207261596577f;
            const int n = lat ? DSEQ : SEQ;
            const bf16_t* km = WSP(bf16_t, WS_KMLA) + (size_t)seq0 * 384 + h * 96;
            const bf16_t* vm = WSP(bf16_t, WS_VMLA) + (size_t)seq0 * 256 + h * 64;
            for (int j = 0; j < n; ++j) sa_add(s, dot_bf<96>(q, km + (size_t)j * 384) * scale, vm + (size_t)j * 256);
            if (lat) {
                const bf16_t* kc = WSP(bf16_t, WS_KCM) + ((size_t)b * DEPTH + l) * PAST * 384 + h * 96;
                const bf16_t* vc = WSP(bf16_t, WS_VCM) + ((size_t)b * DEPTH + l) * PAST * 256 + h * 64;
                for (int j = 0; j < PAST; ++j) sa_add(s, dot_bf<96>(q, kc + (size_t)j * 384) * scale, vc + (size_t)j * 256);
            }
            sa_store(p, s, 0.f, r, 2, h, C_MZ);
        } else {
            float q[64];
#pragma unroll
            for (int d8 = 0; d8 < 8; ++d8) unpack8(WSP(bf16_t, WS_WQR) + (size_t)r * 256 + h * 64 + d8 * 8, q + d8 * 8);
            const int kh = h / 2;
            const float sink = p.in[I_SINK][l * 4 + h];
            int j0 = 0, j1 = SEQ;
            if (lat) { j0 = t - 128 < 0 ? 0 : t - 128; j1 = t + 129 > DSEQ ? DSEQ : t + 129; }
            for (int j = j0; j < j1; ++j)
                sa_add(s, dot_bf<64>(q, WSP(bf16_t, WS_WKR) + (size_t)(seq0 + j) * 128 + kh * 64) * 0.125f, cols + (size_t)(seq0 + j) * NC + C_WV + kh * 64);
            if (lat) {
                const float* ck = p.in[I_CWK] + ((size_t)b * DEPTH + l) * PAST * 128 + kh * 64;
                const float* cv = p.in[I_CWV] + ((size_t)b * DEPTH + l) * PAST * 128 + kh * 64;
                for (int j = 0; j < PAST; ++j) sa_add_f32v(s, dot64_f32k(q, ck + (size_t)j * 128) * 0.125f, cv + (size_t)j * 128);
            }
            float mn = fmaxf(s.m, sink); float corr = expf(s.m - mn);
            s.l *= corr;
#pragma unroll
            for (int d = 0; d < 64; ++d) s.o[d] *= corr;
            s.m = mn;
            sa_store(p, s, expf(sink - mn), r, 3, h, C_WZ);
        }
    }
}

DEV void nv_hgrn(const P& p, int l, long gtid, long gsz) {
    const bf16_t* cols = WSP(bf16_t, WS_COLS);
    float* oh = WSP(float, WS_OH);
    const int NSEQ = BATCH + DB;
    for (long it = gtid; it < (long)NSEQ * 4 * 2 * 64; it += gsz) {
        const int j = (int)(it % 64); const int dir = (int)((it / 64) % 2); const int h = (int)((it / 128) % 4); const int sq = (int)(it / 512);
        const bool lat = sq >= BATCH;
        const int b = lat ? sq - BATCH : sq;
        const int T = lat ? DSEQ : SEQ; const int seq0 = lat ? NCTX + b * DSEQ : b * SEQ;
        const float* lb = WSP(float, WS_LBS) + ((size_t)l * 2 + dir) * 256 + h * 64;
        float S[64];
        if (lat) {
            const float* st = p.in[I_ST] + ((((size_t)b * DEPTH + l) * 2 + dir) * 4 + h) * 4096;
#pragma unroll
            for (int d = 0; d < 64; ++d) S[d] = st[d * 64 + j];
        } else {
#pragma unroll
            for (int d = 0; d < 64; ++d) S[d] = 0.f;
        }
        const int fcol = dir == 0 ? C_HGFF : C_HGFB;
        for (int tt = 0; tt < T; ++tt) {
            const int t = dir == 0 ? tt : T - 1 - tt;
            const bf16_t* c = cols + (size_t)(seq0 + t) * NC;
            const float v = bf2f(c[C_HGI + h * 64 + j]);
            float o = 0.f;
#pragma unroll
            for (int d8 = 0; d8 < 8; ++d8) {
                float fz[8], qq[8]; unpack8(c + fcol + h * 64 + d8 * 8, fz); unpack8(c + C_HGQ + h * 64 + d8 * 8, qq);
#pragma unroll
                for (int e = 0; e < 8; ++e) {
                    const int d = d8 * 8 + e;
                    const float lbv = lb[d];
                    float f = lbv + (1.f - lbv) * sigm(fz[e]);
                    f = fmaxf(f, 1e-30f);
                    const float k = (1.f - lbv) * sigm(-fz[e]);
                    S[d] = f * S[d] + k * v;
                    o += S[d] * siluf(qq[e]);
                }
            }
            oh[((size_t)dir * NTOK + seq0 + t) * 256 + h * 64 + j] = o;
        }
        if (!lat) {
            float* so = p.out + O_ST + ((((size_t)b * DEPTH + l) * 2 + dir) * 4 + h) * 4096;
#pragma unroll
            for (int d = 0; d < 64; ++d) so[d * 64 + j] = S[d];
        }
    }
}

DEV void nv_hgrn_fin(const P& p, int l, long gtid, long gsz) {
    const bf16_t* cols = WSP(bf16_t, WS_COLS);
    const float* oh = WSP(float, WS_OH);
    const float* g = p.in[I_HGG] + (size_t)l * 64;
    for (long it = gtid; it < (long)NTOK * 4; it += gsz) {
        const int h = (int)(it % 4); const int r = (int)(it / 4);
        const float* of = oh + (size_t)r * 256 + h * 64; const float* ob = oh + ((size_t)NTOK + r) * 256 + h * 64;
        float ss = 0.f;
        for (int d = 0; d < 64; ++d) { float v = of[d] + ob[d]; ss += v * v; }
        float rstd = 1.f / sqrtf(ss / 64.f + 1e-6f);
        const bf16_t* c = cols + (size_t)r * NC;
        bf16_t* y = WSP(bf16_t, WS_Y) + (size_t)r * DM + 256 + h * 64;
        for (int d = 0; d < 64; ++d) {
            float v = (of[d] + ob[d]) * rstd * g[d] * sigm(bf2f(c[C_HGOG + h * 64 + d]));
            y[d] = f2bf(v * siluf(bf2f(c[C_HGZ + h * 64 + d])));
        }
    }
}

DEV void nv_merge(const P& p, int l, long gtid, long gsz) {
    const bf16_t* cols = WSP(bf16_t, WS_COLS);
    const bf16_t* Y = WSP(bf16_t, WS_Y);
    const bf16_t* wt = WSP(bf16_t, WS_WTBR) + (size_t)l * 4 * DM * 256;
    bf16_t* mrg = WSP(bf16_t, WS_MRG);
    for (long it = gtid; it < (long)NTOK * DM; it += gsz) {
        const int d = (int)(it % DM); const int r = (int)(it / DM);
        float tot = 0.f;
        for (int b = 0; b < 4; ++b) {
            const bf16_t* y = Y + (size_t)r * DM + b * 256; const bf16_t* w = wt + ((size_t)b * DM + d) * 256;
            float acc = 0.f;
            for (int k = 0; k < 256; k += 8) {
                float a[8], ww[8]; unpack8(y + k, a); unpack8(w + k, ww);
#pragma unroll
                for (int e = 0; e < 8; ++e) acc += a[e] * ww[e];
            }
            tot += sigm(bf2f(cols[(size_t)r * NC + C_MG + b * DM + d])) * acc;
        }
        mrg[it] = f2bf(tot);
    }
}

DEV void nv_out(const P& p, int l, long gtid, long gsz) {
    float* X = WSP(float, WS_X);
    const float* modv = WSP(float, WS_MODV);
    const P pp = p;
    nv_gemm(WSP(bf16_t, WS_MRG), DM, WSP(bf16_t, WS_WTOUT) + (size_t)l * DM * DM, DM, NTOK, DM, DM, gtid, gsz,
        [=](int r, int n, float v) {
            const float gate = modv[((size_t)l * NCB + row_cb(r)) * 3072 + 2048 + n];
            X[(size_t)r * DM + n] = x_row(pp, l, r)[n] + gate * v;
        });
}

DEV void nv_final(const P& p, long gtid, long gsz) {
    const float* X = WSP(float, WS_X); const float* g = p.in[I_FG];
    for (long r = gtid; r < NTOK; r += gsz) {
        const float* x = X + (size_t)r * DM;
        float ss = 0.f;
        for (int k = 0; k < DM; ++k) ss += x[k] * x[k];
        float rstd = 1.f / sqrtf(ss / DM + 1e-6f);
        for (int k = 0; k < DM; ++k) p.out[O_Y + (size_t)r * DM + k] = x[k] * rstd * g[k];
    }
}

constexpr int ST_PREP_W = 0, ST_PREP_CTX = 1, ST_LAYER0 = 2, ST_PER_LAYER = 8;
constexpr int N_STAGES = ST_LAYER0 + DEPTH * ST_PER_LAYER + 1;
DEV void run_stage(const P& p, int st, long gtid, long gsz) {
    if (st == ST_PREP_W) { nv_prep_w(p, gtid, gsz); return; }
    if (st == ST_PREP_CTX) { nv_prep_ctxmla(p, gtid, gsz); return; }
    if (st == N_STAGES - 1) { nv_final(p, gtid, gsz); return; }
    const int l = (st - ST_LAYER0) / ST_PER_LAYER, s = (st - ST_LAYER0) % ST_PER_LAYER;
    switch (s) {
        case 0: nv_normmod(p, l, gtid, gsz); break;
        case 1: nv_inproj(p, l, gtid, gsz); break;
        case 2: nv_rowprep(p, l, gtid, gsz); break;
        case 3: nv_mlaproj(p, l, gtid, gsz); break;
        case 4: nv_attn(p, l, gtid, gsz); nv_hgrn(p, l, gtid, gsz); break;
        case 5: nv_hgrn_fin(p, l, gtid, gsz); break;
        case 6: nv_merge(p, l, gtid, gsz); break;
        case 7: nv_out(p, l, gtid, gsz); break;
    }
}

#ifndef CPU_EMU
__global__ void __launch_bounds__(256) stage_kernel(P p, int st) {
    run_stage(p, st, (long)blockIdx.x * blockDim.x + threadIdx.x, (long)gridDim.x * blockDim.x);
}

extern "C" void kernel_launch(void* const* d_in, const int* in_sizes, int n_in, void* d_out, int out_size, void* d_ws, size_t ws_size, hipStream_t stream) {
    if (n_in != N_IN || (size_t)out_size != O_END || ws_size < WS_END) {
        fprintf(stderr, "kernel_launch: unexpected sizes n_in %d out %d ws %zu (need %zu)\n", n_in, out_size, ws_size, (size_t)WS_END);
        return;
    }
    P p{};
    for (int i = 0; i < N_IN; ++i) p.in[i] = (const float*)d_in[i];
    p.out = (float*)d_out; p.ws = (unsigned char*)d_ws;
    for (int st = 0; st < N_STAGES; ++st) stage_kernel<<<2048, 256, 0, stream>>>(p, st);
}
#endif
```

```cpp
#ifndef CPU_EMU
#include <hip/hip_runtime.h>
#include <hip/hip_cooperative_groups.h>
#include <cstdio>
#define DEV __device__ __forceinline__
#else
#include <cmath>
#include <cstdio>
#include <cstring>
#define DEV inline
#endif
#include <cstdint>
#include <cstddef>

#ifndef CFG_BATCH
#define CFG_BATCH 16
#endif
#ifndef CFG_DEPTH
#define CFG_DEPTH 4
#endif
#ifndef CFG_DEC_BATCH
#define CFG_DEC_BATCH 4
#endif
constexpr int DM = 1024, BATCH = CFG_BATCH, SEQ = 256, DEPTH = CFG_DEPTH, DB = CFG_DEC_BATCH, DSEQ = 2048, PAST = 512;
constexpr int NCTX = BATCH * SEQ, NLAT = DB * DSEQ, NTOK = NCTX + NLAT;
constexpr int NCB = 1 + DB;
constexpr int INW = 8096, NC = 8192;
constexpr int GW = 64, GROWS = DSEQ / GW;
constexpr int C_NAQ = 0, C_NAK = 256, C_NAV = 512, C_NAZ = 768, C_HGQ = 1024, C_HGFF = 1280, C_HGFB = 1536, C_HGI = 1792, C_HGOG = 2048, C_HGZ = 2304,
              C_MQA = 2560, C_CKV = 2816, C_MZ = 2944, C_WQ = 3200, C_WK = 3456, C_WV = 3584, C_WZ = 3712, C_KR = 3968, C_PAD = 4000, C_MG = 4096;
DEV int orig_col(int c) {
    if (c < 2944) return c;
    if (c < 3968) return c + 32;
    if (c < 4000) return 2944 + (c - 3968);
    if (c < 4096) return -1;
    return c - 96;
}
enum { I_XP = 0, I_XS, I_CNAK, I_CNAV, I_ST, I_CCKV, I_CKR, I_CWK, I_CWV, I_C, I_CCTX, I_NG, I_WMOD, I_BMOD, I_WIN, I_RPB, I_LB, I_HGG, I_QG, I_KVG, I_WQB, I_WKVB, I_SINK, I_WBR, I_WOUT, I_FG, N_IN };
constexpr size_t O_Y = 0;
constexpr size_t O_NAK = (size_t)NTOK * DM;
constexpr size_t O_NAV = O_NAK + (size_t)BATCH * DEPTH * SEQ * 256;
constexpr size_t O_ST = O_NAV + (size_t)BATCH * DEPTH * SEQ * 256;
constexpr size_t O_CKV = O_ST + (size_t)BATCH * DEPTH * 2 * 4 * 64 * 64;
constexpr size_t O_KR = O_CKV + (size_t)BATCH * DEPTH * SEQ * 128;
constexpr size_t O_WK = O_KR + (size_t)BATCH * DEPTH * SEQ * 32;
constexpr size_t O_WV = O_WK + (size_t)BATCH * DEPTH * SEQ * 128;
constexpr size_t O_END = O_WV + (size_t)BATCH * DEPTH * SEQ * 128;

typedef unsigned short bf16_t;
constexpr size_t al256(size_t x) { return (x + 255) & ~(size_t)255; }
constexpr size_t WS_CTL = 0;
constexpr size_t WS_WTIN = 1u << 20;
constexpr size_t WS_WTBR = WS_WTIN + (size_t)DEPTH * NC * DM * 2;
constexpr size_t WS_WTOUT = WS_WTBR + (size_t)DEPTH * 4 * DM * 256 * 2;
constexpr size_t WS_WTQB = WS_WTOUT + (size_t)DEPTH * DM * DM * 2;
constexpr size_t WS_WTKVB = WS_WTQB + (size_t)DEPTH * 512 * 256 * 2;
constexpr size_t WS_MODV = WS_WTKVB + (size_t)DEPTH * 512 * 128 * 2;
constexpr size_t WS_LBS = al256(WS_MODV + (size_t)DEPTH * NCB * 3072 * 4);
constexpr size_t WS_ROPEM = al256(WS_LBS + (size_t)DEPTH * 2 * 256 * 4);
constexpr size_t WS_ROPEW = al256(WS_ROPEM + (size_t)DSEQ * 16 * 2 * 4);
constexpr size_t WS_X = al256(WS_ROPEW + (size_t)DSEQ * 32 * 2 * 4);
constexpr size_t WS_H = WS_X + (size_t)NTOK * DM * 4;
constexpr size_t WS_COLS = WS_H + (size_t)NTOK * DM * 2;
constexpr size_t WS_QN = WS_COLS + (size_t)NTOK * NC * 2;
constexpr size_t WS_CKVB = WS_QN + (size_t)NTOK * 256 * 2;
constexpr size_t WS_QMLA = WS_CKVB + (size_t)NTOK * 128 * 2;
constexpr size_t WS_KMLA = WS_QMLA + (size_t)NTOK * 384 * 2;
constexpr size_t WS_VMLA = WS_KMLA + (size_t)NTOK * 384 * 2;
constexpr size_t WS_KCM = WS_VMLA + (size_t)NTOK * 256 * 2;
constexpr size_t WS_VCM = WS_KCM + (size_t)DB * DEPTH * PAST * 384 * 2;
constexpr size_t WS_WQR = WS_VCM + (size_t)DB * DEPTH * PAST * 256 * 2;
constexpr size_t WS_WKR = WS_WQR + (size_t)NTOK * 256 * 2;
constexpr size_t WS_Y = WS_WKR + (size_t)NTOK * 128 * 2;
constexpr size_t WS_MRG = WS_Y + (size_t)NTOK * DM * 2;
constexpr size_t WS_OH = WS_MRG + (size_t)NTOK * DM * 2;
constexpr size_t WS_END = WS_OH + (size_t)2 * NTOK * 256 * 4;

struct P {
    const float* in[N_IN];
    float* out;
    unsigned char* ws;
};

DEV unsigned f2u(float f) { unsigned u; memcpy(&u, &f, 4); return u; }
DEV float u2f(unsigned u) { float f; memcpy(&f, &u, 4); return f; }
DEV bf16_t f2bf(float f) { unsigned u = f2u(f); return (bf16_t)((u + 0x7fffu + ((u >> 16) & 1u)) >> 16); }
DEV float bf2f(bf16_t b) { return u2f((unsigned)b << 16); }
DEV float rbf(float f) { return bf2f(f2bf(f)); }
DEV float sigm(float x) { return 1.f / (1.f + expf(-x)); }
DEV float siluf(float x) { return x * sigm(x); }
DEV int row_cb(int r) { return r < NCTX ? 0 : 1 + (r - NCTX) / DSEQ; }

struct U4 { unsigned x, y, z, w; };
DEV void unpack8(const bf16_t* p, float* f) {
    U4 v = *(const U4*)p;
    f[0] = u2f(v.x << 16); f[1] = u2f(v.x & 0xffff0000u); f[2] = u2f(v.y << 16); f[3] = u2f(v.y & 0xffff0000u);
    f[4] = u2f(v.z << 16); f[5] = u2f(v.z & 0xffff0000u); f[6] = u2f(v.w << 16); f[7] = u2f(v.w & 0xffff0000u);
}

#define WSP(T, off) ((T*)(p.ws + (off)))

DEV void nv_prep_w(const P& p, long gtid, long gsz) {
    bf16_t* wtin = WSP(bf16_t, WS_WTIN);
    const float* win = p.in[I_WIN];
    for (long i = gtid; i < (long)DEPTH * NC * DM; i += gsz) {
        int k = (int)(i % DM); long t = i / DM; int n = (int)(t % NC); int l = (int)(t / NC);
        int oc = orig_col(n);
        wtin[i] = oc < 0 ? (bf16_t)0 : f2bf(win[((size_t)l * DM + k) * INW + oc]);
    }
    bf16_t* wtbr = WSP(bf16_t, WS_WTBR);
    const float* wbr = p.in[I_WBR];
    for (long i = gtid; i < (long)DEPTH * 4 * DM * 256; i += gsz) {
        int w = (int)(i % 256); long t = i / 256; int d = (int)(t % DM); t /= DM; int b = (int)(t % 4); int l = (int)(t / 4);
        wtbr[i] = f2bf(wbr[(((size_t)l * 4 + b) * 256 + w) * DM + d]);
    }
    bf16_t* wtout = WSP(bf16_t, WS_WTOUT);
    const float* wout = p.in[I_WOUT];
    for (long i = gtid; i < (long)DEPTH * DM * DM; i += gsz) {
        int k = (int)(i % DM); long t = i / DM; int n = (int)(t % DM); int l = (int)(t / DM);
        wtout[i] = f2bf(wout[((size_t)l * DM + k) * DM + n]);
    }
    bf16_t* wtqb = WSP(bf16_t, WS_WTQB);
    const float* wqb = p.in[I_WQB];
    for (long i = gtid; i < (long)DEPTH * 512 * 256; i += gsz) {
        int k = (int)(i % 256); long t = i / 256; int n = (int)(t % 512); int l = (int)(t / 512);
        wtqb[i] = n < 384 ? f2bf(wqb[((size_t)l * 256 + k) * 384 + n]) : (bf16_t)0;
    }
    bf16_t* wtkvb = WSP(bf16_t, WS_WTKVB);
    const float* wkvb = p.in[I_WKVB];
    for (long i = gtid; i < (long)DEPTH * 512 * 128; i += gsz) {
        int k = (int)(i % 128); long t = i / 128; int n = (int)(t % 512); int l = (int)(t / 512);
        wtkvb[i] = f2bf(wkvb[((size_t)l * 128 + k) * 512 + n]);
    }
    float* modv = WSP(float, WS_MODV);
    for (long i = gtid; i < (long)DEPTH * NCB * 3072; i += gsz) {
        int j = (int)(i % 3072); long t = i / 3072; int cb = (int)(t % NCB); int l = (int)(t / NCB);
        const float* cv = cb == 0 ? p.in[I_CCTX] : p.in[I_C] + (size_t)(cb - 1) * DM;
        const float* w = p.in[I_WMOD] + (size_t)l * DM * 3072 + j;
        float acc = 0.f;
        for (int k = 0; k < DM; ++k) acc += siluf(cv[k]) * w[(size_t)k * 3072];
        modv[i] = acc + p.in[I_BMOD][(size_t)l * 3072 + j];
    }
    float* lbs = WSP(float, WS_LBS);
    for (long i = gtid; i < 2 * 256; i += gsz) {
        const float* lg = p.in[I_LB];
        float mx = -1e30f;
        for (int l = 0; l < DEPTH; ++l) mx = fmaxf(mx, lg[(size_t)l * 512 + i]);
        float s = 0.f;
        for (int l = 0; l < DEPTH; ++l) s += expf(lg[(size_t)l * 512 + i] - mx);
        float cum = 0.f, p0 = expf(lg[i] - mx) / s;
        for (int l = 0; l < DEPTH; ++l) { cum += expf(lg[(size_t)l * 512 + i] - mx) / s; lbs[(size_t)l * 512 + i] = cum - p0; }
    }
    float* rm = WSP(float, WS_ROPEM);
    for (long i = gtid; i < (long)DSEQ * 16; i += gsz) {
        int j = (int)(i % 16), t = (int)(i / 16);
        float pos = j < 8 ? (float)(t / GW) : (float)(t % GW);
        float inv = powf(10000.f, -(float)(j & 7) / 8.f);
        float a = pos * inv; rm[i * 2] = cosf(a); rm[i * 2 + 1] = sinf(a);
    }
    float* rw = WSP(float, WS_ROPEW);
    for (long i = gtid; i < (long)DSEQ * 32; i += gsz) {
        int j = (int)(i % 32), t = (int)(i / 32);
        float pos = j < 16 ? (float)(t / GW) : (float)(t % GW);
        float inv = powf(10000.f, -(float)(j & 15) / 16.f);
        float a = pos * inv; rw[i * 2] = cosf(a); rw[i * 2 + 1] = sinf(a);
    }
}

DEV void nv_prep_ctxmla(const P& p, long gtid, long gsz) {
    const bf16_t* wtkvb = WSP(bf16_t, WS_WTKVB);
    bf16_t* kcm = WSP(bf16_t, WS_KCM); bf16_t* vcm = WSP(bf16_t, WS_VCM);
    for (long i = gtid; i < (long)DB * DEPTH * PAST * 512; i += gsz) {
        int n = (int)(i % 512); long row = i / 512;
        int l = (int)((row / PAST) % DEPTH);
        const float* ck = p.in[I_CCKV] + (size_t)row * 128;
        const bf16_t* w = wtkvb + ((size_t)l * 512 + n) * 128;
        float acc = 0.f;
        for (int j = 0; j < 128; ++j) acc += rbf(ck[j]) * bf2f(w[j]);
        int h = n / 128, e = n % 128;
        if (e < 64) kcm[(size_t)row * 384 + h * 96 + e] = f2bf(acc);
        else vcm[(size_t)row * 256 + h * 64 + (e - 64)] = f2bf(acc);
    }
    for (long i = gtid; i < (long)DB * DEPTH * PAST * 128; i += gsz) {
        int e = (int)(i % 32); int h = (int)((i / 32) % 4); long row = i / 128;
        kcm[(size_t)row * 384 + h * 96 + 64 + e] = f2bf(p.in[I_CKR][(size_t)row * 32 + e]);
    }
}

DEV const float* x_row(const P& p, int l, int r) {
    if (l == 0) return r < NCTX ? p.in[I_XP] + (size_t)r * DM : p.in[I_XS] + (size_t)(r - NCTX) * DM;
    return WSP(float, WS_X) + (size_t)r * DM;
}

DEV void nv_normmod(const P& p, int l, long gtid, long gsz) {
    bf16_t* H = WSP(bf16_t, WS_H);
    const float* g = p.in[I_NG] + (size_t)l * DM;
    for (long r = gtid; r < NTOK; r += gsz) {
        const float* x = x_row(p, l, (int)r);
        const float* mv = WSP(float, WS_MODV) + ((size_t)l * NCB + row_cb((int)r)) * 3072;
        float ss = 0.f;
        for (int k = 0; k < DM; ++k) ss += x[k] * x[k];
        float rstd = 1.f / sqrtf(ss / DM + 1e-6f);
        for (int k = 0; k < DM; ++k) H[(size_t)r * DM + k] = f2bf(x[k] * rstd * g[k] * (1.f + mv[1024 + k]) + mv[k]);
    }
}

template <class Epi>
DEV void nv_gemm(const bf16_t* A, int lda, const bf16_t* Wt, int ldw, int M, int N, int K, long gtid, long gsz, Epi epi) {
    const long nItems = (long)(M / 4) * (N / 4);
    for (long it = gtid; it < nItems; it += gsz) {
        const int cb = (int)(it % (N / 4)), rb = (int)(it / (N / 4));
        float acc[4][4];
#pragma unroll
        for (int i = 0; i < 4; ++i)
#pragma unroll
            for (int j = 0; j < 4; ++j) acc[i][j] = 0.f;
        for (int k = 0; k < K; k += 8) {
            float a[4][8], w[4][8];
#pragma unroll
            for (int i = 0; i < 4; ++i) unpack8(A + (size_t)(rb * 4 + i) * lda + k, a[i]);
#pragma unroll
            for (int j = 0; j < 4; ++j) unpack8(Wt + (size_t)(cb * 4 + j) * ldw + k, w[j]);
#pragma unroll
            for (int i = 0; i < 4; ++i)
#pragma unroll
                for (int j = 0; j < 4; ++j)
#pragma unroll
                    for (int e = 0; e < 8; ++e) acc[i][j] += a[i][e] * w[j][e];
        }
#pragma unroll
        for (int i = 0; i < 4; ++i)
#pragma unroll
            for (int j = 0; j < 4; ++j) epi(rb * 4 + i, cb * 4 + j, acc[i][j]);
    }
}

DEV void nv_inproj(const P& p, int l, long gtid, long gsz) {
    bf16_t* cols = WSP(bf16_t, WS_COLS);
    float* out = p.out;
    nv_gemm(WSP(bf16_t, WS_H), DM, WSP(bf16_t, WS_WTIN) + (size_t)l * NC * DM, DM, NTOK, NC, DM, gtid, gsz,
        [=](int r, int n, float v) {
            cols[(size_t)r * NC + n] = f2bf(v);
            if (r < NCTX) {
                const int b = r / SEQ, t = r % SEQ; const size_t bl = ((size_t)b * DEPTH + l) * SEQ + t;
                if (n >= C_NAK && n < C_NAK + 256) out[O_NAK + bl * 256 + (n - C_NAK)] = v;
                else if (n >= C_NAV && n < C_NAV + 256) out[O_NAV + bl * 256 + (n - C_NAV)] = v;
                else if (n >= C_WK && n < C_WK + 128) out[O_WK + bl * 128 + (n - C_WK)] = v;
                else if (n >= C_WV && n < C_WV + 128) out[O_WV + bl * 128 + (n - C_WV)] = v;
            }
        });
}

DEV void nv_rowprep(const P& p, int l, long gtid, long gsz) {
    const bf16_t* cols = WSP(bf16_t, WS_COLS);
    for (long r = gtid; r < NTOK; r += gsz) {
        const bf16_t* c = cols + (size_t)r * NC;
        const bool lat = r >= NCTX; const int t = lat ? (int)((r - NCTX) % DSEQ) : 0;
        {
            float ss = 0.f;
            for (int j = 0; j < 128; ++j) { float v = bf2f(c[C_CKV + j]); ss += v * v; }
            float rstd = 1.f / sqrtf(ss / 128.f + 1e-6f);
            const float* g = p.in[I_KVG] + (size_t)l * 128;
            for (int j = 0; j < 128; ++j) {
                float v = bf2f(c[C_CKV + j]) * rstd * g[j];
                WSP(bf16_t, WS_CKVB)[(size_t)r * 128 + j] = f2bf(v);
                if (!lat) p.out[O_CKV + (((size_t)(r / SEQ) * DEPTH + l) * SEQ + (r % SEQ)) * 128 + j] = v;
            }
        }
        {
            const float* rm = WSP(float, WS_ROPEM) + (size_t)t * 32;
            for (int j = 0; j < 16; ++j) {
                float x1 = bf2f(c[C_KR + j]), x2 = bf2f(c[C_KR + 16 + j]);
                float o1 = x1, o2 = x2;
                if (lat) { float cs = rm[j * 2], sn = rm[j * 2 + 1]; o1 = x1 * cs - x2 * sn; o2 = x1 * sn + x2 * cs; }
                else {
                    size_t o = O_KR + (((size_t)(r / SEQ) * DEPTH + l) * SEQ + (r % SEQ)) * 32;
                    p.out[o + j] = x1; p.out[o + 16 + j] = x2;
                }
                for (int h = 0; h < 4; ++h) {
                    WSP(bf16_t, WS_KMLA)[(size_t)r * 384 + h * 96 + 64 + j] = f2bf(o1);
                    WSP(bf16_t, WS_KMLA)[(size_t)r * 384 + h * 96 + 80 + j] = f2bf(o2);
                }
            }
        }
        {
            float ss = 0.f;
            for (int j = 0; j < 256; ++j) { float v = bf2f(c[C_MQA + j]); ss += v * v; }
            float rstd = 1.f / sqrtf(ss / 256.f + 1e-6f);
            const float* g = p.in[I_QG] + (size_t)l * 256;
            for (int j = 0; j < 256; ++j) WSP(bf16_t, WS_QN)[(size_t)r * 256 + j] = f2bf(bf2f(c[C_MQA + j]) * rstd * g[j]);
        }
        {
            const float* rw = WSP(float, WS_ROPEW) + (size_t)t * 64;
            for (int hh = 0; hh < 6; ++hh) {
                const bf16_t* src = hh < 4 ? c + C_WQ + hh * 64 : c + C_WK + (hh - 4) * 64;
                bf16_t* dst = hh < 4 ? WSP(bf16_t, WS_WQR) + (size_t)r * 256 + hh * 64 : WSP(bf16_t, WS_WKR) + (size_t)r * 128 + (hh - 4) * 64;
                for (int j = 0; j < 32; ++j) {
                    float x1 = bf2f(src[j]), x2 = bf2f(src[32 + j]);
                    if (lat) { float cs = rw[j * 2], sn = rw[j * 2 + 1]; dst[j] = f2bf(x1 * cs - x2 * sn); dst[32 + j] = f2bf(x1 * sn + x2 * cs); }
                    else { dst[j] = src[j]; dst[32 + j] = src[32 + j]; }
                }
            }
        }
    }
}

DEV void nv_mlaproj(const P& p, int l, long gtid, long gsz) {
    bf16_t* qm = WSP(bf16_t, WS_QMLA); bf16_t* km = WSP(bf16_t, WS_KMLA); bf16_t* vm = WSP(bf16_t, WS_VMLA);
    nv_gemm(WSP(bf16_t, WS_QN), 256, WSP(bf16_t, WS_WTQB) + (size_t)l * 512 * 256, 256, NTOK, 384, 256, gtid, gsz,
        [=](int r, int n, float v) { qm[(size_t)r * 384 + n] = f2bf(v); });
    nv_gemm(WSP(bf16_t, WS_CKVB), 128, WSP(bf16_t, WS_WTKVB) + (size_t)l * 512 * 128, 128, NTOK, 512, 128, gtid, gsz,
        [=](int r, int n, float v) {
            int h = n / 128, e = n % 128;
            if (e < 64) km[(size_t)r * 384 + h * 96 + e] = f2bf(v); else vm[(size_t)r * 256 + h * 64 + (e - 64)] = f2bf(v);
        });
}

struct SoftAcc { float m, l; float o[64]; };
DEV void sa_init(SoftAcc& s) { s.m = -3e38f; s.l = 0.f;
#pragma unroll
    for (int d = 0; d < 64; ++d) s.o[d] = 0.f; }
DEV void sa_add(SoftAcc& s, float sc, const bf16_t* v) {
    float mn = fmaxf(s.m, sc);
    float corr = expf(s.m - mn), pe = expf(sc - mn);
    s.m = mn; s.l = s.l * corr + pe;
#pragma unroll
    for (int d8 = 0; d8 < 8; ++d8) {
        float f[8]; unpack8(v + d8 * 8, f);
#pragma unroll
        for (int e = 0; e < 8; ++e) s.o[d8 * 8 + e] = s.o[d8 * 8 + e] * corr + pe * f[e];
    }
}
DEV void sa_add_f32v(SoftAcc& s, float sc, const float* v) {
    float mn = fmaxf(s.m, sc);
    float corr = expf(s.m - mn), pe = expf(sc - mn);
    s.m = mn; s.l = s.l * corr + pe;
#pragma unroll
    for (int d = 0; d < 64; ++d) s.o[d] = s.o[d] * corr + pe * rbf(v[d]);
}
template <int DQ> DEV float dot_bf(const float* q, const bf16_t* k) {
    float acc = 0.f;
#pragma unroll
    for (int d8 = 0; d8 < DQ / 8; ++d8) {
        float f[8]; unpack8(k + d8 * 8, f);
#pragma unroll
        for (int e = 0; e < 8; ++e) acc += q[d8 * 8 + e] * f[e];
    }
    return acc;
}
DEV float dot64_f32k(const float* q, const float* k) {
    float acc = 0.f;
#pragma unroll
    for (int d = 0; d < 64; ++d) acc += q[d] * rbf(k[d]);
    return acc;
}
DEV void sa_store(const P& p, const SoftAcc& s, float extra_den, int r, int branch, int h, int zcol) {
    const bf16_t* c = WSP(bf16_t, WS_COLS) + (size_t)r * NC + zcol + h * 64;
    bf16_t* y = WSP(bf16_t, WS_Y) + (size_t)r * DM + branch * 256 + h * 64;
    float inv = 1.f / (s.l + extra_den);
#pragma unroll
    for (int d = 0; d < 64; ++d) y[d] = f2bf(s.o[d] * inv * siluf(bf2f(c[d])));
}

DEV void nv_attn(const P& p, int l, long gtid, long gsz) {
    const bf16_t* cols = WSP(bf16_t, WS_COLS);
    for (long it = gtid; it < (long)NTOK * 12; it += gsz) {
        const int kind = (int)(it % 3); const int h = (int)((it / 3) % 4); const int r = (int)(it / 12);
        const bool lat = r >= NCTX;
        const int b = lat ? (r - NCTX) / DSEQ : r / SEQ, t = lat ? (r - NCTX) % DSEQ : r % SEQ;
        const int seq0 = lat ? NCTX + b * DSEQ : b * SEQ;
        SoftAcc s; sa_init(s);
        if (kind == 0) {
            float q[64];
#pragma unroll
            for (int d8 = 0; d8 < 8; ++d8) unpack8(cols + (size_t)r * NC + C_NAQ + h * 64 + d8 * 8, q + d8 * 8);
            if (!lat) {
                for (int j = 0; j < SEQ; ++j) {
                    const bf16_t* kr = cols + (size_t)(seq0 + j) * NC;
                    sa_add(s, dot_bf<64>(q, kr + C_NAK + h * 64) * 0.125f, kr + C_NAV + h * 64);
                }
            } else {
                const int gi = t / GW, gj = t % GW;
                int rs = gi - 4; rs = rs < 0 ? 0 : (rs > GROWS - 8 ? GROWS - 8 : rs);
                int cs = gj - 8; cs = cs < 0 ? 0 : (cs > GW - 16 ? GW - 16 : cs);
                const float* rpb = p.in[I_RPB] + ((size_t)l * 4 + h) * 15 * 31;
                for (int kr_ = rs; kr_ < rs + 8; ++kr_)
                    for (int kc = cs; kc < cs + 16; ++kc) {
                        const bf16_t* kk = cols + (size_t)(seq0 + kr_ * GW + kc) * NC;
                        int dc = kc - gj + 15; dc = dc < 0 ? 0 : (dc > 30 ? 30 : dc);
                        float bias = rpb[(kr_ - gi + 7) * 31 + dc];
                        sa_add(s, dot_bf<64>(q, kk + C_NAK + h * 64) * 0.125f + bias, kk + C_NAV + h * 64);
                    }
                const float* ck = p.in[I_CNAK] + ((size_t)b * DEPTH + l) * PAST * 256 + h * 64;
                const float* cv = p.in[I_CNAV] + ((size_t)b * DEPTH + l) * PAST * 256 + h * 64;
                for (int j = 0; j < PAST; ++j) sa_add_f32v(s, dot64_f32k(q, ck + (size_t)j * 256) * 0.125f, cv + (size_t)j * 256);
            }
            sa_store(p, s, 0.f, r, 0, h, C_NAZ);
        } else if (kind == 1) {
            float q[96];
            const bf16_t* qp = WSP(bf16_t, WS_QMLA) + (size_t)r * 384 + h * 96;
#pragma unroll
            for (int d8 = 0; d8 < 12; ++d8) unpack8(qp + d8 * 8, q + d8 * 8);
            if (lat) {
                const float* rm = WSP(float, WS_ROPEM) + (size_t)t * 32;
#pragma unroll
                for (int j = 0; j < 16; ++j) {
                    float x1 = q[64 + j], x2 = q[80 + j], cs = rm[j * 2], sn = rm[j * 2 + 1];
                    q[64 + j] = rbf(x1 * cs - x2 * sn); q[80 + j] = rbf(x1 * sn + x2 * cs);
                }
            }
            const float scale = 0.10206207261596577f;
            const int n = lat ? DSEQ : SEQ;
            const bf16_t* km = WSP(bf16_t, WS_KMLA) + (size_t)seq0 * 384 + h * 96;
            const bf16_t* vm = WSP(bf16_t, WS_VMLA) + (size_t)seq0 * 256 + h * 64;
            for (int j = 0; j < n; ++j) sa_add(s, dot_bf<96>(q, km + (size_t)j * 384) * scale, vm + (size_t)j * 256);
            if (lat) {
                const bf16_t* kc = WSP(bf16_t, WS_KCM) + ((size_t)b * DEPTH + l) * PAST * 384 + h * 96;
                const bf16_t* vc = WSP(bf16_t, WS_VCM) + ((size_t)b * DEPTH + l) * PAST * 256 + h * 64;
                for (int j = 0; j < PAST; ++j) sa_add(s, dot_bf<96>(q, kc + (size_t)j * 384) * scale, vc + (size_t)j * 256);
            }
            sa_store(p, s, 0.f, r, 2, h, C_MZ);
        } else {
            float q[64];
#pragma unroll
            for (int d8 = 0; d8 < 8; ++d8) unpack8(WSP(bf16_t, WS_WQR) + (size_t)r * 256 + h * 64 + d8 * 8, q + d8 * 8);
            const int kh = h / 2;
            const float sink = p.in[I_SINK][l * 4 + h];
            int j0 = 0, j1 = SEQ;
            if (lat) { j0 = t - 128 < 0 ? 0 : t - 128; j1 = t + 129 > DSEQ ? DSEQ : t + 129; }
            for (int j = j0; j < j1; ++j)
                sa_add(s, dot_bf<64>(q, WSP(bf16_t, WS_WKR) + (size_t)(seq0 + j) * 128 + kh * 64) * 0.125f, cols + (size_t)(seq0 + j) * NC + C_WV + kh * 64);
            if (lat) {
                const float* ck = p.in[I_CWK] + ((size_t)b * DEPTH + l) * PAST * 128 + kh * 64;
                const float* cv = p.in[I_CWV] + ((size_t)b * DEPTH + l) * PAST * 128 + kh * 64;
                for (int j = 0; j < PAST; ++j) sa_add_f32v(s, dot64_f32k(q, ck + (size_t)j * 128) * 0.125f, cv + (size_t)j * 128);
            }
            float mn = fmaxf(s.m, sink); float corr = expf(s.m - mn);
            s.l *= corr;
#pragma unroll
            for (int d = 0; d < 64; ++d) s.o[d] *= corr;
            s.m = mn;
            sa_store(p, s, expf(sink - mn), r, 3, h, C_WZ);
        }
    }
}

DEV void nv_hgrn(const P& p, int l, long gtid, long gsz) {
    const bf16_t* cols = WSP(bf16_t, WS_COLS);
    float* oh = WSP(float, WS_OH);
    const int NSEQ = BATCH + DB;
    for (long it = gtid; it < (long)NSEQ * 4 * 2 * 64; it += gsz) {
        const int j = (int)(it % 64); const int dir = (int)((it / 64) % 2); const int h = (int)((it / 128) % 4); const int sq = (int)(it / 512);
        const bool lat = sq >= BATCH;
        const int b = lat ? sq - BATCH : sq;
        const int T = lat ? DSEQ : SEQ; const int seq0 = lat ? NCTX + b * DSEQ : b * SEQ;
        const float* lb = WSP(float, WS_LBS) + ((size_t)l * 2 + dir) * 256 + h * 64;
        float S[64];
        if (lat) {
            const float* st = p.in[I_ST] + ((((size_t)b * DEPTH + l) * 2 + dir) * 4 + h) * 4096;
#pragma unroll
            for (int d = 0; d < 64; ++d) S[d] = st[d * 64 + j];
        } else {
#pragma unroll
            for (int d = 0; d < 64; ++d) S[d] = 0.f;
        }
        const int fcol = dir == 0 ? C_HGFF : C_HGFB;
        for (int tt = 0; tt < T; ++tt) {
            const int t = dir == 0 ? tt : T - 1 - tt;
            const bf16_t* c = cols + (size_t)(seq0 + t) * NC;
            const float v = bf2f(c[C_HGI + h * 64 + j]);
            float o = 0.f;
#pragma unroll
            for (int d8 = 0; d8 < 8; ++d8) {
                float fz[8], qq[8]; unpack8(c + fcol + h * 64 + d8 * 8, fz); unpack8(c + C_HGQ + h * 64 + d8 * 8, qq);
#pragma unroll
                for (int e = 0; e < 8; ++e) {
                    const int d = d8 * 8 + e;
                    const float lbv = lb[d];
                    float f = lbv + (1.f - lbv) * sigm(fz[e]);
                    f = fmaxf(f, 1e-30f);
                    const float k = (1.f - lbv) * sigm(-fz[e]);
                    S[d] = f * S[d] + k * v;
                    o += S[d] * siluf(qq[e]);
                }
            }
            oh[((size_t)dir * NTOK + seq0 + t) * 256 + h * 64 + j] = o;
        }
        if (!lat) {
            float* so = p.out + O_ST + ((((size_t)b * DEPTH + l) * 2 + dir) * 4 + h) * 4096;
#pragma unroll
            for (int d = 0; d < 64; ++d) so[d * 64 + j] = S[d];
        }
    }
}

DEV void nv_hgrn_fin(const P& p, int l, long gtid, long gsz) {
    const bf16_t* cols = WSP(bf16_t, WS_COLS);
    const float* oh = WSP(float, WS_OH);
    const float* g = p.in[I_HGG] + (size_t)l * 64;
    for (long it = gtid; it < (long)NTOK * 4; it += gsz) {
        const int h = (int)(it % 4); const int r = (int)(it / 4);
        const float* of = oh + (size_t)r * 256 + h * 64; const float* ob = oh + ((size_t)NTOK + r) * 256 + h * 64;
        float ss = 0.f;
        for (int d = 0; d < 64; ++d) { float v = of[d] + ob[d]; ss += v * v; }
        float rstd = 1.f / sqrtf(ss / 64.f + 1e-6f);
        const bf16_t* c = cols + (size_t)r * NC;
        bf16_t* y = WSP(bf16_t, WS_Y) + (size_t)r * DM + 256 + h * 64;
        for (int d = 0; d < 64; ++d) {
            float v = (of[d] + ob[d]) * rstd * g[d] * sigm(bf2f(c[C_HGOG + h * 64 + d]));
            y[d] = f2bf(v * siluf(bf2f(c[C_HGZ + h * 64 + d])));
        }
    }
}

DEV void nv_merge(const P& p, int l, long gtid, long gsz) {
    const bf16_t* cols = WSP(bf16_t, WS_COLS);
    const bf16_t* Y = WSP(bf16_t, WS_Y);
    const bf16_t* wt = WSP(bf16_t, WS_WTBR) + (size_t)l * 4 * DM * 256;
    bf16_t* mrg = WSP(bf16_t, WS_MRG);
    for (long it = gtid; it < (long)NTOK * DM; it += gsz) {
        const int d = (int)(it % DM); const int r = (int)(it / DM);
        float tot = 0.f;
        for (int b = 0; b < 4; ++b) {
            const bf16_t* y = Y + (size_t)r * DM + b * 256; const bf16_t* w = wt + ((size_t)b * DM + d) * 256;
            float acc = 0.f;
            for (int k = 0; k < 256; k += 8) {
                float a[8], ww[8]; unpack8(y + k, a); unpack8(w + k, ww);
#pragma unroll
                for (int e = 0; e < 8; ++e) acc += a[e] * ww[e];
            }
            tot += sigm(bf2f(cols[(size_t)r * NC + C_MG + b * DM + d])) * acc;
        }
        mrg[it] = f2bf(tot);
    }
}

DEV void nv_out(const P& p, int l, long gtid, long gsz) {
    float* X = WSP(float, WS_X);
    const float* modv = WSP(float, WS_MODV);
    const P pp = p;
    nv_gemm(WSP(bf16_t, WS_MRG), DM, WSP(bf16_t, WS_WTOUT) + (size_t)l * DM * DM, DM, NTOK, DM, DM, gtid, gsz,
        [=](int r, int n, float v) {
            const float gate = modv[((size_t)l * NCB + row_cb(r)) * 3072 + 2048 + n];
            X[(size_t)r * DM + n] = x_row(pp, l, r)[n] + gate * v;
        });
}

DEV void nv_final(const P& p, long gtid, long gsz) {
    const float* X = WSP(float, WS_X); const float* g = p.in[I_FG];
    for (long r = gtid; r < NTOK; r += gsz) {
        const float* x = X + (size_t)r * DM;
        float ss = 0.f;
        for (int k = 0; k < DM; ++k) ss += x[k] * x[k];
        float rstd = 1.f / sqrtf(ss / DM + 1e-6f);
        for (int k = 0; k < DM; ++k) p.out[O_Y + (size_t)r * DM + k] = x[k] * rstd * g[k];
    }
}

constexpr int ST_PREP_W = 0, ST_PREP_CTX = 1, ST_LAYER0 = 2, ST_PER_LAYER = 8;
constexpr int N_STAGES = ST_LAYER0 + DEPTH * ST_PER_LAYER + 1;
DEV void run_stage(const P& p, int st, long gtid, long gsz) {
    if (st == ST_PREP_W) { nv_prep_w(p, gtid, gsz); return; }
    if (st == ST_PREP_CTX) { nv_prep_ctxmla(p, gtid, gsz); return; }
    if (st == N_STAGES - 1) { nv_final(p, gtid, gsz); return; }
    const int l = (st - ST_LAYER0) / ST_PER_LAYER, s = (st - ST_LAYER0) % ST_PER_LAYER;
    switch (s) {
        case 0: nv_normmod(p, l, gtid, gsz); break;
        case 1: nv_inproj(p, l, gtid, gsz); break;
        case 2: nv_rowprep(p, l, gtid, gsz); break;
        case 3: nv_mlaproj(p, l, gtid, gsz); break;
        case 4: nv_attn(p, l, gtid, gsz); nv_hgrn(p, l, gtid, gsz); break;
        case 5: nv_hgrn_fin(p, l, gtid, gsz); break;
        case 6: nv_merge(p, l, gtid, gsz); break;
        case 7: nv_out(p, l, gtid, gsz); break;
    }
}

#ifndef CPU_EMU
namespace cg = cooperative_groups;
constexpr int NTHREADS = 256;
__global__ void __launch_bounds__(NTHREADS) mega_kernel(P p) {
    cg::grid_group grid = cg::this_grid();
    const long gtid = (long)blockIdx.x * blockDim.x + threadIdx.x, gsz = (long)gridDim.x * blockDim.x;
    for (int st = 0; st < N_STAGES; ++st) {
        run_stage(p, st, gtid, gsz);
        if (st + 1 < N_STAGES) grid.sync();
    }
}

extern "C" void kernel_launch(void* const* d_in, const int* in_sizes, int n_in, void* d_out, int out_size, void* d_ws, size_t ws_size, hipStream_t stream) {
    static int grid_blocks = 0;
    if (grid_blocks == 0) {
        if (n_in != N_IN || (size_t)out_size != O_END || ws_size < WS_END) {
            fprintf(stderr, "kernel_launch: unexpected sizes n_in %d out %d ws %zu (need %zu)\n", n_in, out_size, ws_size, (size_t)WS_END);
            grid_blocks = -1; return;
        }
        int dev = 0, cus = 0, per_cu = 0;
        hipGetDevice(&dev);
        hipDeviceGetAttribute(&cus, hipDeviceAttributeMultiprocessorCount, dev);
        hipOccupancyMaxActiveBlocksPerMultiprocessor(&per_cu, (const void*)mega_kernel, NTHREADS, 0);
        if (per_cu < 1) per_cu = 1;
        grid_blocks = cus * per_cu;
    }
    if (grid_blocks < 0) return;
    P p{};
    for (int i = 0; i < N_IN; ++i) p.in[i] = (const float*)d_in[i];
    p.out = (float*)d_out; p.ws = (unsigned char*)d_ws;
    void* args[] = {&p};
    hipError_t e = hipLaunchCooperativeKernel((const void*)mega_kernel, dim3(grid_blocks), dim3(NTHREADS), args, 0, stream);
    if (e != hipSuccess) fprintf(stderr, "cooperative launch failed: %s (grid %d)\n", hipGetErrorString(e), grid_blocks);
}
#endif
```

```cpp
#ifndef CPU_EMU
#include <hip/hip_runtime.h>
#include <hip/hip_cooperative_groups.h>
#include <cstdio>
#define DEV __device__ __forceinline__
#else
#include <cmath>
#include <cstdio>
#include <cstring>
#define DEV inline
#endif
#include <cstdint>
#include <cstddef>

#ifndef CFG_BATCH
#define CFG_BATCH 16
#endif
#ifndef CFG_DEPTH
#define CFG_DEPTH 4
#endif
#ifndef CFG_DEC_BATCH
#define CFG_DEC_BATCH 4
#endif
constexpr int DM = 1024, BATCH = CFG_BATCH, SEQ = 256, DEPTH = CFG_DEPTH, DB = CFG_DEC_BATCH, DSEQ = 2048, PAST = 512;
constexpr int NCTX = BATCH * SEQ, NLAT = DB * DSEQ, NTOK = NCTX + NLAT;
constexpr int NCB = 1 + DB;
constexpr int INW = 8096, NC = 8192;
constexpr int GW = 64, GROWS = DSEQ / GW;
constexpr int C_NAQ = 0, C_NAK = 256, C_NAV = 512, C_NAZ = 768, C_HGQ = 1024, C_HGFF = 1280, C_HGFB = 1536, C_HGI = 1792, C_HGOG = 2048, C_HGZ = 2304,
              C_MQA = 2560, C_CKV = 2816, C_MZ = 2944, C_WQ = 3200, C_WK = 3456, C_WV = 3584, C_WZ = 3712, C_KR = 3968, C_PAD = 4000, C_MG = 4096;
DEV int orig_col(int c) {
    if (c < 2944) return c;
    if (c < 3968) return c + 32;
    if (c < 4000) return 2944 + (c - 3968);
    if (c < 4096) return -1;
    return c - 96;
}
enum { I_XP = 0, I_XS, I_CNAK, I_CNAV, I_ST, I_CCKV, I_CKR, I_CWK, I_CWV, I_C, I_CCTX, I_NG, I_WMOD, I_BMOD, I_WIN, I_RPB, I_LB, I_HGG, I_QG, I_KVG, I_WQB, I_WKVB, I_SINK, I_WBR, I_WOUT, I_FG, N_IN };
constexpr size_t O_Y = 0;
constexpr size_t O_NAK = (size_t)NTOK * DM;
constexpr size_t O_NAV = O_NAK + (size_t)BATCH * DEPTH * SEQ * 256;
constexpr size_t O_ST = O_NAV + (size_t)BATCH * DEPTH * SEQ * 256;
constexpr size_t O_CKV = O_ST + (size_t)BATCH * DEPTH * 2 * 4 * 64 * 64;
constexpr size_t O_KR = O_CKV + (size_t)BATCH * DEPTH * SEQ * 128;
constexpr size_t O_WK = O_KR + (size_t)BATCH * DEPTH * SEQ * 32;
constexpr size_t O_WV = O_WK + (size_t)BATCH * DEPTH * SEQ * 128;
constexpr size_t O_END = O_WV + (size_t)BATCH * DEPTH * SEQ * 128;

typedef unsigned short bf16_t;
constexpr size_t al256(size_t x) { return (x + 255) & ~(size_t)255; }
constexpr size_t WS_CTL = 0;
constexpr size_t WS_WTIN = 1u << 20;
constexpr size_t WS_WTBR = WS_WTIN + (size_t)DEPTH * NC * DM * 2;
constexpr size_t WS_WTOUT = WS_WTBR + (size_t)DEPTH * 4 * DM * 256 * 2;
constexpr size_t WS_WTQB = WS_WTOUT + (size_t)DEPTH * DM * DM * 2;
constexpr size_t WS_WTKVB = WS_WTQB + (size_t)DEPTH * 512 * 256 * 2;
constexpr size_t WS_MODV = WS_WTKVB + (size_t)DEPTH * 512 * 128 * 2;
constexpr size_t WS_LBS = al256(WS_MODV + (size_t)DEPTH * NCB * 3072 * 4);
constexpr size_t WS_ROPEM = al256(WS_LBS + (size_t)DEPTH * 2 * 256 * 4);
constexpr size_t WS_ROPEW = al256(WS_ROPEM + (size_t)DSEQ * 16 * 2 * 4);
constexpr size_t WS_X = al256(WS_ROPEW + (size_t)DSEQ * 32 * 2 * 4);
constexpr size_t WS_H = WS_X + (size_t)NTOK * DM * 4;
constexpr size_t WS_COLS = WS_H + (size_t)NTOK * DM * 2;
constexpr size_t WS_KCM = WS_COLS + (size_t)NTOK * NC * 2;
constexpr size_t WS_VCM = WS_KCM + (size_t)DB * DEPTH * PAST * 384 * 2;
constexpr size_t WS_QN = WS_VCM + (size_t)DB * DEPTH * PAST * 256 * 2;
constexpr size_t WS_CKVB = WS_QN + (size_t)NTOK * 256 * 2;
constexpr size_t WS_QMLA = WS_CKVB + (size_t)NTOK * 128 * 2;
constexpr size_t WS_KMLA = WS_QMLA + (size_t)NTOK * 384 * 2;
constexpr size_t WS_VMLA = WS_KMLA + (size_t)NTOK * 384 * 2;
constexpr size_t WS_WQR = WS_VMLA + (size_t)NTOK * 256 * 2;
constexpr size_t WS_WKR = WS_WQR + (size_t)NTOK * 256 * 2;
constexpr size_t WS_OH = WS_WKR + (size_t)NTOK * 128 * 2;
constexpr size_t WS_Y = WS_OH + (size_t)2 * NTOK * 256 * 4;
constexpr size_t WS_MRG = WS_H;
constexpr size_t WS_HD = WS_Y + (size_t)NTOK * DM * 2;
constexpr size_t WS_CNAK = al256(WS_HD + (size_t)(NTOK / 64) * 4 * 2 * 64 * 4);
constexpr size_t WS_CNAV = WS_CNAK + (size_t)DB * DEPTH * PAST * 256 * 2;
constexpr size_t WS_CWK = WS_CNAV + (size_t)DB * DEPTH * PAST * 256 * 2;
constexpr size_t WS_CWV = WS_CWK + (size_t)DB * DEPTH * PAST * 128 * 2;
constexpr size_t WS_END = WS_CWV + (size_t)DB * DEPTH * PAST * 128 * 2;
constexpr size_t WS_HL = WS_OH;
constexpr size_t WS_MRGF = WS_QN;
static_assert(WS_MRGF + (size_t)NTOK * DM * 4 <= WS_Y, "MRGF alias must end before Y");

struct P {
    const float* in[N_IN];
    float* out;
    unsigned char* ws;
};

DEV unsigned f2u(float f) { unsigned u; memcpy(&u, &f, 4); return u; }
DEV float u2f(unsigned u) { float f; memcpy(&f, &u, 4); return f; }
DEV bf16_t f2bf(float f) { unsigned u = f2u(f); return (bf16_t)((u + 0x7fffu + ((u >> 16) & 1u)) >> 16); }
DEV float bf2f(bf16_t b) { return u2f((unsigned)b << 16); }
DEV float rbf(float f) { return bf2f(f2bf(f)); }
DEV float sigm(float x) { return 1.f / (1.f + expf(-x)); }
DEV float siluf(float x) { return x * sigm(x); }
DEV int row_cb(int r) { return r < NCTX ? 0 : 1 + (r - NCTX) / DSEQ; }

struct U4 { unsigned x, y, z, w; };
DEV void unpack8(const bf16_t* p, float* f) {
    U4 v = *(const U4*)p;
    f[0] = u2f(v.x << 16); f[1] = u2f(v.x & 0xffff0000u); f[2] = u2f(v.y << 16); f[3] = u2f(v.y & 0xffff0000u);
    f[4] = u2f(v.z << 16); f[5] = u2f(v.z & 0xffff0000u); f[6] = u2f(v.w << 16); f[7] = u2f(v.w & 0xffff0000u);
}

#define WSP(T, off) ((T*)(p.ws + (off)))

DEV void nv_prep_w(const P& p, long gtid, long gsz) {
    bf16_t* wtin = WSP(bf16_t, WS_WTIN);
    const float* win = p.in[I_WIN];
    for (long i = gtid; i < (long)DEPTH * NC * DM; i += gsz) {
        int k = (int)(i % DM); long t = i / DM; int n = (int)(t % NC); int l = (int)(t / NC);
        int oc = orig_col(n);
        wtin[i] = oc < 0 ? (bf16_t)0 : f2bf(win[((size_t)l * DM + k) * INW + oc]);
    }
    bf16_t* wtbr = WSP(bf16_t, WS_WTBR);
    const float* wbr = p.in[I_WBR];
    for (long i = gtid; i < (long)DEPTH * 4 * DM * 256; i += gsz) {
        int w = (int)(i % 256); long t = i / 256; int d = (int)(t % DM); t /= DM; int b = (int)(t % 4); int l = (int)(t / 4);
        wtbr[i] = f2bf(wbr[(((size_t)l * 4 + b) * 256 + w) * DM + d]);
    }
    bf16_t* wtout = WSP(bf16_t, WS_WTOUT);
    const float* wout = p.in[I_WOUT];
    for (long i = gtid; i < (long)DEPTH * DM * DM; i += gsz) {
        int k = (int)(i % DM); long t = i / DM; int n = (int)(t % DM); int l = (int)(t / DM);
        wtout[i] = f2bf(wout[((size_t)l * DM + k) * DM + n]);
    }
    bf16_t* wtqb = WSP(bf16_t, WS_WTQB);
    const float* wqb = p.in[I_WQB];
    for (long i = gtid; i < (long)DEPTH * 512 * 256; i += gsz) {
        int k = (int)(i % 256); long t = i / 256; int n = (int)(t % 512); int l = (int)(t / 512);
        wtqb[i] = n < 384 ? f2bf(wqb[((size_t)l * 256 + k) * 384 + n]) : (bf16_t)0;
    }
    bf16_t* wtkvb = WSP(bf16_t, WS_WTKVB);
    const float* wkvb = p.in[I_WKVB];
    for (long i = gtid; i < (long)DEPTH * 512 * 128; i += gsz) {
        int k = (int)(i % 128); long t = i / 128; int n = (int)(t % 512); int l = (int)(t / 512);
        wtkvb[i] = f2bf(wkvb[((size_t)l * 128 + k) * 512 + n]);
    }
    float* modv = WSP(float, WS_MODV);
    for (long i = gtid; i < (long)DEPTH * NCB * 3072; i += gsz) {
        int j = (int)(i % 3072); long t = i / 3072; int cb = (int)(t % NCB); int l = (int)(t / NCB);
        const float* cv = cb == 0 ? p.in[I_CCTX] : p.in[I_C] + (size_t)(cb - 1) * DM;
        const float* w = p.in[I_WMOD] + (size_t)l * DM * 3072 + j;
        float acc = 0.f;
        for (int k = 0; k < DM; ++k) acc += siluf(cv[k]) * w[(size_t)k * 3072];
        modv[i] = acc + p.in[I_BMOD][(size_t)l * 3072 + j];
    }
    float* lbs = WSP(float, WS_LBS);
    for (long i = gtid; i < 2 * 256; i += gsz) {
        const float* lg = p.in[I_LB];
        float mx = -1e30f;
        for (int l = 0; l < DEPTH; ++l) mx = fmaxf(mx, lg[(size_t)l * 512 + i]);
        float s = 0.f;
        for (int l = 0; l < DEPTH; ++l) s += expf(lg[(size_t)l * 512 + i] - mx);
        float cum = 0.f, p0 = expf(lg[i] - mx) / s;
        for (int l = 0; l < DEPTH; ++l) { cum += expf(lg[(size_t)l * 512 + i] - mx) / s; lbs[(size_t)l * 512 + i] = cum - p0; }
    }
    float* rm = WSP(float, WS_ROPEM);
    for (long i = gtid; i < (long)DSEQ * 16; i += gsz) {
        int j = (int)(i % 16), t = (int)(i / 16);
        float pos = j < 8 ? (float)(t / GW) : (float)(t % GW);
        float inv = powf(10000.f, -(float)(j & 7) / 8.f);
        float a = pos * inv; rm[i * 2] = cosf(a); rm[i * 2 + 1] = sinf(a);
    }
    float* rw = WSP(float, WS_ROPEW);
    for (long i = gtid; i < (long)DSEQ * 32; i += gsz) {
        int j = (int)(i % 32), t = (int)(i / 32);
        float pos = j < 16 ? (float)(t / GW) : (float)(t % GW);
        float inv = powf(10000.f, -(float)(j & 15) / 16.f);
        float a = pos * inv; rw[i * 2] = cosf(a); rw[i * 2 + 1] = sinf(a);
    }
}

DEV void nv_prep_ctxmla(const P& p, long gtid, long gsz) {
    const bf16_t* wtkvb = WSP(bf16_t, WS_WTKVB);
    bf16_t* kcm = WSP(bf16_t, WS_KCM); bf16_t* vcm = WSP(bf16_t, WS_VCM);
    for (long i = gtid; i < (long)DB * DEPTH * PAST * 512; i += gsz) {
        int n = (int)(i % 512); long row = i / 512;
        int l = (int)((row / PAST) % DEPTH);
        const float* ck = p.in[I_CCKV] + (size_t)row * 128;
        const bf16_t* w = wtkvb + ((size_t)l * 512 + n) * 128;
        float acc = 0.f;
        for (int j = 0; j < 128; ++j) acc += rbf(ck[j]) * bf2f(w[j]);
        int h = n / 128, e = n % 128;
        if (e < 64) kcm[(size_t)row * 384 + h * 96 + e] = f2bf(acc);
        else vcm[(size_t)row * 256 + h * 64 + (e - 64)] = f2bf(acc);
    }
    for (long i = gtid; i < (long)DB * DEPTH * PAST * 128; i += gsz) {
        int e = (int)(i % 32); int h = (int)((i / 32) % 4); long row = i / 128;
        kcm[(size_t)row * 384 + h * 96 + 64 + e] = f2bf(p.in[I_CKR][(size_t)row * 32 + e]);
    }
    for (long i = gtid; i < (long)DB * DEPTH * PAST * 256; i += gsz) { WSP(bf16_t, WS_CNAK)[i] = f2bf(p.in[I_CNAK][i]); WSP(bf16_t, WS_CNAV)[i] = f2bf(p.in[I_CNAV][i]); }
    for (long i = gtid; i < (long)DB * DEPTH * PAST * 128; i += gsz) { WSP(bf16_t, WS_CWK)[i] = f2bf(p.in[I_CWK][i]); WSP(bf16_t, WS_CWV)[i] = f2bf(p.in[I_CWV][i]); }
}

DEV const float* x_row(const P& p, int l, int r) {
    if (l == 0) return r < NCTX ? p.in[I_XP] + (size_t)r * DM : p.in[I_XS] + (size_t)(r - NCTX) * DM;
    return WSP(float, WS_X) + (size_t)r * DM;
}

DEV void nv_normmod(const P& p, int l, long gtid, long gsz) {
    bf16_t* H = WSP(bf16_t, WS_H);
    const float* g = p.in[I_NG] + (size_t)l * DM;
    for (long r = gtid; r < NTOK; r += gsz) {
        const float* x = x_row(p, l, (int)r);
        const float* mv = WSP(float, WS_MODV) + ((size_t)l * NCB + row_cb((int)r)) * 3072;
        float ss = 0.f;
        for (int k = 0; k < DM; ++k) ss += x[k] * x[k];
        float rstd = 1.f / sqrtf(ss / DM + 1e-6f);
        for (int k = 0; k < DM; ++k) H[(size_t)r * DM + k] = f2bf(x[k] * rstd * g[k] * (1.f + mv[1024 + k]) + mv[k]);
    }
}

template <class Epi>
DEV void nv_gemm(const bf16_t* A, int lda, const bf16_t* Wt, int ldw, int M, int N, int K, long gtid, long gsz, Epi epi) {
    const long nItems = (long)(M / 4) * (N / 4);
    for (long it = gtid; it < nItems; it += gsz) {
        const int cb = (int)(it % (N / 4)), rb = (int)(it / (N / 4));
        float acc[4][4];
#pragma unroll
        for (int i = 0; i < 4; ++i)
#pragma unroll
            for (int j = 0; j < 4; ++j) acc[i][j] = 0.f;
        for (int k = 0; k < K; k += 8) {
            float a[4][8], w[4][8];
#pragma unroll
            for (int i = 0; i < 4; ++i) unpack8(A + (size_t)(rb * 4 + i) * lda + k, a[i]);
#pragma unroll
            for (int j = 0; j < 4; ++j) unpack8(Wt + (size_t)(cb * 4 + j) * ldw + k, w[j]);
#pragma unroll
            for (int i = 0; i < 4; ++i)
#pragma unroll
                for (int j = 0; j < 4; ++j)
#pragma unroll
                    for (int e = 0; e < 8; ++e) acc[i][j] += a[i][e] * w[j][e];
        }
#pragma unroll
        for (int i = 0; i < 4; ++i)
#pragma unroll
            for (int j = 0; j < 4; ++j) epi(rb * 4 + i, cb * 4 + j, acc[i][j]);
    }
}

DEV void nv_inproj(const P& p, int l, long gtid, long gsz) {
    bf16_t* cols = WSP(bf16_t, WS_COLS);
    float* out = p.out;
    nv_gemm(WSP(bf16_t, WS_H), DM, WSP(bf16_t, WS_WTIN) + (size_t)l * NC * DM, DM, NTOK, NC, DM, gtid, gsz,
        [=](int r, int n, float v) {
            cols[(size_t)r * NC + n] = f2bf(v);
            if (r < NCTX) {
                const int b = r / SEQ, t = r % SEQ; const size_t bl = ((size_t)b * DEPTH + l) * SEQ + t;
                if (n >= C_NAK && n < C_NAK + 256) out[O_NAK + bl * 256 + (n - C_NAK)] = v;
                else if (n >= C_NAV && n < C_NAV + 256) out[O_NAV + bl * 256 + (n - C_NAV)] = v;
                else if (n >= C_WK && n < C_WK + 128) out[O_WK + bl * 128 + (n - C_WK)] = v;
                else if (n >= C_WV && n < C_WV + 128) out[O_WV + bl * 128 + (n - C_WV)] = v;
            }
        });
}

DEV void nv_rowprep(const P& p, int l, long gtid, long gsz) {
    const bf16_t* cols = WSP(bf16_t, WS_COLS);
    for (long r = gtid; r < NTOK; r += gsz) {
        const bf16_t* c = cols + (size_t)r * NC;
        const bool lat = r >= NCTX; const int t = lat ? (int)((r - NCTX) % DSEQ) : 0;
        {
            float ss = 0.f;
            for (int j = 0; j < 128; ++j) { float v = bf2f(c[C_CKV + j]); ss += v * v; }
            float rstd = 1.f / sqrtf(ss / 128.f + 1e-6f);
            const float* g = p.in[I_KVG] + (size_t)l * 128;
            for (int j = 0; j < 128; ++j) {
                float v = bf2f(c[C_CKV + j]) * rstd * g[j];
                WSP(bf16_t, WS_CKVB)[(size_t)r * 128 + j] = f2bf(v);
                if (!lat) p.out[O_CKV + (((size_t)(r / SEQ) * DEPTH + l) * SEQ + (r % SEQ)) * 128 + j] = v;
            }
        }
        {
            const float* rm = WSP(float, WS_ROPEM) + (size_t)t * 32;
            for (int j = 0; j < 16; ++j) {
                float x1 = bf2f(c[C_KR + j]), x2 = bf2f(c[C_KR + 16 + j]);
                float o1 = x1, o2 = x2;
                if (lat) { float cs = rm[j * 2], sn = rm[j * 2 + 1]; o1 = x1 * cs - x2 * sn; o2 = x1 * sn + x2 * cs; }
                else {
                    size_t o = O_KR + (((size_t)(r / SEQ) * DEPTH + l) * SEQ + (r % SEQ)) * 32;
                    p.out[o + j] = x1; p.out[o + 16 + j] = x2;
                }
                for (int h = 0; h < 4; ++h) {
                    WSP(bf16_t, WS_KMLA)[(size_t)r * 384 + h * 96 + 64 + j] = f2bf(o1);
                    WSP(bf16_t, WS_KMLA)[(size_t)r * 384 + h * 96 + 80 + j] = f2bf(o2);
                }
            }
        }
        {
            float ss = 0.f;
            for (int j = 0; j < 256; ++j) { float v = bf2f(c[C_MQA + j]); ss += v * v; }
            float rstd = 1.f / sqrtf(ss / 256.f + 1e-6f);
            const float* g = p.in[I_QG] + (size_t)l * 256;
            for (int j = 0; j < 256; ++j) WSP(bf16_t, WS_QN)[(size_t)r * 256 + j] = f2bf(bf2f(c[C_MQA + j]) * rstd * g[j]);
        }
        {
            const float* rw = WSP(float, WS_ROPEW) + (size_t)t * 64;
            for (int hh = 0; hh < 6; ++hh) {
                const bf16_t* src = hh < 4 ? c + C_WQ + hh * 64 : c + C_WK + (hh - 4) * 64;
                bf16_t* dst = hh < 4 ? WSP(bf16_t, WS_WQR) + (size_t)r * 256 + hh * 64 : WSP(bf16_t, WS_WKR) + (size_t)r * 128 + (hh - 4) * 64;
                for (int j = 0; j < 32; ++j) {
                    float x1 = bf2f(src[j]), x2 = bf2f(src[32 + j]);
                    if (lat) { float cs = rw[j * 2], sn = rw[j * 2 + 1]; dst[j] = f2bf(x1 * cs - x2 * sn); dst[32 + j] = f2bf(x1 * sn + x2 * cs); }
                    else { dst[j] = src[j]; dst[32 + j] = src[32 + j]; }
                }
            }
        }
    }
}

DEV void nv_mlaproj(const P& p, int l, long gtid, long gsz) {
    bf16_t* qm = WSP(bf16_t, WS_QMLA); bf16_t* km = WSP(bf16_t, WS_KMLA); bf16_t* vm = WSP(bf16_t, WS_VMLA);
    nv_gemm(WSP(bf16_t, WS_QN), 256, WSP(bf16_t, WS_WTQB) + (size_t)l * 512 * 256, 256, NTOK, 384, 256, gtid, gsz,
        [=](int r, int n, float v) { qm[(size_t)r * 384 + n] = f2bf(v); });
    nv_gemm(WSP(bf16_t, WS_CKVB), 128, WSP(bf16_t, WS_WTKVB) + (size_t)l * 512 * 128, 128, NTOK, 512, 128, gtid, gsz,
        [=](int r, int n, float v) {
            int h = n / 128, e = n % 128;
            if (e < 64) km[(size_t)r * 384 + h * 96 + e] = f2bf(v); else vm[(size_t)r * 256 + h * 64 + (e - 64)] = f2bf(v);
        });
}

struct SoftAcc { float m, l; float o[32]; };
DEV void sa_init(SoftAcc& s) { s.m = -3e38f; s.l = 0.f;
#pragma unroll
    for (int d = 0; d < 32; ++d) s.o[d] = 0.f; }
DEV void sa_add(SoftAcc& s, float sc, const bf16_t* v) {
    float mn = fmaxf(s.m, sc);
    float corr = expf(s.m - mn), pe = expf(sc - mn);
    s.m = mn; s.l = s.l * corr + pe;
#pragma unroll
    for (int d8 = 0; d8 < 4; ++d8) {
        float f[8]; unpack8(v + d8 * 8, f);
#pragma unroll
        for (int e = 0; e < 8; ++e) s.o[d8 * 8 + e] = s.o[d8 * 8 + e] * corr + pe * f[e];
    }
}
DEV void sa_add_f32v(SoftAcc& s, float sc, const float* v) {
    float mn = fmaxf(s.m, sc);
    float corr = expf(s.m - mn), pe = expf(sc - mn);
    s.m = mn; s.l = s.l * corr + pe;
#pragma unroll
    for (int d = 0; d < 32; ++d) s.o[d] = s.o[d] * corr + pe * rbf(v[d]);
}
template <int DQ> DEV float dot_bf(const float* q, const bf16_t* k) {
    float acc = 0.f;
#pragma unroll
    for (int d8 = 0; d8 < DQ / 8; ++d8) {
        float f[8]; unpack8(k + d8 * 8, f);
#pragma unroll
        for (int e = 0; e < 8; ++e) acc += q[d8 * 8 + e] * f[e];
    }
    return acc;
}
DEV float dot64_f32k(const float* q, const float* k) {
    float acc = 0.f;
#pragma unroll
    for (int d = 0; d < 64; ++d) acc += q[d] * rbf(k[d]);
    return acc;
}
DEV void sa_store(const P& p, const SoftAcc& s, float extra_den, int r, int branch, int h, int zcol, int half) {
    const bf16_t* c = WSP(bf16_t, WS_COLS) + (size_t)r * NC + zcol + h * 64 + half * 32;
    bf16_t* y = WSP(bf16_t, WS_Y) + (size_t)r * DM + branch * 256 + h * 64 + half * 32;
    float inv = 1.f / (s.l + extra_den);
#pragma unroll
    for (int d = 0; d < 32; ++d) y[d] = f2bf(s.o[d] * inv * siluf(bf2f(c[d])));
}

DEV void nv_attn(const P& p, int l, long gtid, long gsz) {
    const bf16_t* cols = WSP(bf16_t, WS_COLS);
    for (long it = gtid; it < (long)NTOK * 24; it += gsz) {
        const int half = (int)(it % 2); const int kind = (int)((it / 2) % 3); const int h = (int)((it / 6) % 4); const int r = (int)(it / 24);
        const int vo = half * 32;
        const bool lat = r >= NCTX;
        const int b = lat ? (r - NCTX) / DSEQ : r / SEQ, t = lat ? (r - NCTX) % DSEQ : r % SEQ;
        const int seq0 = lat ? NCTX + b * DSEQ : b * SEQ;
        SoftAcc s; sa_init(s);
        if (kind == 0) {
            float q[64];
#pragma unroll
            for (int d8 = 0; d8 < 8; ++d8) unpack8(cols + (size_t)r * NC + C_NAQ + h * 64 + d8 * 8, q + d8 * 8);
            if (!lat) {
                for (int j = 0; j < SEQ; ++j) {
                    const bf16_t* kr = cols + (size_t)(seq0 + j) * NC;
                    sa_add(s, dot_bf<64>(q, kr + C_NAK + h * 64) * 0.125f, kr + C_NAV + h * 64 + vo);
                }
            } else {
                const int gi = t / GW, gj = t % GW;
                int rs = gi - 4; rs = rs < 0 ? 0 : (rs > GROWS - 8 ? GROWS - 8 : rs);
                int cs = gj - 8; cs = cs < 0 ? 0 : (cs > GW - 16 ? GW - 16 : cs);
                const float* rpb = p.in[I_RPB] + ((size_t)l * 4 + h) * 15 * 31;
                for (int kr_ = rs; kr_ < rs + 8; ++kr_)
                    for (int kc = cs; kc < cs + 16; ++kc) {
                        const bf16_t* kk = cols + (size_t)(seq0 + kr_ * GW + kc) * NC;
                        int dc = kc - gj + 15; dc = dc < 0 ? 0 : (dc > 30 ? 30 : dc);
                        float bias = rpb[(kr_ - gi + 7) * 31 + dc];
                        sa_add(s, dot_bf<64>(q, kk + C_NAK + h * 64) * 0.125f + bias, kk + C_NAV + h * 64 + vo);
                    }
                const float* ck = p.in[I_CNAK] + ((size_t)b * DEPTH + l) * PAST * 256 + h * 64;
                const float* cv = p.in[I_CNAV] + ((size_t)b * DEPTH + l) * PAST * 256 + h * 64 + vo;
                for (int j = 0; j < PAST; ++j) sa_add_f32v(s, dot64_f32k(q, ck + (size_t)j * 256) * 0.125f, cv + (size_t)j * 256);
            }
            sa_store(p, s, 0.f, r, 0, h, C_NAZ, half);
        } else if (kind == 1) {
            float q[96];
            const bf16_t* qp = WSP(bf16_t, WS_QMLA) + (size_t)r * 384 + h * 96;
#pragma unroll
            for (int d8 = 0; d8 < 12; ++d8) unpack8(qp + d8 * 8, q + d8 * 8);
            if (lat) {
                const float* rm = WSP(float, WS_ROPEM) + (size_t)t * 32;
#pragma unroll
                for (int j = 0; j < 16; ++j) {
                    float x1 = q[64 + j], x2 = q[80 + j], cs = rm[j * 2], sn = rm[j * 2 + 1];
                    q[64 + j] = rbf(x1 * cs - x2 * sn); q[80 + j] = rbf(x1 * sn + x2 * cs);
                }
            }
            const float scale = 0.10206207261596577f;
            const int n = lat ? DSEQ : SEQ;
            const bf16_t* km = WSP(bf16_t, WS_KMLA) + (size_t)seq0 * 384 + h * 96;
            const bf16_t* vm = WSP(bf16_t, WS_VMLA) + (size_t)seq0 * 256 + h * 64 + vo;
            for (int j = 0; j < n; ++j) sa_add(s, dot_bf<96>(q, km + (size_t)j * 384) * scale, vm + (size_t)j * 256);
            if (lat) {
                const bf16_t* kc = WSP(bf16_t, WS_KCM) + ((size_t)b * DEPTH + l) * PAST * 384 + h * 96;
                const bf16_t* vc = WSP(bf16_t, WS_VCM) + ((size_t)b * DEPTH + l) * PAST * 256 + h * 64 + vo;
                for (int j = 0; j < PAST; ++j) sa_add(s, dot_bf<96>(q, kc + (size_t)j * 384) * scale, vc + (size_t)j * 256);
            }
            sa_store(p, s, 0.f, r, 2, h, C_MZ, half);
        } else {
            float q[64];
#pragma unroll
            for (int d8 = 0; d8 < 8; ++d8) unpack8(WSP(bf16_t, WS_WQR) + (size_t)r * 256 + h * 64 + d8 * 8, q + d8 * 8);
            const int kh = h / 2;
            const float sink = p.in[I_SINK][l * 4 + h];
            int j0 = 0, j1 = SEQ;
            if (lat) { j0 = t - 128 < 0 ? 0 : t - 128; j1 = t + 129 > DSEQ ? DSEQ : t + 129; }
            for (int j = j0; j < j1; ++j)
                sa_add(s, dot_bf<64>(q, WSP(bf16_t, WS_WKR) + (size_t)(seq0 + j) * 128 + kh * 64) * 0.125f, cols + (size_t)(seq0 + j) * NC + C_WV + kh * 64 + vo);
            if (lat) {
                const float* ck = p.in[I_CWK] + ((size_t)b * DEPTH + l) * PAST * 128 + kh * 64;
                const float* cv = p.in[I_CWV] + ((size_t)b * DEPTH + l) * PAST * 128 + kh * 64 + vo;
                for (int j = 0; j < PAST; ++j) sa_add_f32v(s, dot64_f32k(q, ck + (size_t)j * 128) * 0.125f, cv + (size_t)j * 128);
            }
            float mn = fmaxf(s.m, sink); float corr = expf(s.m - mn);
            s.l *= corr;
#pragma unroll
            for (int d = 0; d < 32; ++d) s.o[d] *= corr;
            s.m = mn;
            sa_store(p, s, expf(sink - mn), r, 3, h, C_WZ, half);
        }
    }
}

DEV void nv_hgrn(const P& p, int l, long gtid, long gsz) {
    const bf16_t* cols = WSP(bf16_t, WS_COLS);
    float* oh = WSP(float, WS_OH);
    const int NSEQ = BATCH + DB;
    for (long it = gtid; it < (long)NSEQ * 4 * 2 * 64; it += gsz) {
        const int j = (int)(it % 64); const int dir = (int)((it / 64) % 2); const int h = (int)((it / 128) % 4); const int sq = (int)(it / 512);
        const bool lat = sq >= BATCH;
        const int b = lat ? sq - BATCH : sq;
        const int T = lat ? DSEQ : SEQ; const int seq0 = lat ? NCTX + b * DSEQ : b * SEQ;
        const float* lb = WSP(float, WS_LBS) + ((size_t)l * 2 + dir) * 256 + h * 64;
        float S[64];
        if (lat) {
            const float* st = p.in[I_ST] + ((((size_t)b * DEPTH + l) * 2 + dir) * 4 + h) * 4096;
#pragma unroll
            for (int d = 0; d < 64; ++d) S[d] = st[d * 64 + j];
        } else {
#pragma unroll
            for (int d = 0; d < 64; ++d) S[d] = 0.f;
        }
        const int fcol = dir == 0 ? C_HGFF : C_HGFB;
        for (int tt = 0; tt < T; ++tt) {
            const int t = dir == 0 ? tt : T - 1 - tt;
            const bf16_t* c = cols + (size_t)(seq0 + t) * NC;
            const float v = bf2f(c[C_HGI + h * 64 + j]);
            float o = 0.f;
#pragma unroll
            for (int d8 = 0; d8 < 8; ++d8) {
                float fz[8], qq[8]; unpack8(c + fcol + h * 64 + d8 * 8, fz); unpack8(c + C_HGQ + h * 64 + d8 * 8, qq);
#pragma unroll
                for (int e = 0; e < 8; ++e) {
                    const int d = d8 * 8 + e;
                    const float lbv = lb[d];
                    float f = lbv + (1.f - lbv) * sigm(fz[e]);
                    f = fmaxf(f, 1e-30f);
                    const float k = (1.f - lbv) * sigm(-fz[e]);
                    S[d] = f * S[d] + k * v;
                    o += S[d] * siluf(qq[e]);
                }
            }
            oh[((size_t)dir * NTOK + seq0 + t) * 256 + h * 64 + j] = o;
        }
        if (!lat) {
            float* so = p.out + O_ST + ((((size_t)b * DEPTH + l) * 2 + dir) * 4 + h) * 4096;
#pragma unroll
            for (int d = 0; d < 64; ++d) so[d * 64 + j] = S[d];
        }
    }
}

DEV void nv_hgrn_fin(const P& p, int l, long gtid, long gsz) {
    const bf16_t* cols = WSP(bf16_t, WS_COLS);
    const float* oh = WSP(float, WS_OH);
    const float* g = p.in[I_HGG] + (size_t)l * 64;
    for (long it = gtid; it < (long)NTOK * 4; it += gsz) {
        const int h = (int)(it % 4); const int r = (int)(it / 4);
        const float* of = oh + (size_t)r * 256 + h * 64; const float* ob = oh + ((size_t)NTOK + r) * 256 + h * 64;
        float ss = 0.f;
        for (int d = 0; d < 64; ++d) { float v = of[d] + ob[d]; ss += v * v; }
        float rstd = 1.f / sqrtf(ss / 64.f + 1e-6f);
        const bf16_t* c = cols + (size_t)r * NC;
        bf16_t* y = WSP(bf16_t, WS_Y) + (size_t)r * DM + 256 + h * 64;
        for (int d = 0; d < 64; ++d) {
            float v = (of[d] + ob[d]) * rstd * g[d] * sigm(bf2f(c[C_HGOG + h * 64 + d]));
            y[d] = f2bf(v * siluf(bf2f(c[C_HGZ + h * 64 + d])));
        }
    }
}

DEV void nv_merge(const P& p, int l, long gtid, long gsz) {
    const bf16_t* cols = WSP(bf16_t, WS_COLS);
    const bf16_t* Y = WSP(bf16_t, WS_Y);
    const bf16_t* wt = WSP(bf16_t, WS_WTBR) + (size_t)l * 4 * DM * 256;
    bf16_t* mrg = WSP(bf16_t, WS_MRG);
    for (long it = gtid; it < (long)NTOK * DM; it += gsz) {
        const int d = (int)(it % DM); const int r = (int)(it / DM);
        float tot = 0.f;
        for (int b = 0; b < 4; ++b) {
            const bf16_t* y = Y + (size_t)r * DM + b * 256; const bf16_t* w = wt + ((size_t)b * DM + d) * 256;
            float acc = 0.f;
            for (int k = 0; k < 256; k += 8) {
                float a[8], ww[8]; unpack8(y + k, a); unpack8(w + k, ww);
#pragma unroll
                for (int e = 0; e < 8; ++e) acc += a[e] * ww[e];
            }
            tot += sigm(bf2f(cols[(size_t)r * NC + C_MG + b * DM + d])) * acc;
        }
        mrg[it] = f2bf(tot);
    }
}

DEV void nv_out(const P& p, int l, long gtid, long gsz) {
    float* X = WSP(float, WS_X);
    const float* modv = WSP(float, WS_MODV);
    const P pp = p;
    nv_gemm(WSP(bf16_t, WS_MRG), DM, WSP(bf16_t, WS_WTOUT) + (size_t)l * DM * DM, DM, NTOK, DM, DM, gtid, gsz,
        [=](int r, int n, float v) {
            const float gate = modv[((size_t)l * NCB + row_cb(r)) * 3072 + 2048 + n];
            X[(size_t)r * DM + n] = x_row(pp, l, r)[n] + gate * v;
        });
}

DEV void nv_final(const P& p, long gtid, long gsz) {
    const float* X = WSP(float, WS_X); const float* g = p.in[I_FG];
    for (long r = gtid; r < NTOK; r += gsz) {
        const float* x = X + (size_t)r * DM;
        float ss = 0.f;
        for (int k = 0; k < DM; ++k) ss += x[k] * x[k];
        float rstd = 1.f / sqrtf(ss / DM + 1e-6f);
        for (int k = 0; k < DM; ++k) p.out[O_Y + (size_t)r * DM + k] = x[k] * rstd * g[k];
    }
}

constexpr int ST_PREP_W = 0, ST_PREP_CTX = 1, ST_LAYER0 = 2, ST_PER_LAYER = 8;
constexpr int N_STAGES = ST_LAYER0 + DEPTH * ST_PER_LAYER + 1;
DEV void run_stage(const P& p, int st, long gtid, long gsz) {
    if (st == ST_PREP_W) { nv_prep_w(p, gtid, gsz); return; }
    if (st == ST_PREP_CTX) { nv_prep_ctxmla(p, gtid, gsz); return; }
    if (st == N_STAGES - 1) { nv_final(p, gtid, gsz); return; }
    const int l = (st - ST_LAYER0) / ST_PER_LAYER, s = (st - ST_LAYER0) % ST_PER_LAYER;
    switch (s) {
        case 0: nv_normmod(p, l, gtid, gsz); break;
        case 1: nv_inproj(p, l, gtid, gsz); break;
        case 2: nv_rowprep(p, l, gtid, gsz); break;
        case 3: nv_mlaproj(p, l, gtid, gsz); break;
        case 4: nv_attn(p, l, gtid, gsz); nv_hgrn(p, l, gtid, gsz); break;
        case 5: nv_hgrn_fin(p, l, gtid, gsz); break;
        case 6: nv_merge(p, l, gtid, gsz); break;
        case 7: nv_out(p, l, gtid, gsz); break;
    }
}

#ifndef CPU_EMU
#define LAS __attribute__((address_space(3)))
typedef short bf16x8 __attribute__((ext_vector_type(8)));
typedef float f32x4 __attribute__((ext_vector_type(4)));
typedef unsigned u32x4 __attribute__((ext_vector_type(4)));
constexpr int NTHREADS = 512;
constexpr int LDS_BYTES = 147456;

__device__ __forceinline__ unsigned cvt_pk_bf16(float lo, float hi) { unsigned r; asm volatile("v_cvt_pk_bf16_f32 %0, %1, %2" : "=v"(r) : "v"(lo), "v"(hi)); return r; }
__device__ __forceinline__ u32x4 pack8(f32x4 a, f32x4 b) { u32x4 w; w.x = cvt_pk_bf16(a[0], a[1]); w.y = cvt_pk_bf16(a[2], a[3]); w.z = cvt_pk_bf16(b[0], b[1]); w.w = cvt_pk_bf16(b[2], b[3]); return w; }
__device__ __forceinline__ void unpack8v(u32x4 v, f32x4& a, f32x4& b) {
    a[0] = u2f(v.x << 16); a[1] = u2f(v.x & 0xffff0000u); a[2] = u2f(v.y << 16); a[3] = u2f(v.y & 0xffff0000u);
    b[0] = u2f(v.z << 16); b[1] = u2f(v.z & 0xffff0000u); b[2] = u2f(v.w << 16); b[3] = u2f(v.w & 0xffff0000u);
}

namespace pg8 {
constexpr int BM = 256, BK = 64, HALF = 128, HTB = HALF * BK * 2  , STAGE_BYTES = 8 * HTB, NXCD = 8, WGM = 8;
__device__ __forceinline__ int lds_byte(int r, int c) { const int st = (r >> 4) * 2 + (c >> 5), rr = r & 15, cc = c & 31, ob = rr * 64 + cc * 2; return st * 1024 + (ob ^ (((ob >> 9) & 1) << 5)); }
__device__ __forceinline__ void stage_rc(int b, int& R, int& C) { const int st = b / 1024, sb = b % 1024, swz = sb ^ (((sb >> 9) & 1) << 5); R = (st >> 1) * 16 + swz / 64; C = (st & 1) * 32 + (swz % 64) / 2; }
__device__ __forceinline__ int perm32(int rho) { const int n = rho >> 4, i = rho & 15; return 8 * (i >> 2) + 4 * n + (i & 3); }

struct Unit { int pm, pn, aux; const char* A; const char* B; };
struct Gemm { int lda, ldb, K; };

struct GridOrder {
    int nM, nN, nwg, G, c; const char* A; const char* B; size_t astep, bstep;
    __device__ void init(int M, int N, int G_, int c_, const void* A_, int lda, const void* B_, int ldb) { nM = M / BM; nN = N / BM; nwg = nM * nN; G = G_; c = c_; A = (const char*)A_; B = (const char*)B_; astep = (size_t)BM * lda * 2; bstep = (size_t)BM * ldb * 2; }
    __device__ bool next(int i, Unit& u) const {
        const long L = (long)i * G + c; if (L >= nwg) return false;
        int wgid = (int)L; { const int q = nwg / NXCD, r = nwg % NXCD, xcd = wgid % NXCD, off = wgid / NXCD; wgid = (xcd < r ? xcd * (q + 1) : r * (q + 1) + (xcd - r) * q) + off; }
        const int nig = WGM * nN, gid = wgid / nig, fm = gid * WGM, gsz = (nM - fm) < WGM ? (nM - fm) : WGM;
        u.pm = fm + ((wgid % nig) % gsz); u.pn = (wgid % nig) / gsz; u.aux = 0; u.A = A + (size_t)u.pm * astep; u.B = B + (size_t)u.pn * bstep; return true;
    }
};

template <class F> struct EpiF {
    F f;
    __device__ __forceinline__ void operator()(const f32x4 (&acc)[2][2][4][2], const Unit& u, int wr, int wc, int fr, int fq) const {
#pragma unroll
        for (int ai = 0; ai < 2; ++ai)
#pragma unroll
            for (int m = 0; m < 4; ++m)
#pragma unroll
                for (int bj = 0; bj < 2; ++bj)
                    f(u, u.pm * BM + ai * HALF + wr * 64 + m * 16 + fr, u.pn * BM + bj * HALF + wc * 32 + 8 * fq, acc[ai][bj][m][0], acc[ai][bj][m][1]);
    }
};

template <class Epi, class Sched>
__device__ __forceinline__ void gemm_phase(LAS unsigned char* lds, const Gemm g, const Sched& S, const Epi& E) {
    int tid_ = threadIdx.x; asm volatile("" : "+v"(tid_));
    const int tid = tid_, wid = __builtin_amdgcn_readfirstlane(tid >> 6), lane = tid & 63, wr = wid >> 2, wc = wid & 3, fr = lane & 15, fq = lane >> 4;
    const int K = g.K, nt = K / BK;
    unsigned voffA[2], voffB[2];
#pragma unroll
    for (int i = 0; i < 2; ++i) { int R, C; stage_rc(tid * 16 + i * 8192, R, C); const int Rb = (R & ~31) + perm32(R & 31);
        voffA[i] = (unsigned)(R * g.lda + C) * 2u; voffB[i] = (unsigned)(Rb * g.ldb + C) * 2u; }
    const size_t kstep = (size_t)(BK * 2);
    const size_t hstepA = (size_t)HALF * g.lda * 2, hstepB = (size_t)HALF * g.ldb * 2;
    const unsigned ldsw = (unsigned)wid * 1024u;
    const int aoff = lds_byte(wr * 64 + fr, fq * 8), boff = lds_byte(wc * 32 + fr, fq * 8);
#define PG8_SA(b, h) (((b) * 2 + (h)) * HTB)
#define PG8_SB(b, h) ((4 + (b) * 2 + (h)) * HTB)
#define PG8_STAGE(bufoff, gbase, voff) do { _Pragma("unroll") for (int _i = 0; _i < 2; ++_i) \
        __builtin_amdgcn_global_load_lds((const unsigned*)((const char*)(gbase) + (voff)[_i]), (LAS unsigned*)(lds + (bufoff) + ldsw + _i * 8192), 16, 0, 0); } while (0)
#define PG8_LDA(dst, b, h) do { _Pragma("unroll") for (int m = 0; m < 4; ++m) _Pragma("unroll") for (int k = 0; k < 2; ++k) dst[m][k] = *(const LAS bf16x8*)(lds + PG8_SA(b, h) + aoff + m * 2048 + k * 1024); } while (0)
#define PG8_LDB(dst, b, h) do { _Pragma("unroll") for (int n = 0; n < 2; ++n) _Pragma("unroll") for (int k = 0; k < 2; ++k) dst[n][k] = *(const LAS bf16x8*)(lds + PG8_SB(b, h) + boff + n * 2048 + k * 1024); } while (0)
#define PG8_MMA(ai, bj, At, Bt) do { __builtin_amdgcn_s_setprio(1); _Pragma("unroll") for (int m = 0; m < 4; ++m) _Pragma("unroll") for (int n = 0; n < 2; ++n) _Pragma("unroll") for (int k = 0; k < 2; ++k) \
        acc[ai][bj][m][n] = __builtin_amdgcn_mfma_f32_16x16x32_bf16(Bt[n][k], At[m][k], acc[ai][bj][m][n], 0, 0, 0); __builtin_amdgcn_s_setprio(0); } while (0)
#define PG8_WAIT_V(n) asm volatile("s_waitcnt vmcnt(" #n ")" ::: "memory")
#define PG8_WAIT_L(n) asm volatile("s_waitcnt lgkmcnt(" #n ")" ::: "memory")
#define PG8_BAR __builtin_amdgcn_s_barrier()
#define PG8_SCHED __builtin_amdgcn_sched_barrier(0)
    Unit cur, nxt; int ui = 0;
    if (!S.next(0, cur)) return;
    f32x4 acc[2][2][4][2];
#pragma unroll
    for (int a = 0; a < 2; ++a)
#pragma unroll
        for (int b = 0; b < 2; ++b)
#pragma unroll
            for (int m = 0; m < 4; ++m)
#pragma unroll
                for (int n = 0; n < 2; ++n) acc[a][b][m][n] = (f32x4){0.f, 0.f, 0.f, 0.f};
    bf16x8 At[4][2], B0[2][2], B1[2][2];
    const char* cA = cur.A; const char* cB = cur.B;
    PG8_STAGE(PG8_SB(0, 0), cB, voffB); PG8_STAGE(PG8_SB(0, 1), cB + hstepB, voffB); PG8_STAGE(PG8_SA(0, 0), cA, voffA); PG8_STAGE(PG8_SA(0, 1), cA + hstepA, voffA);
    if (wr == 1) PG8_BAR;
    PG8_WAIT_V(2); PG8_BAR;
    PG8_STAGE(PG8_SB(1, 0), cB + kstep, voffB); PG8_STAGE(PG8_SA(1, 0), cA + kstep, voffA); PG8_STAGE(PG8_SB(1, 1), cB + hstepB + kstep, voffB);
    PG8_WAIT_V(6); PG8_BAR;
    for (;;) {
        const bool has_next = S.next(ui + 1, nxt);
        const char* nA = has_next ? nxt.A : cA; const char* nB = has_next ? nxt.B : cB;
#pragma nounroll
        for (int t = 0; t < nt; t += 2) {
            const bool last = (t == nt - 2);
            const char* a1 = cA + (size_t)(t + 1) * kstep;
            const char* a2 = last ? nA : cA + (size_t)(t + 2) * kstep; const char* b2 = last ? nB : cB + (size_t)(t + 2) * kstep;
            const char* a3 = a2 + kstep; const char* b3 = b2 + kstep;
            PG8_LDB(B0, 0, 0); PG8_LDB(B1, 0, 1); PG8_SCHED; PG8_LDA(At, 0, 0); PG8_STAGE(PG8_SA(1, 1), a1 + hstepA, voffA);
            PG8_WAIT_V(8); PG8_WAIT_L(0); PG8_BAR; PG8_MMA(0, 0, At, B0); PG8_MMA(0, 1, At, B1); PG8_BAR; PG8_SCHED;
            PG8_LDA(At, 0, 1); PG8_STAGE(PG8_SB(0, 0), b2, voffB); PG8_STAGE(PG8_SB(0, 1), b2 + hstepB, voffB); PG8_STAGE(PG8_SA(0, 0), a2, voffA);
            PG8_WAIT_V(8); PG8_WAIT_L(0); PG8_BAR; PG8_MMA(1, 0, At, B0); PG8_MMA(1, 1, At, B1); PG8_BAR; PG8_SCHED;
            PG8_LDB(B0, 1, 0); PG8_LDB(B1, 1, 1); PG8_SCHED; PG8_LDA(At, 1, 0); PG8_STAGE(PG8_SA(0, 1), a2 + hstepA, voffA);
            PG8_WAIT_V(8); PG8_WAIT_L(0); PG8_BAR; PG8_MMA(0, 0, At, B0); PG8_MMA(0, 1, At, B1); PG8_BAR; PG8_SCHED;
            PG8_LDA(At, 1, 1); PG8_STAGE(PG8_SB(1, 0), b3, voffB); PG8_STAGE(PG8_SB(1, 1), b3 + hstepB, voffB); PG8_STAGE(PG8_SA(1, 0), a3, voffA);
            PG8_WAIT_V(8); PG8_WAIT_L(0); PG8_BAR; PG8_MMA(1, 0, At, B0); PG8_MMA(1, 1, At, B1); PG8_BAR; PG8_SCHED;
        }
        if (wr == 0) PG8_BAR;
        E(acc, cur, wr, wc, fr, fq);
        if (!has_next) break;
#pragma unroll
        for (int a = 0; a < 2; ++a)
#pragma unroll
            for (int b = 0; b < 2; ++b)
#pragma unroll
                for (int m = 0; m < 4; ++m)
#pragma unroll
                    for (int n = 0; n < 2; ++n) acc[a][b][m][n] = (f32x4){0.f, 0.f, 0.f, 0.f};
        cur = nxt; cA = nA; cB = nB; ++ui;
        if (wr == 1) PG8_BAR;
    }
    PG8_WAIT_V(0);
    PG8_BAR;
#undef PG8_SA
#undef PG8_SB
#undef PG8_STAGE
#undef PG8_LDA
#undef PG8_LDB
#undef PG8_MMA
#undef PG8_WAIT_V
#undef PG8_WAIT_L
#undef PG8_BAR
#undef PG8_SCHED
}
}

template <class F> __device__ __forceinline__ pg8::EpiF<F> make_epi(F f) { return pg8::EpiF<F>{f}; }

__device__ __forceinline__ void fs_inproj(const P& p, int l, LAS unsigned char* lds) {
    bf16_t* cols = WSP(bf16_t, WS_COLS); float* out = p.out;
    pg8::GridOrder S; S.init(NTOK, NC, gridDim.x, blockIdx.x, WSP(bf16_t, WS_H), DM, WSP(bf16_t, WS_WTIN) + (size_t)l * NC * DM, DM);
    auto E = make_epi([=](const pg8::Unit& u, int r, int n, f32x4 v0, f32x4 v1) {
        *(u32x4*)(cols + (size_t)r * NC + n) = pack8(v0, v1);
        if (r < NCTX) {
            const int b = r / SEQ, t = r % SEQ; const size_t bl = ((size_t)b * DEPTH + l) * SEQ + t;
            float* o = nullptr;
            if (n >= C_NAK && n < C_NAK + 256) o = out + O_NAK + bl * 256 + (n - C_NAK);
            else if (n >= C_NAV && n < C_NAV + 256) o = out + O_NAV + bl * 256 + (n - C_NAV);
            else if (n >= C_WK && n < C_WK + 128) o = out + O_WK + bl * 128 + (n - C_WK);
            else if (n >= C_WV && n < C_WV + 128) o = out + O_WV + bl * 128 + (n - C_WV);
            if (o) { *(f32x4*)o = v0; *(f32x4*)(o + 4) = v1; }
        }
    });
    pg8::gemm_phase(lds, pg8::Gemm{DM, DM, DM}, S, E);
}

struct SubOrder {
    int nM, nN, c, c0, nwgs; const char* A; const char* B; size_t astep, bstep;
    __device__ bool next(int i, pg8::Unit& u) const {
        const int cc = c - c0; if (cc < 0 || cc >= nwgs) return false;
        const int L = i * nwgs + cc; if (L >= nM * nN) return false;
        u.pm = L / nN; u.pn = L % nN; u.aux = 0; u.A = A + (size_t)u.pm * astep; u.B = B + (size_t)u.pn * bstep; return true;
    }
};
__device__ __forceinline__ void fs_mlaproj(const P& p, int l, LAS unsigned char* lds) {
    bf16_t* qm = WSP(bf16_t, WS_QMLA); bf16_t* km = WSP(bf16_t, WS_KMLA); bf16_t* vm = WSP(bf16_t, WS_VMLA);
    const int G = gridDim.x, half = G / 2;
    const bool isq = (int)blockIdx.x < half;
    const int K = isq ? 256 : 128;
    SubOrder S{NTOK / 256, 2, (int)blockIdx.x, isq ? 0 : half, isq ? half : G - half,
               isq ? (const char*)WSP(bf16_t, WS_QN) : (const char*)WSP(bf16_t, WS_CKVB),
               isq ? (const char*)(WSP(bf16_t, WS_WTQB) + (size_t)l * 512 * 256) : (const char*)(WSP(bf16_t, WS_WTKVB) + (size_t)l * 512 * 128),
               (size_t)256 * K * 2, (size_t)256 * K * 2};
    auto E = make_epi([=](const pg8::Unit& u, int r, int n, f32x4 v0, f32x4 v1) {
        const u32x4 w = pack8(v0, v1);
        if (isq) { if (n < 384) *(u32x4*)(qm + (size_t)r * 384 + n) = w; }
        else {
            const int h = n >> 7, e = n & 127;
            if (e < 64) *(u32x4*)(km + (size_t)r * 384 + h * 96 + e) = w; else *(u32x4*)(vm + (size_t)r * 256 + h * 64 + (e - 64)) = w;
        }
    });
    pg8::gemm_phase(lds, pg8::Gemm{K, K, K}, S, E);
}

struct MergeOrder {
    int c, nwgs; const char* Y; const char* W;
    __device__ bool next(int i, pg8::Unit& u) const {
        const int tiles = (NTOK / 256) * 4;
        const int L = (i >> 2) * nwgs + c; if (L >= tiles) return false;
        u.pm = L >> 2; u.pn = L & 3; u.aux = i & 3;
        u.A = Y + ((size_t)u.pm * 256 * DM + u.aux * 256) * 2; u.B = W + ((size_t)u.aux * DM + u.pn * 256) * 256 * 2; return true;
    }
};
__device__ __forceinline__ void fs_merge(const P& p, int l, LAS unsigned char* lds) {
    const bf16_t* cols = WSP(bf16_t, WS_COLS); float* mf = WSP(float, WS_MRGF); bf16_t* mrg = WSP(bf16_t, WS_MRG);
    MergeOrder S{(int)blockIdx.x, (int)gridDim.x, (const char*)WSP(bf16_t, WS_Y), (const char*)(WSP(bf16_t, WS_WTBR) + (size_t)l * 4 * DM * 256)};
    auto E = make_epi([=](const pg8::Unit& u, int r, int n, f32x4 v0, f32x4 v1) {
        const int b = u.aux;
        f32x4 g0, g1; unpack8v(*(const u32x4*)(cols + (size_t)r * NC + C_MG + b * DM + n), g0, g1);
#pragma unroll
        for (int e = 0; e < 4; ++e) { v0[e] *= 1.f / (1.f + __expf(-g0[e])); v1[e] *= 1.f / (1.f + __expf(-g1[e])); }
        float* m = mf + (size_t)r * DM + n;
        if (b > 0) { v0 += *(const f32x4*)m; v1 += *(const f32x4*)(m + 4); }
        if (b < 3) { *(f32x4*)m = v0; *(f32x4*)(m + 4) = v1; }
        else *(u32x4*)(mrg + (size_t)r * DM + n) = pack8(v0, v1);
    });
    pg8::gemm_phase(lds, pg8::Gemm{DM, 256, 256}, S, E);
}

__device__ __forceinline__ void fs_out(const P& p, int l, LAS unsigned char* lds) {
    float* X = WSP(float, WS_X); const float* modv = WSP(float, WS_MODV);
    const float* xp = p.in[I_XP]; const float* xs = p.in[I_XS];
    SubOrder S{NTOK / 256, 4, (int)blockIdx.x, 0, (int)gridDim.x, (const char*)WSP(bf16_t, WS_MRG), (const char*)(WSP(bf16_t, WS_WTOUT) + (size_t)l * DM * DM), (size_t)256 * DM * 2, (size_t)256 * DM * 2};
    auto E = make_epi([=](const pg8::Unit& u, int r, int n, f32x4 v0, f32x4 v1) {
        const float* gate = modv + ((size_t)l * NCB + row_cb(r)) * 3072 + 2048 + n;
        const float* xr = l == 0 ? (r < NCTX ? xp + (size_t)r * DM : xs + (size_t)(r - NCTX) * DM) : X + (size_t)r * DM;
        const f32x4 x0 = *(const f32x4*)(xr + n), x1 = *(const f32x4*)(xr + n + 4);
        const f32x4 g0 = *(const f32x4*)gate, g1 = *(const f32x4*)(gate + 4);
        *(f32x4*)(X + (size_t)r * DM + n) = x0 + g0 * v0; *(f32x4*)(X + (size_t)r * DM + n + 4) = x1 + g1 * v1;
    });
    pg8::gemm_phase(lds, pg8::Gemm{DM, DM, DM}, S, E);
}

__device__ __forceinline__ int otid() { int t = threadIdx.x; asm volatile("" : "+v"(t)); return t; }
constexpr int HG_LD = 72;
constexpr int HG_MAT = 64 * HG_LD * 2;
struct HgPrep { float k[16], b[16]; float btot, ref1; };
__device__ __forceinline__ void hg_prep(const P& p, int tid, int l, int r0, int h, LAS float* seg  , HgPrep& o) {
    const int dir = tid >> 8, tq = (tid >> 6) & 3, d = tid & 63;
    const bf16_t* c = WSP(bf16_t, WS_COLS) + (size_t)(r0 + 16 * tq) * NC + (dir == 0 ? C_HGFF : C_HGFB) + h * 64 + d;
    const float lbv = WSP(float, WS_LBS)[((size_t)l * 2 + dir) * 256 + h * 64 + d];
    float g[16];
#pragma unroll
    for (int i = 0; i < 16; ++i) {
        const float fz = bf2f(c[(size_t)i * NC]);
        const float e = __expf(-fz), inv = 1.f / (1.f + e);
        const float f = fmaxf(lbv + (1.f - lbv) * inv, 1e-30f);
        o.k[i] = (1.f - lbv) * e * inv;
        g[i] = __logf(f);
    }
    float run = 0.f;
    if (dir == 0) {
#pragma unroll
        for (int i = 0; i < 16; ++i) { run += g[i]; o.b[i] = run; }
    } else {
#pragma unroll
        for (int i = 15; i >= 0; --i) { run += g[i]; o.b[i] = run; }
    }
    seg[(dir * 4 + tq) * 64 + d] = run;
    __syncthreads();
    const float s0 = seg[(dir * 4 + 0) * 64 + d], s1 = seg[(dir * 4 + 1) * 64 + d], s2 = seg[(dir * 4 + 2) * 64 + d], s3 = seg[(dir * 4 + 3) * 64 + d];
    float off;
    if (dir == 0) off = tq == 0 ? 0.f : (tq == 1 ? s0 : (tq == 2 ? s0 + s1 : s0 + s1 + s2));
    else off = tq == 3 ? 0.f : (tq == 2 ? s3 : (tq == 1 ? s3 + s2 : s3 + s2 + s1));
#pragma unroll
    for (int i = 0; i < 16; ++i) o.b[i] += off;
    o.btot = (s0 + s1) + (s2 + s3);
    o.ref1 = dir == 0 ? s0 + s1 : s2 + s3;
}
__device__ __forceinline__ void hg_stage_vt(const P& p, int tid, int r0, int h, LAS unsigned char* vt) {
    const int j = tid & 63, sg = tid >> 6;
    const bf16_t* c = WSP(bf16_t, WS_COLS) + (size_t)(r0 + 8 * sg) * NC + C_HGI + h * 64 + j;
    unsigned w[4];
#pragma unroll
    for (int i = 0; i < 4; ++i) w[i] = (unsigned)c[(size_t)(2 * i) * NC] | ((unsigned)c[(size_t)(2 * i + 1) * NC] << 16);
    *(LAS u32x4*)(vt + (j * HG_LD + 8 * sg) * 2) = (u32x4){w[0], w[1], w[2], w[3]};
}
__device__ __forceinline__ void hg_mma_strip(f32x4 (&acc)[4], const LAS unsigned char* A, int arow0, const LAS unsigned char* Bt, int lane) {
    const int fr = lane & 15, fq = lane >> 4;
#pragma unroll
    for (int ks = 0; ks < 2; ++ks) {
        const bf16x8 a = *(const LAS bf16x8*)(A + ((arow0 + fr) * HG_LD + 32 * ks + 8 * fq) * 2);
#pragma unroll
        for (int n = 0; n < 4; ++n) {
            const bf16x8 b = *(const LAS bf16x8*)(Bt + ((16 * n + fr) * HG_LD + 32 * ks + 8 * fq) * 2);
            acc[n] = __builtin_amdgcn_mfma_f32_16x16x32_bf16(a, b, acc[n], 0, 0, 0);
        }
    }
}

__device__ __forceinline__ void fs_hgrn_a(const P& p, int l, LAS unsigned char* lds) {
    LAS float* seg = (LAS float*)lds;
    LAS unsigned char* kt = lds + 2048;
    LAS unsigned char* vt = kt + 2 * HG_MAT;
    const int tid = otid(), lane = tid & 63, wave = tid >> 6, dir = tid >> 8, tq = (tid >> 6) & 3, d = tid & 63;
    for (int u = blockIdx.x; u < (NTOK / 64) * 4; u += gridDim.x) {
        const int gc = u >> 2, h = u & 3, r0 = gc * 64;
        HgPrep hp; hg_prep(p, tid, l, r0, h, seg, hp);
        unsigned w[8];
#pragma unroll
        for (int i = 0; i < 8; ++i) w[i] = cvt_pk_bf16(hp.k[2 * i] * __expf(hp.btot - hp.b[2 * i]), hp.k[2 * i + 1] * __expf(hp.btot - hp.b[2 * i + 1]));
        LAS unsigned char* kd = kt + dir * HG_MAT + (d * HG_LD + 16 * tq) * 2;
        *(LAS u32x4*)kd = (u32x4){w[0], w[1], w[2], w[3]}; *(LAS u32x4*)(kd + 16) = (u32x4){w[4], w[5], w[6], w[7]};
        hg_stage_vt(p, tid, r0, h, vt);
        if (tq == 0) WSP(float, WS_HD)[((size_t)u * 2 + dir) * 64 + d] = __expf(hp.btot);
        __syncthreads();
        f32x4 acc[4];
#pragma unroll
        for (int n = 0; n < 4; ++n) acc[n] = (f32x4){0.f, 0.f, 0.f, 0.f};
        const int w4 = wave & 3;
        hg_mma_strip(acc, kt + dir * HG_MAT, 16 * w4, vt, lane);
        float* L = WSP(float, WS_HL) + ((size_t)u * 2 + dir) * 4096;
#pragma unroll
        for (int n = 0; n < 4; ++n)
#pragma unroll
            for (int e = 0; e < 4; ++e) L[(16 * w4 + 4 * (lane >> 4) + e) * 64 + 16 * n + (lane & 15)] = acc[n][e];
        __syncthreads();
    }
}

__device__ __forceinline__ void fs_hgrn_b(const P& p, int l, long gtid, long gsz) {
    float* HL = WSP(float, WS_HL); const float* HD = WSP(float, WS_HD);
    const long nItems = (long)(BATCH + DB) * 4 * 2 * 4096;
    for (long it = gtid; it < nItems; it += gsz) {
        const int e = (int)(it & 4095), dir = (int)((it >> 12) & 1), h = (int)((it >> 13) & 3), sq = (int)(it >> 15);
        const bool lat = sq >= BATCH; const int b = lat ? sq - BATCH : sq;
        const int nch = lat ? DSEQ / 64 : SEQ / 64, gc0 = lat ? (NCTX + b * DSEQ) / 64 : (b * SEQ) / 64;
        float s = lat ? p.in[I_ST][((((size_t)b * DEPTH + l) * 2 + dir) * 4 + h) * 4096 + e] : 0.f;
        for (int cc = 0; cc < nch; ++cc) {
            const int c = dir == 0 ? cc : nch - 1 - cc;
            const size_t ui = ((size_t)(gc0 + c) * 4 + h) * 2 + dir;
            const float Lv = HL[ui * 4096 + e], Dv = HD[ui * 64 + (e >> 6)];
            HL[ui * 4096 + e] = s;
            s = Dv * s + Lv;
        }
        if (!lat) p.out[O_ST + ((((size_t)b * DEPTH + l) * 2 + dir) * 4 + h) * 4096 + e] = s;
    }
}

__device__ __forceinline__ void fs_hgrn_c(const P& p, int l, LAS unsigned char* lds) {
    LAS float* seg = (LAS float*)lds;
    LAS unsigned char* base = lds + 2048;
    const int tid = otid(), lane = tid & 63, wave = tid >> 6, dir = tid >> 8, tq = (tid >> 6) & 3, d = tid & 63, w4 = wave & 3;
    LAS unsigned char* mQh = base + (dir * 6 + 0) * HG_MAT; LAS unsigned char* mQc = base + (dir * 6 + 1) * HG_MAT;
    LAS unsigned char* mK0 = base + (dir * 6 + 2) * HG_MAT; LAS unsigned char* mK1 = base + (dir * 6 + 3) * HG_MAT;
    LAS unsigned char* mAtt = base + (dir * 6 + 4) * HG_MAT; LAS unsigned char* mSt = base + (dir * 6 + 5) * HG_MAT;
    LAS unsigned char* vt = base + 12 * HG_MAT;
    LAS float* Ob = (LAS float*)(base + 6 * HG_MAT);
    const bf16_t* cols = WSP(bf16_t, WS_COLS);
    for (int u = blockIdx.x; u < (NTOK / 64) * 4; u += gridDim.x) {
        const int gc = u >> 2, h = u & 3, r0 = gc * 64;
        HgPrep hp; hg_prep(p, tid, l, r0, h, seg, hp);
        const bool first = dir == 0 ? (tq < 2) : (tq >= 2);
        {
            const bf16_t* cq = cols + (size_t)(r0 + 16 * tq) * NC + C_HGQ + h * 64 + d;
#pragma unroll
            for (int i = 0; i < 16; ++i) {
                const float qv = bf2f(cq[(size_t)i * NC]);
                const float q = qv / (1.f + __expf(-qv));
                const float bb = hp.b[i];
                const int o = ((16 * tq + i) * HG_LD + d) * 2;
                *(LAS bf16_t*)(mQh + o) = f2bf(q * __expf(first ? bb : bb - hp.ref1));
                *(LAS bf16_t*)(mQc + o) = f2bf(q * __expf(bb));
                *(LAS bf16_t*)(mK0 + o) = first ? f2bf(hp.k[i] * __expf(-bb)) : (bf16_t)0;
                *(LAS bf16_t*)(mK1 + o) = f2bf(hp.k[i] * __expf(hp.ref1 - bb));
            }
        }
        hg_stage_vt(p, tid, r0, h, vt);
        {
            const float* S = WSP(float, WS_HL) + ((size_t)u * 2 + dir) * 4096;
            const int j = tid & 63, dq = (tid >> 6) & 3;
            unsigned w[8];
#pragma unroll
            for (int i = 0; i < 8; ++i) w[i] = cvt_pk_bf16(S[(16 * dq + 2 * i) * 64 + j], S[(16 * dq + 2 * i + 1) * 64 + j]);
            LAS unsigned char* sd = mSt + (j * HG_LD + 16 * dq) * 2;
            *(LAS u32x4*)sd = (u32x4){w[0], w[1], w[2], w[3]}; *(LAS u32x4*)(sd + 16) = (u32x4){w[4], w[5], w[6], w[7]};
        }
        __syncthreads();
        {
            f32x4 acc[4];
#pragma unroll
            for (int n = 0; n < 4; ++n) acc[n] = (f32x4){0.f, 0.f, 0.f, 0.f};
            const bool wfirst = dir == 0 ? (w4 < 2) : (w4 >= 2);
            hg_mma_strip(acc, mQh, 16 * w4, wfirst ? mK0 : mK1, lane);
#pragma unroll
            for (int n = 0; n < 4; ++n)
#pragma unroll
                for (int e = 0; e < 4; ++e) {
                    const int t = 16 * w4 + 4 * (lane >> 4) + e, s = 16 * n + (lane & 15);
                    const bool keep = dir == 0 ? (s <= t) : (s >= t);
                    *(LAS bf16_t*)(mAtt + (t * HG_LD + s) * 2) = keep ? f2bf(acc[n][e]) : (bf16_t)0;
                }
        }
        __syncthreads();
        f32x4 o[4];
#pragma unroll
        for (int n = 0; n < 4; ++n) o[n] = (f32x4){0.f, 0.f, 0.f, 0.f};
        hg_mma_strip(o, mAtt, 16 * w4, vt, lane);
        hg_mma_strip(o, mQc, 16 * w4, mSt, lane);
        __syncthreads();
        if (dir == 1) {
#pragma unroll
            for (int n = 0; n < 4; ++n)
#pragma unroll
                for (int e = 0; e < 4; ++e) Ob[(16 * w4 + 4 * (lane >> 4) + e) * 64 + 16 * n + (lane & 15)] = o[n][e];
        }
        __syncthreads();
        if (dir == 0) {
            const float* gn = p.in[I_HGG] + (size_t)l * 64;
            float ss[4] = {0.f, 0.f, 0.f, 0.f};
#pragma unroll
            for (int n = 0; n < 4; ++n)
#pragma unroll
                for (int e = 0; e < 4; ++e) { o[n][e] += Ob[(16 * w4 + 4 * (lane >> 4) + e) * 64 + 16 * n + (lane & 15)]; ss[e] += o[n][e] * o[n][e]; }
#pragma unroll
            for (int e = 0; e < 4; ++e) {
                float v = ss[e];
                v += __shfl_xor(v, 1); v += __shfl_xor(v, 2); v += __shfl_xor(v, 4); v += __shfl_xor(v, 8);
                ss[e] = 1.f / sqrtf(v * (1.f / 64.f) + 1e-6f);
            }
#pragma unroll
            for (int n = 0; n < 4; ++n)
#pragma unroll
                for (int e = 0; e < 4; ++e) {
                    const int t = 16 * w4 + 4 * (lane >> 4) + e, j = 16 * n + (lane & 15);
                    const bf16_t* c = cols + (size_t)(r0 + t) * NC;
                    const float og = bf2f(c[C_HGOG + h * 64 + j]), z = bf2f(c[C_HGZ + h * 64 + j]);
                    const float v = o[n][e] * ss[e] * gn[j] / (1.f + __expf(-og)) * (z / (1.f + __expf(-z)));
                    WSP(bf16_t, WS_Y)[(size_t)(r0 + t) * DM + 256 + h * 64 + j] = f2bf(v);
                }
        }
        __syncthreads();
    }
}

constexpr int AT_KBUF = 64 * (96 + 8) * 2;
constexpr int AT_VBUF = 64 * 72 * 2;
constexpr int AT_OFF_V = 2 * AT_KBUF, AT_OFF_RPB = AT_OFF_V + 2 * AT_VBUF;
struct AttnSrc { const bf16_t* k; const bf16_t* v; int kp, vp, n; };
struct AttnMask { int type, a, b; };

template <int DQ>
__device__ __forceinline__ void attn_unit(LAS unsigned char* lds, const int tid, const bf16_t* qbase, const int qpitch, const AttnSrc s0, const AttnSrc s1, const AttnMask mk,
                                          const float* rpb, const float sink, const bool has_sink, const float scale, const float* ropeq  ,
                                          const bf16_t* zbase, bf16_t* ybase  ) {
    constexpr int KS = DQ / 32, KP = DQ + 8;
    constexpr float L2E = 1.4426950408889634f;
    const int lane = tid & 63, wave = tid >> 6, c = lane & 15, fq = lane >> 4;
    LAS float* rpbl = (LAS float*)(lds + AT_OFF_RPB);
    if (mk.type == 1) { for (int i = tid; i < 465; i += NTHREADS) rpbl[i] = rpb[i] * L2E; }
    bf16x8 qf[KS];
    {
        const bf16_t* qr = qbase + (size_t)(16 * wave + c) * qpitch + 8 * fq;
#pragma unroll
        for (int ks = 0; ks < KS; ++ks) qf[ks] = *(const bf16x8*)(qr + 32 * ks);
        if (DQ == 96 && ropeq) {
            const u32x4 mine = __builtin_bit_cast(u32x4, qf[KS - 1]);
            u32x4 oth; oth.x = __shfl_xor(mine.x, 32); oth.y = __shfl_xor(mine.y, 32); oth.z = __shfl_xor(mine.z, 32); oth.w = __shfl_xor(mine.w, 32);
            f32x4 m0, m1, o0, o1; unpack8v(mine, m0, m1); unpack8v(oth, o0, o1);
            const float* rr = ropeq + (size_t)(16 * wave + c) * 32 + (8 * (fq & 1)) * 2;
            float r[8];
#pragma unroll
            for (int j = 0; j < 8; ++j) {
                const float cs = rr[2 * j], sn = rr[2 * j + 1];
                const float mv = j < 4 ? m0[j & 3] : m1[j & 3], ov = j < 4 ? o0[j & 3] : o1[j & 3];
                r[j] = fq < 2 ? mv * cs - ov * sn : ov * sn + mv * cs;
            }
            u32x4 w; w.x = cvt_pk_bf16(r[0], r[1]); w.y = cvt_pk_bf16(r[2], r[3]); w.z = cvt_pk_bf16(r[4], r[5]); w.w = cvt_pk_bf16(r[6], r[7]);
            qf[KS - 1] = __builtin_bit_cast(bf16x8, w);
        }
    }
    int qa = 0, qb = 0;
    if (mk.type == 1) { qa = mk.a + (wave >> 2); qb = 16 * (wave & 3) + c; }
    else if (mk.type == 2) { qa = mk.a + 16 * wave + c; }
    int na_rs = qa - 4; na_rs = na_rs < 0 ? 0 : (na_rs > GROWS - 8 ? GROWS - 8 : na_rs);
    int na_cs = qb - 8; na_cs = na_cs < 0 ? 0 : (na_cs > GW - 16 ? GW - 16 : na_cs);
    const float sl2 = scale * L2E;
    float m = has_sink ? sink * L2E : -3.0e38f, lsum = 0.f;
    f32x4 o[4];
#pragma unroll
    for (int n = 0; n < 4; ++n) o[n] = (f32x4){0.f, 0.f, 0.f, 0.f};
    const int nsteps = s0.n + s1.n;
    u32x4 kreg0, kreg1, vreg;
    const int krow0 = DQ == 64 ? (tid >> 3) : tid / 12, kch0 = DQ == 64 ? (tid & 7) : tid % 12;
    const int krow1 = (tid + 512) / 12, kch1 = (tid + 512) % 12;
    const int vkey = tid & 63, vg = tid >> 6;
#define AT_LOAD(step) do { const bool f0_ = (step) < s0.n; const int bi_ = f0_ ? (step) : (step) - s0.n; \
        const bf16_t* kb_ = (f0_ ? s0.k : s1.k) + (size_t)bi_ * 64 * (f0_ ? s0.kp : s1.kp); const int kp_ = f0_ ? s0.kp : s1.kp; \
        const bf16_t* vb_ = (f0_ ? s0.v : s1.v) + (size_t)bi_ * 64 * (f0_ ? s0.vp : s1.vp); const int vp_ = f0_ ? s0.vp : s1.vp; \
        kreg0 = *(const u32x4*)(kb_ + (size_t)krow0 * kp_ + 8 * kch0); \
        if (DQ == 96 && tid < 256) kreg1 = *(const u32x4*)(kb_ + (size_t)krow1 * kp_ + 8 * kch1); \
        vreg = *(const u32x4*)(vb_ + (size_t)vkey * vp_ + 8 * vg); } while (0)
#define AT_STORE(buf) do { LAS unsigned char* kd_ = lds + (buf) * AT_KBUF; LAS unsigned char* vd_ = lds + AT_OFF_V + (buf) * AT_VBUF; \
        *(LAS u32x4*)(kd_ + (krow0 * KP + 8 * kch0) * 2) = kreg0; \
        if (DQ == 96 && tid < 256) *(LAS u32x4*)(kd_ + (krow1 * KP + 8 * kch1) * 2) = kreg1; \
        const unsigned vw_[4] = {vreg.x, vreg.y, vreg.z, vreg.w}; \
        _Pragma("unroll") for (int e_ = 0; e_ < 4; ++e_) { \
            *(LAS bf16_t*)(vd_ + ((8 * vg + 2 * e_) * 72 + vkey) * 2) = (bf16_t)(vw_[e_] & 0xffffu); \
            *(LAS bf16_t*)(vd_ + ((8 * vg + 2 * e_ + 1) * 72 + vkey) * 2) = (bf16_t)(vw_[e_] >> 16); } } while (0)
    AT_LOAD(0); AT_STORE(0);
    __syncthreads();
    for (int step = 0; step < nsteps; ++step) {
        const int buf = step & 1;
        if (step + 1 < nsteps) AT_LOAD(step + 1);
        const LAS unsigned char* kl = lds + buf * AT_KBUF; const LAS unsigned char* vl = lds + AT_OFF_V + buf * AT_VBUF;
        f32x4 acc[4];
#pragma unroll
        for (int n = 0; n < 4; ++n) {
            acc[n] = (f32x4){0.f, 0.f, 0.f, 0.f};
#pragma unroll
            for (int ks = 0; ks < KS; ++ks) {
                const bf16x8 kf = *(const LAS bf16x8*)(kl + ((16 * n + c) * KP + 32 * ks + 8 * fq) * 2);
                acc[n] = __builtin_amdgcn_mfma_f32_16x16x32_bf16(kf, qf[ks], acc[n], 0, 0, 0);
            }
        }
        const bool msk = step < s0.n && mk.type != 0;
        float mloc = -3.0e38f;
#pragma unroll
        for (int n = 0; n < 4; ++n)
#pragma unroll
            for (int e = 0; e < 4; ++e) {
                float sv = acc[n][e] * sl2;
                if (msk) {
                    const int kk = 16 * n + 4 * fq + e;
                    if (mk.type == 1) {
                        const int kr = mk.b + step;
                        const bool ok = kr >= na_rs && kr < na_rs + 8 && kk >= na_cs && kk < na_cs + 16;
                        int dr = kr - qa + 7; dr = dr < 0 ? 0 : (dr > 14 ? 14 : dr);
                        int dc = kk - qb + 15; dc = dc < 0 ? 0 : (dc > 30 ? 30 : dc);
                        sv = ok ? sv + rpbl[dr * 31 + dc] : -1.0e30f;
                    } else {
                        const int dd = mk.b + 64 * step + kk - qa;
                        sv = (dd <= 128 && dd >= -128) ? sv : -1.0e30f;
                    }
                }
                acc[n][e] = sv; mloc = fmaxf(mloc, sv);
            }
        mloc = fmaxf(mloc, __shfl_xor(mloc, 16)); mloc = fmaxf(mloc, __shfl_xor(mloc, 32));
        const float mn = fmaxf(m, mloc), corr = exp2f(m - mn);
        m = mn;
        float ps = 0.f;
#pragma unroll
        for (int n = 0; n < 4; ++n)
#pragma unroll
            for (int e = 0; e < 4; ++e) { const float pv = exp2f(acc[n][e] - mn); acc[n][e] = pv; ps += pv; }
        lsum = lsum * corr + ps;
#pragma unroll
        for (int n = 0; n < 4; ++n) o[n] *= corr;
#pragma unroll
        for (int ks = 0; ks < 2; ++ks) {
            u32x4 pw; pw.x = cvt_pk_bf16(acc[2 * ks][0], acc[2 * ks][1]); pw.y = cvt_pk_bf16(acc[2 * ks][2], acc[2 * ks][3]);
            pw.z = cvt_pk_bf16(acc[2 * ks + 1][0], acc[2 * ks + 1][1]); pw.w = cvt_pk_bf16(acc[2 * ks + 1][2], acc[2 * ks + 1][3]);
            const bf16x8 pf = __builtin_bit_cast(bf16x8, pw);
#pragma unroll
            for (int n = 0; n < 4; ++n) {
                const LAS unsigned char* vr = vl + ((16 * n + c) * 72 + 32 * ks + 4 * fq) * 2;
                typedef unsigned u32x2 __attribute__((ext_vector_type(2)));
                const u32x2 v0 = *(const LAS u32x2*)vr, v1 = *(const LAS u32x2*)(vr + 32);
                const u32x4 vw = (u32x4){v0.x, v0.y, v1.x, v1.y};
                o[n] = __builtin_amdgcn_mfma_f32_16x16x32_bf16(__builtin_bit_cast(bf16x8, vw), pf, o[n], 0, 0, 0);
            }
        }
        if (step + 1 < nsteps) AT_STORE(buf ^ 1);
        __syncthreads();
    }
#undef AT_LOAD
#undef AT_STORE
    lsum += __shfl_xor(lsum, 16); lsum += __shfl_xor(lsum, 32);
    if (has_sink) lsum += exp2f(sink * L2E - m);
    const float inv = 1.f / lsum;
    const bf16_t* zr = zbase + (size_t)(16 * wave + c) * NC; bf16_t* yr = ybase + (size_t)(16 * wave + c) * DM;
#pragma unroll
    for (int n = 0; n < 4; ++n) {
        typedef unsigned u32x2 __attribute__((ext_vector_type(2)));
        const u32x2 zz = *(const u32x2*)(zr + 16 * n + 4 * fq);
        const float z0 = u2f(zz.x << 16), z1 = u2f(zz.x & 0xffff0000u), z2 = u2f(zz.y << 16), z3 = u2f(zz.y & 0xffff0000u);
        u32x2 w;
        w.x = cvt_pk_bf16(o[n][0] * inv * (z0 / (1.f + __expf(-z0))), o[n][1] * inv * (z1 / (1.f + __expf(-z1))));
        w.y = cvt_pk_bf16(o[n][2] * inv * (z2 / (1.f + __expf(-z2))), o[n][3] * inv * (z3 / (1.f + __expf(-z3))));
        *(u32x2*)(yr + 16 * n + 4 * fq) = w;
    }
}

__device__ __forceinline__ void fs_attn(const P& p, int l, LAS unsigned char* lds) {
    const int tid = otid();
    constexpr int NL = (NLAT / 128) * 4, NCU = (NCTX / 128) * 4 * 3, NU = 3 * NL + NCU;
    const bf16_t* cols = WSP(bf16_t, WS_COLS);
    bf16_t* Y = WSP(bf16_t, WS_Y);
    for (int u = blockIdx.x; u < NU; u += gridDim.x) {
        if (u < 3 * NL) {
            const int kind = u / NL, v = u % NL;
            int bh, qt;
            if (NL % 64 == 0) { const int x = v & 7, idx = v >> 3, per = NL / 8; const int bhx = (DB * 4) / 8 > 0 ? (DB * 4) / 8 : 1; bh = x * bhx + idx / (per / bhx); qt = idx % (per / bhx); }
            else { bh = v / (DSEQ / 128); qt = v % (DSEQ / 128); }
            const int b = bh >> 2, h = bh & 3;
            const int r0 = NCTX + b * DSEQ + qt * 128, t0 = qt * 128;
            const size_t cb = ((size_t)b * DEPTH + l) * PAST;
            if (kind == 0) {
                AttnSrc s0{WSP(bf16_t, WS_KMLA) + (size_t)(NCTX + b * DSEQ) * 384 + h * 96, WSP(bf16_t, WS_VMLA) + (size_t)(NCTX + b * DSEQ) * 256 + h * 64, 384, 256, DSEQ / 64};
                AttnSrc s1{WSP(bf16_t, WS_KCM) + cb * 384 + h * 96, WSP(bf16_t, WS_VCM) + cb * 256 + h * 64, 384, 256, PAST / 64};
                attn_unit<96>(lds, tid, WSP(bf16_t, WS_QMLA) + (size_t)r0 * 384 + h * 96, 384, s0, s1, AttnMask{0, 0, 0}, nullptr, 0.f, false, 0.10206207261596577f,
                              WSP(float, WS_ROPEM) + (size_t)t0 * 32, cols + (size_t)r0 * NC + C_MZ + h * 64, Y + (size_t)r0 * DM + 512 + h * 64);
            } else if (kind == 1) {
                const int i0 = 2 * qt;
                int rlo = i0 - 4; rlo = rlo < 0 ? 0 : (rlo > GROWS - 8 ? GROWS - 8 : rlo);
                int rhi = i0 + 1 - 4; rhi = (rhi < 0 ? 0 : (rhi > GROWS - 8 ? GROWS - 8 : rhi)) + 8;
                const size_t kr0 = (size_t)(NCTX + b * DSEQ + rlo * 64);
                AttnSrc s0{cols + kr0 * NC + C_NAK + h * 64, cols + kr0 * NC + C_NAV + h * 64, NC, NC, rhi - rlo};
                AttnSrc s1{WSP(bf16_t, WS_CNAK) + cb * 256 + h * 64, WSP(bf16_t, WS_CNAV) + cb * 256 + h * 64, 256, 256, PAST / 64};
                attn_unit<64>(lds, tid, cols + (size_t)r0 * NC + C_NAQ + h * 64, NC, s0, s1, AttnMask{1, i0, rlo}, p.in[I_RPB] + ((size_t)l * 4 + h) * 465, 0.f, false, 0.125f,
                              nullptr, cols + (size_t)r0 * NC + C_NAZ + h * 64, Y + (size_t)r0 * DM + 0 + h * 64);
            } else {
                const int kh = h >> 1;
                const int klo = t0 - 128 < 0 ? 0 : t0 - 128, khi = t0 + 256 > DSEQ ? DSEQ : t0 + 256;
                const size_t kr0 = (size_t)(NCTX + b * DSEQ + klo);
                AttnSrc s0{WSP(bf16_t, WS_WKR) + kr0 * 128 + kh * 64, cols + kr0 * NC + C_WV + kh * 64, 128, NC, (khi - klo) / 64};
                AttnSrc s1{WSP(bf16_t, WS_CWK) + cb * 128 + kh * 64, WSP(bf16_t, WS_CWV) + cb * 128 + kh * 64, 128, 128, PAST / 64};
                attn_unit<64>(lds, tid, WSP(bf16_t, WS_WQR) + (size_t)r0 * 256 + h * 64, 256, s0, s1, AttnMask{2, t0, klo}, nullptr, p.in[I_SINK][l * 4 + h], true, 0.125f,
                              nullptr, cols + (size_t)r0 * NC + C_WZ + h * 64, Y + (size_t)r0 * DM + 768 + h * 64);
            }
        } else {
            const int v = u - 3 * NL, kind = v % 3, h = (v / 3) & 3, tile = v / 12;
            const int r0 = tile * 128, sq0 = (r0 / SEQ) * SEQ;
            const AttnSrc none{nullptr, nullptr, 0, 0, 0};
            if (kind == 0) {
                AttnSrc s0{cols + (size_t)sq0 * NC + C_NAK + h * 64, cols + (size_t)sq0 * NC + C_NAV + h * 64, NC, NC, SEQ / 64};
                attn_unit<64>(lds, tid, cols + (size_t)r0 * NC + C_NAQ + h * 64, NC, s0, none, AttnMask{0, 0, 0}, nullptr, 0.f, false, 0.125f, nullptr,
                              cols + (size_t)r0 * NC + C_NAZ + h * 64, Y + (size_t)r0 * DM + 0 + h * 64);
            } else if (kind == 1) {
                AttnSrc s0{WSP(bf16_t, WS_KMLA) + (size_t)sq0 * 384 + h * 96, WSP(bf16_t, WS_VMLA) + (size_t)sq0 * 256 + h * 64, 384, 256, SEQ / 64};
                attn_unit<96>(lds, tid, WSP(bf16_t, WS_QMLA) + (size_t)r0 * 384 + h * 96, 384, s0, none, AttnMask{0, 0, 0}, nullptr, 0.f, false, 0.10206207261596577f, nullptr,
                              cols + (size_t)r0 * NC + C_MZ + h * 64, Y + (size_t)r0 * DM + 512 + h * 64);
            } else {
                const int kh = h >> 1;
                AttnSrc s0{WSP(bf16_t, WS_WKR) + (size_t)sq0 * 128 + kh * 64, cols + (size_t)sq0 * NC + C_WV + kh * 64, 128, NC, SEQ / 64};
                attn_unit<64>(lds, tid, WSP(bf16_t, WS_WQR) + (size_t)r0 * 256 + h * 64, 256, s0, none, AttnMask{0, 0, 0}, nullptr, p.in[I_SINK][l * 4 + h], true, 0.125f, nullptr,
                              cols + (size_t)r0 * NC + C_WZ + h * 64, Y + (size_t)r0 * DM + 768 + h * 64);
            }
        }
    }
}

namespace cg = cooperative_groups;
__global__ void __launch_bounds__(NTHREADS) mega_kernel(P p) {
    extern __shared__ __attribute__((aligned(16))) unsigned char lds_raw[];
    LAS unsigned char* lds = (LAS unsigned char*)lds_raw;
    cg::grid_group grid = cg::this_grid();
    const long gsz = (long)gridDim.x * blockDim.x;
#define GTID() ({ int t_ = threadIdx.x; asm volatile("" : "+v"(t_)); (long)blockIdx.x * blockDim.x + t_; })
#define PP ({ const __attribute__((address_space(4))) P* k_ = (const __attribute__((address_space(4))) P*)__builtin_amdgcn_kernarg_segment_ptr(); asm volatile("" : "+s"(k_)); k_; })
#define PPR (*(const P*)PP)
    nv_prep_w(PPR, GTID(), gsz); grid.sync();
    nv_prep_ctxmla(PPR, GTID(), gsz); grid.sync();
#pragma nounroll
    for (int l = 0; l < DEPTH; ++l) {
        nv_normmod(PPR, l, GTID(), gsz); grid.sync();
        fs_inproj(PPR, l, lds); grid.sync();
        nv_rowprep(PPR, l, GTID(), gsz); fs_hgrn_a(PPR, l, lds); grid.sync();
        fs_mlaproj(PPR, l, lds); grid.sync();
        fs_hgrn_b(PPR, l, GTID(), gsz); fs_attn(PPR, l, lds); grid.sync();
        fs_hgrn_c(PPR, l, lds); grid.sync();
        fs_merge(PPR, l, lds); grid.sync();
        fs_out(PPR, l, lds); grid.sync();
    }
    nv_final(PPR, GTID(), gsz);
}

extern "C" void kernel_launch(void* const* d_in, const int* in_sizes, int n_in, void* d_out, int out_size, void* d_ws, size_t ws_size, hipStream_t stream) {
    static int grid_blocks = 0;
    if (grid_blocks == 0) {
        if (n_in != N_IN || (size_t)out_size != O_END || ws_size < WS_END) {
            fprintf(stderr, "kernel_launch: unexpected sizes n_in %d out %d ws %zu (need %zu)\n", n_in, out_size, ws_size, (size_t)WS_END);
            grid_blocks = -1; return;
        }
        int dev = 0, cus = 0, per_cu = 0;
        hipGetDevice(&dev);
        hipDeviceGetAttribute(&cus, hipDeviceAttributeMultiprocessorCount, dev);
        hipFuncSetAttribute((const void*)mega_kernel, hipFuncAttributeMaxDynamicSharedMemorySize, LDS_BYTES);
        hipOccupancyMaxActiveBlocksPerMultiprocessor(&per_cu, (const void*)mega_kernel, NTHREADS, LDS_BYTES);
        if (per_cu < 1) per_cu = 1;
        grid_blocks = cus * per_cu;
    }
    if (grid_blocks < 0) return;
    P p{};
    for (int i = 0; i < N_IN; ++i) p.in[i] = (const float*)d_in[i];
    p.out = (float*)d_out; p.ws = (unsigned char*)d_ws;
    void* args[] = {&p};
    hipError_t e = hipLaunchCooperativeKernel((const void*)mega_kernel, dim3(grid_blocks), dim3(NTHREADS), args, LDS_BYTES, stream);
    if (e != hipSuccess) fprintf(stderr, "cooperative launch failed: %s (grid %d)\n", hipGetErrorString(e), grid_blocks);
}
#endif
```

```cpp
#ifndef CPU_EMU
#include <hip/hip_runtime.h>
#include <hip/hip_cooperative_groups.h>
#include <cstdio>
#define DEV __device__ __forceinline__
#else
#include <cmath>
#include <cstdio>
#include <cstring>
#define DEV inline
#endif
#include <cstdint>
#include <cstddef>

#ifndef CFG_BATCH
#define CFG_BATCH 16
#endif
#ifndef CFG_DEPTH
#define CFG_DEPTH 4
#endif
#ifndef CFG_DEC_BATCH
#define CFG_DEC_BATCH 4
#endif
constexpr int DM = 1024, BATCH = CFG_BATCH, SEQ = 256, DEPTH = CFG_DEPTH, DB = CFG_DEC_BATCH, DSEQ = 2048, PAST = 512;
constexpr int NCTX = BATCH * SEQ, NLAT = DB * DSEQ, NTOK = NCTX + NLAT;
constexpr int NCB = 1 + DB;
constexpr int INW = 8096, NC = 8192;
constexpr int GW = 64, GROWS = DSEQ / GW;
constexpr int C_NAQ = 0, C_NAK = 256, C_NAV = 512, C_NAZ = 768, C_HGQ = 1024, C_HGFF = 1280, C_HGFB = 1536, C_HGI = 1792, C_HGOG = 2048, C_HGZ = 2304,
              C_MQA = 2560, C_CKV = 2816, C_MZ = 2944, C_WQ = 3200, C_WK = 3456, C_WV = 3584, C_WZ = 3712, C_KR = 3968, C_PAD = 4000, C_MG = 4096;
DEV int orig_col(int c) {
    if (c < 2944) return c;
    if (c < 3968) return c + 32;
    if (c < 4000) return 2944 + (c - 3968);
    if (c < 4096) return -1;
    return c - 96;
}
enum { I_XP = 0, I_XS, I_CNAK, I_CNAV, I_ST, I_CCKV, I_CKR, I_CWK, I_CWV, I_C, I_CCTX, I_NG, I_WMOD, I_BMOD, I_WIN, I_RPB, I_LB, I_HGG, I_QG, I_KVG, I_WQB, I_WKVB, I_SINK, I_WBR, I_WOUT, I_FG, N_IN };
constexpr size_t O_Y = 0;
constexpr size_t O_NAK = (size_t)NTOK * DM;
constexpr size_t O_NAV = O_NAK + (size_t)BATCH * DEPTH * SEQ * 256;
constexpr size_t O_ST = O_NAV + (size_t)BATCH * DEPTH * SEQ * 256;
constexpr size_t O_CKV = O_ST + (size_t)BATCH * DEPTH * 2 * 4 * 64 * 64;
constexpr size_t O_KR = O_CKV + (size_t)BATCH * DEPTH * SEQ * 128;
constexpr size_t O_WK = O_KR + (size_t)BATCH * DEPTH * SEQ * 32;
constexpr size_t O_WV = O_WK + (size_t)BATCH * DEPTH * SEQ * 128;
constexpr size_t O_END = O_WV + (size_t)BATCH * DEPTH * SEQ * 128;

typedef unsigned short bf16_t;
constexpr size_t al256(size_t x) { return (x + 255) & ~(size_t)255; }
constexpr size_t WS_CTL = 0;
constexpr size_t WS_WTIN = 1u << 20;
constexpr size_t WS_WTBR = WS_WTIN + (size_t)DEPTH * NC * DM * 2;
constexpr size_t WS_WTOUT = WS_WTBR + (size_t)DEPTH * 4 * DM * 256 * 2;
constexpr size_t WS_WTQB = WS_WTOUT + (size_t)DEPTH * DM * DM * 2;
constexpr size_t WS_WTKVB = WS_WTQB + (size_t)DEPTH * 512 * 256 * 2;
constexpr size_t WS_MODV = WS_WTKVB + (size_t)DEPTH * 512 * 128 * 2;
constexpr size_t WS_LBS = al256(WS_MODV + (size_t)DEPTH * NCB * 3072 * 4);
constexpr size_t WS_ROPEM = al256(WS_LBS + (size_t)DEPTH * 2 * 256 * 4);
constexpr size_t WS_ROPEW = al256(WS_ROPEM + (size_t)DSEQ * 16 * 2 * 4);
constexpr size_t WS_X = al256(WS_ROPEW + (size_t)DSEQ * 32 * 2 * 4);
constexpr size_t WS_H = WS_X + (size_t)NTOK * DM * 4;
constexpr size_t WS_COLS = WS_H + (size_t)NTOK * DM * 2;
constexpr size_t WS_KCM = WS_COLS + (size_t)NTOK * NC * 2;
constexpr size_t WS_VCM = WS_KCM + (size_t)DB * DEPTH * PAST * 384 * 2;
constexpr size_t WS_QN = WS_VCM + (size_t)DB * DEPTH * PAST * 256 * 2;
constexpr size_t WS_CKVB = WS_QN + (size_t)NTOK * 256 * 2;
constexpr size_t WS_QMLA = WS_CKVB + (size_t)NTOK * 128 * 2;
constexpr size_t WS_KMLA = WS_QMLA + (size_t)NTOK * 384 * 2;
constexpr size_t WS_VMLA = WS_KMLA + (size_t)NTOK * 384 * 2;
constexpr size_t WS_WQR = WS_VMLA + (size_t)NTOK * 256 * 2;
constexpr size_t WS_WKR = WS_WQR + (size_t)NTOK * 256 * 2;
constexpr size_t WS_OH = WS_WKR + (size_t)NTOK * 128 * 2;
constexpr size_t WS_Y = WS_OH + (size_t)2 * NTOK * 256 * 4;
constexpr size_t WS_MRG = WS_H;
constexpr size_t WS_HD = WS_Y + (size_t)NTOK * DM * 2;
constexpr size_t WS_CNAK = al256(WS_HD + (size_t)(NTOK / 64) * 4 * 2 * 64 * 4);
constexpr size_t WS_CNAV = WS_CNAK + (size_t)DB * DEPTH * PAST * 256 * 2;
constexpr size_t WS_CWK = WS_CNAV + (size_t)DB * DEPTH * PAST * 256 * 2;
constexpr size_t WS_CWV = WS_CWK + (size_t)DB * DEPTH * PAST * 128 * 2;
constexpr size_t WS_CCKVB = WS_CWV + (size_t)DB * DEPTH * PAST * 128 * 2;
constexpr size_t WS_END = WS_CCKVB + (size_t)DB * DEPTH * PAST * 128 * 2;
constexpr size_t WS_HL = WS_OH;
constexpr size_t WS_MRGF = WS_QN;
static_assert(WS_MRGF + (size_t)NTOK * DM * 4 <= WS_Y, "MRGF alias must end before Y");

struct P {
    const float* in[N_IN];
    float* out;
    unsigned char* ws;
};

DEV unsigned f2u(float f) { unsigned u; memcpy(&u, &f, 4); return u; }
DEV float u2f(unsigned u) { float f; memcpy(&f, &u, 4); return f; }
DEV bf16_t f2bf(float f) { unsigned u = f2u(f); return (bf16_t)((u + 0x7fffu + ((u >> 16) & 1u)) >> 16); }
DEV float bf2f(bf16_t b) { return u2f((unsigned)b << 16); }
DEV float rbf(float f) { return bf2f(f2bf(f)); }
DEV float sigm(float x) { return 1.f / (1.f + expf(-x)); }
DEV float siluf(float x) { return x * sigm(x); }
DEV int row_cb(int r) { return r < NCTX ? 0 : 1 + (r - NCTX) / DSEQ; }

struct U4 { unsigned x, y, z, w; };
DEV void unpack8(const bf16_t* p, float* f) {
    U4 v = *(const U4*)p;
    f[0] = u2f(v.x << 16); f[1] = u2f(v.x & 0xffff0000u); f[2] = u2f(v.y << 16); f[3] = u2f(v.y & 0xffff0000u);
    f[4] = u2f(v.z << 16); f[5] = u2f(v.z & 0xffff0000u); f[6] = u2f(v.w << 16); f[7] = u2f(v.w & 0xffff0000u);
}

#define WSP(T, off) ((T*)(p.ws + (off)))

DEV void nv_prep_w(const P& p, long gtid, long gsz) {
    bf16_t* wtin = WSP(bf16_t, WS_WTIN);
    const float* win = p.in[I_WIN];
    for (long i = gtid; i < (long)DEPTH * NC * DM; i += gsz) {
        int k = (int)(i % DM); long t = i / DM; int n = (int)(t % NC); int l = (int)(t / NC);
        int oc = orig_col(n);
        wtin[i] = oc < 0 ? (bf16_t)0 : f2bf(win[((size_t)l * DM + k) * INW + oc]);
    }
    bf16_t* wtbr = WSP(bf16_t, WS_WTBR);
    const float* wbr = p.in[I_WBR];
    for (long i = gtid; i < (long)DEPTH * 4 * DM * 256; i += gsz) {
        int w = (int)(i % 256); long t = i / 256; int d = (int)(t % DM); t /= DM; int b = (int)(t % 4); int l = (int)(t / 4);
        wtbr[i] = f2bf(wbr[(((size_t)l * 4 + b) * 256 + w) * DM + d]);
    }
    bf16_t* wtout = WSP(bf16_t, WS_WTOUT);
    const float* wout = p.in[I_WOUT];
    for (long i = gtid; i < (long)DEPTH * DM * DM; i += gsz) {
        int k = (int)(i % DM); long t = i / DM; int n = (int)(t % DM); int l = (int)(t / DM);
        wtout[i] = f2bf(wout[((size_t)l * DM + k) * DM + n]);
    }
    bf16_t* wtqb = WSP(bf16_t, WS_WTQB);
    const float* wqb = p.in[I_WQB];
    for (long i = gtid; i < (long)DEPTH * 512 * 256; i += gsz) {
        int k = (int)(i % 256); long t = i / 256; int n = (int)(t % 512); int l = (int)(t / 512);
        wtqb[i] = n < 384 ? f2bf(wqb[((size_t)l * 256 + k) * 384 + n]) : (bf16_t)0;
    }
    bf16_t* wtkvb = WSP(bf16_t, WS_WTKVB);
    const float* wkvb = p.in[I_WKVB];
    for (long i = gtid; i < (long)DEPTH * 512 * 128; i += gsz) {
        int k = (int)(i % 128); long t = i / 128; int n = (int)(t % 512); int l = (int)(t / 512);
        wtkvb[i] = f2bf(wkvb[((size_t)l * 128 + k) * 512 + n]);
    }
    float* modv = WSP(float, WS_MODV);
    for (long i = gtid; i < (long)DEPTH * NCB * 3072; i += gsz) {
        int j = (int)(i % 3072); long t = i / 3072; int cb = (int)(t % NCB); int l = (int)(t / NCB);
        const float* cv = cb == 0 ? p.in[I_CCTX] : p.in[I_C] + (size_t)(cb - 1) * DM;
        const float* w = p.in[I_WMOD] + (size_t)l * DM * 3072 + j;
        float acc = 0.f;
        for (int k = 0; k < DM; ++k) acc += siluf(cv[k]) * w[(size_t)k * 3072];
        modv[i] = acc + p.in[I_BMOD][(size_t)l * 3072 + j];
    }
    float* lbs = WSP(float, WS_LBS);
    for (long i = gtid; i < 2 * 256; i += gsz) {
        const float* lg = p.in[I_LB];
        float mx = -1e30f;
        for (int l = 0; l < DEPTH; ++l) mx = fmaxf(mx, lg[(size_t)l * 512 + i]);
        float s = 0.f;
        for (int l = 0; l < DEPTH; ++l) s += expf(lg[(size_t)l * 512 + i] - mx);
        float cum = 0.f, p0 = expf(lg[i] - mx) / s;
        for (int l = 0; l < DEPTH; ++l) { cum += expf(lg[(size_t)l * 512 + i] - mx) / s; lbs[(size_t)l * 512 + i] = cum - p0; }
    }
    float* rm = WSP(float, WS_ROPEM);
    for (long i = gtid; i < (long)DSEQ * 16; i += gsz) {
        int j = (int)(i % 16), t = (int)(i / 16);
        float pos = j < 8 ? (float)(t / GW) : (float)(t % GW);
        float inv = powf(10000.f, -(float)(j & 7) / 8.f);
        float a = pos * inv; rm[i * 2] = cosf(a); rm[i * 2 + 1] = sinf(a);
    }
    float* rw = WSP(float, WS_ROPEW);
    for (long i = gtid; i < (long)DSEQ * 32; i += gsz) {
        int j = (int)(i % 32), t = (int)(i / 32);
        float pos = j < 16 ? (float)(t / GW) : (float)(t % GW);
        float inv = powf(10000.f, -(float)(j & 15) / 16.f);
        float a = pos * inv; rw[i * 2] = cosf(a); rw[i * 2 + 1] = sinf(a);
    }
}

DEV void nv_prep_ctxmla(const P& p, long gtid, long gsz) {
    const bf16_t* wtkvb = WSP(bf16_t, WS_WTKVB);
    bf16_t* kcm = WSP(bf16_t, WS_KCM); bf16_t* vcm = WSP(bf16_t, WS_VCM);
    for (long i = gtid; i < (long)DB * DEPTH * PAST * 512; i += gsz) {
        int n = (int)(i % 512); long row = i / 512;
        int l = (int)((row / PAST) % DEPTH);
        const float* ck = p.in[I_CCKV] + (size_t)row * 128;
        const bf16_t* w = wtkvb + ((size_t)l * 512 + n) * 128;
        float acc = 0.f;
        for (int j = 0; j < 128; ++j) acc += rbf(ck[j]) * bf2f(w[j]);
        int h = n / 128, e = n % 128;
        if (e < 64) kcm[(size_t)row * 384 + h * 96 + e] = f2bf(acc);
        else vcm[(size_t)row * 256 + h * 64 + (e - 64)] = f2bf(acc);
    }
    for (long i = gtid; i < (long)DB * DEPTH * PAST * 128; i += gsz) {
        int e = (int)(i % 32); int h = (int)((i / 32) % 4); long row = i / 128;
        kcm[(size_t)row * 384 + h * 96 + 64 + e] = f2bf(p.in[I_CKR][(size_t)row * 32 + e]);
    }
    for (long i = gtid; i < (long)DB * DEPTH * PAST * 256; i += gsz) { WSP(bf16_t, WS_CNAK)[i] = f2bf(p.in[I_CNAK][i]); WSP(bf16_t, WS_CNAV)[i] = f2bf(p.in[I_CNAV][i]); }
    for (long i = gtid; i < (long)DB * DEPTH * PAST * 128; i += gsz) { WSP(bf16_t, WS_CWK)[i] = f2bf(p.in[I_CWK][i]); WSP(bf16_t, WS_CWV)[i] = f2bf(p.in[I_CWV][i]); }
}

DEV const float* x_row(const P& p, int l, int r) {
    if (l == 0) return r < NCTX ? p.in[I_XP] + (size_t)r * DM : p.in[I_XS] + (size_t)(r - NCTX) * DM;
    return WSP(float, WS_X) + (size_t)r * DM;
}

DEV void nv_normmod(const P& p, int l, long gtid, long gsz) {
    bf16_t* H = WSP(bf16_t, WS_H);
    const float* g = p.in[I_NG] + (size_t)l * DM;
    for (long r = gtid; r < NTOK; r += gsz) {
        const float* x = x_row(p, l, (int)r);
        const float* mv = WSP(float, WS_MODV) + ((size_t)l * NCB + row_cb((int)r)) * 3072;
        float ss = 0.f;
        for (int k = 0; k < DM; ++k) ss += x[k] * x[k];
        float rstd = 1.f / sqrtf(ss / DM + 1e-6f);
        for (int k = 0; k < DM; ++k) H[(size_t)r * DM + k] = f2bf(x[k] * rstd * g[k] * (1.f + mv[1024 + k]) + mv[k]);
    }
}

template <class Epi>
DEV void nv_gemm(const bf16_t* A, int lda, const bf16_t* Wt, int ldw, int M, int N, int K, long gtid, long gsz, Epi epi) {
    const long nItems = (long)(M / 4) * (N / 4);
    for (long it = gtid; it < nItems; it += gsz) {
        const int cb = (int)(it % (N / 4)), rb = (int)(it / (N / 4));
        float acc[4][4];
#pragma unroll
        for (int i = 0; i < 4; ++i)
#pragma unroll
            for (int j = 0; j < 4; ++j) acc[i][j] = 0.f;
        for (int k = 0; k < K; k += 8) {
            float a[4][8], w[4][8];
#pragma unroll
            for (int i = 0; i < 4; ++i) unpack8(A + (size_t)(rb * 4 + i) * lda + k, a[i]);
#pragma unroll
            for (int j = 0; j < 4; ++j) unpack8(Wt + (size_t)(cb * 4 + j) * ldw + k, w[j]);
#pragma unroll
            for (int i = 0; i < 4; ++i)
#pragma unroll
                for (int j = 0; j < 4; ++j)
#pragma unroll
                    for (int e = 0; e < 8; ++e) acc[i][j] += a[i][e] * w[j][e];
        }
#pragma unroll
        for (int i = 0; i < 4; ++i)
#pragma unroll
            for (int j = 0; j < 4; ++j) epi(rb * 4 + i, cb * 4 + j, acc[i][j]);
    }
}

DEV void nv_inproj(const P& p, int l, long gtid, long gsz) {
    bf16_t* cols = WSP(bf16_t, WS_COLS);
    float* out = p.out;
    nv_gemm(WSP(bf16_t, WS_H), DM, WSP(bf16_t, WS_WTIN) + (size_t)l * NC * DM, DM, NTOK, NC, DM, gtid, gsz,
        [=](int r, int n, float v) {
            cols[(size_t)r * NC + n] = f2bf(v);
            if (r < NCTX) {
                const int b = r / SEQ, t = r % SEQ; const size_t bl = ((size_t)b * DEPTH + l) * SEQ + t;
                if (n >= C_NAK && n < C_NAK + 256) out[O_NAK + bl * 256 + (n - C_NAK)] = v;
                else if (n >= C_NAV && n < C_NAV + 256) out[O_NAV + bl * 256 + (n - C_NAV)] = v;
                else if (n >= C_WK && n < C_WK + 128) out[O_WK + bl * 128 + (n - C_WK)] = v;
                else if (n >= C_WV && n < C_WV + 128) out[O_WV + bl * 128 + (n - C_WV)] = v;
            }
        });
}

DEV void nv_rowprep(const P& p, int l, long gtid, long gsz) {
    const bf16_t* cols = WSP(bf16_t, WS_COLS);
    for (long r = gtid; r < NTOK; r += gsz) {
        const bf16_t* c = cols + (size_t)r * NC;
        const bool lat = r >= NCTX; const int t = lat ? (int)((r - NCTX) % DSEQ) : 0;
        {
            float ss = 0.f;
            for (int j = 0; j < 128; ++j) { float v = bf2f(c[C_CKV + j]); ss += v * v; }
            float rstd = 1.f / sqrtf(ss / 128.f + 1e-6f);
            const float* g = p.in[I_KVG] + (size_t)l * 128;
            for (int j = 0; j < 128; ++j) {
                float v = bf2f(c[C_CKV + j]) * rstd * g[j];
                WSP(bf16_t, WS_CKVB)[(size_t)r * 128 + j] = f2bf(v);
                if (!lat) p.out[O_CKV + (((size_t)(r / SEQ) * DEPTH + l) * SEQ + (r % SEQ)) * 128 + j] = v;
            }
        }
        {
            const float* rm = WSP(float, WS_ROPEM) + (size_t)t * 32;
            for (int j = 0; j < 16; ++j) {
                float x1 = bf2f(c[C_KR + j]), x2 = bf2f(c[C_KR + 16 + j]);
                float o1 = x1, o2 = x2;
                if (lat) { float cs = rm[j * 2], sn = rm[j * 2 + 1]; o1 = x1 * cs - x2 * sn; o2 = x1 * sn + x2 * cs; }
                else {
                    size_t o = O_KR + (((size_t)(r / SEQ) * DEPTH + l) * SEQ + (r % SEQ)) * 32;
                    p.out[o + j] = x1; p.out[o + 16 + j] = x2;
                }
                for (int h = 0; h < 4; ++h) {
                    WSP(bf16_t, WS_KMLA)[(size_t)r * 384 + h * 96 + 64 + j] = f2bf(o1);
                    WSP(bf16_t, WS_KMLA)[(size_t)r * 384 + h * 96 + 80 + j] = f2bf(o2);
                }
            }
        }
        {
            float ss = 0.f;
            for (int j = 0; j < 256; ++j) { float v = bf2f(c[C_MQA + j]); ss += v * v; }
            float rstd = 1.f / sqrtf(ss / 256.f + 1e-6f);
            const float* g = p.in[I_QG] + (size_t)l * 256;
            for (int j = 0; j < 256; ++j) WSP(bf16_t, WS_QN)[(size_t)r * 256 + j] = f2bf(bf2f(c[C_MQA + j]) * rstd * g[j]);
        }
        {
            const float* rw = WSP(float, WS_ROPEW) + (size_t)t * 64;
            for (int hh = 0; hh < 6; ++hh) {
                const bf16_t* src = hh < 4 ? c + C_WQ + hh * 64 : c + C_WK + (hh - 4) * 64;
                bf16_t* dst = hh < 4 ? WSP(bf16_t, WS_WQR) + (size_t)r * 256 + hh * 64 : WSP(bf16_t, WS_WKR) + (size_t)r * 128 + (hh - 4) * 64;
                for (int j = 0; j < 32; ++j) {
                    float x1 = bf2f(src[j]), x2 = bf2f(src[32 + j]);
                    if (lat) { float cs = rw[j * 2], sn = rw[j * 2 + 1]; dst[j] = f2bf(x1 * cs - x2 * sn); dst[32 + j] = f2bf(x1 * sn + x2 * cs); }
                    else { dst[j] = src[j]; dst[32 + j] = src[32 + j]; }
                }
            }
        }
    }
}

DEV void nv_mlaproj(const P& p, int l, long gtid, long gsz) {
    bf16_t* qm = WSP(bf16_t, WS_QMLA); bf16_t* km = WSP(bf16_t, WS_KMLA); bf16_t* vm = WSP(bf16_t, WS_VMLA);
    nv_gemm(WSP(bf16_t, WS_QN), 256, WSP(bf16_t, WS_WTQB) + (size_t)l * 512 * 256, 256, NTOK, 384, 256, gtid, gsz,
        [=](int r, int n, float v) { qm[(size_t)r * 384 + n] = f2bf(v); });
    nv_gemm(WSP(bf16_t, WS_CKVB), 128, WSP(bf16_t, WS_WTKVB) + (size_t)l * 512 * 128, 128, NTOK, 512, 128, gtid, gsz,
        [=](int r, int n, float v) {
            int h = n / 128, e = n % 128;
            if (e < 64) km[(size_t)r * 384 + h * 96 + e] = f2bf(v); else vm[(size_t)r * 256 + h * 64 + (e - 64)] = f2bf(v);
        });
}

struct SoftAcc { float m, l; float o[32]; };
DEV void sa_init(SoftAcc& s) { s.m = -3e38f; s.l = 0.f;
#pragma unroll
    for (int d = 0; d < 32; ++d) s.o[d] = 0.f; }
DEV void sa_add(SoftAcc& s, float sc, const bf16_t* v) {
    float mn = fmaxf(s.m, sc);
    float corr = expf(s.m - mn), pe = expf(sc - mn);
    s.m = mn; s.l = s.l * corr + pe;
#pragma unroll
    for (int d8 = 0; d8 < 4; ++d8) {
        float f[8]; unpack8(v + d8 * 8, f);
#pragma unroll
        for (int e = 0; e < 8; ++e) s.o[d8 * 8 + e] = s.o[d8 * 8 + e] * corr + pe * f[e];
    }
}
DEV void sa_add_f32v(SoftAcc& s, float sc, const float* v) {
    float mn = fmaxf(s.m, sc);
    float corr = expf(s.m - mn), pe = expf(sc - mn);
    s.m = mn; s.l = s.l * corr + pe;
#pragma unroll
    for (int d = 0; d < 32; ++d) s.o[d] = s.o[d] * corr + pe * rbf(v[d]);
}
template <int DQ> DEV float dot_bf(const float* q, const bf16_t* k) {
    float acc = 0.f;
#pragma unroll
    for (int d8 = 0; d8 < DQ / 8; ++d8) {
        float f[8]; unpack8(k + d8 * 8, f);
#pragma unroll
        for (int e = 0; e < 8; ++e) acc += q[d8 * 8 + e] * f[e];
    }
    return acc;
}
DEV float dot64_f32k(const float* q, const float* k) {
    float acc = 0.f;
#pragma unroll
    for (int d = 0; d < 64; ++d) acc += q[d] * rbf(k[d]);
    return acc;
}
DEV void sa_store(const P& p, const SoftAcc& s, float extra_den, int r, int branch, int h, int zcol, int half) {
    const bf16_t* c = WSP(bf16_t, WS_COLS) + (size_t)r * NC + zcol + h * 64 + half * 32;
    bf16_t* y = WSP(bf16_t, WS_Y) + (size_t)r * DM + branch * 256 + h * 64 + half * 32;
    float inv = 1.f / (s.l + extra_den);
#pragma unroll
    for (int d = 0; d < 32; ++d) y[d] = f2bf(s.o[d] * inv * siluf(bf2f(c[d])));
}

DEV void nv_attn(const P& p, int l, long gtid, long gsz) {
    const bf16_t* cols = WSP(bf16_t, WS_COLS);
    for (long it = gtid; it < (long)NTOK * 24; it += gsz) {
        const int half = (int)(it % 2); const int kind = (int)((it / 2) % 3); const int h = (int)((it / 6) % 4); const int r = (int)(it / 24);
        const int vo = half * 32;
        const bool lat = r >= NCTX;
        const int b = lat ? (r - NCTX) / DSEQ : r / SEQ, t = lat ? (r - NCTX) % DSEQ : r % SEQ;
        const int seq0 = lat ? NCTX + b * DSEQ : b * SEQ;
        SoftAcc s; sa_init(s);
        if (kind == 0) {
            float q[64];
#pragma unroll
            for (int d8 = 0; d8 < 8; ++d8) unpack8(cols + (size_t)r * NC + C_NAQ + h * 64 + d8 * 8, q + d8 * 8);
            if (!lat) {
                for (int j = 0; j < SEQ; ++j) {
                    const bf16_t* kr = cols + (size_t)(seq0 + j) * NC;
                    sa_add(s, dot_bf<64>(q, kr + C_NAK + h * 64) * 0.125f, kr + C_NAV + h * 64 + vo);
                }
            } else {
                const int gi = t / GW, gj = t % GW;
                int rs = gi - 4; rs = rs < 0 ? 0 : (rs > GROWS - 8 ? GROWS - 8 : rs);
                int cs = gj - 8; cs = cs < 0 ? 0 : (cs > GW - 16 ? GW - 16 : cs);
                const float* rpb = p.in[I_RPB] + ((size_t)l * 4 + h) * 15 * 31;
                for (int kr_ = rs; kr_ < rs + 8; ++kr_)
                    for (int kc = cs; kc < cs + 16; ++kc) {
                        const bf16_t* kk = cols + (size_t)(seq0 + kr_ * GW + kc) * NC;
                        int dc = kc - gj + 15; dc = dc < 0 ? 0 : (dc > 30 ? 30 : dc);
                        float bias = rpb[(kr_ - gi + 7) * 31 + dc];
                        sa_add(s, dot_bf<64>(q, kk + C_NAK + h * 64) * 0.125f + bias, kk + C_NAV + h * 64 + vo);
                    }
                const float* ck = p.in[I_CNAK] + ((size_t)b * DEPTH + l) * PAST * 256 + h * 64;
                const float* cv = p.in[I_CNAV] + ((size_t)b * DEPTH + l) * PAST * 256 + h * 64 + vo;
                for (int j = 0; j < PAST; ++j) sa_add_f32v(s, dot64_f32k(q, ck + (size_t)j * 256) * 0.125f, cv + (size_t)j * 256);
            }
            sa_store(p, s, 0.f, r, 0, h, C_NAZ, half);
        } else if (kind == 1) {
            float q[96];
            const bf16_t* qp = WSP(bf16_t, WS_QMLA) + (size_t)r * 384 + h * 96;
#pragma unroll
            for (int d8 = 0; d8 < 12; ++d8) unpack8(qp + d8 * 8, q + d8 * 8);
            if (lat) {
                const float* rm = WSP(float, WS_ROPEM) + (size_t)t * 32;
#pragma unroll
                for (int j = 0; j < 16; ++j) {
                    float x1 = q[64 + j], x2 = q[80 + j], cs = rm[j * 2], sn = rm[j * 2 + 1];
                    q[64 + j] = rbf(x1 * cs - x2 * sn); q[80 + j] = rbf(x1 * sn + x2 * cs);
                }
            }
            const float scale = 0.10206207261596577f;
            const int n = lat ? DSEQ : SEQ;
            const bf16_t* km = WSP(bf16_t, WS_KMLA) + (size_t)seq0 * 384 + h * 96;
            const bf16_t* vm = WSP(bf16_t, WS_VMLA) + (size_t)seq0 * 256 + h * 64 + vo;
            for (int j = 0; j < n; ++j) sa_add(s, dot_bf<96>(q, km + (size_t)j * 384) * scale, vm + (size_t)j * 256);
            if (lat) {
                const bf16_t* kc = WSP(bf16_t, WS_KCM) + ((size_t)b * DEPTH + l) * PAST * 384 + h * 96;
                const bf16_t* vc = WSP(bf16_t, WS_VCM) + ((size_t)b * DEPTH + l) * PAST * 256 + h * 64 + vo;
                for (int j = 0; j < PAST; ++j) sa_add(s, dot_bf<96>(q, kc + (size_t)j * 384) * scale, vc + (size_t)j * 256);
            }
            sa_store(p, s, 0.f, r, 2, h, C_MZ, half);
        } else {
            float q[64];
#pragma unroll
            for (int d8 = 0; d8 < 8; ++d8) unpack8(WSP(bf16_t, WS_WQR) + (size_t)r * 256 + h * 64 + d8 * 8, q + d8 * 8);
            const int kh = h / 2;
            const float sink = p.in[I_SINK][l * 4 + h];
            int j0 = 0, j1 = SEQ;
            if (lat) { j0 = t - 128 < 0 ? 0 : t - 128; j1 = t + 129 > DSEQ ? DSEQ : t + 129; }
            for (int j = j0; j < j1; ++j)
                sa_add(s, dot_bf<64>(q, WSP(bf16_t, WS_WKR) + (size_t)(seq0 + j) * 128 + kh * 64) * 0.125f, cols + (size_t)(seq0 + j) * NC + C_WV + kh * 64 + vo);
            if (lat) {
                const float* ck = p.in[I_CWK] + ((size_t)b * DEPTH + l) * PAST * 128 + kh * 64;
                const float* cv = p.in[I_CWV] + ((size_t)b * DEPTH + l) * PAST * 128 + kh * 64 + vo;
                for (int j = 0; j < PAST; ++j) sa_add_f32v(s, dot64_f32k(q, ck + (size_t)j * 128) * 0.125f, cv + (size_t)j * 128);
            }
            float mn = fmaxf(s.m, sink); float corr = expf(s.m - mn);
            s.l *= corr;
#pragma unroll
            for (int d = 0; d < 32; ++d) s.o[d] *= corr;
            s.m = mn;
            sa_store(p, s, expf(sink - mn), r, 3, h, C_WZ, half);
        }
    }
}

DEV void nv_hgrn(const P& p, int l, long gtid, long gsz) {
    const bf16_t* cols = WSP(bf16_t, WS_COLS);
    float* oh = WSP(float, WS_OH);
    const int NSEQ = BATCH + DB;
    for (long it = gtid; it < (long)NSEQ * 4 * 2 * 64; it += gsz) {
        const int j = (int)(it % 64); const int dir = (int)((it / 64) % 2); const int h = (int)((it / 128) % 4); const int sq = (int)(it / 512);
        const bool lat = sq >= BATCH;
        const int b = lat ? sq - BATCH : sq;
        const int T = lat ? DSEQ : SEQ; const int seq0 = lat ? NCTX + b * DSEQ : b * SEQ;
        const float* lb = WSP(float, WS_LBS) + ((size_t)l * 2 + dir) * 256 + h * 64;
        float S[64];
        if (lat) {
            const float* st = p.in[I_ST] + ((((size_t)b * DEPTH + l) * 2 + dir) * 4 + h) * 4096;
#pragma unroll
            for (int d = 0; d < 64; ++d) S[d] = st[d * 64 + j];
        } else {
#pragma unroll
            for (int d = 0; d < 64; ++d) S[d] = 0.f;
        }
        const int fcol = dir == 0 ? C_HGFF : C_HGFB;
        for (int tt = 0; tt < T; ++tt) {
            const int t = dir == 0 ? tt : T - 1 - tt;
            const bf16_t* c = cols + (size_t)(seq0 + t) * NC;
            const float v = bf2f(c[C_HGI + h * 64 + j]);
            float o = 0.f;
#pragma unroll
            for (int d8 = 0; d8 < 8; ++d8) {
                float fz[8], qq[8]; unpack8(c + fcol + h * 64 + d8 * 8, fz); unpack8(c + C_HGQ + h * 64 + d8 * 8, qq);
#pragma unroll
                for (int e = 0; e < 8; ++e) {
                    const int d = d8 * 8 + e;
                    const float lbv = lb[d];
                    float f = lbv + (1.f - lbv) * sigm(fz[e]);
                    f = fmaxf(f, 1e-30f);
                    const float k = (1.f - lbv) * sigm(-fz[e]);
                    S[d] = f * S[d] + k * v;
                    o += S[d] * siluf(qq[e]);
                }
            }
            oh[((size_t)dir * NTOK + seq0 + t) * 256 + h * 64 + j] = o;
        }
        if (!lat) {
            float* so = p.out + O_ST + ((((size_t)b * DEPTH + l) * 2 + dir) * 4 + h) * 4096;
#pragma unroll
            for (int d = 0; d < 64; ++d) so[d * 64 + j] = S[d];
        }
    }
}

DEV void nv_hgrn_fin(const P& p, int l, long gtid, long gsz) {
    const bf16_t* cols = WSP(bf16_t, WS_COLS);
    const float* oh = WSP(float, WS_OH);
    const float* g = p.in[I_HGG] + (size_t)l * 64;
    for (long it = gtid; it < (long)NTOK * 4; it += gsz) {
        const int h = (int)(it % 4); const int r = (int)(it / 4);
        const float* of = oh + (size_t)r * 256 + h * 64; const float* ob = oh + ((size_t)NTOK + r) * 256 + h * 64;
        float ss = 0.f;
        for (int d = 0; d < 64; ++d) { float v = of[d] + ob[d]; ss += v * v; }
        float rstd = 1.f / sqrtf(ss / 64.f + 1e-6f);
        const bf16_t* c = cols + (size_t)r * NC;
        bf16_t* y = WSP(bf16_t, WS_Y) + (size_t)r * DM + 256 + h * 64;
        for (int d = 0; d < 64; ++d) {
            float v = (of[d] + ob[d]) * rstd * g[d] * sigm(bf2f(c[C_HGOG + h * 64 + d]));
            y[d] = f2bf(v * siluf(bf2f(c[C_HGZ + h * 64 + d])));
        }
    }
}

DEV void nv_merge(const P& p, int l, long gtid, long gsz) {
    const bf16_t* cols = WSP(bf16_t, WS_COLS);
    const bf16_t* Y = WSP(bf16_t, WS_Y);
    const bf16_t* wt = WSP(bf16_t, WS_WTBR) + (size_t)l * 4 * DM * 256;
    bf16_t* mrg = WSP(bf16_t, WS_MRG);
    for (long it = gtid; it < (long)NTOK * DM; it += gsz) {
        const int d = (int)(it % DM); const int r = (int)(it / DM);
        float tot = 0.f;
        for (int b = 0; b < 4; ++b) {
            const bf16_t* y = Y + (size_t)r * DM + b * 256; const bf16_t* w = wt + ((size_t)b * DM + d) * 256;
            float acc = 0.f;
            for (int k = 0; k < 256; k += 8) {
                float a[8], ww[8]; unpack8(y + k, a); unpack8(w + k, ww);
#pragma unroll
                for (int e = 0; e < 8; ++e) acc += a[e] * ww[e];
            }
            tot += sigm(bf2f(cols[(size_t)r * NC + C_MG + b * DM + d])) * acc;
        }
        mrg[it] = f2bf(tot);
    }
}

DEV void nv_out(const P& p, int l, long gtid, long gsz) {
    float* X = WSP(float, WS_X);
    const float* modv = WSP(float, WS_MODV);
    const P pp = p;
    nv_gemm(WSP(bf16_t, WS_MRG), DM, WSP(bf16_t, WS_WTOUT) + (size_t)l * DM * DM, DM, NTOK, DM, DM, gtid, gsz,
        [=](int r, int n, float v) {
            const float gate = modv[((size_t)l * NCB + row_cb(r)) * 3072 + 2048 + n];
            X[(size_t)r * DM + n] = x_row(pp, l, r)[n] + gate * v;
        });
}

DEV void nv_final(const P& p, long gtid, long gsz) {
    const float* X = WSP(float, WS_X); const float* g = p.in[I_FG];
    for (long r = gtid; r < NTOK; r += gsz) {
        const float* x = X + (size_t)r * DM;
        float ss = 0.f;
        for (int k = 0; k < DM; ++k) ss += x[k] * x[k];
        float rstd = 1.f / sqrtf(ss / DM + 1e-6f);
        for (int k = 0; k < DM; ++k) p.out[O_Y + (size_t)r * DM + k] = x[k] * rstd * g[k];
    }
}

constexpr int ST_PREP_W = 0, ST_PREP_CTX = 1, ST_LAYER0 = 2, ST_PER_LAYER = 8;
constexpr int N_STAGES = ST_LAYER0 + DEPTH * ST_PER_LAYER + 1;
DEV void run_stage(const P& p, int st, long gtid, long gsz) {
    if (st == ST_PREP_W) { nv_prep_w(p, gtid, gsz); return; }
    if (st == ST_PREP_CTX) { nv_prep_ctxmla(p, gtid, gsz); return; }
    if (st == N_STAGES - 1) { nv_final(p, gtid, gsz); return; }
    const int l = (st - ST_LAYER0) / ST_PER_LAYER, s = (st - ST_LAYER0) % ST_PER_LAYER;
    switch (s) {
        case 0: nv_normmod(p, l, gtid, gsz); break;
        case 1: nv_inproj(p, l, gtid, gsz); break;
        case 2: nv_rowprep(p, l, gtid, gsz); break;
        case 3: nv_mlaproj(p, l, gtid, gsz); break;
        case 4: nv_attn(p, l, gtid, gsz); nv_hgrn(p, l, gtid, gsz); break;
        case 5: nv_hgrn_fin(p, l, gtid, gsz); break;
        case 6: nv_merge(p, l, gtid, gsz); break;
        case 7: nv_out(p, l, gtid, gsz); break;
    }
}

#ifndef CPU_EMU
#define LAS __attribute__((address_space(3)))
typedef short bf16x8 __attribute__((ext_vector_type(8)));
typedef float f32x4 __attribute__((ext_vector_type(4)));
typedef unsigned u32x4 __attribute__((ext_vector_type(4)));
constexpr int NTHREADS = 512;
constexpr int LDS_BYTES = 147456;

__device__ __forceinline__ unsigned cvt_pk_bf16(float lo, float hi) { unsigned r; asm volatile("v_cvt_pk_bf16_f32 %0, %1, %2" : "=v"(r) : "v"(lo), "v"(hi)); return r; }
__device__ __forceinline__ u32x4 pack8(f32x4 a, f32x4 b) { u32x4 w; w.x = cvt_pk_bf16(a[0], a[1]); w.y = cvt_pk_bf16(a[2], a[3]); w.z = cvt_pk_bf16(b[0], b[1]); w.w = cvt_pk_bf16(b[2], b[3]); return w; }
__device__ __forceinline__ void unpack8v(u32x4 v, f32x4& a, f32x4& b) {
    a[0] = u2f(v.x << 16); a[1] = u2f(v.x & 0xffff0000u); a[2] = u2f(v.y << 16); a[3] = u2f(v.y & 0xffff0000u);
    b[0] = u2f(v.z << 16); b[1] = u2f(v.z & 0xffff0000u); b[2] = u2f(v.w << 16); b[3] = u2f(v.w & 0xffff0000u);
}

namespace pg8 {
constexpr int BM = 256, BK = 64, HALF = 128, HTB = HALF * BK * 2  , STAGE_BYTES = 8 * HTB, NXCD = 8, WGM = 8;
__device__ __forceinline__ int lds_byte(int r, int c) { const int st = (r >> 4) * 2 + (c >> 5), rr = r & 15, cc = c & 31, ob = rr * 64 + cc * 2; return st * 1024 + (ob ^ (((ob >> 9) & 1) << 5)); }
__device__ __forceinline__ void stage_rc(int b, int& R, int& C) { const int st = b / 1024, sb = b % 1024, swz = sb ^ (((sb >> 9) & 1) << 5); R = (st >> 1) * 16 + swz / 64; C = (st & 1) * 32 + (swz % 64) / 2; }
__device__ __forceinline__ int perm32(int rho) { const int n = rho >> 4, i = rho & 15; return 8 * (i >> 2) + 4 * n + (i & 3); }

struct Unit { int pm, pn, aux; const char* A; const char* B; };
struct Gemm { int lda, ldb, K; };

struct GridOrder {
    int nM, nN, nwg, G, c; const char* A; const char* B; size_t astep, bstep;
    __device__ void init(int M, int N, int G_, int c_, const void* A_, int lda, const void* B_, int ldb) { nM = M / BM; nN = N / BM; nwg = nM * nN; G = G_; c = c_; A = (const char*)A_; B = (const char*)B_; astep = (size_t)BM * lda * 2; bstep = (size_t)BM * ldb * 2; }
    __device__ bool next(int i, Unit& u) const {
        const long L = (long)i * G + c; if (L >= nwg) return false;
        int wgid = (int)L; { const int q = nwg / NXCD, r = nwg % NXCD, xcd = wgid % NXCD, off = wgid / NXCD; wgid = (xcd < r ? xcd * (q + 1) : r * (q + 1) + (xcd - r) * q) + off; }
        const int nig = WGM * nN, gid = wgid / nig, fm = gid * WGM, gsz = (nM - fm) < WGM ? (nM - fm) : WGM;
        u.pm = fm + ((wgid % nig) % gsz); u.pn = (wgid % nig) / gsz; u.aux = 0; u.A = A + (size_t)u.pm * astep; u.B = B + (size_t)u.pn * bstep; return true;
    }
};

template <class F> struct EpiF {
    F f;
    __device__ __forceinline__ void operator()(const f32x4 (&acc)[2][2][4][2], const Unit& u, int wr, int wc, int fr, int fq) const {
#pragma unroll
        for (int ai = 0; ai < 2; ++ai)
#pragma unroll
            for (int m = 0; m < 4; ++m)
#pragma unroll
                for (int bj = 0; bj < 2; ++bj)
                    f(u, u.pm * BM + ai * HALF + wr * 64 + m * 16 + fr, u.pn * BM + bj * HALF + wc * 32 + 8 * fq, acc[ai][bj][m][0], acc[ai][bj][m][1]);
    }
};

template <class Epi, class Sched>
__device__ __forceinline__ void gemm_phase(LAS unsigned char* lds, const Gemm g, const Sched& S, const Epi& E) {
    int tid_ = threadIdx.x; asm volatile("" : "+v"(tid_));
    const int tid = tid_, wid = __builtin_amdgcn_readfirstlane(tid >> 6), lane = tid & 63, wr = wid >> 2, wc = wid & 3, fr = lane & 15, fq = lane >> 4;
    const int K = g.K, nt = K / BK;
    unsigned voffA[2], voffB[2];
#pragma unroll
    for (int i = 0; i < 2; ++i) { int R, C; stage_rc(tid * 16 + i * 8192, R, C); const int Rb = (R & ~31) + perm32(R & 31);
        voffA[i] = (unsigned)(R * g.lda + C) * 2u; voffB[i] = (unsigned)(Rb * g.ldb + C) * 2u; }
    const size_t kstep = (size_t)(BK * 2);
    const size_t hstepA = (size_t)HALF * g.lda * 2, hstepB = (size_t)HALF * g.ldb * 2;
    const unsigned ldsw = (unsigned)wid * 1024u;
    const int aoff = lds_byte(wr * 64 + fr, fq * 8), boff = lds_byte(wc * 32 + fr, fq * 8);
#define PG8_SA(b, h) (((b) * 2 + (h)) * HTB)
#define PG8_SB(b, h) ((4 + (b) * 2 + (h)) * HTB)
#define PG8_STAGE(bufoff, gbase, voff) do { _Pragma("unroll") for (int _i = 0; _i < 2; ++_i) \
        __builtin_amdgcn_global_load_lds((const unsigned*)((const char*)(gbase) + (voff)[_i]), (LAS unsigned*)(lds + (bufoff) + ldsw + _i * 8192), 16, 0, 0); } while (0)
#define PG8_LDA(dst, b, h) do { _Pragma("unroll") for (int m = 0; m < 4; ++m) _Pragma("unroll") for (int k = 0; k < 2; ++k) dst[m][k] = *(const LAS bf16x8*)(lds + PG8_SA(b, h) + aoff + m * 2048 + k * 1024); } while (0)
#define PG8_LDB(dst, b, h) do { _Pragma("unroll") for (int n = 0; n < 2; ++n) _Pragma("unroll") for (int k = 0; k < 2; ++k) dst[n][k] = *(const LAS bf16x8*)(lds + PG8_SB(b, h) + boff + n * 2048 + k * 1024); } while (0)
#define PG8_MMA(ai, bj, At, Bt) do { __builtin_amdgcn_s_setprio(1); _Pragma("unroll") for (int m = 0; m < 4; ++m) _Pragma("unroll") for (int n = 0; n < 2; ++n) _Pragma("unroll") for (int k = 0; k < 2; ++k) \
        acc[ai][bj][m][n] = __builtin_amdgcn_mfma_f32_16x16x32_bf16(Bt[n][k], At[m][k], acc[ai][bj][m][n], 0, 0, 0); __builtin_amdgcn_s_setprio(0); } while (0)
#define PG8_WAIT_V(n) asm volatile("s_waitcnt vmcnt(" #n ")" ::: "memory")
#define PG8_WAIT_L(n) asm volatile("s_waitcnt lgkmcnt(" #n ")" ::: "memory")
#define PG8_BAR __builtin_amdgcn_s_barrier()
#define PG8_SCHED __builtin_amdgcn_sched_barrier(0)
    Unit cur, nxt; int ui = 0;
    if (!S.next(0, cur)) return;
    f32x4 acc[2][2][4][2];
#pragma unroll
    for (int a = 0; a < 2; ++a)
#pragma unroll
        for (int b = 0; b < 2; ++b)
#pragma unroll
            for (int m = 0; m < 4; ++m)
#pragma unroll
                for (int n = 0; n < 2; ++n) acc[a][b][m][n] = (f32x4){0.f, 0.f, 0.f, 0.f};
    bf16x8 At[4][2], B0[2][2], B1[2][2];
    const char* cA = cur.A; const char* cB = cur.B;
    PG8_STAGE(PG8_SB(0, 0), cB, voffB); PG8_STAGE(PG8_SB(0, 1), cB + hstepB, voffB); PG8_STAGE(PG8_SA(0, 0), cA, voffA); PG8_STAGE(PG8_SA(0, 1), cA + hstepA, voffA);
    if (wr == 1) PG8_BAR;
    PG8_WAIT_V(2); PG8_BAR;
    PG8_STAGE(PG8_SB(1, 0), cB + kstep, voffB); PG8_STAGE(PG8_SA(1, 0), cA + kstep, voffA); PG8_STAGE(PG8_SB(1, 1), cB + hstepB + kstep, voffB);
    PG8_WAIT_V(6); PG8_BAR;
    for (;;) {
        const bool has_next = S.next(ui + 1, nxt);
        const char* nA = has_next ? nxt.A : cA; const char* nB = has_next ? nxt.B : cB;
#pragma nounroll
        for (int t = 0; t < nt; t += 2) {
            const bool last = (t == nt - 2);
            const char* a1 = cA + (size_t)(t + 1) * kstep;
            const char* a2 = last ? nA : cA + (size_t)(t + 2) * kstep; const char* b2 = last ? nB : cB + (size_t)(t + 2) * kstep;
            const char* a3 = a2 + kstep; const char* b3 = b2 + kstep;
            PG8_LDB(B0, 0, 0); PG8_LDB(B1, 0, 1); PG8_SCHED; PG8_LDA(At, 0, 0); PG8_STAGE(PG8_SA(1, 1), a1 + hstepA, voffA);
            PG8_WAIT_V(8); PG8_WAIT_L(0); PG8_BAR; PG8_MMA(0, 0, At, B0); PG8_MMA(0, 1, At, B1); PG8_BAR; PG8_SCHED;
            PG8_LDA(At, 0, 1); PG8_STAGE(PG8_SB(0, 0), b2, voffB); PG8_STAGE(PG8_SB(0, 1), b2 + hstepB, voffB); PG8_STAGE(PG8_SA(0, 0), a2, voffA);
            PG8_WAIT_V(8); PG8_WAIT_L(0); PG8_BAR; PG8_MMA(1, 0, At, B0); PG8_MMA(1, 1, At, B1); PG8_BAR; PG8_SCHED;
            PG8_LDB(B0, 1, 0); PG8_LDB(B1, 1, 1); PG8_SCHED; PG8_LDA(At, 1, 0); PG8_STAGE(PG8_SA(0, 1), a2 + hstepA, voffA);
            PG8_WAIT_V(8); PG8_WAIT_L(0); PG8_BAR; PG8_MMA(0, 0, At, B0); PG8_MMA(0, 1, At, B1); PG8_BAR; PG8_SCHED;
            PG8_LDA(At, 1, 1); PG8_STAGE(PG8_SB(1, 0), b3, voffB); PG8_STAGE(PG8_SB(1, 1), b3 + hstepB, voffB); PG8_STAGE(PG8_SA(1, 0), a3, voffA);
            PG8_WAIT_V(8); PG8_WAIT_L(0); PG8_BAR; PG8_MMA(1, 0, At, B0); PG8_MMA(1, 1, At, B1); PG8_BAR; PG8_SCHED;
        }
        if (wr == 0) PG8_BAR;
        E(acc, cur, wr, wc, fr, fq);
        if (!has_next) break;
#pragma unroll
        for (int a = 0; a < 2; ++a)
#pragma unroll
            for (int b = 0; b < 2; ++b)
#pragma unroll
                for (int m = 0; m < 4; ++m)
#pragma unroll
                    for (int n = 0; n < 2; ++n) acc[a][b][m][n] = (f32x4){0.f, 0.f, 0.f, 0.f};
        cur = nxt; cA = nA; cB = nB; ++ui;
        if (wr == 1) PG8_BAR;
    }
    PG8_WAIT_V(0);
    PG8_BAR;
#undef PG8_SA
#undef PG8_SB
#undef PG8_STAGE
#undef PG8_LDA
#undef PG8_LDB
#undef PG8_MMA
#undef PG8_WAIT_V
#undef PG8_WAIT_L
#undef PG8_BAR
#undef PG8_SCHED
}
}

template <class F> __device__ __forceinline__ pg8::EpiF<F> make_epi(F f) { return pg8::EpiF<F>{f}; }

__device__ __forceinline__ void fs_inproj(const P& p, int l, LAS unsigned char* lds) {
    bf16_t* cols = WSP(bf16_t, WS_COLS); float* out = p.out;
    pg8::GridOrder S; S.init(NTOK, NC, gridDim.x, blockIdx.x, WSP(bf16_t, WS_H), DM, WSP(bf16_t, WS_WTIN) + (size_t)l * NC * DM, DM);
    auto E = make_epi([=](const pg8::Unit& u, int r, int n, f32x4 v0, f32x4 v1) {
        *(u32x4*)(cols + (size_t)r * NC + n) = pack8(v0, v1);
        if (r < NCTX) {
            const int b = r / SEQ, t = r % SEQ; const size_t bl = ((size_t)b * DEPTH + l) * SEQ + t;
            float* o = nullptr;
            if (n >= C_NAK && n < C_NAK + 256) o = out + O_NAK + bl * 256 + (n - C_NAK);
            else if (n >= C_NAV && n < C_NAV + 256) o = out + O_NAV + bl * 256 + (n - C_NAV);
            else if (n >= C_WK && n < C_WK + 128) o = out + O_WK + bl * 128 + (n - C_WK);
            else if (n >= C_WV && n < C_WV + 128) o = out + O_WV + bl * 128 + (n - C_WV);
            if (o) { *(f32x4*)o = v0; *(f32x4*)(o + 4) = v1; }
        }
    });
    pg8::gemm_phase(lds, pg8::Gemm{DM, DM, DM}, S, E);
}

struct SubOrder {
    int nM, nN, c, c0, nwgs; const char* A; const char* B; size_t astep, bstep;
    __device__ bool next(int i, pg8::Unit& u) const {
        const int cc = c - c0; if (cc < 0 || cc >= nwgs) return false;
        const int L = i * nwgs + cc; if (L >= nM * nN) return false;
        u.pm = L / nN; u.pn = L % nN; u.aux = 0; u.A = A + (size_t)u.pm * astep; u.B = B + (size_t)u.pn * bstep; return true;
    }
};
__device__ __forceinline__ void fs_mlaproj(const P& p, int l, LAS unsigned char* lds) {
    bf16_t* qm = WSP(bf16_t, WS_QMLA); bf16_t* km = WSP(bf16_t, WS_KMLA); bf16_t* vm = WSP(bf16_t, WS_VMLA);
    const int G = gridDim.x, half = G / 2;
    const bool isq = (int)blockIdx.x < half;
    const int K = isq ? 256 : 128;
    SubOrder S{NTOK / 256, 2, (int)blockIdx.x, isq ? 0 : half, isq ? half : G - half,
               isq ? (const char*)WSP(bf16_t, WS_QN) : (const char*)WSP(bf16_t, WS_CKVB),
               isq ? (const char*)(WSP(bf16_t, WS_WTQB) + (size_t)l * 512 * 256) : (const char*)(WSP(bf16_t, WS_WTKVB) + (size_t)l * 512 * 128),
               (size_t)256 * K * 2, (size_t)256 * K * 2};
    auto E = make_epi([=](const pg8::Unit& u, int r, int n, f32x4 v0, f32x4 v1) {
        const u32x4 w = pack8(v0, v1);
        if (isq) { if (n < 384) *(u32x4*)(qm + (size_t)r * 384 + n) = w; }
        else {
            const int h = n >> 7, e = n & 127;
            if (e < 64) *(u32x4*)(km + (size_t)r * 384 + h * 96 + e) = w; else *(u32x4*)(vm + (size_t)r * 256 + h * 64 + (e - 64)) = w;
        }
    });
    pg8::gemm_phase(lds, pg8::Gemm{K, K, K}, S, E);
}

struct MergeOrder {
    int c, nwgs; const char* Y; const char* W;
    __device__ bool next(int i, pg8::Unit& u) const {
        const int tiles = (NTOK / 256) * 4;
        const int L = (i >> 2) * nwgs + c; if (L >= tiles) return false;
        u.pm = L >> 2; u.pn = L & 3; u.aux = i & 3;
        u.A = Y + ((size_t)u.pm * 256 * DM + u.aux * 256) * 2; u.B = W + ((size_t)u.aux * DM + u.pn * 256) * 256 * 2; return true;
    }
};
__device__ __forceinline__ void fs_merge(const P& p, int l, LAS unsigned char* lds) {
    const bf16_t* cols = WSP(bf16_t, WS_COLS); float* mf = WSP(float, WS_MRGF); bf16_t* mrg = WSP(bf16_t, WS_MRG);
    MergeOrder S{(int)blockIdx.x, (int)gridDim.x, (const char*)WSP(bf16_t, WS_Y), (const char*)(WSP(bf16_t, WS_WTBR) + (size_t)l * 4 * DM * 256)};
    auto E = make_epi([=](const pg8::Unit& u, int r, int n, f32x4 v0, f32x4 v1) {
        const int b = u.aux;
        f32x4 g0, g1; unpack8v(*(const u32x4*)(cols + (size_t)r * NC + C_MG + b * DM + n), g0, g1);
#pragma unroll
        for (int e = 0; e < 4; ++e) { v0[e] *= 1.f / (1.f + __expf(-g0[e])); v1[e] *= 1.f / (1.f + __expf(-g1[e])); }
        float* m = mf + (size_t)r * DM + n;
        if (b > 0) { v0 += *(const f32x4*)m; v1 += *(const f32x4*)(m + 4); }
        if (b < 3) { *(f32x4*)m = v0; *(f32x4*)(m + 4) = v1; }
        else *(u32x4*)(mrg + (size_t)r * DM + n) = pack8(v0, v1);
    });
    pg8::gemm_phase(lds, pg8::Gemm{DM, 256, 256}, S, E);
}

__device__ __forceinline__ void fs_out(const P& p, int l, LAS unsigned char* lds) {
    float* X = WSP(float, WS_X); const float* modv = WSP(float, WS_MODV);
    const float* xp = p.in[I_XP]; const float* xs = p.in[I_XS];
    SubOrder S{NTOK / 256, 4, (int)blockIdx.x, 0, (int)gridDim.x, (const char*)WSP(bf16_t, WS_MRG), (const char*)(WSP(bf16_t, WS_WTOUT) + (size_t)l * DM * DM), (size_t)256 * DM * 2, (size_t)256 * DM * 2};
    auto E = make_epi([=](const pg8::Unit& u, int r, int n, f32x4 v0, f32x4 v1) {
        const float* gate = modv + ((size_t)l * NCB + row_cb(r)) * 3072 + 2048 + n;
        const float* xr = l == 0 ? (r < NCTX ? xp + (size_t)r * DM : xs + (size_t)(r - NCTX) * DM) : X + (size_t)r * DM;
        const f32x4 x0 = *(const f32x4*)(xr + n), x1 = *(const f32x4*)(xr + n + 4);
        const f32x4 g0 = *(const f32x4*)gate, g1 = *(const f32x4*)(gate + 4);
        *(f32x4*)(X + (size_t)r * DM + n) = x0 + g0 * v0; *(f32x4*)(X + (size_t)r * DM + n + 4) = x1 + g1 * v1;
    });
    pg8::gemm_phase(lds, pg8::Gemm{DM, DM, DM}, S, E);
}

__device__ __forceinline__ int otid() { int t = threadIdx.x; asm volatile("" : "+v"(t)); return t; }
constexpr int HG_LD = 72;
constexpr int HG_MAT = 64 * HG_LD * 2;
struct HgPrep { float k[16], b[16]; float btot, ref1; };
__device__ __forceinline__ void hg_prep(const P& p, int tid, int l, int r0, int h, LAS float* seg  , HgPrep& o) {
    const int dir = tid >> 8, tq = (tid >> 6) & 3, d = tid & 63;
    const bf16_t* c = WSP(bf16_t, WS_COLS) + (size_t)(r0 + 16 * tq) * NC + (dir == 0 ? C_HGFF : C_HGFB) + h * 64 + d;
    const float lbv = WSP(float, WS_LBS)[((size_t)l * 2 + dir) * 256 + h * 64 + d];
    float g[16];
#pragma unroll
    for (int i = 0; i < 16; ++i) {
        const float fz = bf2f(c[(size_t)i * NC]);
        const float e = __expf(-fz), inv = 1.f / (1.f + e);
        const float f = fmaxf(lbv + (1.f - lbv) * inv, 1e-30f);
        o.k[i] = (1.f - lbv) * e * inv;
        g[i] = __logf(f);
    }
    float run = 0.f;
    if (dir == 0) {
#pragma unroll
        for (int i = 0; i < 16; ++i) { run += g[i]; o.b[i] = run; }
    } else {
#pragma unroll
        for (int i = 15; i >= 0; --i) { run += g[i]; o.b[i] = run; }
    }
    seg[(dir * 4 + tq) * 64 + d] = run;
    __syncthreads();
    const float s0 = seg[(dir * 4 + 0) * 64 + d], s1 = seg[(dir * 4 + 1) * 64 + d], s2 = seg[(dir * 4 + 2) * 64 + d], s3 = seg[(dir * 4 + 3) * 64 + d];
    float off;
    if (dir == 0) off = tq == 0 ? 0.f : (tq == 1 ? s0 : (tq == 2 ? s0 + s1 : s0 + s1 + s2));
    else off = tq == 3 ? 0.f : (tq == 2 ? s3 : (tq == 1 ? s3 + s2 : s3 + s2 + s1));
#pragma unroll
    for (int i = 0; i < 16; ++i) o.b[i] += off;
    o.btot = (s0 + s1) + (s2 + s3);
    o.ref1 = dir == 0 ? s0 + s1 : s2 + s3;
}
__device__ __forceinline__ void hg_stage_vt(const P& p, int tid, int r0, int h, LAS unsigned char* vt) {
    const int j = tid & 63, sg = tid >> 6;
    const bf16_t* c = WSP(bf16_t, WS_COLS) + (size_t)(r0 + 8 * sg) * NC + C_HGI + h * 64 + j;
    unsigned w[4];
#pragma unroll
    for (int i = 0; i < 4; ++i) w[i] = (unsigned)c[(size_t)(2 * i) * NC] | ((unsigned)c[(size_t)(2 * i + 1) * NC] << 16);
    *(LAS u32x4*)(vt + (j * HG_LD + 8 * sg) * 2) = (u32x4){w[0], w[1], w[2], w[3]};
}
__device__ __forceinline__ void hg_mma_strip(f32x4 (&acc)[4], const LAS unsigned char* A, int arow0, const LAS unsigned char* Bt, int lane) {
    const int fr = lane & 15, fq = lane >> 4;
#pragma unroll
    for (int ks = 0; ks < 2; ++ks) {
        const bf16x8 a = *(const LAS bf16x8*)(A + ((arow0 + fr) * HG_LD + 32 * ks + 8 * fq) * 2);
#pragma unroll
        for (int n = 0; n < 4; ++n) {
            const bf16x8 b = *(const LAS bf16x8*)(Bt + ((16 * n + fr) * HG_LD + 32 * ks + 8 * fq) * 2);
            acc[n] = __builtin_amdgcn_mfma_f32_16x16x32_bf16(a, b, acc[n], 0, 0, 0);
        }
    }
}

__device__ __forceinline__ void fs_hgrn_a(const P& p, int l, LAS unsigned char* lds) {
    LAS float* seg = (LAS float*)lds;
    LAS unsigned char* kt = lds + 2048;
    LAS unsigned char* vt = kt + 2 * HG_MAT;
    const int tid = otid(), lane = tid & 63, wave = tid >> 6, dir = tid >> 8, tq = (tid >> 6) & 3, d = tid & 63;
    for (int u = blockIdx.x; u < (NTOK / 64) * 4; u += gridDim.x) {
        const int gc = u >> 2, h = u & 3, r0 = gc * 64;
        HgPrep hp; hg_prep(p, tid, l, r0, h, seg, hp);
        unsigned w[8];
#pragma unroll
        for (int i = 0; i < 8; ++i) w[i] = cvt_pk_bf16(hp.k[2 * i] * __expf(hp.btot - hp.b[2 * i]), hp.k[2 * i + 1] * __expf(hp.btot - hp.b[2 * i + 1]));
        LAS unsigned char* kd = kt + dir * HG_MAT + (d * HG_LD + 16 * tq) * 2;
        *(LAS u32x4*)kd = (u32x4){w[0], w[1], w[2], w[3]}; *(LAS u32x4*)(kd + 16) = (u32x4){w[4], w[5], w[6], w[7]};
        hg_stage_vt(p, tid, r0, h, vt);
        if (tq == 0) WSP(float, WS_HD)[((size_t)u * 2 + dir) * 64 + d] = __expf(hp.btot);
        __syncthreads();
        f32x4 acc[4];
#pragma unroll
        for (int n = 0; n < 4; ++n) acc[n] = (f32x4){0.f, 0.f, 0.f, 0.f};
        const int w4 = wave & 3;
        hg_mma_strip(acc, kt + dir * HG_MAT, 16 * w4, vt, lane);
        float* L = WSP(float, WS_HL) + ((size_t)u * 2 + dir) * 4096;
#pragma unroll
        for (int n = 0; n < 4; ++n)
#pragma unroll
            for (int e = 0; e < 4; ++e) L[(16 * w4 + 4 * (lane >> 4) + e) * 64 + 16 * n + (lane & 15)] = acc[n][e];
        __syncthreads();
    }
}

__device__ __forceinline__ void fs_hgrn_b(const P& p, int l, long gtid, long gsz) {
    float* HL = WSP(float, WS_HL); const float* HD = WSP(float, WS_HD);
    const long nItems = (long)(BATCH + DB) * 4 * 2 * 4096;
    for (long it = gtid; it < nItems; it += gsz) {
        const int e = (int)(it & 4095), dir = (int)((it >> 12) & 1), h = (int)((it >> 13) & 3), sq = (int)(it >> 15);
        const bool lat = sq >= BATCH; const int b = lat ? sq - BATCH : sq;
        const int nch = lat ? DSEQ / 64 : SEQ / 64, gc0 = lat ? (NCTX + b * DSEQ) / 64 : (b * SEQ) / 64;
        float s = lat ? p.in[I_ST][((((size_t)b * DEPTH + l) * 2 + dir) * 4 + h) * 4096 + e] : 0.f;
        for (int cc = 0; cc < nch; ++cc) {
            const int c = dir == 0 ? cc : nch - 1 - cc;
            const size_t ui = ((size_t)(gc0 + c) * 4 + h) * 2 + dir;
            const float Lv = HL[ui * 4096 + e], Dv = HD[ui * 64 + (e >> 6)];
            HL[ui * 4096 + e] = s;
            s = Dv * s + Lv;
        }
        if (!lat) p.out[O_ST + ((((size_t)b * DEPTH + l) * 2 + dir) * 4 + h) * 4096 + e] = s;
    }
}

__device__ __forceinline__ void fs_hgrn_c(const P& p, int l, LAS unsigned char* lds) {
    LAS float* seg = (LAS float*)lds;
    LAS unsigned char* base = lds + 2048;
    const int tid = otid(), lane = tid & 63, wave = tid >> 6, dir = tid >> 8, tq = (tid >> 6) & 3, d = tid & 63, w4 = wave & 3;
    LAS unsigned char* mQh = base + (dir * 6 + 0) * HG_MAT; LAS unsigned char* mQc = base + (dir * 6 + 1) * HG_MAT;
    LAS unsigned char* mK0 = base + (dir * 6 + 2) * HG_MAT; LAS unsigned char* mK1 = base + (dir * 6 + 3) * HG_MAT;
    LAS unsigned char* mAtt = base + (dir * 6 + 4) * HG_MAT; LAS unsigned char* mSt = base + (dir * 6 + 5) * HG_MAT;
    LAS unsigned char* vt = base + 12 * HG_MAT;
    LAS float* Ob = (LAS float*)(base + 6 * HG_MAT);
    const bf16_t* cols = WSP(bf16_t, WS_COLS);
    for (int u = blockIdx.x; u < (NTOK / 64) * 4; u += gridDim.x) {
        const int gc = u >> 2, h = u & 3, r0 = gc * 64;
        HgPrep hp; hg_prep(p, tid, l, r0, h, seg, hp);
        const bool first = dir == 0 ? (tq < 2) : (tq >= 2);
        {
            const bf16_t* cq = cols + (size_t)(r0 + 16 * tq) * NC + C_HGQ + h * 64 + d;
#pragma unroll
            for (int i = 0; i < 16; ++i) {
                const float qv = bf2f(cq[(size_t)i * NC]);
                const float q = qv / (1.f + __expf(-qv));
                const float bb = hp.b[i];
                const int o = ((16 * tq + i) * HG_LD + d) * 2;
                *(LAS bf16_t*)(mQh + o) = f2bf(q * __expf(first ? bb : bb - hp.ref1));
                *(LAS bf16_t*)(mQc + o) = f2bf(q * __expf(bb));
                *(LAS bf16_t*)(mK0 + o) = first ? f2bf(hp.k[i] * __expf(-bb)) : (bf16_t)0;
                *(LAS bf16_t*)(mK1 + o) = f2bf(hp.k[i] * __expf(hp.ref1 - bb));
            }
        }
        hg_stage_vt(p, tid, r0, h, vt);
        {
            const float* S = WSP(float, WS_HL) + ((size_t)u * 2 + dir) * 4096;
            const int j = tid & 63, dq = (tid >> 6) & 3;
            unsigned w[8];
#pragma unroll
            for (int i = 0; i < 8; ++i) w[i] = cvt_pk_bf16(S[(16 * dq + 2 * i) * 64 + j], S[(16 * dq + 2 * i + 1) * 64 + j]);
            LAS unsigned char* sd = mSt + (j * HG_LD + 16 * dq) * 2;
            *(LAS u32x4*)sd = (u32x4){w[0], w[1], w[2], w[3]}; *(LAS u32x4*)(sd + 16) = (u32x4){w[4], w[5], w[6], w[7]};
        }
        __syncthreads();
        {
            f32x4 acc[4];
#pragma unroll
            for (int n = 0; n < 4; ++n) acc[n] = (f32x4){0.f, 0.f, 0.f, 0.f};
            const bool wfirst = dir == 0 ? (w4 < 2) : (w4 >= 2);
            hg_mma_strip(acc, mQh, 16 * w4, wfirst ? mK0 : mK1, lane);
#pragma unroll
            for (int n = 0; n < 4; ++n)
#pragma unroll
                for (int e = 0; e < 4; ++e) {
                    const int t = 16 * w4 + 4 * (lane >> 4) + e, s = 16 * n + (lane & 15);
                    const bool keep = dir == 0 ? (s <= t) : (s >= t);
                    *(LAS bf16_t*)(mAtt + (t * HG_LD + s) * 2) = keep ? f2bf(acc[n][e]) : (bf16_t)0;
                }
        }
        __syncthreads();
        f32x4 o[4];
#pragma unroll
        for (int n = 0; n < 4; ++n) o[n] = (f32x4){0.f, 0.f, 0.f, 0.f};
        hg_mma_strip(o, mAtt, 16 * w4, vt, lane);
        hg_mma_strip(o, mQc, 16 * w4, mSt, lane);
        __syncthreads();
        if (dir == 1) {
#pragma unroll
            for (int n = 0; n < 4; ++n)
#pragma unroll
                for (int e = 0; e < 4; ++e) Ob[(16 * w4 + 4 * (lane >> 4) + e) * 64 + 16 * n + (lane & 15)] = o[n][e];
        }
        __syncthreads();
        if (dir == 0) {
            const float* gn = p.in[I_HGG] + (size_t)l * 64;
            float ss[4] = {0.f, 0.f, 0.f, 0.f};
#pragma unroll
            for (int n = 0; n < 4; ++n)
#pragma unroll
                for (int e = 0; e < 4; ++e) { o[n][e] += Ob[(16 * w4 + 4 * (lane >> 4) + e) * 64 + 16 * n + (lane & 15)]; ss[e] += o[n][e] * o[n][e]; }
#pragma unroll
            for (int e = 0; e < 4; ++e) {
                float v = ss[e];
                v += __shfl_xor(v, 1); v += __shfl_xor(v, 2); v += __shfl_xor(v, 4); v += __shfl_xor(v, 8);
                ss[e] = 1.f / sqrtf(v * (1.f / 64.f) + 1e-6f);
            }
#pragma unroll
            for (int n = 0; n < 4; ++n)
#pragma unroll
                for (int e = 0; e < 4; ++e) {
                    const int t = 16 * w4 + 4 * (lane >> 4) + e, j = 16 * n + (lane & 15);
                    const bf16_t* c = cols + (size_t)(r0 + t) * NC;
                    const float og = bf2f(c[C_HGOG + h * 64 + j]), z = bf2f(c[C_HGZ + h * 64 + j]);
                    const float v = o[n][e] * ss[e] * gn[j] / (1.f + __expf(-og)) * (z / (1.f + __expf(-z)));
                    WSP(bf16_t, WS_Y)[(size_t)(r0 + t) * DM + 256 + h * 64 + j] = f2bf(v);
                }
        }
        __syncthreads();
    }
}

constexpr int AT_KBUF = 64 * (96 + 8) * 2;
constexpr int AT_VBUF = 64 * 72 * 2;
constexpr int AT_OFF_V = 2 * AT_KBUF, AT_OFF_RPB = AT_OFF_V + 2 * AT_VBUF;
struct AttnSrc { const bf16_t* k; const bf16_t* v; int kp, vp, n; };
struct AttnMask { int type, a, b; };

template <int DQ>
__device__ __forceinline__ void attn_unit(LAS unsigned char* lds, const int tid, const bf16_t* qbase, const int qpitch, const AttnSrc s0, const AttnSrc s1, const AttnMask mk,
                                          const float* rpb, const float sink, const bool has_sink, const float scale, const float* ropeq  ,
                                          const bf16_t* zbase, bf16_t* ybase  ) {
    constexpr int KS = DQ / 32, KP = DQ + 8;
    constexpr float L2E = 1.4426950408889634f;
    const int lane = tid & 63, wave = tid >> 6, c = lane & 15, fq = lane >> 4;
    LAS float* rpbl = (LAS float*)(lds + AT_OFF_RPB);
    if (mk.type == 1) { for (int i = tid; i < 465; i += NTHREADS) rpbl[i] = rpb[i] * L2E; }
    bf16x8 qf[KS];
    {
        const bf16_t* qr = qbase + (size_t)(16 * wave + c) * qpitch + 8 * fq;
#pragma unroll
        for (int ks = 0; ks < KS; ++ks) qf[ks] = *(const bf16x8*)(qr + 32 * ks);
        if (DQ == 96 && ropeq) {
            const u32x4 mine = __builtin_bit_cast(u32x4, qf[KS - 1]);
            u32x4 oth; oth.x = __shfl_xor(mine.x, 32); oth.y = __shfl_xor(mine.y, 32); oth.z = __shfl_xor(mine.z, 32); oth.w = __shfl_xor(mine.w, 32);
            f32x4 m0, m1, o0, o1; unpack8v(mine, m0, m1); unpack8v(oth, o0, o1);
            const float* rr = ropeq + (size_t)(16 * wave + c) * 32 + (8 * (fq & 1)) * 2;
            float r[8];
#pragma unroll
            for (int j = 0; j < 8; ++j) {
                const float cs = rr[2 * j], sn = rr[2 * j + 1];
                const float mv = j < 4 ? m0[j & 3] : m1[j & 3], ov = j < 4 ? o0[j & 3] : o1[j & 3];
                r[j] = fq < 2 ? mv * cs - ov * sn : ov * sn + mv * cs;
            }
            u32x4 w; w.x = cvt_pk_bf16(r[0], r[1]); w.y = cvt_pk_bf16(r[2], r[3]); w.z = cvt_pk_bf16(r[4], r[5]); w.w = cvt_pk_bf16(r[6], r[7]);
            qf[KS - 1] = __builtin_bit_cast(bf16x8, w);
        }
    }
    int qa = 0, qb = 0;
    if (mk.type == 1) { qa = mk.a + (wave >> 2); qb = 16 * (wave & 3) + c; }
    else if (mk.type == 2) { qa = mk.a + 16 * wave + c; }
    int na_rs = qa - 4; na_rs = na_rs < 0 ? 0 : (na_rs > GROWS - 8 ? GROWS - 8 : na_rs);
    int na_cs = qb - 8; na_cs = na_cs < 0 ? 0 : (na_cs > GW - 16 ? GW - 16 : na_cs);
    const float sl2 = scale * L2E;
    float m = has_sink ? sink * L2E : -3.0e38f, lsum = 0.f;
    f32x4 o[4];
#pragma unroll
    for (int n = 0; n < 4; ++n) o[n] = (f32x4){0.f, 0.f, 0.f, 0.f};
    const int nsteps = s0.n + s1.n;
    u32x4 kreg0, kreg1, vreg;
    const int krow0 = DQ == 64 ? (tid >> 3) : tid / 12, kch0 = DQ == 64 ? (tid & 7) : tid % 12;
    const int krow1 = (tid + 512) / 12, kch1 = (tid + 512) % 12;
    const int vkey = tid & 63, vg = tid >> 6;
#define AT_LOAD(step) do { const bool f0_ = (step) < s0.n; const int bi_ = f0_ ? (step) : (step) - s0.n; \
        const bf16_t* kb_ = (f0_ ? s0.k : s1.k) + (size_t)bi_ * 64 * (f0_ ? s0.kp : s1.kp); const int kp_ = f0_ ? s0.kp : s1.kp; \
        const bf16_t* vb_ = (f0_ ? s0.v : s1.v) + (size_t)bi_ * 64 * (f0_ ? s0.vp : s1.vp); const int vp_ = f0_ ? s0.vp : s1.vp; \
        kreg0 = *(const u32x4*)(kb_ + (size_t)krow0 * kp_ + 8 * kch0); \
        if (DQ == 96 && tid < 256) kreg1 = *(const u32x4*)(kb_ + (size_t)krow1 * kp_ + 8 * kch1); \
        vreg = *(const u32x4*)(vb_ + (size_t)vkey * vp_ + 8 * vg); } while (0)
#define AT_STORE(buf) do { LAS unsigned char* kd_ = lds + (buf) * AT_KBUF; LAS unsigned char* vd_ = lds + AT_OFF_V + (buf) * AT_VBUF; \
        *(LAS u32x4*)(kd_ + (krow0 * KP + 8 * kch0) * 2) = kreg0; \
        if (DQ == 96 && tid < 256) *(LAS u32x4*)(kd_ + (krow1 * KP + 8 * kch1) * 2) = kreg1; \
        const unsigned vw_[4] = {vreg.x, vreg.y, vreg.z, vreg.w}; \
        _Pragma("unroll") for (int e_ = 0; e_ < 4; ++e_) { \
            *(LAS bf16_t*)(vd_ + ((8 * vg + 2 * e_) * 72 + vkey) * 2) = (bf16_t)(vw_[e_] & 0xffffu); \
            *(LAS bf16_t*)(vd_ + ((8 * vg + 2 * e_ + 1) * 72 + vkey) * 2) = (bf16_t)(vw_[e_] >> 16); } } while (0)
    AT_LOAD(0); AT_STORE(0);
    __syncthreads();
    for (int step = 0; step < nsteps; ++step) {
        const int buf = step & 1;
        if (step + 1 < nsteps) AT_LOAD(step + 1);
        const LAS unsigned char* kl = lds + buf * AT_KBUF; const LAS unsigned char* vl = lds + AT_OFF_V + buf * AT_VBUF;
        f32x4 acc[4];
#pragma unroll
        for (int n = 0; n < 4; ++n) {
            acc[n] = (f32x4){0.f, 0.f, 0.f, 0.f};
#pragma unroll
            for (int ks = 0; ks < KS; ++ks) {
                const bf16x8 kf = *(const LAS bf16x8*)(kl + ((16 * n + c) * KP + 32 * ks + 8 * fq) * 2);
                acc[n] = __builtin_amdgcn_mfma_f32_16x16x32_bf16(kf, qf[ks], acc[n], 0, 0, 0);
            }
        }
        const bool msk = step < s0.n && mk.type != 0;
        float mloc = -3.0e38f;
#pragma unroll
        for (int n = 0; n < 4; ++n)
#pragma unroll
            for (int e = 0; e < 4; ++e) {
                float sv = acc[n][e] * sl2;
                if (msk) {
                    const int kk = 16 * n + 4 * fq + e;
                    if (mk.type == 1) {
                        const int kr = mk.b + step;
                        const bool ok = kr >= na_rs && kr < na_rs + 8 && kk >= na_cs && kk < na_cs + 16;
                        int dr = kr - qa + 7; dr = dr < 0 ? 0 : (dr > 14 ? 14 : dr);
                        int dc = kk - qb + 15; dc = dc < 0 ? 0 : (dc > 30 ? 30 : dc);
                        sv = ok ? sv + rpbl[dr * 31 + dc] : -1.0e30f;
                    } else {
                        const int dd = mk.b + 64 * step + kk - qa;
                        sv = (dd <= 128 && dd >= -128) ? sv : -1.0e30f;
                    }
                }
                acc[n][e] = sv; mloc = fmaxf(mloc, sv);
            }
        mloc = fmaxf(mloc, __shfl_xor(mloc, 16)); mloc = fmaxf(mloc, __shfl_xor(mloc, 32));
        const float mn = fmaxf(m, mloc), corr = exp2f(m - mn);
        m = mn;
        float ps = 0.f;
#pragma unroll
        for (int n = 0; n < 4; ++n)
#pragma unroll
            for (int e = 0; e < 4; ++e) { const float pv = exp2f(acc[n][e] - mn); acc[n][e] = pv; ps += pv; }
        lsum = lsum * corr + ps;
#pragma unroll
        for (int n = 0; n < 4; ++n) o[n] *= corr;
#pragma unroll
        for (int ks = 0; ks < 2; ++ks) {
            u32x4 pw; pw.x = cvt_pk_bf16(acc[2 * ks][0], acc[2 * ks][1]); pw.y = cvt_pk_bf16(acc[2 * ks][2], acc[2 * ks][3]);
            pw.z = cvt_pk_bf16(acc[2 * ks + 1][0], acc[2 * ks + 1][1]); pw.w = cvt_pk_bf16(acc[2 * ks + 1][2], acc[2 * ks + 1][3]);
            const bf16x8 pf = __builtin_bit_cast(bf16x8, pw);
#pragma unroll
            for (int n = 0; n < 4; ++n) {
                const LAS unsigned char* vr = vl + ((16 * n + c) * 72 + 32 * ks + 4 * fq) * 2;
                typedef unsigned u32x2 __attribute__((ext_vector_type(2)));
                const u32x2 v0 = *(const LAS u32x2*)vr, v1 = *(const LAS u32x2*)(vr + 32);
                const u32x4 vw = (u32x4){v0.x, v0.y, v1.x, v1.y};
                o[n] = __builtin_amdgcn_mfma_f32_16x16x32_bf16(__builtin_bit_cast(bf16x8, vw), pf, o[n], 0, 0, 0);
            }
        }
        if (step + 1 < nsteps) AT_STORE(buf ^ 1);
        __syncthreads();
    }
#undef AT_LOAD
#undef AT_STORE
    lsum += __shfl_xor(lsum, 16); lsum += __shfl_xor(lsum, 32);
    if (has_sink) lsum += exp2f(sink * L2E - m);
    const float inv = 1.f / lsum;
    const bf16_t* zr = zbase + (size_t)(16 * wave + c) * NC; bf16_t* yr = ybase + (size_t)(16 * wave + c) * DM;
#pragma unroll
    for (int n = 0; n < 4; ++n) {
        typedef unsigned u32x2 __attribute__((ext_vector_type(2)));
        const u32x2 zz = *(const u32x2*)(zr + 16 * n + 4 * fq);
        const float z0 = u2f(zz.x << 16), z1 = u2f(zz.x & 0xffff0000u), z2 = u2f(zz.y << 16), z3 = u2f(zz.y & 0xffff0000u);
        u32x2 w;
        w.x = cvt_pk_bf16(o[n][0] * inv * (z0 / (1.f + __expf(-z0))), o[n][1] * inv * (z1 / (1.f + __expf(-z1))));
        w.y = cvt_pk_bf16(o[n][2] * inv * (z2 / (1.f + __expf(-z2))), o[n][3] * inv * (z3 / (1.f + __expf(-z3))));
        *(u32x2*)(yr + 16 * n + 4 * fq) = w;
    }
}

__device__ __forceinline__ void fs_attn(const P& p, int l, LAS unsigned char* lds) {
    const int tid = otid();
    constexpr int NL = (NLAT / 128) * 4, NCU = (NCTX / 128) * 4 * 3, NU = 3 * NL + NCU;
    const bf16_t* cols = WSP(bf16_t, WS_COLS);
    bf16_t* Y = WSP(bf16_t, WS_Y);
    for (int u = blockIdx.x; u < NU; u += gridDim.x) {
        if (u < 3 * NL) {
            const int kind = u / NL, v = u % NL;
            int bh, qt;
            if (NL % 64 == 0) { const int x = v & 7, idx = v >> 3, per = NL / 8; const int bhx = (DB * 4) / 8 > 0 ? (DB * 4) / 8 : 1; bh = x * bhx + idx / (per / bhx); qt = idx % (per / bhx); }
            else { bh = v / (DSEQ / 128); qt = v % (DSEQ / 128); }
            const int b = bh >> 2, h = bh & 3;
            const int r0 = NCTX + b * DSEQ + qt * 128, t0 = qt * 128;
            const size_t cb = ((size_t)b * DEPTH + l) * PAST;
            if (kind == 0) {
                AttnSrc s0{WSP(bf16_t, WS_KMLA) + (size_t)(NCTX + b * DSEQ) * 384 + h * 96, WSP(bf16_t, WS_VMLA) + (size_t)(NCTX + b * DSEQ) * 256 + h * 64, 384, 256, DSEQ / 64};
                AttnSrc s1{WSP(bf16_t, WS_KCM) + cb * 384 + h * 96, WSP(bf16_t, WS_VCM) + cb * 256 + h * 64, 384, 256, PAST / 64};
                attn_unit<96>(lds, tid, WSP(bf16_t, WS_QMLA) + (size_t)r0 * 384 + h * 96, 384, s0, s1, AttnMask{0, 0, 0}, nullptr, 0.f, false, 0.10206207261596577f,
                              WSP(float, WS_ROPEM) + (size_t)t0 * 32, cols + (size_t)r0 * NC + C_MZ + h * 64, Y + (size_t)r0 * DM + 512 + h * 64);
            } else if (kind == 1) {
                const int i0 = 2 * qt;
                int rlo = i0 - 4; rlo = rlo < 0 ? 0 : (rlo > GROWS - 8 ? GROWS - 8 : rlo);
                int rhi = i0 + 1 - 4; rhi = (rhi < 0 ? 0 : (rhi > GROWS - 8 ? GROWS - 8 : rhi)) + 8;
                const size_t kr0 = (size_t)(NCTX + b * DSEQ + rlo * 64);
                AttnSrc s0{cols + kr0 * NC + C_NAK + h * 64, cols + kr0 * NC + C_NAV + h * 64, NC, NC, rhi - rlo};
                AttnSrc s1{WSP(bf16_t, WS_CNAK) + cb * 256 + h * 64, WSP(bf16_t, WS_CNAV) + cb * 256 + h * 64, 256, 256, PAST / 64};
                attn_unit<64>(lds, tid, cols + (size_t)r0 * NC + C_NAQ + h * 64, NC, s0, s1, AttnMask{1, i0, rlo}, p.in[I_RPB] + ((size_t)l * 4 + h) * 465, 0.f, false, 0.125f,
                              nullptr, cols + (size_t)r0 * NC + C_NAZ + h * 64, Y + (size_t)r0 * DM + 0 + h * 64);
            } else {
                const int kh = h >> 1;
                const int klo = t0 - 128 < 0 ? 0 : t0 - 128, khi = t0 + 256 > DSEQ ? DSEQ : t0 + 256;
                const size_t kr0 = (size_t)(NCTX + b * DSEQ + klo);
                AttnSrc s0{WSP(bf16_t, WS_WKR) + kr0 * 128 + kh * 64, cols + kr0 * NC + C_WV + kh * 64, 128, NC, (khi - klo) / 64};
                AttnSrc s1{WSP(bf16_t, WS_CWK) + cb * 128 + kh * 64, WSP(bf16_t, WS_CWV) + cb * 128 + kh * 64, 128, 128, PAST / 64};
                attn_unit<64>(lds, tid, WSP(bf16_t, WS_WQR) + (size_t)r0 * 256 + h * 64, 256, s0, s1, AttnMask{2, t0, klo}, nullptr, p.in[I_SINK][l * 4 + h], true, 0.125f,
                              nullptr, cols + (size_t)r0 * NC + C_WZ + h * 64, Y + (size_t)r0 * DM + 768 + h * 64);
            }
        } else {
            const int v = u - 3 * NL, kind = v % 3, h = (v / 3) & 3, tile = v / 12;
            const int r0 = tile * 128, sq0 = (r0 / SEQ) * SEQ;
            const AttnSrc none{nullptr, nullptr, 0, 0, 0};
            if (kind == 0) {
                AttnSrc s0{cols + (size_t)sq0 * NC + C_NAK + h * 64, cols + (size_t)sq0 * NC + C_NAV + h * 64, NC, NC, SEQ / 64};
                attn_unit<64>(lds, tid, cols + (size_t)r0 * NC + C_NAQ + h * 64, NC, s0, none, AttnMask{0, 0, 0}, nullptr, 0.f, false, 0.125f, nullptr,
                              cols + (size_t)r0 * NC + C_NAZ + h * 64, Y + (size_t)r0 * DM + 0 + h * 64);
            } else if (kind == 1) {
                AttnSrc s0{WSP(bf16_t, WS_KMLA) + (size_t)sq0 * 384 + h * 96, WSP(bf16_t, WS_VMLA) + (size_t)sq0 * 256 + h * 64, 384, 256, SEQ / 64};
                attn_unit<96>(lds, tid, WSP(bf16_t, WS_QMLA) + (size_t)r0 * 384 + h * 96, 384, s0, none, AttnMask{0, 0, 0}, nullptr, 0.f, false, 0.10206207261596577f, nullptr,
                              cols + (size_t)r0 * NC + C_MZ + h * 64, Y + (size_t)r0 * DM + 512 + h * 64);
            } else {
                const int kh = h >> 1;
                AttnSrc s0{WSP(bf16_t, WS_WKR) + (size_t)sq0 * 128 + kh * 64, cols + (size_t)sq0 * NC + C_WV + kh * 64, 128, NC, SEQ / 64};
                attn_unit<64>(lds, tid, WSP(bf16_t, WS_WQR) + (size_t)r0 * 256 + h * 64, 256, s0, none, AttnMask{0, 0, 0}, nullptr, p.in[I_SINK][l * 4 + h], true, 0.125f, nullptr,
                              cols + (size_t)r0 * NC + C_WZ + h * 64, Y + (size_t)r0 * DM + 768 + h * 64);
            }
        }
    }
}

__device__ __forceinline__ float wave_sum(float v) {
#pragma unroll
    for (int o = 1; o < 64; o <<= 1) v += __shfl_xor(v, o);
    return v;
}
typedef unsigned u32x2 __attribute__((ext_vector_type(2)));
typedef float f32x2 __attribute__((ext_vector_type(2)));

template <bool FINAL>
__device__ __forceinline__ void fs_norm(const P& p, int l) {
    const int tid = otid(), lane = tid & 63, gw = blockIdx.x * (NTHREADS / 64) + (tid >> 6), ngw = gridDim.x * (NTHREADS / 64);
    const float* g = FINAL ? p.in[I_FG] : p.in[I_NG] + (size_t)l * DM;
    for (int r = gw; r < NTOK; r += ngw) {
        const float* x = (FINAL || l > 0) ? WSP(float, WS_X) + (size_t)r * DM : (r < NCTX ? p.in[I_XP] + (size_t)r * DM : p.in[I_XS] + (size_t)(r - NCTX) * DM);
        f32x4 v[4]; float ss = 0.f;
#pragma unroll
        for (int j = 0; j < 4; ++j) { v[j] = *(const f32x4*)(x + 256 * j + 4 * lane); ss += (v[j][0] * v[j][0] + v[j][1] * v[j][1]) + (v[j][2] * v[j][2] + v[j][3] * v[j][3]); }
        const float rstd = 1.f / sqrtf(wave_sum(ss) * (1.f / DM) + 1e-6f);
        if (FINAL) {
#pragma unroll
            for (int j = 0; j < 4; ++j) { const f32x4 gg = *(const f32x4*)(g + 256 * j + 4 * lane); *(f32x4*)(p.out + O_Y + (size_t)r * DM + 256 * j + 4 * lane) = v[j] * rstd * gg; }
        } else {
            const float* mv = WSP(float, WS_MODV) + ((size_t)l * NCB + row_cb(r)) * 3072;
            bf16_t* H = WSP(bf16_t, WS_H) + (size_t)r * DM;
#pragma unroll
            for (int j = 0; j < 4; ++j) {
                const int k = 256 * j + 4 * lane;
                const f32x4 gg = *(const f32x4*)(g + k), sh = *(const f32x4*)(mv + k), sc = *(const f32x4*)(mv + 1024 + k);
                const f32x4 y = v[j] * rstd * gg * (sc + 1.f) + sh;
                u32x2 w; w.x = cvt_pk_bf16(y[0], y[1]); w.y = cvt_pk_bf16(y[2], y[3]);
                *(u32x2*)(H + k) = w;
            }
        }
    }
}

__device__ __forceinline__ void fs_rowprep(const P& p, int l) {
    const int tid = otid(), lane = tid & 63, gw = blockIdx.x * (NTHREADS / 64) + (tid >> 6), ngw = gridDim.x * (NTHREADS / 64);
    const bf16_t* cols = WSP(bf16_t, WS_COLS);
    for (int r = gw; r < NTOK; r += ngw) {
        const bf16_t* c = cols + (size_t)r * NC;
        const bool lat = r >= NCTX; const int t = lat ? (r - NCTX) % DSEQ : 0;
        const size_t bl = lat ? 0 : ((size_t)(r / SEQ) * DEPTH + l) * SEQ + (r % SEQ);
        {
            const unsigned w = *(const unsigned*)(c + C_CKV + 2 * lane);
            const float a = u2f(w << 16), b = u2f(w & 0xffff0000u);
            const float rstd = 1.f / sqrtf(wave_sum(a * a + b * b) * (1.f / 128.f) + 1e-6f);
            const float* g = p.in[I_KVG] + (size_t)l * 128 + 2 * lane;
            const float va = a * rstd * g[0], vb = b * rstd * g[1];
            *(unsigned*)(WSP(bf16_t, WS_CKVB) + (size_t)r * 128 + 2 * lane) = cvt_pk_bf16(va, vb);
            if (!lat) { f32x2 o; o.x = va; o.y = vb; *(f32x2*)(p.out + O_CKV + bl * 128 + 2 * lane) = o; }
        }
        {
            const u32x2 w = *(const u32x2*)(c + C_MQA + 4 * lane);
            const float a0 = u2f(w.x << 16), a1 = u2f(w.x & 0xffff0000u), a2 = u2f(w.y << 16), a3 = u2f(w.y & 0xffff0000u);
            const float rstd = 1.f / sqrtf(wave_sum((a0 * a0 + a1 * a1) + (a2 * a2 + a3 * a3)) * (1.f / 256.f) + 1e-6f);
            const f32x4 g = *(const f32x4*)(p.in[I_QG] + (size_t)l * 256 + 4 * lane);
            u32x2 o; o.x = cvt_pk_bf16(a0 * rstd * g[0], a1 * rstd * g[1]); o.y = cvt_pk_bf16(a2 * rstd * g[2], a3 * rstd * g[3]);
            *(u32x2*)(WSP(bf16_t, WS_QN) + (size_t)r * 256 + 4 * lane) = o;
        }
        if (lane < 16) {
            const float x1 = bf2f(c[C_KR + lane]), x2 = bf2f(c[C_KR + 16 + lane]);
            float o1 = x1, o2 = x2;
            if (lat) { const float* rm = WSP(float, WS_ROPEM) + (size_t)t * 32 + 2 * lane; o1 = x1 * rm[0] - x2 * rm[1]; o2 = x1 * rm[1] + x2 * rm[0]; }
            else { p.out[O_KR + bl * 32 + lane] = x1; p.out[O_KR + bl * 32 + 16 + lane] = x2; }
            bf16_t* km = WSP(bf16_t, WS_KMLA) + (size_t)r * 384 + 64 + lane;
            const bf16_t b1 = f2bf(o1), b2 = f2bf(o2);
#pragma unroll
            for (int h = 0; h < 4; ++h) { km[h * 96] = b1; km[h * 96 + 16] = b2; }
        }
        {
            const float* rw = WSP(float, WS_ROPEW) + (size_t)t * 64;
#pragma unroll
            for (int i = 0; i < 3; ++i) {
                const int pi = lane + 64 * i, hh = pi >> 5, j = pi & 31;
                const bf16_t* src = hh < 4 ? c + C_WQ + hh * 64 : c + C_WK + (hh - 4) * 64;
                bf16_t* dst = hh < 4 ? WSP(bf16_t, WS_WQR) + (size_t)r * 256 + hh * 64 : WSP(bf16_t, WS_WKR) + (size_t)r * 128 + (hh - 4) * 64;
                const float x1 = bf2f(src[j]), x2 = bf2f(src[32 + j]);
                if (lat) { const float cs = rw[2 * j], sn = rw[2 * j + 1]; dst[j] = f2bf(x1 * cs - x2 * sn); dst[32 + j] = f2bf(x1 * sn + x2 * cs); }
                else { dst[j] = src[j]; dst[32 + j] = src[32 + j]; }
            }
        }
    }
}

__device__ __forceinline__ void tr_item(const float* W, int N, int ncol0, bf16_t* WT, int K, int nrow0, int k0, LAS float* scr, int lane) {
    if (ncol0 >= 0) {
#pragma unroll 8
        for (int i = 0; i < 32; ++i) { const int kk = 2 * i + (lane >> 5); scr[kk * 33 + (lane & 31)] = W[(size_t)(k0 + kk) * N + ncol0 + (lane & 31)]; }
    }
    asm volatile("s_waitcnt lgkmcnt(0)" ::: "memory");
    const int c = lane & 7;
#pragma unroll
    for (int j = 0; j < 4; ++j) {
        const int n = (lane >> 3) + 8 * j; const LAS float* sp = scr + (8 * c) * 33 + n;
        u32x4 o = (u32x4){0u, 0u, 0u, 0u};
        if (ncol0 >= 0) { o.x = cvt_pk_bf16(sp[0 * 33], sp[1 * 33]); o.y = cvt_pk_bf16(sp[2 * 33], sp[3 * 33]); o.z = cvt_pk_bf16(sp[4 * 33], sp[5 * 33]); o.w = cvt_pk_bf16(sp[6 * 33], sp[7 * 33]); }
        *(u32x4*)(WT + (size_t)(nrow0 + n) * K + k0 + 8 * c) = o;
    }
    asm volatile("s_waitcnt lgkmcnt(0)" ::: "memory");
}
__device__ __forceinline__ void fs_prep(const P& p, LAS unsigned char* lds) {
    const int tid = otid(), lane = tid & 63, wave = tid >> 6, gw = blockIdx.x * (NTHREADS / 64) + wave, ngw = gridDim.x * (NTHREADS / 64);
    LAS float* scr = (LAS float*)(lds + wave * 16384);
    constexpr int I_IN = DEPTH * 16 * 256, I_OUT = DEPTH * 16 * 32, I_BR = DEPTH * 4 * 4 * 32, I_QB = DEPTH * 4 * 16, I_KVB = DEPTH * 2 * 16;
    for (int it = gw; it < I_IN + I_OUT + I_BR + I_QB + I_KVB; it += ngw) {
        int r = it;
        if (r < I_IN) { const int nb = r & 255, kb = (r >> 8) & 15, l = r >> 12;
            tr_item(p.in[I_WIN] + (size_t)l * DM * INW, INW, orig_col(nb * 32), WSP(bf16_t, WS_WTIN) + (size_t)l * NC * DM, DM, nb * 32, kb * 64, scr, lane); continue; } r -= I_IN;
        if (r < I_OUT) { const int nb = r & 31, kb = (r >> 5) & 15, l = r >> 9;
            tr_item(p.in[I_WOUT] + (size_t)l * DM * DM, DM, nb * 32, WSP(bf16_t, WS_WTOUT) + (size_t)l * DM * DM, DM, nb * 32, kb * 64, scr, lane); continue; } r -= I_OUT;
        if (r < I_BR) { const int nb = r & 31, kb = (r >> 5) & 3, lb = r >> 7;
            tr_item(p.in[I_WBR] + (size_t)lb * 256 * DM, DM, nb * 32, WSP(bf16_t, WS_WTBR) + (size_t)lb * DM * 256, 256, nb * 32, kb * 64, scr, lane); continue; } r -= I_BR;
        if (r < I_QB) { const int nb = r & 15, kb = (r >> 4) & 3, l = r >> 6;
            tr_item(p.in[I_WQB] + (size_t)l * 256 * 384, 384, nb < 12 ? nb * 32 : -1, WSP(bf16_t, WS_WTQB) + (size_t)l * 512 * 256, 256, nb * 32, kb * 64, scr, lane); continue; } r -= I_QB;
        { const int nb = r & 15, kb = (r >> 4) & 1, l = r >> 5;
            tr_item(p.in[I_WKVB] + (size_t)l * 128 * 512, 512, nb * 32, WSP(bf16_t, WS_WTKVB) + (size_t)l * 512 * 128, 128, nb * 32, kb * 64, scr, lane); }
    }
    __syncthreads();
    {
        LAS float* sl = (LAS float*)lds;
        LAS float* red = sl + NCB * 1024;
        for (int i = tid; i < NCB * 1024; i += NTHREADS) { const int cb = i >> 10, k = i & 1023; const float cv = cb == 0 ? p.in[I_CCTX][k] : p.in[I_C][(size_t)(cb - 1) * DM + k]; sl[i] = cv / (1.f + __expf(-cv)); }
        __syncthreads();
        for (int it = blockIdx.x; it < DEPTH * 48; it += gridDim.x) {
            const int l = it / 48, j = (it % 48) * 64 + (tid & 63), kp = tid >> 6;
            const float* w = p.in[I_WMOD] + ((size_t)l * DM + kp * 128) * 3072 + j;
            float acc[NCB];
#pragma unroll
            for (int cb = 0; cb < NCB; ++cb) acc[cb] = 0.f;
#pragma unroll 8
            for (int k = 0; k < 128; ++k) { const float wv = w[(size_t)k * 3072];
#pragma unroll
                for (int cb = 0; cb < NCB; ++cb) acc[cb] += sl[cb * 1024 + kp * 128 + k] * wv; }
#pragma unroll
            for (int cb = 0; cb < NCB; ++cb) red[(kp * NCB + cb) * 64 + (tid & 63)] = acc[cb];
            __syncthreads();
            if (tid < NCB * 64) { const int cb = tid >> 6, jj = tid & 63; float sm = 0.f;
#pragma unroll
                for (int q = 0; q < 8; ++q) sm += red[(q * NCB + cb) * 64 + jj];
                WSP(float, WS_MODV)[((size_t)l * NCB + cb) * 3072 + (it % 48) * 64 + jj] = sm + p.in[I_BMOD][(size_t)l * 3072 + (it % 48) * 64 + jj]; }
            __syncthreads();
        }
    }
    const long gtid = (long)blockIdx.x * NTHREADS + tid, gsz = (long)gridDim.x * NTHREADS;
    {
        float* lbs = WSP(float, WS_LBS);
        for (long i = gtid; i < 2 * 256; i += gsz) {
            const float* lg = p.in[I_LB];
            float mx = -1e30f;
            for (int l = 0; l < DEPTH; ++l) mx = fmaxf(mx, lg[(size_t)l * 512 + i]);
            float sm = 0.f;
            for (int l = 0; l < DEPTH; ++l) sm += expf(lg[(size_t)l * 512 + i] - mx);
            float cum = 0.f; const float p0 = expf(lg[i] - mx) / sm;
            for (int l = 0; l < DEPTH; ++l) { cum += expf(lg[(size_t)l * 512 + i] - mx) / sm; lbs[(size_t)l * 512 + i] = cum - p0; }
        }
        float* rm = WSP(float, WS_ROPEM);
        for (long i = gtid; i < (long)DSEQ * 16; i += gsz) {
            const int j = (int)(i % 16), t = (int)(i / 16);
            const float pos = j < 8 ? (float)(t / GW) : (float)(t % GW);
            const float a = pos * powf(10000.f, -(float)(j & 7) / 8.f); rm[i * 2] = cosf(a); rm[i * 2 + 1] = sinf(a);
        }
        float* rw = WSP(float, WS_ROPEW);
        for (long i = gtid; i < (long)DSEQ * 32; i += gsz) {
            const int j = (int)(i % 32), t = (int)(i / 32);
            const float pos = j < 16 ? (float)(t / GW) : (float)(t % GW);
            const float a = pos * powf(10000.f, -(float)(j & 15) / 16.f); rw[i * 2] = cosf(a); rw[i * 2 + 1] = sinf(a);
        }
        for (long i = gtid; i < (long)DB * DEPTH * PAST * 256 / 4; i += gsz) {
            const f32x4 a = *(const f32x4*)(p.in[I_CNAK] + 4 * i), b = *(const f32x4*)(p.in[I_CNAV] + 4 * i);
            u32x2 wa, wb; wa.x = cvt_pk_bf16(a[0], a[1]); wa.y = cvt_pk_bf16(a[2], a[3]); wb.x = cvt_pk_bf16(b[0], b[1]); wb.y = cvt_pk_bf16(b[2], b[3]);
            *(u32x2*)(WSP(bf16_t, WS_CNAK) + 4 * i) = wa; *(u32x2*)(WSP(bf16_t, WS_CNAV) + 4 * i) = wb;
        }
        for (long i = gtid; i < (long)DB * DEPTH * PAST * 128 / 4; i += gsz) {
            const f32x4 a = *(const f32x4*)(p.in[I_CWK] + 4 * i), b = *(const f32x4*)(p.in[I_CWV] + 4 * i), cc = *(const f32x4*)(p.in[I_CCKV] + 4 * i);
            u32x2 wa, wb, wc; wa.x = cvt_pk_bf16(a[0], a[1]); wa.y = cvt_pk_bf16(a[2], a[3]); wb.x = cvt_pk_bf16(b[0], b[1]); wb.y = cvt_pk_bf16(b[2], b[3]); wc.x = cvt_pk_bf16(cc[0], cc[1]); wc.y = cvt_pk_bf16(cc[2], cc[3]);
            *(u32x2*)(WSP(bf16_t, WS_CWK) + 4 * i) = wa; *(u32x2*)(WSP(bf16_t, WS_CWV) + 4 * i) = wb; *(u32x2*)(WSP(bf16_t, WS_CCKVB) + 4 * i) = wc;
        }
        for (long i = gtid; i < (long)DB * DEPTH * PAST * 128; i += gsz) {
            const int e = (int)(i % 32), h = (int)((i / 32) % 4); const long rowi = i / 128;
            WSP(bf16_t, WS_KCM)[(size_t)rowi * 384 + h * 96 + 64 + e] = f2bf(p.in[I_CKR][(size_t)rowi * 32 + e]);
        }
    }
}
struct CtxOrder {
    int c, nwgs; const char* A; const char* B;
    __device__ bool next(int i, pg8::Unit& u) const {
        const int L = i * nwgs + c; if (L >= (DB * DEPTH * PAST / 256) * 2) return false;
        u.pm = L >> 1; u.pn = L & 1; u.aux = 0;
        const int lyr = (u.pm / (PAST / 256)) % DEPTH;
        u.A = A + (size_t)u.pm * 256 * 128 * 2; u.B = B + ((size_t)lyr * 512 + u.pn * 256) * 128 * 2; return true;
    }
};
__device__ __forceinline__ void fs_prep_ctx(const P& p, LAS unsigned char* lds) {
    bf16_t* km = WSP(bf16_t, WS_KCM); bf16_t* vm = WSP(bf16_t, WS_VCM);
    CtxOrder S{(int)blockIdx.x, (int)gridDim.x, (const char*)WSP(bf16_t, WS_CCKVB), (const char*)WSP(bf16_t, WS_WTKVB)};
    auto E = make_epi([=](const pg8::Unit& u, int r, int n, f32x4 v0, f32x4 v1) {
        const u32x4 w = pack8(v0, v1); const int h = n >> 7, e = n & 127;
        if (e < 64) *(u32x4*)(km + (size_t)r * 384 + h * 96 + e) = w; else *(u32x4*)(vm + (size_t)r * 256 + h * 64 + (e - 64)) = w;
    });
    pg8::gemm_phase(lds, pg8::Gemm{128, 128, 128}, S, E);
}

namespace cg = cooperative_groups;
__global__ void __launch_bounds__(NTHREADS) mega_kernel(P p) {
    extern __shared__ __attribute__((aligned(16))) unsigned char lds_raw[];
    LAS unsigned char* lds = (LAS unsigned char*)lds_raw;
    cg::grid_group grid = cg::this_grid();
    const long gsz = (long)gridDim.x * blockDim.x;
#define GTID() ({ int t_ = threadIdx.x; asm volatile("" : "+v"(t_)); (long)blockIdx.x * blockDim.x + t_; })
#define PP ({ const __attribute__((address_space(4))) P* k_ = (const __attribute__((address_space(4))) P*)__builtin_amdgcn_kernarg_segment_ptr(); asm volatile("" : "+s"(k_)); k_; })
#define PPR (*(const P*)PP)
    fs_prep(PPR, lds); grid.sync();
    fs_prep_ctx(PPR, lds); grid.sync();
#pragma nounroll
    for (int l = 0; l < DEPTH; ++l) {
        fs_norm<false>(PPR, l); grid.sync();
        fs_inproj(PPR, l, lds); grid.sync();
        fs_rowprep(PPR, l); fs_hgrn_a(PPR, l, lds); grid.sync();
        fs_mlaproj(PPR, l, lds); grid.sync();
        fs_hgrn_b(PPR, l, GTID(), gsz); fs_attn(PPR, l, lds); grid.sync();
        fs_hgrn_c(PPR, l, lds); grid.sync();
        fs_merge(PPR, l, lds); grid.sync();
        fs_out(PPR, l, lds); grid.sync();
    }
    fs_norm<true>(PPR, 0);
}

extern "C" void kernel_launch(void* const* d_in, const int* in_sizes, int n_in, void* d_out, int out_size, void* d_ws, size_t ws_size, hipStream_t stream) {
    static int grid_blocks = 0;
    if (grid_blocks == 0) {
        if (n_in != N_IN || (size_t)out_size != O_END || ws_size < WS_END) {
            fprintf(stderr, "kernel_launch: unexpected sizes n_in %d out %d ws %zu (need %zu)\n", n_in, out_size, ws_size, (size_t)WS_END);
            grid_blocks = -1; return;
        }
        int dev = 0, cus = 0, per_cu = 0;
        hipGetDevice(&dev);
        hipDeviceGetAttribute(&cus, hipDeviceAttributeMultiprocessorCount, dev);
        hipFuncSetAttribute((const void*)mega_kernel, hipFuncAttributeMaxDynamicSharedMemorySize, LDS_BYTES);
        hipOccupancyMaxActiveBlocksPerMultiprocessor(&per_cu, (const void*)mega_kernel, NTHREADS, LDS_BYTES);
        if (per_cu < 1) per_cu = 1;
        grid_blocks = cus * per_cu;
    }
    if (grid_blocks < 0) return;
    P p{};
    for (int i = 0; i < N_IN; ++i) p.in[i] = (const float*)d_in[i];
    p.out = (float*)d_out; p.ws = (unsigned char*)d_ws;
    void* args[] = {&p};
    hipError_t e = hipLaunchCooperativeKernel((const void*)mega_kernel, dim3(grid_blocks), dim3(NTHREADS), args, LDS_BYTES, stream);
    if (e != hipSuccess) fprintf(stderr, "cooperative launch failed: %s (grid %d)\n", hipGetErrorString(e), grid_blocks);
}
#endif
```

```cpp
#ifndef CPU_EMU
#include <hip/hip_runtime.h>
#include <cstdio>
#define DEV __device__ __forceinline__
#else
#include <cmath>
#include <cstdio>
#include <cstring>
#define DEV inline
#endif
#include <cstdint>
#include <cstddef>

#ifndef CFG_BATCH
#define CFG_BATCH 16
#endif
#ifndef CFG_DEPTH
#define CFG_DEPTH 4
#endif
#ifndef CFG_DEC_BATCH
#define CFG_DEC_BATCH 4
#endif
constexpr int DM = 1024, BATCH = CFG_BATCH, SEQ = 256, DEPTH = CFG_DEPTH, DB = CFG_DEC_BATCH, DSEQ = 2048, PAST = 512;
constexpr int NCTX = BATCH * SEQ, NLAT = DB * DSEQ, NTOK = NCTX + NLAT;
constexpr int NCB = 1 + DB;
constexpr int INW = 8096, NC = 8192;
constexpr int GW = 64, GROWS = DSEQ / GW;
constexpr int C_NAQ = 0, C_NAK = 256, C_NAV = 512, C_NAZ = 768, C_HGQ = 1024, C_HGFF = 1280, C_HGFB = 1536, C_HGI = 1792, C_HGOG = 2048, C_HGZ = 2304,
              C_MQA = 2560, C_CKV = 2816, C_MZ = 2944, C_WQ = 3200, C_WK = 3456, C_WV = 3584, C_WZ = 3712, C_KR = 3968, C_PAD = 4000, C_MG = 4096;
DEV int orig_col(int c) {
    if (c < 2944) return c;
    if (c < 3968) return c + 32;
    if (c < 4000) return 2944 + (c - 3968);
    if (c < 4096) return -1;
    return c - 96;
}
enum { I_XP = 0, I_XS, I_CNAK, I_CNAV, I_ST, I_CCKV, I_CKR, I_CWK, I_CWV, I_C, I_CCTX, I_NG, I_WMOD, I_BMOD, I_WIN, I_RPB, I_LB, I_HGG, I_QG, I_KVG, I_WQB, I_WKVB, I_SINK, I_WBR, I_WOUT, I_FG, N_IN };
constexpr size_t O_Y = 0;
constexpr size_t O_NAK = (size_t)NTOK * DM;
constexpr size_t O_NAV = O_NAK + (size_t)BATCH * DEPTH * SEQ * 256;
constexpr size_t O_ST = O_NAV + (size_t)BATCH * DEPTH * SEQ * 256;
constexpr size_t O_CKV = O_ST + (size_t)BATCH * DEPTH * 2 * 4 * 64 * 64;
constexpr size_t O_KR = O_CKV + (size_t)BATCH * DEPTH * SEQ * 128;
constexpr size_t O_WK = O_KR + (size_t)BATCH * DEPTH * SEQ * 32;
constexpr size_t O_WV = O_WK + (size_t)BATCH * DEPTH * SEQ * 128;
constexpr size_t O_END = O_WV + (size_t)BATCH * DEPTH * SEQ * 128;

typedef unsigned short bf16_t;
constexpr size_t al256(size_t x) { return (x + 255) & ~(size_t)255; }
constexpr size_t WS_CTL = 0;
constexpr size_t WS_WTIN = 1u << 20;
constexpr size_t WS_WTBR = WS_WTIN + (size_t)DEPTH * NC * DM * 2;
constexpr size_t WS_WTOUT = WS_WTBR + (size_t)DEPTH * 4 * DM * 256 * 2;
constexpr size_t WS_WTQB = WS_WTOUT + (size_t)DEPTH * DM * DM * 2;
constexpr size_t WS_WTKVB = WS_WTQB + (size_t)DEPTH * 512 * 256 * 2;
constexpr size_t WS_MODV = WS_WTKVB + (size_t)DEPTH * 512 * 128 * 2;
constexpr size_t WS_LBS = al256(WS_MODV + (size_t)DEPTH * NCB * 3072 * 4);
constexpr size_t WS_ROPEM = al256(WS_LBS + (size_t)DEPTH * 2 * 256 * 4);
constexpr size_t WS_ROPEW = al256(WS_ROPEM + (size_t)DSEQ * 16 * 2 * 4);
constexpr size_t WS_X = al256(WS_ROPEW + (size_t)DSEQ * 32 * 2 * 4);
constexpr size_t WS_H = WS_X + (size_t)NTOK * DM * 4;
constexpr size_t WS_COLS = WS_H + (size_t)NTOK * DM * 2;
constexpr size_t WS_KCM = WS_COLS + (size_t)NTOK * NC * 2;
constexpr size_t WS_VCM = WS_KCM + (size_t)DB * DEPTH * PAST * 384 * 2;
constexpr size_t WS_QN = WS_VCM + (size_t)DB * DEPTH * PAST * 256 * 2;
constexpr size_t WS_CKVB = WS_QN + (size_t)NTOK * 256 * 2;
constexpr size_t WS_QMLA = WS_CKVB + (size_t)NTOK * 128 * 2;
constexpr size_t WS_KMLA = WS_QMLA + (size_t)NTOK * 384 * 2;
constexpr size_t WS_VMLA = WS_KMLA + (size_t)NTOK * 384 * 2;
constexpr size_t WS_WQR = WS_VMLA + (size_t)NTOK * 256 * 2;
constexpr size_t WS_WKR = WS_WQR + (size_t)NTOK * 256 * 2;
constexpr size_t WS_OH = WS_WKR + (size_t)NTOK * 128 * 2;
constexpr size_t WS_Y = WS_OH + (size_t)2 * NTOK * 256 * 4;
constexpr size_t WS_MRG = WS_H;
constexpr size_t WS_HD = WS_Y + (size_t)NTOK * DM * 2;
constexpr size_t WS_CNAK = al256(WS_HD + (size_t)(NTOK / 64) * 4 * 2 * 64 * 4);
constexpr size_t WS_CNAV = WS_CNAK + (size_t)DB * DEPTH * PAST * 256 * 2;
constexpr size_t WS_CWK = WS_CNAV + (size_t)DB * DEPTH * PAST * 256 * 2;
constexpr size_t WS_CWV = WS_CWK + (size_t)DB * DEPTH * PAST * 128 * 2;
constexpr size_t WS_CCKVB = WS_CWV + (size_t)DB * DEPTH * PAST * 128 * 2;
constexpr size_t WS_END = WS_CCKVB + (size_t)DB * DEPTH * PAST * 128 * 2;
constexpr size_t WS_HL = WS_OH;
constexpr size_t WS_MRGF = WS_QN;
static_assert(WS_MRGF + (size_t)NTOK * DM * 4 <= WS_Y, "MRGF alias must end before Y");

struct P {
    const float* in[N_IN];
    float* out;
    unsigned char* ws;
};

DEV unsigned f2u(float f) { unsigned u; memcpy(&u, &f, 4); return u; }
DEV float u2f(unsigned u) { float f; memcpy(&f, &u, 4); return f; }
DEV bf16_t f2bf(float f) { unsigned u = f2u(f); return (bf16_t)((u + 0x7fffu + ((u >> 16) & 1u)) >> 16); }
DEV float bf2f(bf16_t b) { return u2f((unsigned)b << 16); }
DEV float rbf(float f) { return bf2f(f2bf(f)); }
DEV float sigm(float x) { return 1.f / (1.f + expf(-x)); }
DEV float siluf(float x) { return x * sigm(x); }
DEV int row_cb(int r) { return r < NCTX ? 0 : 1 + (r - NCTX) / DSEQ; }

struct U4 { unsigned x, y, z, w; };
DEV void unpack8(const bf16_t* p, float* f) {
    U4 v = *(const U4*)p;
    f[0] = u2f(v.x << 16); f[1] = u2f(v.x & 0xffff0000u); f[2] = u2f(v.y << 16); f[3] = u2f(v.y & 0xffff0000u);
    f[4] = u2f(v.z << 16); f[5] = u2f(v.z & 0xffff0000u); f[6] = u2f(v.w << 16); f[7] = u2f(v.w & 0xffff0000u);
}

#define WSP(T, off) ((T*)(p.ws + (off)))

DEV void nv_prep_w(const P& p, long gtid, long gsz) {
    bf16_t* wtin = WSP(bf16_t, WS_WTIN);
    const float* win = p.in[I_WIN];
    for (long i = gtid; i < (long)DEPTH * NC * DM; i += gsz) {
        int k = (int)(i % DM); long t = i / DM; int n = (int)(t % NC); int l = (int)(t / NC);
        int oc = orig_col(n);
        wtin[i] = oc < 0 ? (bf16_t)0 : f2bf(win[((size_t)l * DM + k) * INW + oc]);
    }
    bf16_t* wtbr = WSP(bf16_t, WS_WTBR);
    const float* wbr = p.in[I_WBR];
    for (long i = gtid; i < (long)DEPTH * 4 * DM * 256; i += gsz) {
        int w = (int)(i % 256); long t = i / 256; int d = (int)(t % DM); t /= DM; int b = (int)(t % 4); int l = (int)(t / 4);
        wtbr[i] = f2bf(wbr[(((size_t)l * 4 + b) * 256 + w) * DM + d]);
    }
    bf16_t* wtout = WSP(bf16_t, WS_WTOUT);
    const float* wout = p.in[I_WOUT];
    for (long i = gtid; i < (long)DEPTH * DM * DM; i += gsz) {
        int k = (int)(i % DM); long t = i / DM; int n = (int)(t % DM); int l = (int)(t / DM);
        wtout[i] = f2bf(wout[((size_t)l * DM + k) * DM + n]);
    }
    bf16_t* wtqb = WSP(bf16_t, WS_WTQB);
    const float* wqb = p.in[I_WQB];
    for (long i = gtid; i < (long)DEPTH * 512 * 256; i += gsz) {
        int k = (int)(i % 256); long t = i / 256; int n = (int)(t % 512); int l = (int)(t / 512);
        wtqb[i] = n < 384 ? f2bf(wqb[((size_t)l * 256 + k) * 384 + n]) : (bf16_t)0;
    }
    bf16_t* wtkvb = WSP(bf16_t, WS_WTKVB);
    const float* wkvb = p.in[I_WKVB];
    for (long i = gtid; i < (long)DEPTH * 512 * 128; i += gsz) {
        int k = (int)(i % 128); long t = i / 128; int n = (int)(t % 512); int l = (int)(t / 512);
        wtkvb[i] = f2bf(wkvb[((size_t)l * 128 + k) * 512 + n]);
    }
    float* modv = WSP(float, WS_MODV);
    for (long i = gtid; i < (long)DEPTH * NCB * 3072; i += gsz) {
        int j = (int)(i % 3072); long t = i / 3072; int cb = (int)(t % NCB); int l = (int)(t / NCB);
        const float* cv = cb == 0 ? p.in[I_CCTX] : p.in[I_C] + (size_t)(cb - 1) * DM;
        const float* w = p.in[I_WMOD] + (size_t)l * DM * 3072 + j;
        float acc = 0.f;
        for (int k = 0; k < DM; ++k) acc += siluf(cv[k]) * w[(size_t)k * 3072];
        modv[i] = acc + p.in[I_BMOD][(size_t)l * 3072 + j];
    }
    float* lbs = WSP(float, WS_LBS);
    for (long i = gtid; i < 2 * 256; i += gsz) {
        const float* lg = p.in[I_LB];
        float mx = -1e30f;
        for (int l = 0; l < DEPTH; ++l) mx = fmaxf(mx, lg[(size_t)l * 512 + i]);
        float s = 0.f;
        for (int l = 0; l < DEPTH; ++l) s += expf(lg[(size_t)l * 512 + i] - mx);
        float cum = 0.f, p0 = expf(lg[i] - mx) / s;
        for (int l = 0; l < DEPTH; ++l) { cum += expf(lg[(size_t)l * 512 + i] - mx) / s; lbs[(size_t)l * 512 + i] = cum - p0; }
    }
    float* rm = WSP(float, WS_ROPEM);
    for (long i = gtid; i < (long)DSEQ * 16; i += gsz) {
        int j = (int)(i % 16), t = (int)(i / 16);
        float pos = j < 8 ? (float)(t / GW) : (float)(t % GW);
        float inv = powf(10000.f, -(float)(j & 7) / 8.f);
        float a = pos * inv; rm[i * 2] = cosf(a); rm[i * 2 + 1] = sinf(a);
    }
    float* rw = WSP(float, WS_ROPEW);
    for (long i = gtid; i < (long)DSEQ * 32; i += gsz) {
        int j = (int)(i % 32), t = (int)(i / 32);
        float pos = j < 16 ? (float)(t / GW) : (float)(t % GW);
        float inv = powf(10000.f, -(float)(j & 15) / 16.f);
        float a = pos * inv; rw[i * 2] = cosf(a); rw[i * 2 + 1] = sinf(a);
    }
}

DEV void nv_prep_ctxmla(const P& p, long gtid, long gsz) {
    const bf16_t* wtkvb = WSP(bf16_t, WS_WTKVB);
    bf16_t* kcm = WSP(bf16_t, WS_KCM); bf16_t* vcm = WSP(bf16_t, WS_VCM);
    for (long i = gtid; i < (long)DB * DEPTH * PAST * 512; i += gsz) {
        int n = (int)(i % 512); long row = i / 512;
        int l = (int)((row / PAST) % DEPTH);
        const float* ck = p.in[I_CCKV] + (size_t)row * 128;
        const bf16_t* w = wtkvb + ((size_t)l * 512 + n) * 128;
        float acc = 0.f;
        for (int j = 0; j < 128; ++j) acc += rbf(ck[j]) * bf2f(w[j]);
        int h = n / 128, e = n % 128;
        if (e < 64) kcm[(size_t)row * 384 + h * 96 + e] = f2bf(acc);
        else vcm[(size_t)row * 256 + h * 64 + (e - 64)] = f2bf(acc);
    }
    for (long i = gtid; i < (long)DB * DEPTH * PAST * 128; i += gsz) {
        int e = (int)(i % 32); int h = (int)((i / 32) % 4); long row = i / 128;
        kcm[(size_t)row * 384 + h * 96 + 64 + e] = f2bf(p.in[I_CKR][(size_t)row * 32 + e]);
    }
    for (long i = gtid; i < (long)DB * DEPTH * PAST * 256; i += gsz) { WSP(bf16_t, WS_CNAK)[i] = f2bf(p.in[I_CNAK][i]); WSP(bf16_t, WS_CNAV)[i] = f2bf(p.in[I_CNAV][i]); }
    for (long i = gtid; i < (long)DB * DEPTH * PAST * 128; i += gsz) { WSP(bf16_t, WS_CWK)[i] = f2bf(p.in[I_CWK][i]); WSP(bf16_t, WS_CWV)[i] = f2bf(p.in[I_CWV][i]); }
}

DEV const float* x_row(const P& p, int l, int r) {
    if (l == 0) return r < NCTX ? p.in[I_XP] + (size_t)r * DM : p.in[I_XS] + (size_t)(r - NCTX) * DM;
    return WSP(float, WS_X) + (size_t)r * DM;
}

DEV void nv_normmod(const P& p, int l, long gtid, long gsz) {
    bf16_t* H = WSP(bf16_t, WS_H);
    const float* g = p.in[I_NG] + (size_t)l * DM;
    for (long r = gtid; r < NTOK; r += gsz) {
        const float* x = x_row(p, l, (int)r);
        const float* mv = WSP(float, WS_MODV) + ((size_t)l * NCB + row_cb((int)r)) * 3072;
        float ss = 0.f;
        for (int k = 0; k < DM; ++k) ss += x[k] * x[k];
        float rstd = 1.f / sqrtf(ss / DM + 1e-6f);
        for (int k = 0; k < DM; ++k) H[(size_t)r * DM + k] = f2bf(x[k] * rstd * g[k] * (1.f + mv[1024 + k]) + mv[k]);
    }
}

template <class Epi>
DEV void nv_gemm(const bf16_t* A, int lda, const bf16_t* Wt, int ldw, int M, int N, int K, long gtid, long gsz, Epi epi) {
    const long nItems = (long)(M / 4) * (N / 4);
    for (long it = gtid; it < nItems; it += gsz) {
        const int cb = (int)(it % (N / 4)), rb = (int)(it / (N / 4));
        float acc[4][4];
#pragma unroll
        for (int i = 0; i < 4; ++i)
#pragma unroll
            for (int j = 0; j < 4; ++j) acc[i][j] = 0.f;
        for (int k = 0; k < K; k += 8) {
            float a[4][8], w[4][8];
#pragma unroll
            for (int i = 0; i < 4; ++i) unpack8(A + (size_t)(rb * 4 + i) * lda + k, a[i]);
#pragma unroll
            for (int j = 0; j < 4; ++j) unpack8(Wt + (size_t)(cb * 4 + j) * ldw + k, w[j]);
#pragma unroll
            for (int i = 0; i < 4; ++i)
#pragma unroll
                for (int j = 0; j < 4; ++j)
#pragma unroll
                    for (int e = 0; e < 8; ++e) acc[i][j] += a[i][e] * w[j][e];
        }
#pragma unroll
        for (int i = 0; i < 4; ++i)
#pragma unroll
            for (int j = 0; j < 4; ++j) epi(rb * 4 + i, cb * 4 + j, acc[i][j]);
    }
}

DEV void nv_inproj(const P& p, int l, long gtid, long gsz) {
    bf16_t* cols = WSP(bf16_t, WS_COLS);
    float* out = p.out;
    nv_gemm(WSP(bf16_t, WS_H), DM, WSP(bf16_t, WS_WTIN) + (size_t)l * NC * DM, DM, NTOK, NC, DM, gtid, gsz,
        [=](int r, int n, float v) {
            cols[(size_t)r * NC + n] = f2bf(v);
            if (r < NCTX) {
                const int b = r / SEQ, t = r % SEQ; const size_t bl = ((size_t)b * DEPTH + l) * SEQ + t;
                if (n >= C_NAK && n < C_NAK + 256) out[O_NAK + bl * 256 + (n - C_NAK)] = v;
                else if (n >= C_NAV && n < C_NAV + 256) out[O_NAV + bl * 256 + (n - C_NAV)] = v;
                else if (n >= C_WK && n < C_WK + 128) out[O_WK + bl * 128 + (n - C_WK)] = v;
                else if (n >= C_WV && n < C_WV + 128) out[O_WV + bl * 128 + (n - C_WV)] = v;
            }
        });
}

DEV void nv_rowprep(const P& p, int l, long gtid, long gsz) {
    const bf16_t* cols = WSP(bf16_t, WS_COLS);
    for (long r = gtid; r < NTOK; r += gsz) {
        const bf16_t* c = cols + (size_t)r * NC;
        const bool lat = r >= NCTX; const int t = lat ? (int)((r - NCTX) % DSEQ) : 0;
        {
            float ss = 0.f;
            for (int j = 0; j < 128; ++j) { float v = bf2f(c[C_CKV + j]); ss += v * v; }
            float rstd = 1.f / sqrtf(ss / 128.f + 1e-6f);
            const float* g = p.in[I_KVG] + (size_t)l * 128;
            for (int j = 0; j < 128; ++j) {
                float v = bf2f(c[C_CKV + j]) * rstd * g[j];
                WSP(bf16_t, WS_CKVB)[(size_t)r * 128 + j] = f2bf(v);
                if (!lat) p.out[O_CKV + (((size_t)(r / SEQ) * DEPTH + l) * SEQ + (r % SEQ)) * 128 + j] = v;
            }
        }
        {
            const float* rm = WSP(float, WS_ROPEM) + (size_t)t * 32;
            for (int j = 0; j < 16; ++j) {
                float x1 = bf2f(c[C_KR + j]), x2 = bf2f(c[C_KR + 16 + j]);
                float o1 = x1, o2 = x2;
                if (lat) { float cs = rm[j * 2], sn = rm[j * 2 + 1]; o1 = x1 * cs - x2 * sn; o2 = x1 * sn + x2 * cs; }
                else {
                    size_t o = O_KR + (((size_t)(r / SEQ) * DEPTH + l) * SEQ + (r % SEQ)) * 32;
                    p.out[o + j] = x1; p.out[o + 16 + j] = x2;
                }
                for (int h = 0; h < 4; ++h) {
                    WSP(bf16_t, WS_KMLA)[(size_t)r * 384 + h * 96 + 64 + j] = f2bf(o1);
                    WSP(bf16_t, WS_KMLA)[(size_t)r * 384 + h * 96 + 80 + j] = f2bf(o2);
                }
            }
        }
        {
            float ss = 0.f;
            for (int j = 0; j < 256; ++j) { float v = bf2f(c[C_MQA + j]); ss += v * v; }
            float rstd = 1.f / sqrtf(ss / 256.f + 1e-6f);
            const float* g = p.in[I_QG] + (size_t)l * 256;
            for (int j = 0; j < 256; ++j) WSP(bf16_t, WS_QN)[(size_t)r * 256 + j] = f2bf(bf2f(c[C_MQA + j]) * rstd * g[j]);
        }
        {
            const float* rw = WSP(float, WS_ROPEW) + (size_t)t * 64;
            for (int hh = 0; hh < 6; ++hh) {
                const bf16_t* src = hh < 4 ? c + C_WQ + hh * 64 : c + C_WK + (hh - 4) * 64;
                bf16_t* dst = hh < 4 ? WSP(bf16_t, WS_WQR) + (size_t)r * 256 + hh * 64 : WSP(bf16_t, WS_WKR) + (size_t)r * 128 + (hh - 4) * 64;
                for (int j = 0; j < 32; ++j) {
                    float x1 = bf2f(src[j]), x2 = bf2f(src[32 + j]);
                    if (lat) { float cs = rw[j * 2], sn = rw[j * 2 + 1]; dst[j] = f2bf(x1 * cs - x2 * sn); dst[32 + j] = f2bf(x1 * sn + x2 * cs); }
                    else { dst[j] = src[j]; dst[32 + j] = src[32 + j]; }
                }
            }
        }
    }
}

DEV void nv_mlaproj(const P& p, int l, long gtid, long gsz) {
    bf16_t* qm = WSP(bf16_t, WS_QMLA); bf16_t* km = WSP(bf16_t, WS_KMLA); bf16_t* vm = WSP(bf16_t, WS_VMLA);
    nv_gemm(WSP(bf16_t, WS_QN), 256, WSP(bf16_t, WS_WTQB) + (size_t)l * 512 * 256, 256, NTOK, 384, 256, gtid, gsz,
        [=](int r, int n, float v) { qm[(size_t)r * 384 + n] = f2bf(v); });
    nv_gemm(WSP(bf16_t, WS_CKVB), 128, WSP(bf16_t, WS_WTKVB) + (size_t)l * 512 * 128, 128, NTOK, 512, 128, gtid, gsz,
        [=](int r, int n, float v) {
            int h = n / 128, e = n % 128;
            if (e < 64) km[(size_t)r * 384 + h * 96 + e] = f2bf(v); else vm[(size_t)r * 256 + h * 64 + (e - 64)] = f2bf(v);
        });
}

struct SoftAcc { float m, l; float o[32]; };
DEV void sa_init(SoftAcc& s) { s.m = -3e38f; s.l = 0.f;
#pragma unroll
    for (int d = 0; d < 32; ++d) s.o[d] = 0.f; }
DEV void sa_add(SoftAcc& s, float sc, const bf16_t* v) {
    float mn = fmaxf(s.m, sc);
    float corr = expf(s.m - mn), pe = expf(sc - mn);
    s.m = mn; s.l = s.l * corr + pe;
#pragma unroll
    for (int d8 = 0; d8 < 4; ++d8) {
        float f[8]; unpack8(v + d8 * 8, f);
#pragma unroll
        for (int e = 0; e < 8; ++e) s.o[d8 * 8 + e] = s.o[d8 * 8 + e] * corr + pe * f[e];
    }
}
DEV void sa_add_f32v(SoftAcc& s, float sc, const float* v) {
    float mn = fmaxf(s.m, sc);
    float corr = expf(s.m - mn), pe = expf(sc - mn);
    s.m = mn; s.l = s.l * corr + pe;
#pragma unroll
    for (int d = 0; d < 32; ++d) s.o[d] = s.o[d] * corr + pe * rbf(v[d]);
}
template <int DQ> DEV float dot_bf(const float* q, const bf16_t* k) {
    float acc = 0.f;
#pragma unroll
    for (int d8 = 0; d8 < DQ / 8; ++d8) {
        float f[8]; unpack8(k + d8 * 8, f);
#pragma unroll
        for (int e = 0; e < 8; ++e) acc += q[d8 * 8 + e] * f[e];
    }
    return acc;
}
DEV float dot64_f32k(const float* q, const float* k) {
    float acc = 0.f;
#pragma unroll
    for (int d = 0; d < 64; ++d) acc += q[d] * rbf(k[d]);
    return acc;
}
DEV void sa_store(const P& p, const SoftAcc& s, float extra_den, int r, int branch, int h, int zcol, int half) {
    const bf16_t* c = WSP(bf16_t, WS_COLS) + (size_t)r * NC + zcol + h * 64 + half * 32;
    bf16_t* y = WSP(bf16_t, WS_Y) + (size_t)r * DM + branch * 256 + h * 64 + half * 32;
    float inv = 1.f / (s.l + extra_den);
#pragma unroll
    for (int d = 0; d < 32; ++d) y[d] = f2bf(s.o[d] * inv * siluf(bf2f(c[d])));
}

DEV void nv_attn(const P& p, int l, long gtid, long gsz) {
    const bf16_t* cols = WSP(bf16_t, WS_COLS);
    for (long it = gtid; it < (long)NTOK * 24; it += gsz) {
        const int half = (int)(it % 2); const int kind = (int)((it / 2) % 3); const int h = (int)((it / 6) % 4); const int r = (int)(it / 24);
        const int vo = half * 32;
        const bool lat = r >= NCTX;
        const int b = lat ? (r - NCTX) / DSEQ : r / SEQ, t = lat ? (r - NCTX) % DSEQ : r % SEQ;
        const int seq0 = lat ? NCTX + b * DSEQ : b * SEQ;
        SoftAcc s; sa_init(s);
        if (kind == 0) {
            float q[64];
#pragma unroll
            for (int d8 = 0; d8 < 8; ++d8) unpack8(cols + (size_t)r * NC + C_NAQ + h * 64 + d8 * 8, q + d8 * 8);
            if (!lat) {
                for (int j = 0; j < SEQ; ++j) {
                    const bf16_t* kr = cols + (size_t)(seq0 + j) * NC;
                    sa_add(s, dot_bf<64>(q, kr + C_NAK + h * 64) * 0.125f, kr + C_NAV + h * 64 + vo);
                }
            } else {
                const int gi = t / GW, gj = t % GW;
                int rs = gi - 4; rs = rs < 0 ? 0 : (rs > GROWS - 8 ? GROWS - 8 : rs);
                int cs = gj - 8; cs = cs < 0 ? 0 : (cs > GW - 16 ? GW - 16 : cs);
                const float* rpb = p.in[I_RPB] + ((size_t)l * 4 + h) * 15 * 31;
                for (int kr_ = rs; kr_ < rs + 8; ++kr_)
                    for (int kc = cs; kc < cs + 16; ++kc) {
                        const bf16_t* kk = cols + (size_t)(seq0 + kr_ * GW + kc) * NC;
                        int dc = kc - gj + 15; dc = dc < 0 ? 0 : (dc > 30 ? 30 : dc);
                        float bias = rpb[(kr_ - gi + 7) * 31 + dc];
                        sa_add(s, dot_bf<64>(q, kk + C_NAK + h * 64) * 0.125f + bias, kk + C_NAV + h * 64 + vo);
                    }
                const float* ck = p.in[I_CNAK] + ((size_t)b * DEPTH + l) * PAST * 256 + h * 64;
                const float* cv = p.in[I_CNAV] + ((size_t)b * DEPTH + l) * PAST * 256 + h * 64 + vo;
                for (int j = 0; j < PAST; ++j) sa_add_f32v(s, dot64_f32k(q, ck + (size_t)j * 256) * 0.125f, cv + (size_t)j * 256);
            }
            sa_store(p, s, 0.f, r, 0, h, C_NAZ, half);
        } else if (kind == 1) {
            float q[96];
            const bf16_t* qp = WSP(bf16_t, WS_QMLA) + (size_t)r * 384 + h * 96;
#pragma unroll
            for (int d8 = 0; d8 < 12; ++d8) unpack8(qp + d8 * 8, q + d8 * 8);
            if (lat) {
                const float* rm = WSP(float, WS_ROPEM) + (size_t)t * 32;
#pragma unroll
                for (int j = 0; j < 16; ++j) {
                    float x1 = q[64 + j], x2 = q[80 + j], cs = rm[j * 2], sn = rm[j * 2 + 1];
                    q[64 + j] = rbf(x1 * cs - x2 * sn); q[80 + j] = rbf(x1 * sn + x2 * cs);
                }
            }
            const float scale = 0.10206207261596577f;
            const int n = lat ? DSEQ : SEQ;
            const bf16_t* km = WSP(bf16_t, WS_KMLA) + (size_t)seq0 * 384 + h * 96;
            const bf16_t* vm = WSP(bf16_t, WS_VMLA) + (size_t)seq0 * 256 + h * 64 + vo;
            for (int j = 0; j < n; ++j) sa_add(s, dot_bf<96>(q, km + (size_t)j * 384) * scale, vm + (size_t)j * 256);
            if (lat) {
                const bf16_t* kc = WSP(bf16_t, WS_KCM) + ((size_t)b * DEPTH + l) * PAST * 384 + h * 96;
                const bf16_t* vc = WSP(bf16_t, WS_VCM) + ((size_t)b * DEPTH + l) * PAST * 256 + h * 64 + vo;
                for (int j = 0; j < PAST; ++j) sa_add(s, dot_bf<96>(q, kc + (size_t)j * 384) * scale, vc + (size_t)j * 256);
            }
            sa_store(p, s, 0.f, r, 2, h, C_MZ, half);
        } else {
            float q[64];
#pragma unroll
            for (int d8 = 0; d8 < 8; ++d8) unpack8(WSP(bf16_t, WS_WQR) + (size_t)r * 256 + h * 64 + d8 * 8, q + d8 * 8);
            const int kh = h / 2;
            const float sink = p.in[I_SINK][l * 4 + h];
            int j0 = 0, j1 = SEQ;
            if (lat) { j0 = t - 128 < 0 ? 0 : t - 128; j1 = t + 129 > DSEQ ? DSEQ : t + 129; }
            for (int j = j0; j < j1; ++j)
                sa_add(s, dot_bf<64>(q, WSP(bf16_t, WS_WKR) + (size_t)(seq0 + j) * 128 + kh * 64) * 0.125f, cols + (size_t)(seq0 + j) * NC + C_WV + kh * 64 + vo);
            if (lat) {
                const float* ck = p.in[I_CWK] + ((size_t)b * DEPTH + l) * PAST * 128 + kh * 64;
                const float* cv = p.in[I_CWV] + ((size_t)b * DEPTH + l) * PAST * 128 + kh * 64 + vo;
                for (int j = 0; j < PAST; ++j) sa_add_f32v(s, dot64_f32k(q, ck + (size_t)j * 128) * 0.125f, cv + (size_t)j * 128);
            }
            float mn = fmaxf(s.m, sink); float corr = expf(s.m - mn);
            s.l *= corr;
#pragma unroll
            for (int d = 0; d < 32; ++d) s.o[d] *= corr;
            s.m = mn;
            sa_store(p, s, expf(sink - mn), r, 3, h, C_WZ, half);
        }
    }
}

DEV void nv_hgrn(const P& p, int l, long gtid, long gsz) {
    const bf16_t* cols = WSP(bf16_t, WS_COLS);
    float* oh = WSP(float, WS_OH);
    const int NSEQ = BATCH + DB;
    for (long it = gtid; it < (long)NSEQ * 4 * 2 * 64; it += gsz) {
        const int j = (int)(it % 64); const int dir = (int)((it / 64) % 2); const int h = (int)((it / 128) % 4); const int sq = (int)(it / 512);
        const bool lat = sq >= BATCH;
        const int b = lat ? sq - BATCH : sq;
        const int T = lat ? DSEQ : SEQ; const int seq0 = lat ? NCTX + b * DSEQ : b * SEQ;
        const float* lb = WSP(float, WS_LBS) + ((size_t)l * 2 + dir) * 256 + h * 64;
        float S[64];
        if (lat) {
            const float* st = p.in[I_ST] + ((((size_t)b * DEPTH + l) * 2 + dir) * 4 + h) * 4096;
#pragma unroll
            for (int d = 0; d < 64; ++d) S[d] = st[d * 64 + j];
        } else {
#pragma unroll
            for (int d = 0; d < 64; ++d) S[d] = 0.f;
        }
        const int fcol = dir == 0 ? C_HGFF : C_HGFB;
        for (int tt = 0; tt < T; ++tt) {
            const int t = dir == 0 ? tt : T - 1 - tt;
            const bf16_t* c = cols + (size_t)(seq0 + t) * NC;
            const float v = bf2f(c[C_HGI + h * 64 + j]);
            float o = 0.f;
#pragma unroll
            for (int d8 = 0; d8 < 8; ++d8) {
                float fz[8], qq[8]; unpack8(c + fcol + h * 64 + d8 * 8, fz); unpack8(c + C_HGQ + h * 64 + d8 * 8, qq);
#pragma unroll
                for (int e = 0; e < 8; ++e) {
                    const int d = d8 * 8 + e;
                    const float lbv = lb[d];
                    float f = lbv + (1.f - lbv) * sigm(fz[e]);
                    f = fmaxf(f, 1e-30f);
                    const float k = (1.f - lbv) * sigm(-fz[e]);
                    S[d] = f * S[d] + k * v;
                    o += S[d] * siluf(qq[e]);
                }
            }
            oh[((size_t)dir * NTOK + seq0 + t) * 256 + h * 64 + j] = o;
        }
        if (!lat) {
            float* so = p.out + O_ST + ((((size_t)b * DEPTH + l) * 2 + dir) * 4 + h) * 4096;
#pragma unroll
            for (int d = 0; d < 64; ++d) so[d * 64 + j] = S[d];
        }
    }
}

DEV void nv_hgrn_fin(const P& p, int l, long gtid, long gsz) {
    const bf16_t* cols = WSP(bf16_t, WS_COLS);
    const float* oh = WSP(float, WS_OH);
    const float* g = p.in[I_HGG] + (size_t)l * 64;
    for (long it = gtid; it < (long)NTOK * 4; it += gsz) {
        const int h = (int)(it % 4); const int r = (int)(it / 4);
        const float* of = oh + (size_t)r * 256 + h * 64; const float* ob = oh + ((size_t)NTOK + r) * 256 + h * 64;
        float ss = 0.f;
        for (int d = 0; d < 64; ++d) { float v = of[d] + ob[d]; ss += v * v; }
        float rstd = 1.f / sqrtf(ss / 64.f + 1e-6f);
        const bf16_t* c = cols + (size_t)r * NC;
        bf16_t* y = WSP(bf16_t, WS_Y) + (size_t)r * DM + 256 + h * 64;
        for (int d = 0; d < 64; ++d) {
            float v = (of[d] + ob[d]) * rstd * g[d] * sigm(bf2f(c[C_HGOG + h * 64 + d]));
            y[d] = f2bf(v * siluf(bf2f(c[C_HGZ + h * 64 + d])));
        }
    }
}

DEV void nv_merge(const P& p, int l, long gtid, long gsz) {
    const bf16_t* cols = WSP(bf16_t, WS_COLS);
    const bf16_t* Y = WSP(bf16_t, WS_Y);
    const bf16_t* wt = WSP(bf16_t, WS_WTBR) + (size_t)l * 4 * DM * 256;
    bf16_t* mrg = WSP(bf16_t, WS_MRG);
    for (long it = gtid; it < (long)NTOK * DM; it += gsz) {
        const int d = (int)(it % DM); const int r = (int)(it / DM);
        float tot = 0.f;
        for (int b = 0; b < 4; ++b) {
            const bf16_t* y = Y + (size_t)r * DM + b * 256; const bf16_t* w = wt + ((size_t)b * DM + d) * 256;
            float acc = 0.f;
            for (int k = 0; k < 256; k += 8) {
                float a[8], ww[8]; unpack8(y + k, a); unpack8(w + k, ww);
#pragma unroll
                for (int e = 0; e < 8; ++e) acc += a[e] * ww[e];
            }
            tot += sigm(bf2f(cols[(size_t)r * NC + C_MG + b * DM + d])) * acc;
        }
        mrg[it] = f2bf(tot);
    }
}

DEV void nv_out(const P& p, int l, long gtid, long gsz) {
    float* X = WSP(float, WS_X);
    const float* modv = WSP(float, WS_MODV);
    const P pp = p;
    nv_gemm(WSP(bf16_t, WS_MRG), DM, WSP(bf16_t, WS_WTOUT) + (size_t)l * DM * DM, DM, NTOK, DM, DM, gtid, gsz,
        [=](int r, int n, float v) {
            const float gate = modv[((size_t)l * NCB + row_cb(r)) * 3072 + 2048 + n];
            X[(size_t)r * DM + n] = x_row(pp, l, r)[n] + gate * v;
        });
}

DEV void nv_final(const P& p, long gtid, long gsz) {
    const float* X = WSP(float, WS_X); const float* g = p.in[I_FG];
    for (long r = gtid; r < NTOK; r += gsz) {
        const float* x = X + (size_t)r * DM;
        float ss = 0.f;
        for (int k = 0; k < DM; ++k) ss += x[k] * x[k];
        float rstd = 1.f / sqrtf(ss / DM + 1e-6f);
        for (int k = 0; k < DM; ++k) p.out[O_Y + (size_t)r * DM + k] = x[k] * rstd * g[k];
    }
}

constexpr int ST_PREP_W = 0, ST_PREP_CTX = 1, ST_LAYER0 = 2, ST_PER_LAYER = 8;
constexpr int N_STAGES = ST_LAYER0 + DEPTH * ST_PER_LAYER + 1;
DEV void run_stage(const P& p, int st, long gtid, long gsz) {
    if (st == ST_PREP_W) { nv_prep_w(p, gtid, gsz); return; }
    if (st == ST_PREP_CTX) { nv_prep_ctxmla(p, gtid, gsz); return; }
    if (st == N_STAGES - 1) { nv_final(p, gtid, gsz); return; }
    const int l = (st - ST_LAYER0) / ST_PER_LAYER, s = (st - ST_LAYER0) % ST_PER_LAYER;
    switch (s) {
        case 0: nv_normmod(p, l, gtid, gsz); break;
        case 1: nv_inproj(p, l, gtid, gsz); break;
        case 2: nv_rowprep(p, l, gtid, gsz); break;
        case 3: nv_mlaproj(p, l, gtid, gsz); break;
        case 4: nv_attn(p, l, gtid, gsz); nv_hgrn(p, l, gtid, gsz); break;
        case 5: nv_hgrn_fin(p, l, gtid, gsz); break;
        case 6: nv_merge(p, l, gtid, gsz); break;
        case 7: nv_out(p, l, gtid, gsz); break;
    }
}

#ifndef CPU_EMU
#define LAS __attribute__((address_space(3)))
typedef short bf16x8 __attribute__((ext_vector_type(8)));
typedef float f32x4 __attribute__((ext_vector_type(4)));
typedef unsigned u32x4 __attribute__((ext_vector_type(4)));
constexpr int NTHREADS = 512;
constexpr int LDS_BYTES = 147456;

__device__ __forceinline__ unsigned cvt_pk_bf16(float lo, float hi) { unsigned r; asm volatile("v_cvt_pk_bf16_f32 %0, %1, %2" : "=v"(r) : "v"(lo), "v"(hi)); return r; }
__device__ __forceinline__ u32x4 pack8(f32x4 a, f32x4 b) { u32x4 w; w.x = cvt_pk_bf16(a[0], a[1]); w.y = cvt_pk_bf16(a[2], a[3]); w.z = cvt_pk_bf16(b[0], b[1]); w.w = cvt_pk_bf16(b[2], b[3]); return w; }
__device__ __forceinline__ void unpack8v(u32x4 v, f32x4& a, f32x4& b) {
    a[0] = u2f(v.x << 16); a[1] = u2f(v.x & 0xffff0000u); a[2] = u2f(v.y << 16); a[3] = u2f(v.y & 0xffff0000u);
    b[0] = u2f(v.z << 16); b[1] = u2f(v.z & 0xffff0000u); b[2] = u2f(v.w << 16); b[3] = u2f(v.w & 0xffff0000u);
}

namespace pg8 {
constexpr int BM = 256, BK = 64, HALF = 128, HTB = HALF * BK * 2  , STAGE_BYTES = 8 * HTB, NXCD = 8, WGM = 8;
__device__ __forceinline__ int lds_byte(int r, int c) { const int st = (r >> 4) * 2 + (c >> 5), rr = r & 15, cc = c & 31, ob = rr * 64 + cc * 2; return st * 1024 + (ob ^ (((ob >> 9) & 1) << 5)); }
__device__ __forceinline__ void stage_rc(int b, int& R, int& C) { const int st = b / 1024, sb = b % 1024, swz = sb ^ (((sb >> 9) & 1) << 5); R = (st >> 1) * 16 + swz / 64; C = (st & 1) * 32 + (swz % 64) / 2; }
__device__ __forceinline__ int perm32(int rho) { const int n = rho >> 4, i = rho & 15; return 8 * (i >> 2) + 4 * n + (i & 3); }

struct Unit { int pm, pn, aux; const char* A; const char* B; };
struct Gemm { int lda, ldb, K; };

struct GridOrder {
    int nM, nN, nwg, G, c; const char* A; const char* B; size_t astep, bstep;
    __device__ void init(int M, int N, int G_, int c_, const void* A_, int lda, const void* B_, int ldb) { nM = M / BM; nN = N / BM; nwg = nM * nN; G = G_; c = c_; A = (const char*)A_; B = (const char*)B_; astep = (size_t)BM * lda * 2; bstep = (size_t)BM * ldb * 2; }
    __device__ bool next(int i, Unit& u) const {
        const long L = (long)i * G + c; if (L >= nwg) return false;
        int wgid = (int)L; { const int q = nwg / NXCD, r = nwg % NXCD, xcd = wgid % NXCD, off = wgid / NXCD; wgid = (xcd < r ? xcd * (q + 1) : r * (q + 1) + (xcd - r) * q) + off; }
        const int nig = WGM * nN, gid = wgid / nig, fm = gid * WGM, gsz = (nM - fm) < WGM ? (nM - fm) : WGM;
        u.pm = fm + ((wgid % nig) % gsz); u.pn = (wgid % nig) / gsz; u.aux = 0; u.A = A + (size_t)u.pm * astep; u.B = B + (size_t)u.pn * bstep; return true;
    }
};

template <class F> struct EpiF {
    F f;
    __device__ __forceinline__ void operator()(const f32x4 (&acc)[2][2][4][2], const Unit& u, int wr, int wc, int fr, int fq) const {
#pragma unroll
        for (int ai = 0; ai < 2; ++ai)
#pragma unroll
            for (int m = 0; m < 4; ++m)
#pragma unroll
                for (int bj = 0; bj < 2; ++bj)
                    f(u, u.pm * BM + ai * HALF + wr * 64 + m * 16 + fr, u.pn * BM + bj * HALF + wc * 32 + 8 * fq, acc[ai][bj][m][0], acc[ai][bj][m][1]);
    }
};

template <class Epi, class Sched>
__device__ __forceinline__ void gemm_phase(LAS unsigned char* lds, const Gemm g, const Sched& S, const Epi& E) {
    int tid_ = threadIdx.x; asm volatile("" : "+v"(tid_));
    const int tid = tid_, wid = __builtin_amdgcn_readfirstlane(tid >> 6), lane = tid & 63, wr = wid >> 2, wc = wid & 3, fr = lane & 15, fq = lane >> 4;
    const int K = g.K, nt = K / BK;
    unsigned voffA[2], voffB[2];
#pragma unroll
    for (int i = 0; i < 2; ++i) { int R, C; stage_rc(tid * 16 + i * 8192, R, C); const int Rb = (R & ~31) + perm32(R & 31);
        voffA[i] = (unsigned)(R * g.lda + C) * 2u; voffB[i] = (unsigned)(Rb * g.ldb + C) * 2u; }
    const size_t kstep = (size_t)(BK * 2);
    const size_t hstepA = (size_t)HALF * g.lda * 2, hstepB = (size_t)HALF * g.ldb * 2;
    const unsigned ldsw = (unsigned)wid * 1024u;
    const int aoff = lds_byte(wr * 64 + fr, fq * 8), boff = lds_byte(wc * 32 + fr, fq * 8);
#define PG8_SA(b, h) (((b) * 2 + (h)) * HTB)
#define PG8_SB(b, h) ((4 + (b) * 2 + (h)) * HTB)
#define PG8_STAGE(bufoff, gbase, voff) do { _Pragma("unroll") for (int _i = 0; _i < 2; ++_i) \
        __builtin_amdgcn_global_load_lds((const unsigned*)((const char*)(gbase) + (voff)[_i]), (LAS unsigned*)(lds + (bufoff) + ldsw + _i * 8192), 16, 0, 0); } while (0)
#define PG8_LDA(dst, b, h) do { _Pragma("unroll") for (int m = 0; m < 4; ++m) _Pragma("unroll") for (int k = 0; k < 2; ++k) dst[m][k] = *(const LAS bf16x8*)(lds + PG8_SA(b, h) + aoff + m * 2048 + k * 1024); } while (0)
#define PG8_LDB(dst, b, h) do { _Pragma("unroll") for (int n = 0; n < 2; ++n) _Pragma("unroll") for (int k = 0; k < 2; ++k) dst[n][k] = *(const LAS bf16x8*)(lds + PG8_SB(b, h) + boff + n * 2048 + k * 1024); } while (0)
#define PG8_MMA(ai, bj, At, Bt) do { __builtin_amdgcn_s_setprio(1); _Pragma("unroll") for (int m = 0; m < 4; ++m) _Pragma("unroll") for (int n = 0; n < 2; ++n) _Pragma("unroll") for (int k = 0; k < 2; ++k) \
        acc[ai][bj][m][n] = __builtin_amdgcn_mfma_f32_16x16x32_bf16(Bt[n][k], At[m][k], acc[ai][bj][m][n], 0, 0, 0); __builtin_amdgcn_s_setprio(0); } while (0)
#define PG8_WAIT_V(n) asm volatile("s_waitcnt vmcnt(" #n ")" ::: "memory")
#define PG8_WAIT_L(n) asm volatile("s_waitcnt lgkmcnt(" #n ")" ::: "memory")
#define PG8_BAR __builtin_amdgcn_s_barrier()
#define PG8_SCHED __builtin_amdgcn_sched_barrier(0)
    Unit cur, nxt; int ui = 0;
    if (!S.next(0, cur)) return;
    f32x4 acc[2][2][4][2];
#pragma unroll
    for (int a = 0; a < 2; ++a)
#pragma unroll
        for (int b = 0; b < 2; ++b)
#pragma unroll
            for (int m = 0; m < 4; ++m)
#pragma unroll
                for (int n = 0; n < 2; ++n) acc[a][b][m][n] = (f32x4){0.f, 0.f, 0.f, 0.f};
    bf16x8 At[4][2], B0[2][2], B1[2][2];
    const char* cA = cur.A; const char* cB = cur.B;
    PG8_STAGE(PG8_SB(0, 0), cB, voffB); PG8_STAGE(PG8_SB(0, 1), cB + hstepB, voffB); PG8_STAGE(PG8_SA(0, 0), cA, voffA); PG8_STAGE(PG8_SA(0, 1), cA + hstepA, voffA);
    if (wr == 1) PG8_BAR;
    PG8_WAIT_V(2); PG8_BAR;
    PG8_STAGE(PG8_SB(1, 0), cB + kstep, voffB); PG8_STAGE(PG8_SA(1, 0), cA + kstep, voffA); PG8_STAGE(PG8_SB(1, 1), cB + hstepB + kstep, voffB);
    PG8_WAIT_V(6); PG8_BAR;
    for (;;) {
        const bool has_next = S.next(ui + 1, nxt);
        const char* nA = has_next ? nxt.A : cA; const char* nB = has_next ? nxt.B : cB;
#pragma nounroll
        for (int t = 0; t < nt; t += 2) {
            const bool last = (t == nt - 2);
            const char* a1 = cA + (size_t)(t + 1) * kstep;
            const char* a2 = last ? nA : cA + (size_t)(t + 2) * kstep; const char* b2 = last ? nB : cB + (size_t)(t + 2) * kstep;
            const char* a3 = a2 + kstep; const char* b3 = b2 + kstep;
            PG8_LDB(B0, 0, 0); PG8_LDB(B1, 0, 1); PG8_SCHED; PG8_LDA(At, 0, 0); PG8_STAGE(PG8_SA(1, 1), a1 + hstepA, voffA);
            PG8_WAIT_V(8); PG8_WAIT_L(0); PG8_BAR; PG8_MMA(0, 0, At, B0); PG8_MMA(0, 1, At, B1); PG8_BAR; PG8_SCHED;
            PG8_LDA(At, 0, 1); PG8_STAGE(PG8_SB(0, 0), b2, voffB); PG8_STAGE(PG8_SB(0, 1), b2 + hstepB, voffB); PG8_STAGE(PG8_SA(0, 0), a2, voffA);
            PG8_WAIT_V(8); PG8_WAIT_L(0); PG8_BAR; PG8_MMA(1, 0, At, B0); PG8_MMA(1, 1, At, B1); PG8_BAR; PG8_SCHED;
            PG8_LDB(B0, 1, 0); PG8_LDB(B1, 1, 1); PG8_SCHED; PG8_LDA(At, 1, 0); PG8_STAGE(PG8_SA(0, 1), a2 + hstepA, voffA);
            PG8_WAIT_V(8); PG8_WAIT_L(0); PG8_BAR; PG8_MMA(0, 0, At, B0); PG8_MMA(0, 1, At, B1); PG8_BAR; PG8_SCHED;
            PG8_LDA(At, 1, 1); PG8_STAGE(PG8_SB(1, 0), b3, voffB); PG8_STAGE(PG8_SB(1, 1), b3 + hstepB, voffB); PG8_STAGE(PG8_SA(1, 0), a3, voffA);
            PG8_WAIT_V(8); PG8_WAIT_L(0); PG8_BAR; PG8_MMA(1, 0, At, B0); PG8_MMA(1, 1, At, B1); PG8_BAR; PG8_SCHED;
        }
        if (wr == 0) PG8_BAR;
        E(acc, cur, wr, wc, fr, fq);
        if (!has_next) break;
#pragma unroll
        for (int a = 0; a < 2; ++a)
#pragma unroll
            for (int b = 0; b < 2; ++b)
#pragma unroll
                for (int m = 0; m < 4; ++m)
#pragma unroll
                    for (int n = 0; n < 2; ++n) acc[a][b][m][n] = (f32x4){0.f, 0.f, 0.f, 0.f};
        cur = nxt; cA = nA; cB = nB; ++ui;
        if (wr == 1) PG8_BAR;
    }
    PG8_WAIT_V(0);
    PG8_BAR;
#undef PG8_SA
#undef PG8_SB
#undef PG8_STAGE
#undef PG8_LDA
#undef PG8_LDB
#undef PG8_MMA
#undef PG8_WAIT_V
#undef PG8_WAIT_L
#undef PG8_BAR
#undef PG8_SCHED
}
}

template <class F> __device__ __forceinline__ pg8::EpiF<F> make_epi(F f) { return pg8::EpiF<F>{f}; }

__device__ __forceinline__ void fs_inproj(const P& p, int l, LAS unsigned char* lds) {
    bf16_t* cols = WSP(bf16_t, WS_COLS); float* out = p.out;
    pg8::GridOrder S; S.init(NTOK, NC, gridDim.x, blockIdx.x, WSP(bf16_t, WS_H), DM, WSP(bf16_t, WS_WTIN) + (size_t)l * NC * DM, DM);
    auto E = make_epi([=](const pg8::Unit& u, int r, int n, f32x4 v0, f32x4 v1) {
        *(u32x4*)(cols + (size_t)r * NC + n) = pack8(v0, v1);
        if (r < NCTX) {
            const int b = r / SEQ, t = r % SEQ; const size_t bl = ((size_t)b * DEPTH + l) * SEQ + t;
            float* o = nullptr;
            if (n >= C_NAK && n < C_NAK + 256) o = out + O_NAK + bl * 256 + (n - C_NAK);
            else if (n >= C_NAV && n < C_NAV + 256) o = out + O_NAV + bl * 256 + (n - C_NAV);
            else if (n >= C_WK && n < C_WK + 128) o = out + O_WK + bl * 128 + (n - C_WK);
            else if (n >= C_WV && n < C_WV + 128) o = out + O_WV + bl * 128 + (n - C_WV);
            if (o) { *(f32x4*)o = v0; *(f32x4*)(o + 4) = v1; }
        }
    });
    pg8::gemm_phase(lds, pg8::Gemm{DM, DM, DM}, S, E);
}

struct SubOrder {
    int nM, nN, c, c0, nwgs; const char* A; const char* B; size_t astep, bstep;
    __device__ bool next(int i, pg8::Unit& u) const {
        const int cc = c - c0; if (cc < 0 || cc >= nwgs) return false;
        const int L = i * nwgs + cc; if (L >= nM * nN) return false;
        u.pm = L / nN; u.pn = L % nN; u.aux = 0; u.A = A + (size_t)u.pm * astep; u.B = B + (size_t)u.pn * bstep; return true;
    }
};
__device__ __forceinline__ void fs_mlaproj(const P& p, int l, LAS unsigned char* lds) {
    bf16_t* qm = WSP(bf16_t, WS_QMLA); bf16_t* km = WSP(bf16_t, WS_KMLA); bf16_t* vm = WSP(bf16_t, WS_VMLA);
    const int G = gridDim.x, half = G / 2;
    const bool isq = (int)blockIdx.x < half;
    const int K = isq ? 256 : 128;
    SubOrder S{NTOK / 256, 2, (int)blockIdx.x, isq ? 0 : half, isq ? half : G - half,
               isq ? (const char*)WSP(bf16_t, WS_QN) : (const char*)WSP(bf16_t, WS_CKVB),
               isq ? (const char*)(WSP(bf16_t, WS_WTQB) + (size_t)l * 512 * 256) : (const char*)(WSP(bf16_t, WS_WTKVB) + (size_t)l * 512 * 128),
               (size_t)256 * K * 2, (size_t)256 * K * 2};
    auto E = make_epi([=](const pg8::Unit& u, int r, int n, f32x4 v0, f32x4 v1) {
        const u32x4 w = pack8(v0, v1);
        if (isq) { if (n < 384) *(u32x4*)(qm + (size_t)r * 384 + n) = w; }
        else {
            const int h = n >> 7, e = n & 127;
            if (e < 64) *(u32x4*)(km + (size_t)r * 384 + h * 96 + e) = w; else *(u32x4*)(vm + (size_t)r * 256 + h * 64 + (e - 64)) = w;
        }
    });
    pg8::gemm_phase(lds, pg8::Gemm{K, K, K}, S, E);
}

struct MergeOrder {
    int c, nwgs; const char* Y; const char* W;
    __device__ bool next(int i, pg8::Unit& u) const {
        const int tiles = (NTOK / 256) * 4;
        const int L = (i >> 2) * nwgs + c; if (L >= tiles) return false;
        u.pm = L >> 2; u.pn = L & 3; u.aux = i & 3;
        u.A = Y + ((size_t)u.pm * 256 * DM + u.aux * 256) * 2; u.B = W + ((size_t)u.aux * DM + u.pn * 256) * 256 * 2; return true;
    }
};
__device__ __forceinline__ void fs_merge(const P& p, int l, LAS unsigned char* lds) {
    const bf16_t* cols = WSP(bf16_t, WS_COLS); float* mf = WSP(float, WS_MRGF); bf16_t* mrg = WSP(bf16_t, WS_MRG);
    MergeOrder S{(int)blockIdx.x, (int)gridDim.x, (const char*)WSP(bf16_t, WS_Y), (const char*)(WSP(bf16_t, WS_WTBR) + (size_t)l * 4 * DM * 256)};
    auto E = make_epi([=](const pg8::Unit& u, int r, int n, f32x4 v0, f32x4 v1) {
        const int b = u.aux;
        f32x4 g0, g1; unpack8v(*(const u32x4*)(cols + (size_t)r * NC + C_MG + b * DM + n), g0, g1);
#pragma unroll
        for (int e = 0; e < 4; ++e) { v0[e] *= 1.f / (1.f + __expf(-g0[e])); v1[e] *= 1.f / (1.f + __expf(-g1[e])); }
        float* m = mf + (size_t)r * DM + n;
        if (b > 0) { v0 += *(const f32x4*)m; v1 += *(const f32x4*)(m + 4); }
        if (b < 3) { *(f32x4*)m = v0; *(f32x4*)(m + 4) = v1; }
        else *(u32x4*)(mrg + (size_t)r * DM + n) = pack8(v0, v1);
    });
    pg8::gemm_phase(lds, pg8::Gemm{DM, 256, 256}, S, E);
}

__device__ __forceinline__ void fs_out(const P& p, int l, LAS unsigned char* lds) {
    float* X = WSP(float, WS_X); const float* modv = WSP(float, WS_MODV);
    const float* xp = p.in[I_XP]; const float* xs = p.in[I_XS];
    SubOrder S{NTOK / 256, 4, (int)blockIdx.x, 0, (int)gridDim.x, (const char*)WSP(bf16_t, WS_MRG), (const char*)(WSP(bf16_t, WS_WTOUT) + (size_t)l * DM * DM), (size_t)256 * DM * 2, (size_t)256 * DM * 2};
    auto E = make_epi([=](const pg8::Unit& u, int r, int n, f32x4 v0, f32x4 v1) {
        const float* gate = modv + ((size_t)l * NCB + row_cb(r)) * 3072 + 2048 + n;
        const float* xr = l == 0 ? (r < NCTX ? xp + (size_t)r * DM : xs + (size_t)(r - NCTX) * DM) : X + (size_t)r * DM;
        const f32x4 x0 = *(const f32x4*)(xr + n), x1 = *(const f32x4*)(xr + n + 4);
        const f32x4 g0 = *(const f32x4*)gate, g1 = *(const f32x4*)(gate + 4);
        *(f32x4*)(X + (size_t)r * DM + n) = x0 + g0 * v0; *(f32x4*)(X + (size_t)r * DM + n + 4) = x1 + g1 * v1;
    });
    pg8::gemm_phase(lds, pg8::Gemm{DM, DM, DM}, S, E);
}

__device__ __forceinline__ int otid() { int t = threadIdx.x; asm volatile("" : "+v"(t)); return t; }
constexpr int HG_LD = 72;
constexpr int HG_MAT = 64 * HG_LD * 2;
struct HgPrep { float k[16], b[16]; float btot, ref1; };
__device__ __forceinline__ void hg_prep(const P& p, int tid, int l, int r0, int h, LAS float* seg  , HgPrep& o) {
    const int dir = tid >> 8, tq = (tid >> 6) & 3, d = tid & 63;
    const bf16_t* c = WSP(bf16_t, WS_COLS) + (size_t)(r0 + 16 * tq) * NC + (dir == 0 ? C_HGFF : C_HGFB) + h * 64 + d;
    const float lbv = WSP(float, WS_LBS)[((size_t)l * 2 + dir) * 256 + h * 64 + d];
    float g[16];
#pragma unroll
    for (int i = 0; i < 16; ++i) {
        const float fz = bf2f(c[(size_t)i * NC]);
        const float e = __expf(-fz), inv = 1.f / (1.f + e);
        const float f = fmaxf(lbv + (1.f - lbv) * inv, 1e-30f);
        o.k[i] = (1.f - lbv) * e * inv;
        g[i] = __logf(f);
    }
    float run = 0.f;
    if (dir == 0) {
#pragma unroll
        for (int i = 0; i < 16; ++i) { run += g[i]; o.b[i] = run; }
    } else {
#pragma unroll
        for (int i = 15; i >= 0; --i) { run += g[i]; o.b[i] = run; }
    }
    seg[(dir * 4 + tq) * 64 + d] = run;
    __syncthreads();
    const float s0 = seg[(dir * 4 + 0) * 64 + d], s1 = seg[(dir * 4 + 1) * 64 + d], s2 = seg[(dir * 4 + 2) * 64 + d], s3 = seg[(dir * 4 + 3) * 64 + d];
    float off;
    if (dir == 0) off = tq == 0 ? 0.f : (tq == 1 ? s0 : (tq == 2 ? s0 + s1 : s0 + s1 + s2));
    else off = tq == 3 ? 0.f : (tq == 2 ? s3 : (tq == 1 ? s3 + s2 : s3 + s2 + s1));
#pragma unroll
    for (int i = 0; i < 16; ++i) o.b[i] += off;
    o.btot = (s0 + s1) + (s2 + s3);
    o.ref1 = dir == 0 ? s0 + s1 : s2 + s3;
}
__device__ __forceinline__ void hg_stage_vt(const P& p, int tid, int r0, int h, LAS unsigned char* vt) {
    const int j = tid & 63, sg = tid >> 6;
    const bf16_t* c = WSP(bf16_t, WS_COLS) + (size_t)(r0 + 8 * sg) * NC + C_HGI + h * 64 + j;
    unsigned w[4];
#pragma unroll
    for (int i = 0; i < 4; ++i) w[i] = (unsigned)c[(size_t)(2 * i) * NC] | ((unsigned)c[(size_t)(2 * i + 1) * NC] << 16);
    *(LAS u32x4*)(vt + (j * HG_LD + 8 * sg) * 2) = (u32x4){w[0], w[1], w[2], w[3]};
}
__device__ __forceinline__ void hg_mma_strip(f32x4 (&acc)[4], const LAS unsigned char* A, int arow0, const LAS unsigned char* Bt, int lane) {
    const int fr = lane & 15, fq = lane >> 4;
#pragma unroll
    for (int ks = 0; ks < 2; ++ks) {
        const bf16x8 a = *(const LAS bf16x8*)(A + ((arow0 + fr) * HG_LD + 32 * ks + 8 * fq) * 2);
#pragma unroll
        for (int n = 0; n < 4; ++n) {
            const bf16x8 b = *(const LAS bf16x8*)(Bt + ((16 * n + fr) * HG_LD + 32 * ks + 8 * fq) * 2);
            acc[n] = __builtin_amdgcn_mfma_f32_16x16x32_bf16(a, b, acc[n], 0, 0, 0);
        }
    }
}

__device__ __forceinline__ void fs_hgrn_a(const P& p, int l, LAS unsigned char* lds) {
    LAS float* seg = (LAS float*)lds;
    LAS unsigned char* kt = lds + 2048;
    LAS unsigned char* vt = kt + 2 * HG_MAT;
    const int tid = otid(), lane = tid & 63, wave = tid >> 6, dir = tid >> 8, tq = (tid >> 6) & 3, d = tid & 63;
    for (int u = blockIdx.x; u < (NTOK / 64) * 4; u += gridDim.x) {
        const int gc = u >> 2, h = u & 3, r0 = gc * 64;
        HgPrep hp; hg_prep(p, tid, l, r0, h, seg, hp);
        unsigned w[8];
#pragma unroll
        for (int i = 0; i < 8; ++i) w[i] = cvt_pk_bf16(hp.k[2 * i] * __expf(hp.btot - hp.b[2 * i]), hp.k[2 * i + 1] * __expf(hp.btot - hp.b[2 * i + 1]));
        LAS unsigned char* kd = kt + dir * HG_MAT + (d * HG_LD + 16 * tq) * 2;
        *(LAS u32x4*)kd = (u32x4){w[0], w[1], w[2], w[3]}; *(LAS u32x4*)(kd + 16) = (u32x4){w[4], w[5], w[6], w[7]};
        hg_stage_vt(p, tid, r0, h, vt);
        if (tq == 0) WSP(float, WS_HD)[((size_t)u * 2 + dir) * 64 + d] = __expf(hp.btot);
        __syncthreads();
        f32x4 acc[4];
#pragma unroll
        for (int n = 0; n < 4; ++n) acc[n] = (f32x4){0.f, 0.f, 0.f, 0.f};
        const int w4 = wave & 3;
        hg_mma_strip(acc, kt + dir * HG_MAT, 16 * w4, vt, lane);
        float* L = WSP(float, WS_HL) + ((size_t)u * 2 + dir) * 4096;
#pragma unroll
        for (int n = 0; n < 4; ++n)
#pragma unroll
            for (int e = 0; e < 4; ++e) L[(16 * w4 + 4 * (lane >> 4) + e) * 64 + 16 * n + (lane & 15)] = acc[n][e];
        __syncthreads();
    }
}

__device__ __forceinline__ void fs_hgrn_b(const P& p, int l, long gtid, long gsz) {
    float* HL = WSP(float, WS_HL); const float* HD = WSP(float, WS_HD);
    const long nItems = (long)(BATCH + DB) * 4 * 2 * 4096;
    for (long it = gtid; it < nItems; it += gsz) {
        const int e = (int)(it & 4095), dir = (int)((it >> 12) & 1), h = (int)((it >> 13) & 3), sq = (int)(it >> 15);
        const bool lat = sq >= BATCH; const int b = lat ? sq - BATCH : sq;
        const int nch = lat ? DSEQ / 64 : SEQ / 64, gc0 = lat ? (NCTX + b * DSEQ) / 64 : (b * SEQ) / 64;
        float s = lat ? p.in[I_ST][((((size_t)b * DEPTH + l) * 2 + dir) * 4 + h) * 4096 + e] : 0.f;
        for (int cc = 0; cc < nch; ++cc) {
            const int c = dir == 0 ? cc : nch - 1 - cc;
            const size_t ui = ((size_t)(gc0 + c) * 4 + h) * 2 + dir;
            const float Lv = HL[ui * 4096 + e], Dv = HD[ui * 64 + (e >> 6)];
            HL[ui * 4096 + e] = s;
            s = Dv * s + Lv;
        }
        if (!lat) p.out[O_ST + ((((size_t)b * DEPTH + l) * 2 + dir) * 4 + h) * 4096 + e] = s;
    }
}

__device__ __forceinline__ void fs_hgrn_c(const P& p, int l, LAS unsigned char* lds) {
    LAS float* seg = (LAS float*)lds;
    LAS unsigned char* base = lds + 2048;
    const int tid = otid(), lane = tid & 63, wave = tid >> 6, dir = tid >> 8, tq = (tid >> 6) & 3, d = tid & 63, w4 = wave & 3;
    LAS unsigned char* mQh = base + (dir * 6 + 0) * HG_MAT; LAS unsigned char* mQc = base + (dir * 6 + 1) * HG_MAT;
    LAS unsigned char* mK0 = base + (dir * 6 + 2) * HG_MAT; LAS unsigned char* mK1 = base + (dir * 6 + 3) * HG_MAT;
    LAS unsigned char* mAtt = base + (dir * 6 + 4) * HG_MAT; LAS unsigned char* mSt = base + (dir * 6 + 5) * HG_MAT;
    LAS unsigned char* vt = base + 12 * HG_MAT;
    LAS float* Ob = (LAS float*)(base + 6 * HG_MAT);
    const bf16_t* cols = WSP(bf16_t, WS_COLS);
    for (int u = blockIdx.x; u < (NTOK / 64) * 4; u += gridDim.x) {
        const int gc = u >> 2, h = u & 3, r0 = gc * 64;
        HgPrep hp; hg_prep(p, tid, l, r0, h, seg, hp);
        const bool first = dir == 0 ? (tq < 2) : (tq >= 2);
        {
            const bf16_t* cq = cols + (size_t)(r0 + 16 * tq) * NC + C_HGQ + h * 64 + d;
#pragma unroll
            for (int i = 0; i < 16; ++i) {
                const float qv = bf2f(cq[(size_t)i * NC]);
                const float q = qv / (1.f + __expf(-qv));
                const float bb = hp.b[i];
                const int o = ((16 * tq + i) * HG_LD + d) * 2;
                *(LAS bf16_t*)(mQh + o) = f2bf(q * __expf(first ? bb : bb - hp.ref1));
                *(LAS bf16_t*)(mQc + o) = f2bf(q * __expf(bb));
                *(LAS bf16_t*)(mK0 + o) = first ? f2bf(hp.k[i] * __expf(-bb)) : (bf16_t)0;
                *(LAS bf16_t*)(mK1 + o) = f2bf(hp.k[i] * __expf(hp.ref1 - bb));
            }
        }
        hg_stage_vt(p, tid, r0, h, vt);
        {
            const float* S = WSP(float, WS_HL) + ((size_t)u * 2 + dir) * 4096;
            const int j = tid & 63, dq = (tid >> 6) & 3;
            unsigned w[8];
#pragma unroll
            for (int i = 0; i < 8; ++i) w[i] = cvt_pk_bf16(S[(16 * dq + 2 * i) * 64 + j], S[(16 * dq + 2 * i + 1) * 64 + j]);
            LAS unsigned char* sd = mSt + (j * HG_LD + 16 * dq) * 2;
            *(LAS u32x4*)sd = (u32x4){w[0], w[1], w[2], w[3]}; *(LAS u32x4*)(sd + 16) = (u32x4){w[4], w[5], w[6], w[7]};
        }
        __syncthreads();
        {
            f32x4 acc[4];
#pragma unroll
            for (int n = 0; n < 4; ++n) acc[n] = (f32x4){0.f, 0.f, 0.f, 0.f};
            const bool wfirst = dir == 0 ? (w4 < 2) : (w4 >= 2);
            hg_mma_strip(acc, mQh, 16 * w4, wfirst ? mK0 : mK1, lane);
#pragma unroll
            for (int n = 0; n < 4; ++n)
#pragma unroll
                for (int e = 0; e < 4; ++e) {
                    const int t = 16 * w4 + 4 * (lane >> 4) + e, s = 16 * n + (lane & 15);
                    const bool keep = dir == 0 ? (s <= t) : (s >= t);
                    *(LAS bf16_t*)(mAtt + (t * HG_LD + s) * 2) = keep ? f2bf(acc[n][e]) : (bf16_t)0;
                }
        }
        __syncthreads();
        f32x4 o[4];
#pragma unroll
        for (int n = 0; n < 4; ++n) o[n] = (f32x4){0.f, 0.f, 0.f, 0.f};
        hg_mma_strip(o, mAtt, 16 * w4, vt, lane);
        hg_mma_strip(o, mQc, 16 * w4, mSt, lane);
        __syncthreads();
        if (dir == 1) {
#pragma unroll
            for (int n = 0; n < 4; ++n)
#pragma unroll
                for (int e = 0; e < 4; ++e) Ob[(16 * w4 + 4 * (lane >> 4) + e) * 64 + 16 * n + (lane & 15)] = o[n][e];
        }
        __syncthreads();
        if (dir == 0) {
            const float* gn = p.in[I_HGG] + (size_t)l * 64;
            float ss[4] = {0.f, 0.f, 0.f, 0.f};
#pragma unroll
            for (int n = 0; n < 4; ++n)
#pragma unroll
                for (int e = 0; e < 4; ++e) { o[n][e] += Ob[(16 * w4 + 4 * (lane >> 4) + e) * 64 + 16 * n + (lane & 15)]; ss[e] += o[n][e] * o[n][e]; }
#pragma unroll
            for (int e = 0; e < 4; ++e) {
                float v = ss[e];
                v += __shfl_xor(v, 1); v += __shfl_xor(v, 2); v += __shfl_xor(v, 4); v += __shfl_xor(v, 8);
                ss[e] = 1.f / sqrtf(v * (1.f / 64.f) + 1e-6f);
            }
#pragma unroll
            for (int n = 0; n < 4; ++n)
#pragma unroll
                for (int e = 0; e < 4; ++e) {
                    const int t = 16 * w4 + 4 * (lane >> 4) + e, j = 16 * n + (lane & 15);
                    const bf16_t* c = cols + (size_t)(r0 + t) * NC;
                    const float og = bf2f(c[C_HGOG + h * 64 + j]), z = bf2f(c[C_HGZ + h * 64 + j]);
                    const float v = o[n][e] * ss[e] * gn[j] / (1.f + __expf(-og)) * (z / (1.f + __expf(-z)));
                    WSP(bf16_t, WS_Y)[(size_t)(r0 + t) * DM + 256 + h * 64 + j] = f2bf(v);
                }
        }
        __syncthreads();
    }
}

constexpr int AT_KBUF = 64 * (96 + 8) * 2;
constexpr int AT_VBUF = 64 * 72 * 2;
constexpr int AT_OFF_V = 2 * AT_KBUF, AT_OFF_RPB = AT_OFF_V + 2 * AT_VBUF;
struct AttnSrc { const bf16_t* k; const bf16_t* v; int kp, vp, n; };
struct AttnMask { int type, a, b; };

template <int DQ>
__device__ __forceinline__ void attn_unit(LAS unsigned char* lds, const int tid, const bf16_t* qbase, const int qpitch, const AttnSrc s0, const AttnSrc s1, const AttnMask mk,
                                          const float* rpb, const float sink, const bool has_sink, const float scale, const float* ropeq  ,
                                          const bf16_t* zbase, bf16_t* ybase  ) {
    constexpr int KS = DQ / 32, KP = DQ + 8;
    constexpr float L2E = 1.4426950408889634f;
    const int lane = tid & 63, wave = tid >> 6, c = lane & 15, fq = lane >> 4;
    LAS float* rpbl = (LAS float*)(lds + AT_OFF_RPB);
    if (mk.type == 1) { for (int i = tid; i < 465; i += NTHREADS) rpbl[i] = rpb[i] * L2E; }
    bf16x8 qf[KS];
    {
        const bf16_t* qr = qbase + (size_t)(16 * wave + c) * qpitch + 8 * fq;
#pragma unroll
        for (int ks = 0; ks < KS; ++ks) qf[ks] = *(const bf16x8*)(qr + 32 * ks);
        if (DQ == 96 && ropeq) {
            const u32x4 mine = __builtin_bit_cast(u32x4, qf[KS - 1]);
            u32x4 oth; oth.x = __shfl_xor(mine.x, 32); oth.y = __shfl_xor(mine.y, 32); oth.z = __shfl_xor(mine.z, 32); oth.w = __shfl_xor(mine.w, 32);
            f32x4 m0, m1, o0, o1; unpack8v(mine, m0, m1); unpack8v(oth, o0, o1);
            const float* rr = ropeq + (size_t)(16 * wave + c) * 32 + (8 * (fq & 1)) * 2;
            float r[8];
#pragma unroll
            for (int j = 0; j < 8; ++j) {
                const float cs = rr[2 * j], sn = rr[2 * j + 1];
                const float mv = j < 4 ? m0[j & 3] : m1[j & 3], ov = j < 4 ? o0[j & 3] : o1[j & 3];
                r[j] = fq < 2 ? mv * cs - ov * sn : ov * sn + mv * cs;
            }
            u32x4 w; w.x = cvt_pk_bf16(r[0], r[1]); w.y = cvt_pk_bf16(r[2], r[3]); w.z = cvt_pk_bf16(r[4], r[5]); w.w = cvt_pk_bf16(r[6], r[7]);
            qf[KS - 1] = __builtin_bit_cast(bf16x8, w);
        }
    }
    int qa = 0, qb = 0;
    if (mk.type == 1) { qa = mk.a + (wave >> 2); qb = 16 * (wave & 3) + c; }
    else if (mk.type == 2) { qa = mk.a + 16 * wave + c; }
    int na_rs = qa - 4; na_rs = na_rs < 0 ? 0 : (na_rs > GROWS - 8 ? GROWS - 8 : na_rs);
    int na_cs = qb - 8; na_cs = na_cs < 0 ? 0 : (na_cs > GW - 16 ? GW - 16 : na_cs);
    const float sl2 = scale * L2E;
    float m = has_sink ? sink * L2E : -3.0e38f, lsum = 0.f;
    f32x4 o[4];
#pragma unroll
    for (int n = 0; n < 4; ++n) o[n] = (f32x4){0.f, 0.f, 0.f, 0.f};
    const int nsteps = s0.n + s1.n;
    u32x4 kreg0, kreg1, vreg;
    const int krow0 = DQ == 64 ? (tid >> 3) : tid / 12, kch0 = DQ == 64 ? (tid & 7) : tid % 12;
    const int krow1 = (tid + 512) / 12, kch1 = (tid + 512) % 12;
    const int vkey = tid & 63, vg = tid >> 6;
#define AT_LOAD(step) do { const bool f0_ = (step) < s0.n; const int bi_ = f0_ ? (step) : (step) - s0.n; \
        const bf16_t* kb_ = (f0_ ? s0.k : s1.k) + (size_t)bi_ * 64 * (f0_ ? s0.kp : s1.kp); const int kp_ = f0_ ? s0.kp : s1.kp; \
        const bf16_t* vb_ = (f0_ ? s0.v : s1.v) + (size_t)bi_ * 64 * (f0_ ? s0.vp : s1.vp); const int vp_ = f0_ ? s0.vp : s1.vp; \
        kreg0 = *(const u32x4*)(kb_ + (size_t)krow0 * kp_ + 8 * kch0); \
        if (DQ == 96 && tid < 256) kreg1 = *(const u32x4*)(kb_ + (size_t)krow1 * kp_ + 8 * kch1); \
        vreg = *(const u32x4*)(vb_ + (size_t)vkey * vp_ + 8 * vg); } while (0)
#define AT_STORE(buf) do { LAS unsigned char* kd_ = lds + (buf) * AT_KBUF; LAS unsigned char* vd_ = lds + AT_OFF_V + (buf) * AT_VBUF; \
        *(LAS u32x4*)(kd_ + (krow0 * KP + 8 * kch0) * 2) = kreg0; \
        if (DQ == 96 && tid < 256) *(LAS u32x4*)(kd_ + (krow1 * KP + 8 * kch1) * 2) = kreg1; \
        const unsigned vw_[4] = {vreg.x, vreg.y, vreg.z, vreg.w}; \
        _Pragma("unroll") for (int e_ = 0; e_ < 4; ++e_) { \
            *(LAS bf16_t*)(vd_ + ((8 * vg + 2 * e_) * 72 + vkey) * 2) = (bf16_t)(vw_[e_] & 0xffffu); \
            *(LAS bf16_t*)(vd_ + ((8 * vg + 2 * e_ + 1) * 72 + vkey) * 2) = (bf16_t)(vw_[e_] >> 16); } } while (0)
    AT_LOAD(0); AT_STORE(0);
    __syncthreads();
    for (int step = 0; step < nsteps; ++step) {
        const int buf = step & 1;
        if (step + 1 < nsteps) AT_LOAD(step + 1);
        const LAS unsigned char* kl = lds + buf * AT_KBUF; const LAS unsigned char* vl = lds + AT_OFF_V + buf * AT_VBUF;
        f32x4 acc[4];
#pragma unroll
        for (int n = 0; n < 4; ++n) {
            acc[n] = (f32x4){0.f, 0.f, 0.f, 0.f};
#pragma unroll
            for (int ks = 0; ks < KS; ++ks) {
                const bf16x8 kf = *(const LAS bf16x8*)(kl + ((16 * n + c) * KP + 32 * ks + 8 * fq) * 2);
                acc[n] = __builtin_amdgcn_mfma_f32_16x16x32_bf16(kf, qf[ks], acc[n], 0, 0, 0);
            }
        }
        const bool msk = step < s0.n && mk.type != 0;
        float mloc = -3.0e38f;
#pragma unroll
        for (int n = 0; n < 4; ++n)
#pragma unroll
            for (int e = 0; e < 4; ++e) {
                float sv = acc[n][e] * sl2;
                if (msk) {
                    const int kk = 16 * n + 4 * fq + e;
                    if (mk.type == 1) {
                        const int kr = mk.b + step;
                        const bool ok = kr >= na_rs && kr < na_rs + 8 && kk >= na_cs && kk < na_cs + 16;
                        int dr = kr - qa + 7; dr = dr < 0 ? 0 : (dr > 14 ? 14 : dr);
                        int dc = kk - qb + 15; dc = dc < 0 ? 0 : (dc > 30 ? 30 : dc);
                        sv = ok ? sv + rpbl[dr * 31 + dc] : -1.0e30f;
                    } else {
                        const int dd = mk.b + 64 * step + kk - qa;
                        sv = (dd <= 128 && dd >= -128) ? sv : -1.0e30f;
                    }
                }
                acc[n][e] = sv; mloc = fmaxf(mloc, sv);
            }
        mloc = fmaxf(mloc, __shfl_xor(mloc, 16)); mloc = fmaxf(mloc, __shfl_xor(mloc, 32));
        const float mn = fmaxf(m, mloc), corr = exp2f(m - mn);
        m = mn;
        float ps = 0.f;
#pragma unroll
        for (int n = 0; n < 4; ++n)
#pragma unroll
            for (int e = 0; e < 4; ++e) { const float pv = exp2f(acc[n][e] - mn); acc[n][e] = pv; ps += pv; }
        lsum = lsum * corr + ps;
#pragma unroll
        for (int n = 0; n < 4; ++n) o[n] *= corr;
#pragma unroll
        for (int ks = 0; ks < 2; ++ks) {
            u32x4 pw; pw.x = cvt_pk_bf16(acc[2 * ks][0], acc[2 * ks][1]); pw.y = cvt_pk_bf16(acc[2 * ks][2], acc[2 * ks][3]);
            pw.z = cvt_pk_bf16(acc[2 * ks + 1][0], acc[2 * ks + 1][1]); pw.w = cvt_pk_bf16(acc[2 * ks + 1][2], acc[2 * ks + 1][3]);
            const bf16x8 pf = __builtin_bit_cast(bf16x8, pw);
#pragma unroll
            for (int n = 0; n < 4; ++n) {
                const LAS unsigned char* vr = vl + ((16 * n + c) * 72 + 32 * ks + 4 * fq) * 2;
                typedef unsigned u32x2 __attribute__((ext_vector_type(2)));
                const u32x2 v0 = *(const LAS u32x2*)vr, v1 = *(const LAS u32x2*)(vr + 32);
                const u32x4 vw = (u32x4){v0.x, v0.y, v1.x, v1.y};
                o[n] = __builtin_amdgcn_mfma_f32_16x16x32_bf16(__builtin_bit_cast(bf16x8, vw), pf, o[n], 0, 0, 0);
            }
        }
        if (step + 1 < nsteps) AT_STORE(buf ^ 1);
        __syncthreads();
    }
#undef AT_LOAD
#undef AT_STORE
    lsum += __shfl_xor(lsum, 16); lsum += __shfl_xor(lsum, 32);
    if (has_sink) lsum += exp2f(sink * L2E - m);
    const float inv = 1.f / lsum;
    const bf16_t* zr = zbase + (size_t)(16 * wave + c) * NC; bf16_t* yr = ybase + (size_t)(16 * wave + c) * DM;
#pragma unroll
    for (int n = 0; n < 4; ++n) {
        typedef unsigned u32x2 __attribute__((ext_vector_type(2)));
        const u32x2 zz = *(const u32x2*)(zr + 16 * n + 4 * fq);
        const float z0 = u2f(zz.x << 16), z1 = u2f(zz.x & 0xffff0000u), z2 = u2f(zz.y << 16), z3 = u2f(zz.y & 0xffff0000u);
        u32x2 w;
        w.x = cvt_pk_bf16(o[n][0] * inv * (z0 / (1.f + __expf(-z0))), o[n][1] * inv * (z1 / (1.f + __expf(-z1))));
        w.y = cvt_pk_bf16(o[n][2] * inv * (z2 / (1.f + __expf(-z2))), o[n][3] * inv * (z3 / (1.f + __expf(-z3))));
        *(u32x2*)(yr + 16 * n + 4 * fq) = w;
    }
}

__device__ __forceinline__ void fs_attn(const P& p, int l, LAS unsigned char* lds) {
    const int tid = otid();
    constexpr int NL = (NLAT / 128) * 4, NCU = (NCTX / 128) * 4 * 3, NU = 3 * NL + NCU;
    const bf16_t* cols = WSP(bf16_t, WS_COLS);
    bf16_t* Y = WSP(bf16_t, WS_Y);
    for (int u = blockIdx.x; u < NU; u += gridDim.x) {
        if (u < 3 * NL) {
            const int kind = u / NL, v = u % NL;
            int bh, qt;
            if (NL % 64 == 0) { const int x = v & 7, idx = v >> 3, per = NL / 8; const int bhx = (DB * 4) / 8 > 0 ? (DB * 4) / 8 : 1; bh = x * bhx + idx / (per / bhx); qt = idx % (per / bhx); }
            else { bh = v / (DSEQ / 128); qt = v % (DSEQ / 128); }
            const int b = bh >> 2, h = bh & 3;
            const int r0 = NCTX + b * DSEQ + qt * 128, t0 = qt * 128;
            const size_t cb = ((size_t)b * DEPTH + l) * PAST;
            if (kind == 0) {
                AttnSrc s0{WSP(bf16_t, WS_KMLA) + (size_t)(NCTX + b * DSEQ) * 384 + h * 96, WSP(bf16_t, WS_VMLA) + (size_t)(NCTX + b * DSEQ) * 256 + h * 64, 384, 256, DSEQ / 64};
                AttnSrc s1{WSP(bf16_t, WS_KCM) + cb * 384 + h * 96, WSP(bf16_t, WS_VCM) + cb * 256 + h * 64, 384, 256, PAST / 64};
                attn_unit<96>(lds, tid, WSP(bf16_t, WS_QMLA) + (size_t)r0 * 384 + h * 96, 384, s0, s1, AttnMask{0, 0, 0}, nullptr, 0.f, false, 0.10206207261596577f,
                              WSP(float, WS_ROPEM) + (size_t)t0 * 32, cols + (size_t)r0 * NC + C_MZ + h * 64, Y + (size_t)r0 * DM + 512 + h * 64);
            } else if (kind == 1) {
                const int i0 = 2 * qt;
                int rlo = i0 - 4; rlo = rlo < 0 ? 0 : (rlo > GROWS - 8 ? GROWS - 8 : rlo);
                int rhi = i0 + 1 - 4; rhi = (rhi < 0 ? 0 : (rhi > GROWS - 8 ? GROWS - 8 : rhi)) + 8;
                const size_t kr0 = (size_t)(NCTX + b * DSEQ + rlo * 64);
                AttnSrc s0{cols + kr0 * NC + C_NAK + h * 64, cols + kr0 * NC + C_NAV + h * 64, NC, NC, rhi - rlo};
                AttnSrc s1{WSP(bf16_t, WS_CNAK) + cb * 256 + h * 64, WSP(bf16_t, WS_CNAV) + cb * 256 + h * 64, 256, 256, PAST / 64};
                attn_unit<64>(lds, tid, cols + (size_t)r0 * NC + C_NAQ + h * 64, NC, s0, s1, AttnMask{1, i0, rlo}, p.in[I_RPB] + ((size_t)l * 4 + h) * 465, 0.f, false, 0.125f,
                              nullptr, cols + (size_t)r0 * NC + C_NAZ + h * 64, Y + (size_t)r0 * DM + 0 + h * 64);
            } else {
                const int kh = h >> 1;
                const int klo = t0 - 128 < 0 ? 0 : t0 - 128, khi = t0 + 256 > DSEQ ? DSEQ : t0 + 256;
                const size_t kr0 = (size_t)(NCTX + b * DSEQ + klo);
                AttnSrc s0{WSP(bf16_t, WS_WKR) + kr0 * 128 + kh * 64, cols + kr0 * NC + C_WV + kh * 64, 128, NC, (khi - klo) / 64};
                AttnSrc s1{WSP(bf16_t, WS_CWK) + cb * 128 + kh * 64, WSP(bf16_t, WS_CWV) + cb * 128 + kh * 64, 128, 128, PAST / 64};
                attn_unit<64>(lds, tid, WSP(bf16_t, WS_WQR) + (size_t)r0 * 256 + h * 64, 256, s0, s1, AttnMask{2, t0, klo}, nullptr, p.in[I_SINK][l * 4 + h], true, 0.125f,
                              nullptr, cols + (size_t)r0 * NC + C_WZ + h * 64, Y + (size_t)r0 * DM + 768 + h * 64);
            }
        } else {
            const int v = u - 3 * NL, kind = v % 3, h = (v / 3) & 3, tile = v / 12;
            const int r0 = tile * 128, sq0 = (r0 / SEQ) * SEQ;
            const AttnSrc none{nullptr, nullptr, 0, 0, 0};
            if (kind == 0) {
                AttnSrc s0{cols + (size_t)sq0 * NC + C_NAK + h * 64, cols + (size_t)sq0 * NC + C_NAV + h * 64, NC, NC, SEQ / 64};
                attn_unit<64>(lds, tid, cols + (size_t)r0 * NC + C_NAQ + h * 64, NC, s0, none, AttnMask{0, 0, 0}, nullptr, 0.f, false, 0.125f, nullptr,
                              cols + (size_t)r0 * NC + C_NAZ + h * 64, Y + (size_t)r0 * DM + 0 + h * 64);
            } else if (kind == 1) {
                AttnSrc s0{WSP(bf16_t, WS_KMLA) + (size_t)sq0 * 384 + h * 96, WSP(bf16_t, WS_VMLA) + (size_t)sq0 * 256 + h * 64, 384, 256, SEQ / 64};
                attn_unit<96>(lds, tid, WSP(bf16_t, WS_QMLA) + (size_t)r0 * 384 + h * 96, 384, s0, none, AttnMask{0, 0, 0}, nullptr, 0.f, false, 0.10206207261596577f, nullptr,
                              cols + (size_t)r0 * NC + C_MZ + h * 64, Y + (size_t)r0 * DM + 512 + h * 64);
            } else {
                const int kh = h >> 1;
                AttnSrc s0{WSP(bf16_t, WS_WKR) + (size_t)sq0 * 128 + kh * 64, cols + (size_t)sq0 * NC + C_WV + kh * 64, 128, NC, SEQ / 64};
                attn_unit<64>(lds, tid, WSP(bf16_t, WS_WQR) + (size_t)r0 * 256 + h * 64, 256, s0, none, AttnMask{0, 0, 0}, nullptr, p.in[I_SINK][l * 4 + h], true, 0.125f, nullptr,
                              cols + (size_t)r0 * NC + C_WZ + h * 64, Y + (size_t)r0 * DM + 768 + h * 64);
            }
        }
    }
}

__device__ __forceinline__ float wave_sum(float v) {
#pragma unroll
    for (int o = 1; o < 64; o <<= 1) v += __shfl_xor(v, o);
    return v;
}
typedef unsigned u32x2 __attribute__((ext_vector_type(2)));
typedef float f32x2 __attribute__((ext_vector_type(2)));

template <bool FINAL>
__device__ __forceinline__ void fs_norm(const P& p, int l) {
    const int tid = otid(), lane = tid & 63, gw = blockIdx.x * (NTHREADS / 64) + (tid >> 6), ngw = gridDim.x * (NTHREADS / 64);
    const float* g = FINAL ? p.in[I_FG] : p.in[I_NG] + (size_t)l * DM;
    for (int r = gw; r < NTOK; r += ngw) {
        const float* x = (FINAL || l > 0) ? WSP(float, WS_X) + (size_t)r * DM : (r < NCTX ? p.in[I_XP] + (size_t)r * DM : p.in[I_XS] + (size_t)(r - NCTX) * DM);
        f32x4 v[4]; float ss = 0.f;
#pragma unroll
        for (int j = 0; j < 4; ++j) { v[j] = *(const f32x4*)(x + 256 * j + 4 * lane); ss += (v[j][0] * v[j][0] + v[j][1] * v[j][1]) + (v[j][2] * v[j][2] + v[j][3] * v[j][3]); }
        const float rstd = 1.f / sqrtf(wave_sum(ss) * (1.f / DM) + 1e-6f);
        if (FINAL) {
#pragma unroll
            for (int j = 0; j < 4; ++j) { const f32x4 gg = *(const f32x4*)(g + 256 * j + 4 * lane); *(f32x4*)(p.out + O_Y + (size_t)r * DM + 256 * j + 4 * lane) = v[j] * rstd * gg; }
        } else {
            const float* mv = WSP(float, WS_MODV) + ((size_t)l * NCB + row_cb(r)) * 3072;
            bf16_t* H = WSP(bf16_t, WS_H) + (size_t)r * DM;
#pragma unroll
            for (int j = 0; j < 4; ++j) {
                const int k = 256 * j + 4 * lane;
                const f32x4 gg = *(const f32x4*)(g + k), sh = *(const f32x4*)(mv + k), sc = *(const f32x4*)(mv + 1024 + k);
                const f32x4 y = v[j] * rstd * gg * (sc + 1.f) + sh;
                u32x2 w; w.x = cvt_pk_bf16(y[0], y[1]); w.y = cvt_pk_bf16(y[2], y[3]);
                *(u32x2*)(H + k) = w;
            }
        }
    }
}

__device__ __forceinline__ void fs_rowprep(const P& p, int l) {
    const int tid = otid(), lane = tid & 63, gw = blockIdx.x * (NTHREADS / 64) + (tid >> 6), ngw = gridDim.x * (NTHREADS / 64);
    const bf16_t* cols = WSP(bf16_t, WS_COLS);
    for (int r = gw; r < NTOK; r += ngw) {
        const bf16_t* c = cols + (size_t)r * NC;
        const bool lat = r >= NCTX; const int t = lat ? (r - NCTX) % DSEQ : 0;
        const size_t bl = lat ? 0 : ((size_t)(r / SEQ) * DEPTH + l) * SEQ + (r % SEQ);
        {
            const unsigned w = *(const unsigned*)(c + C_CKV + 2 * lane);
            const float a = u2f(w << 16), b = u2f(w & 0xffff0000u);
            const float rstd = 1.f / sqrtf(wave_sum(a * a + b * b) * (1.f / 128.f) + 1e-6f);
            const float* g = p.in[I_KVG] + (size_t)l * 128 + 2 * lane;
            const float va = a * rstd * g[0], vb = b * rstd * g[1];
            *(unsigned*)(WSP(bf16_t, WS_CKVB) + (size_t)r * 128 + 2 * lane) = cvt_pk_bf16(va, vb);
            if (!lat) { f32x2 o; o.x = va; o.y = vb; *(f32x2*)(p.out + O_CKV + bl * 128 + 2 * lane) = o; }
        }
        {
            const u32x2 w = *(const u32x2*)(c + C_MQA + 4 * lane);
            const float a0 = u2f(w.x << 16), a1 = u2f(w.x & 0xffff0000u), a2 = u2f(w.y << 16), a3 = u2f(w.y & 0xffff0000u);
            const float rstd = 1.f / sqrtf(wave_sum((a0 * a0 + a1 * a1) + (a2 * a2 + a3 * a3)) * (1.f / 256.f) + 1e-6f);
            const f32x4 g = *(const f32x4*)(p.in[I_QG] + (size_t)l * 256 + 4 * lane);
            u32x2 o; o.x = cvt_pk_bf16(a0 * rstd * g[0], a1 * rstd * g[1]); o.y = cvt_pk_bf16(a2 * rstd * g[2], a3 * rstd * g[3]);
            *(u32x2*)(WSP(bf16_t, WS_QN) + (size_t)r * 256 + 4 * lane) = o;
        }
        if (lane < 16) {
            const float x1 = bf2f(c[C_KR + lane]), x2 = bf2f(c[C_KR + 16 + lane]);
            float o1 = x1, o2 = x2;
            if (lat) { const float* rm = WSP(float, WS_ROPEM) + (size_t)t * 32 + 2 * lane; o1 = x1 * rm[0] - x2 * rm[1]; o2 = x1 * rm[1] + x2 * rm[0]; }
            else { p.out[O_KR + bl * 32 + lane] = x1; p.out[O_KR + bl * 32 + 16 + lane] = x2; }
            bf16_t* km = WSP(bf16_t, WS_KMLA) + (size_t)r * 384 + 64 + lane;
            const bf16_t b1 = f2bf(o1), b2 = f2bf(o2);
#pragma unroll
            for (int h = 0; h < 4; ++h) { km[h * 96] = b1; km[h * 96 + 16] = b2; }
        }
        {
            const float* rw = WSP(float, WS_ROPEW) + (size_t)t * 64;
#pragma unroll
            for (int i = 0; i < 3; ++i) {
                const int pi = lane + 64 * i, hh = pi >> 5, j = pi & 31;
                const bf16_t* src = hh < 4 ? c + C_WQ + hh * 64 : c + C_WK + (hh - 4) * 64;
                bf16_t* dst = hh < 4 ? WSP(bf16_t, WS_WQR) + (size_t)r * 256 + hh * 64 : WSP(bf16_t, WS_WKR) + (size_t)r * 128 + (hh - 4) * 64;
                const float x1 = bf2f(src[j]), x2 = bf2f(src[32 + j]);
                if (lat) { const float cs = rw[2 * j], sn = rw[2 * j + 1]; dst[j] = f2bf(x1 * cs - x2 * sn); dst[32 + j] = f2bf(x1 * sn + x2 * cs); }
                else { dst[j] = src[j]; dst[32 + j] = src[32 + j]; }
            }
        }
    }
}

__device__ __forceinline__ void tr_item(const float* W, int N, int ncol0, bf16_t* WT, int K, int nrow0, int k0, LAS float* scr, int lane) {
    if (ncol0 >= 0) {
#pragma unroll 8
        for (int i = 0; i < 32; ++i) { const int kk = 2 * i + (lane >> 5); scr[kk * 33 + (lane & 31)] = W[(size_t)(k0 + kk) * N + ncol0 + (lane & 31)]; }
    }
    asm volatile("s_waitcnt lgkmcnt(0)" ::: "memory");
    const int c = lane & 7;
#pragma unroll
    for (int j = 0; j < 4; ++j) {
        const int n = (lane >> 3) + 8 * j; const LAS float* sp = scr + (8 * c) * 33 + n;
        u32x4 o = (u32x4){0u, 0u, 0u, 0u};
        if (ncol0 >= 0) { o.x = cvt_pk_bf16(sp[0 * 33], sp[1 * 33]); o.y = cvt_pk_bf16(sp[2 * 33], sp[3 * 33]); o.z = cvt_pk_bf16(sp[4 * 33], sp[5 * 33]); o.w = cvt_pk_bf16(sp[6 * 33], sp[7 * 33]); }
        *(u32x4*)(WT + (size_t)(nrow0 + n) * K + k0 + 8 * c) = o;
    }
    asm volatile("s_waitcnt lgkmcnt(0)" ::: "memory");
}
__device__ __forceinline__ void fs_prep(const P& p, LAS unsigned char* lds) {
    const int tid = otid(), lane = tid & 63, wave = tid >> 6, gw = blockIdx.x * (NTHREADS / 64) + wave, ngw = gridDim.x * (NTHREADS / 64);
    LAS float* scr = (LAS float*)(lds + wave * 16384);
    constexpr int I_IN = DEPTH * 16 * 256, I_OUT = DEPTH * 16 * 32, I_BR = DEPTH * 4 * 4 * 32, I_QB = DEPTH * 4 * 16, I_KVB = DEPTH * 2 * 16;
    for (int it = gw; it < I_IN + I_OUT + I_BR + I_QB + I_KVB; it += ngw) {
        int r = it;
        if (r < I_IN) { const int nb = r & 255, kb = (r >> 8) & 15, l = r >> 12;
            tr_item(p.in[I_WIN] + (size_t)l * DM * INW, INW, orig_col(nb * 32), WSP(bf16_t, WS_WTIN) + (size_t)l * NC * DM, DM, nb * 32, kb * 64, scr, lane); continue; } r -= I_IN;
        if (r < I_OUT) { const int nb = r & 31, kb = (r >> 5) & 15, l = r >> 9;
            tr_item(p.in[I_WOUT] + (size_t)l * DM * DM, DM, nb * 32, WSP(bf16_t, WS_WTOUT) + (size_t)l * DM * DM, DM, nb * 32, kb * 64, scr, lane); continue; } r -= I_OUT;
        if (r < I_BR) { const int nb = r & 31, kb = (r >> 5) & 3, lb = r >> 7;
            tr_item(p.in[I_WBR] + (size_t)lb * 256 * DM, DM, nb * 32, WSP(bf16_t, WS_WTBR) + (size_t)lb * DM * 256, 256, nb * 32, kb * 64, scr, lane); continue; } r -= I_BR;
        if (r < I_QB) { const int nb = r & 15, kb = (r >> 4) & 3, l = r >> 6;
            tr_item(p.in[I_WQB] + (size_t)l * 256 * 384, 384, nb < 12 ? nb * 32 : -1, WSP(bf16_t, WS_WTQB) + (size_t)l * 512 * 256, 256, nb * 32, kb * 64, scr, lane); continue; } r -= I_QB;
        { const int nb = r & 15, kb = (r >> 4) & 1, l = r >> 5;
            tr_item(p.in[I_WKVB] + (size_t)l * 128 * 512, 512, nb * 32, WSP(bf16_t, WS_WTKVB) + (size_t)l * 512 * 128, 128, nb * 32, kb * 64, scr, lane); }
    }
    __syncthreads();
    {
        LAS float* sl = (LAS float*)lds;
        LAS float* red = sl + NCB * 1024;
        for (int i = tid; i < NCB * 1024; i += NTHREADS) { const int cb = i >> 10, k = i & 1023; const float cv = cb == 0 ? p.in[I_CCTX][k] : p.in[I_C][(size_t)(cb - 1) * DM + k]; sl[i] = cv / (1.f + __expf(-cv)); }
        __syncthreads();
        for (int it = blockIdx.x; it < DEPTH * 48; it += gridDim.x) {
            const int l = it / 48, j = (it % 48) * 64 + (tid & 63), kp = tid >> 6;
            const float* w = p.in[I_WMOD] + ((size_t)l * DM + kp * 128) * 3072 + j;
            float acc[NCB];
#pragma unroll
            for (int cb = 0; cb < NCB; ++cb) acc[cb] = 0.f;
#pragma unroll 8
            for (int k = 0; k < 128; ++k) { const float wv = w[(size_t)k * 3072];
#pragma unroll
                for (int cb = 0; cb < NCB; ++cb) acc[cb] += sl[cb * 1024 + kp * 128 + k] * wv; }
#pragma unroll
            for (int cb = 0; cb < NCB; ++cb) red[(kp * NCB + cb) * 64 + (tid & 63)] = acc[cb];
            __syncthreads();
            if (tid < NCB * 64) { const int cb = tid >> 6, jj = tid & 63; float sm = 0.f;
#pragma unroll
                for (int q = 0; q < 8; ++q) sm += red[(q * NCB + cb) * 64 + jj];
                WSP(float, WS_MODV)[((size_t)l * NCB + cb) * 3072 + (it % 48) * 64 + jj] = sm + p.in[I_BMOD][(size_t)l * 3072 + (it % 48) * 64 + jj]; }
            __syncthreads();
        }
    }
    const long gtid = (long)blockIdx.x * NTHREADS + tid, gsz = (long)gridDim.x * NTHREADS;
    {
        float* lbs = WSP(float, WS_LBS);
        for (long i = gtid; i < 2 * 256; i += gsz) {
            const float* lg = p.in[I_LB];
            float mx = -1e30f;
            for (int l = 0; l < DEPTH; ++l) mx = fmaxf(mx, lg[(size_t)l * 512 + i]);
            float sm = 0.f;
            for (int l = 0; l < DEPTH; ++l) sm += expf(lg[(size_t)l * 512 + i] - mx);
            float cum = 0.f; const float p0 = expf(lg[i] - mx) / sm;
            for (int l = 0; l < DEPTH; ++l) { cum += expf(lg[(size_t)l * 512 + i] - mx) / sm; lbs[(size_t)l * 512 + i] = cum - p0; }
        }
        float* rm = WSP(float, WS_ROPEM);
        for (long i = gtid; i < (long)DSEQ * 16; i += gsz) {
            const int j = (int)(i % 16), t = (int)(i / 16);
            const float pos = j < 8 ? (float)(t / GW) : (float)(t % GW);
            const float a = pos * powf(10000.f, -(float)(j & 7) / 8.f); rm[i * 2] = cosf(a); rm[i * 2 + 1] = sinf(a);
        }
        float* rw = WSP(float, WS_ROPEW);
        for (long i = gtid; i < (long)DSEQ * 32; i += gsz) {
            const int j = (int)(i % 32), t = (int)(i / 32);
            const float pos = j < 16 ? (float)(t / GW) : (float)(t % GW);
            const float a = pos * powf(10000.f, -(float)(j & 15) / 16.f); rw[i * 2] = cosf(a); rw[i * 2 + 1] = sinf(a);
        }
        for (long i = gtid; i < (long)DB * DEPTH * PAST * 256 / 4; i += gsz) {
            const f32x4 a = *(const f32x4*)(p.in[I_CNAK] + 4 * i), b = *(const f32x4*)(p.in[I_CNAV] + 4 * i);
            u32x2 wa, wb; wa.x = cvt_pk_bf16(a[0], a[1]); wa.y = cvt_pk_bf16(a[2], a[3]); wb.x = cvt_pk_bf16(b[0], b[1]); wb.y = cvt_pk_bf16(b[2], b[3]);
            *(u32x2*)(WSP(bf16_t, WS_CNAK) + 4 * i) = wa; *(u32x2*)(WSP(bf16_t, WS_CNAV) + 4 * i) = wb;
        }
        for (long i = gtid; i < (long)DB * DEPTH * PAST * 128 / 4; i += gsz) {
            const f32x4 a = *(const f32x4*)(p.in[I_CWK] + 4 * i), b = *(const f32x4*)(p.in[I_CWV] + 4 * i), cc = *(const f32x4*)(p.in[I_CCKV] + 4 * i);
            u32x2 wa, wb, wc; wa.x = cvt_pk_bf16(a[0], a[1]); wa.y = cvt_pk_bf16(a[2], a[3]); wb.x = cvt_pk_bf16(b[0], b[1]); wb.y = cvt_pk_bf16(b[2], b[3]); wc.x = cvt_pk_bf16(cc[0], cc[1]); wc.y = cvt_pk_bf16(cc[2], cc[3]);
            *(u32x2*)(WSP(bf16_t, WS_CWK) + 4 * i) = wa; *(u32x2*)(WSP(bf16_t, WS_CWV) + 4 * i) = wb; *(u32x2*)(WSP(bf16_t, WS_CCKVB) + 4 * i) = wc;
        }
        for (long i = gtid; i < (long)DB * DEPTH * PAST * 128; i += gsz) {
            const int e = (int)(i % 32), h = (int)((i / 32) % 4); const long rowi = i / 128;
            WSP(bf16_t, WS_KCM)[(size_t)rowi * 384 + h * 96 + 64 + e] = f2bf(p.in[I_CKR][(size_t)rowi * 32 + e]);
        }
    }
}
struct CtxOrder {
    int c, nwgs; const char* A; const char* B;
    __device__ bool next(int i, pg8::Unit& u) const {
        const int L = i * nwgs + c; if (L >= (DB * DEPTH * PAST / 256) * 2) return false;
        u.pm = L >> 1; u.pn = L & 1; u.aux = 0;
        const int lyr = (u.pm / (PAST / 256)) % DEPTH;
        u.A = A + (size_t)u.pm * 256 * 128 * 2; u.B = B + ((size_t)lyr * 512 + u.pn * 256) * 128 * 2; return true;
    }
};
__device__ __forceinline__ void fs_prep_ctx(const P& p, LAS unsigned char* lds) {
    bf16_t* km = WSP(bf16_t, WS_KCM); bf16_t* vm = WSP(bf16_t, WS_VCM);
    CtxOrder S{(int)blockIdx.x, (int)gridDim.x, (const char*)WSP(bf16_t, WS_CCKVB), (const char*)WSP(bf16_t, WS_WTKVB)};
    auto E = make_epi([=](const pg8::Unit& u, int r, int n, f32x4 v0, f32x4 v1) {
        const u32x4 w = pack8(v0, v1); const int h = n >> 7, e = n & 127;
        if (e < 64) *(u32x4*)(km + (size_t)r * 384 + h * 96 + e) = w; else *(u32x4*)(vm + (size_t)r * 256 + h * 64 + (e - 64)) = w;
    });
    pg8::gemm_phase(lds, pg8::Gemm{128, 128, 128}, S, E);
}

#define XB_TMO      128
#define XB_XCNT(j)  (256  + 64 * (j))
#define XB_XSUB(j)  (1280 + 64 * (j))
#define XB_XGEN(j)  (2304 + 64 * (j))
#define XB_TOP      3328
#define XB_TOPGEN   3392
#define XCD_BAR_WORDS 3456
#define XB_SPIN_CAP (1u << 20)
__device__ __forceinline__ unsigned xb_ld(unsigned* p)              { return __hip_atomic_load(p, __ATOMIC_RELAXED, __HIP_MEMORY_SCOPE_AGENT); }
__device__ __forceinline__ unsigned xb_add(unsigned* p, unsigned v) { return __hip_atomic_fetch_add(p, v, __ATOMIC_RELAXED, __HIP_MEMORY_SCOPE_AGENT); }
__device__ __forceinline__ unsigned xb_xcc_id() { return (unsigned)__builtin_amdgcn_s_getreg((3 << 11) | 20) & 0xFu; }
#define XB_SPIN(cond, bar) do { unsigned _sp = 0; while (cond) { __builtin_amdgcn_s_sleep(1); \
    if ((++_sp & 255u) == 0u) { if (xb_ld(&(bar)[XB_TMO])) break; if (_sp > XB_SPIN_CAP) { atomicAdd(&(bar)[XB_TMO], 1u); break; } } } } while (0)
struct XcdBarrier { unsigned* bar; unsigned x; volatile LAS unsigned* st; };
__device__ __forceinline__ XcdBarrier xcd_barrier_post(unsigned* bar, volatile LAS unsigned* st) {
    XcdBarrier b; b.bar = bar; b.x = xb_xcc_id(); b.st = st;
    if (threadIdx.x == 0) (void)xb_add(&bar[XB_XCNT(b.x)], 1u);
    return b;
}
__device__ __forceinline__ void xcd_barrier_complete(unsigned* bar, unsigned x, unsigned& nloc, unsigned& nx) {
    const unsigned G = gridDim.x * gridDim.y * gridDim.z;
    unsigned sum, cnt, mine, sp = 0u;
    for (;;) {
        sum = 0u; cnt = 0u; mine = 0u;
#pragma unroll
        for (unsigned j = 0; j < 16; ++j) { const unsigned c = xb_ld(&bar[XB_XCNT(j)]); sum += c; cnt += (c > 0u) ? 1u : 0u; mine = (j == x) ? c : mine; }
        if (sum == G) break;
        __builtin_amdgcn_s_sleep(1);
        if ((++sp & 255u) == 0u) { if (xb_ld(&bar[XB_TMO])) break; if (sp > XB_SPIN_CAP) { atomicAdd(&bar[XB_TMO], 1u); break; } }
    }
    nloc = mine > 0u ? mine : 1u; nx = cnt > 0u ? cnt : 1u;
}
__device__ __forceinline__ void xcd_barrier(const XcdBarrier& b) {
    asm volatile("s_waitcnt vmcnt(0)" ::: "memory");
    __syncthreads();
    if (threadIdx.x == 0) {
        unsigned* bar = b.bar;
        __builtin_amdgcn_s_waitcnt(0);
        unsigned nloc = b.st[0], nx = b.st[1];
        if (nloc == 0u) { xcd_barrier_complete(bar, b.x, nloc, nx); b.st[0] = nloc; b.st[1] = nx; }
        const unsigned old = xb_add(&bar[XB_XSUB(b.x)], 1u);
        const unsigned gen = old / nloc;
        if (old + 1u == (gen + 1u) * nloc) {
            __builtin_amdgcn_fence(__ATOMIC_RELEASE, "agent");
            asm volatile("s_waitcnt vmcnt(0)" ::: "memory");
            const unsigned og = xb_add(&bar[XB_TOP], 1u);
            const unsigned tg = og / nx;
            if (og + 1u == (tg + 1u) * nx) xb_add(&bar[XB_TOPGEN], 1u);
            else XB_SPIN(xb_ld(&bar[XB_TOPGEN]) == tg, bar);
            __builtin_amdgcn_fence(__ATOMIC_ACQUIRE, "agent");
            xb_add(&bar[XB_XGEN(b.x)], 1u);
            asm volatile("s_waitcnt vmcnt(0)" ::: "memory");
        } else {
            XB_SPIN(xb_ld(&bar[XB_XGEN(b.x)]) == gen, bar);
            __builtin_amdgcn_fence(__ATOMIC_ACQUIRE, "agent");
            asm volatile("s_waitcnt vmcnt(0)" ::: "memory");
        }
    }
    __syncthreads();
}

__global__ void __launch_bounds__(NTHREADS) mega_kernel(P p) {
    extern __shared__ __attribute__((aligned(16))) unsigned char lds_raw[];
    LAS unsigned char* lds = (LAS unsigned char*)lds_raw;
    { LAS unsigned* stz = (LAS unsigned*)(lds + LDS_BYTES - 64); if (threadIdx.x < 16) stz[threadIdx.x] = 0u; }
    __syncthreads();
    const XcdBarrier gbar = xcd_barrier_post((unsigned*)((*(const P*)__builtin_amdgcn_kernarg_segment_ptr()).ws + WS_CTL), (volatile LAS unsigned*)(lds + LDS_BYTES - 64));
    const long gsz = (long)gridDim.x * blockDim.x;
#define GTID() ({ int t_ = threadIdx.x; asm volatile("" : "+v"(t_)); (long)blockIdx.x * blockDim.x + t_; })
#define PP ({ const __attribute__((address_space(4))) P* k_ = (const __attribute__((address_space(4))) P*)__builtin_amdgcn_kernarg_segment_ptr(); asm volatile("" : "+s"(k_)); k_; })
#define PPR (*(const P*)PP)
#ifndef DUPM
#define DUPM 0
#endif
#define DUP(bit, stmt) do { if (DUPM & (1 << (bit))) { stmt; } } while (0)
    fs_prep(PPR, lds); DUP(0, __syncthreads(); fs_prep(PPR, lds)); xcd_barrier(gbar);
    fs_prep_ctx(PPR, lds); xcd_barrier(gbar);
#pragma nounroll
    for (int l = 0; l < DEPTH; ++l) {
        fs_norm<false>(PPR, l); xcd_barrier(gbar);
        fs_inproj(PPR, l, lds); DUP(1, fs_inproj(PPR, l, lds)); xcd_barrier(gbar);
        fs_rowprep(PPR, l); fs_hgrn_a(PPR, l, lds); DUP(6, fs_rowprep(PPR, l); fs_hgrn_a(PPR, l, lds)); xcd_barrier(gbar);
        fs_mlaproj(PPR, l, lds); DUP(7, fs_mlaproj(PPR, l, lds)); xcd_barrier(gbar);
        fs_hgrn_b(PPR, l, GTID(), gsz); fs_attn(PPR, l, lds); DUP(2, fs_attn(PPR, l, lds)); xcd_barrier(gbar);
        fs_hgrn_c(PPR, l, lds); DUP(5, fs_hgrn_c(PPR, l, lds)); xcd_barrier(gbar);
        fs_merge(PPR, l, lds); DUP(3, fs_merge(PPR, l, lds)); DUP(4, xcd_barrier(gbar); xcd_barrier(gbar); xcd_barrier(gbar); xcd_barrier(gbar); xcd_barrier(gbar); xcd_barrier(gbar); xcd_barrier(gbar); xcd_barrier(gbar)); xcd_barrier(gbar);
        fs_out(PPR, l, lds); xcd_barrier(gbar);
    }
    fs_norm<true>(PPR, 0);
}

extern "C" void kernel_launch(void* const* d_in, const int* in_sizes, int n_in, void* d_out, int out_size, void* d_ws, size_t ws_size, hipStream_t stream) {
    static int grid_blocks = 0;
    if (grid_blocks == 0) {
        if (n_in != N_IN || (size_t)out_size != O_END || ws_size < WS_END) {
            fprintf(stderr, "kernel_launch: unexpected sizes n_in %d out %d ws %zu (need %zu)\n", n_in, out_size, ws_size, (size_t)WS_END);
            grid_blocks = -1; return;
        }
        int dev = 0, cus = 0, per_cu = 0;
        hipGetDevice(&dev);
        hipDeviceGetAttribute(&cus, hipDeviceAttributeMultiprocessorCount, dev);
        hipFuncSetAttribute((const void*)mega_kernel, hipFuncAttributeMaxDynamicSharedMemorySize, LDS_BYTES);
        hipOccupancyMaxActiveBlocksPerMultiprocessor(&per_cu, (const void*)mega_kernel, NTHREADS, LDS_BYTES);
        if (per_cu < 1) per_cu = 1;
        grid_blocks = cus * per_cu;
    }
    if (grid_blocks < 0) return;
    P p{};
    for (int i = 0; i < N_IN; ++i) p.in[i] = (const float*)d_in[i];
    p.out = (float*)d_out; p.ws = (unsigned char*)d_ws;
    if (hipMemsetAsync((char*)d_ws + WS_CTL, 0, 16384, stream) != hipSuccess) { fprintf(stderr, "kernel_launch: memset of the barrier words failed\n"); return; }
    hipLaunchKernelGGL(mega_kernel, dim3(grid_blocks), dim3(NTHREADS), LDS_BYTES, stream, p);
    hipError_t e = hipPeekAtLastError();
    if (e != hipSuccess) fprintf(stderr, "launch failed: %s (grid %d)\n", hipGetErrorString(e), grid_blocks);
}
#endif
```

```cpp
#ifndef CPU_EMU
#include <hip/hip_runtime.h>
#include <cstdio>
#define DEV __device__ __forceinline__
#else
#include <cmath>
#include <cstdio>
#include <cstring>
#define DEV inline
#endif
#include <cstdint>
#include <cstddef>

#ifndef CFG_BATCH
#define CFG_BATCH 16
#endif
#ifndef CFG_DEPTH
#define CFG_DEPTH 4
#endif
#ifndef CFG_DEC_BATCH
#define CFG_DEC_BATCH 4
#endif
constexpr int DM = 1024, BATCH = CFG_BATCH, SEQ = 256, DEPTH = CFG_DEPTH, DB = CFG_DEC_BATCH, DSEQ = 2048, PAST = 512;
constexpr int NCTX = BATCH * SEQ, NLAT = DB * DSEQ, NTOK = NCTX + NLAT;
constexpr int NCB = 1 + DB;
constexpr int INW = 8096, NC = 8192;
constexpr int GW = 64, GROWS = DSEQ / GW;
constexpr int C_NAQ = 0, C_NAK = 256, C_NAV = 512, C_NAZ = 768, C_HGQ = 1024, C_HGFF = 1280, C_HGFB = 1536, C_HGI = 1792, C_HGOG = 2048, C_HGZ = 2304,
              C_MQA = 2560, C_CKV = 2816, C_MZ = 2944, C_WQ = 3200, C_WK = 3456, C_WV = 3584, C_WZ = 3712, C_KR = 3968, C_PAD = 4000, C_MG = 4096;
DEV int orig_col(int c) {
    if (c < 2944) return c;
    if (c < 3968) return c + 32;
    if (c < 4000) return 2944 + (c - 3968);
    if (c < 4096) return -1;
    return c - 96;
}
enum { I_XP = 0, I_XS, I_CNAK, I_CNAV, I_ST, I_CCKV, I_CKR, I_CWK, I_CWV, I_C, I_CCTX, I_NG, I_WMOD, I_BMOD, I_WIN, I_RPB, I_LB, I_HGG, I_QG, I_KVG, I_WQB, I_WKVB, I_SINK, I_WBR, I_WOUT, I_FG, N_IN };
constexpr size_t O_Y = 0;
constexpr size_t O_NAK = (size_t)NTOK * DM;
constexpr size_t O_NAV = O_NAK + (size_t)BATCH * DEPTH * SEQ * 256;
constexpr size_t O_ST = O_NAV + (size_t)BATCH * DEPTH * SEQ * 256;
constexpr size_t O_CKV = O_ST + (size_t)BATCH * DEPTH * 2 * 4 * 64 * 64;
constexpr size_t O_KR = O_CKV + (size_t)BATCH * DEPTH * SEQ * 128;
constexpr size_t O_WK = O_KR + (size_t)BATCH * DEPTH * SEQ * 32;
constexpr size_t O_WV = O_WK + (size_t)BATCH * DEPTH * SEQ * 128;
constexpr size_t O_END = O_WV + (size_t)BATCH * DEPTH * SEQ * 128;

typedef unsigned short bf16_t;
constexpr size_t al256(size_t x) { return (x + 255) & ~(size_t)255; }
constexpr size_t WS_CTL = 0;
constexpr size_t WS_WTIN = 1u << 20;
constexpr size_t WS_WTBR = WS_WTIN + (size_t)DEPTH * NC * DM * 2;
constexpr size_t WS_WTOUT = WS_WTBR + (size_t)DEPTH * 4 * DM * 256 * 2;
constexpr size_t WS_WTQB = WS_WTOUT + (size_t)DEPTH * DM * DM * 2;
constexpr size_t WS_WTKVB = WS_WTQB + (size_t)DEPTH * 512 * 256 * 2;
constexpr size_t WS_MODV = WS_WTKVB + (size_t)DEPTH * 512 * 128 * 2;
constexpr size_t WS_LBS = al256(WS_MODV + (size_t)DEPTH * NCB * 3072 * 4);
constexpr size_t WS_ROPEM = al256(WS_LBS + (size_t)DEPTH * 2 * 256 * 4);
constexpr size_t WS_ROPEW = al256(WS_ROPEM + (size_t)DSEQ * 16 * 2 * 4);
constexpr size_t WS_X = al256(WS_ROPEW + (size_t)DSEQ * 32 * 2 * 4);
constexpr size_t WS_H = WS_X + (size_t)NTOK * DM * 4;
constexpr size_t WS_COLS = WS_H + (size_t)NTOK * DM * 2;
constexpr size_t WS_KCM = WS_COLS + (size_t)NTOK * NC * 2;
constexpr size_t WS_VCM = WS_KCM + (size_t)DB * DEPTH * PAST * 384 * 2;
constexpr size_t WS_QN = WS_VCM + (size_t)DB * DEPTH * PAST * 256 * 2;
constexpr size_t WS_CKVB = WS_QN + (size_t)NTOK * 256 * 2;
constexpr size_t WS_QMLA = WS_CKVB + (size_t)NTOK * 128 * 2;
constexpr size_t WS_KMLA = WS_QMLA + (size_t)NTOK * 384 * 2;
constexpr size_t WS_VMLA = WS_KMLA + (size_t)NTOK * 384 * 2;
constexpr size_t WS_WQR = WS_VMLA + (size_t)NTOK * 256 * 2;
constexpr size_t WS_WKR = WS_WQR + (size_t)NTOK * 256 * 2;
constexpr size_t WS_OH = WS_WKR + (size_t)NTOK * 128 * 2;
constexpr size_t WS_Y = WS_OH + (size_t)2 * NTOK * 256 * 4;
constexpr size_t WS_MRG = WS_H;
constexpr size_t WS_HD = WS_Y + (size_t)NTOK * DM * 2;
constexpr size_t WS_CNAK = al256(WS_HD + (size_t)(NTOK / 64) * 4 * 2 * 64 * 4);
constexpr size_t WS_CNAV = WS_CNAK + (size_t)DB * DEPTH * PAST * 256 * 2;
constexpr size_t WS_CWK = WS_CNAV + (size_t)DB * DEPTH * PAST * 256 * 2;
constexpr size_t WS_CWV = WS_CWK + (size_t)DB * DEPTH * PAST * 128 * 2;
constexpr size_t WS_CCKVB = WS_CWV + (size_t)DB * DEPTH * PAST * 128 * 2;
constexpr size_t WS_END = WS_CCKVB + (size_t)DB * DEPTH * PAST * 128 * 2;
constexpr size_t WS_HL = WS_OH;
constexpr size_t WS_MRGF = WS_QN;
static_assert(WS_MRGF + (size_t)NTOK * DM * 4 <= WS_Y, "MRGF alias must end before Y");

struct P {
    const float* in[N_IN];
    float* out;
    unsigned char* ws;
};

DEV unsigned f2u(float f) { unsigned u; memcpy(&u, &f, 4); return u; }
DEV float u2f(unsigned u) { float f; memcpy(&f, &u, 4); return f; }
DEV bf16_t f2bf(float f) { unsigned u = f2u(f); return (bf16_t)((u + 0x7fffu + ((u >> 16) & 1u)) >> 16); }
DEV float bf2f(bf16_t b) { return u2f((unsigned)b << 16); }
DEV float rbf(float f) { return bf2f(f2bf(f)); }
DEV float sigm(float x) { return 1.f / (1.f + expf(-x)); }
DEV float siluf(float x) { return x * sigm(x); }
DEV int row_cb(int r) { return r < NCTX ? 0 : 1 + (r - NCTX) / DSEQ; }

struct U4 { unsigned x, y, z, w; };
DEV void unpack8(const bf16_t* p, float* f) {
    U4 v = *(const U4*)p;
    f[0] = u2f(v.x << 16); f[1] = u2f(v.x & 0xffff0000u); f[2] = u2f(v.y << 16); f[3] = u2f(v.y & 0xffff0000u);
    f[4] = u2f(v.z << 16); f[5] = u2f(v.z & 0xffff0000u); f[6] = u2f(v.w << 16); f[7] = u2f(v.w & 0xffff0000u);
}

#define WSP(T, off) ((T*)(p.ws + (off)))

DEV void nv_prep_w(const P& p, long gtid, long gsz) {
    bf16_t* wtin = WSP(bf16_t, WS_WTIN);
    const float* win = p.in[I_WIN];
    for (long i = gtid; i < (long)DEPTH * NC * DM; i += gsz) {
        int k = (int)(i % DM); long t = i / DM; int n = (int)(t % NC); int l = (int)(t / NC);
        int oc = orig_col(n);
        wtin[i] = oc < 0 ? (bf16_t)0 : f2bf(win[((size_t)l * DM + k) * INW + oc]);
    }
    bf16_t* wtbr = WSP(bf16_t, WS_WTBR);
    const float* wbr = p.in[I_WBR];
    for (long i = gtid; i < (long)DEPTH * 4 * DM * 256; i += gsz) {
        int w = (int)(i % 256); long t = i / 256; int d = (int)(t % DM); t /= DM; int b = (int)(t % 4); int l = (int)(t / 4);
        wtbr[i] = f2bf(wbr[(((size_t)l * 4 + b) * 256 + w) * DM + d]);
    }
    bf16_t* wtout = WSP(bf16_t, WS_WTOUT);
    const float* wout = p.in[I_WOUT];
    for (long i = gtid; i < (long)DEPTH * DM * DM; i += gsz) {
        int k = (int)(i % DM); long t = i / DM; int n = (int)(t % DM); int l = (int)(t / DM);
        wtout[i] = f2bf(wout[((size_t)l * DM + k) * DM + n]);
    }
    bf16_t* wtqb = WSP(bf16_t, WS_WTQB);
    const float* wqb = p.in[I_WQB];
    for (long i = gtid; i < (long)DEPTH * 512 * 256; i += gsz) {
        int k = (int)(i % 256); long t = i / 256; int n = (int)(t % 512); int l = (int)(t / 512);
        wtqb[i] = n < 384 ? f2bf(wqb[((size_t)l * 256 + k) * 384 + n]) : (bf16_t)0;
    }
    bf16_t* wtkvb = WSP(bf16_t, WS_WTKVB);
    const float* wkvb = p.in[I_WKVB];
    for (long i = gtid; i < (long)DEPTH * 512 * 128; i += gsz) {
        int k = (int)(i % 128); long t = i / 128; int n = (int)(t % 512); int l = (int)(t / 512);
        wtkvb[i] = f2bf(wkvb[((size_t)l * 128 + k) * 512 + n]);
    }
    float* modv = WSP(float, WS_MODV);
    for (long i = gtid; i < (long)DEPTH * NCB * 3072; i += gsz) {
        int j = (int)(i % 3072); long t = i / 3072; int cb = (int)(t % NCB); int l = (int)(t / NCB);
        const float* cv = cb == 0 ? p.in[I_CCTX] : p.in[I_C] + (size_t)(cb - 1) * DM;
        const float* w = p.in[I_WMOD] + (size_t)l * DM * 3072 + j;
        float acc = 0.f;
        for (int k = 0; k < DM; ++k) acc += siluf(cv[k]) * w[(size_t)k * 3072];
        modv[i] = acc + p.in[I_BMOD][(size_t)l * 3072 + j];
    }
    float* lbs = WSP(float, WS_LBS);
    for (long i = gtid; i < 2 * 256; i += gsz) {
        const float* lg = p.in[I_LB];
        float mx = -1e30f;
        for (int l = 0; l < DEPTH; ++l) mx = fmaxf(mx, lg[(size_t)l * 512 + i]);
        float s = 0.f;
        for (int l = 0; l < DEPTH; ++l) s += expf(lg[(size_t)l * 512 + i] - mx);
        float cum = 0.f, p0 = expf(lg[i] - mx) / s;
        for (int l = 0; l < DEPTH; ++l) { cum += expf(lg[(size_t)l * 512 + i] - mx) / s; lbs[(size_t)l * 512 + i] = cum - p0; }
    }
    float* rm = WSP(float, WS_ROPEM);
    for (long i = gtid; i < (long)DSEQ * 16; i += gsz) {
        int j = (int)(i % 16), t = (int)(i / 16);
        float pos = j < 8 ? (float)(t / GW) : (float)(t % GW);
        float inv = powf(10000.f, -(float)(j & 7) / 8.f);
        float a = pos * inv; rm[i * 2] = cosf(a); rm[i * 2 + 1] = sinf(a);
    }
    float* rw = WSP(float, WS_ROPEW);
    for (long i = gtid; i < (long)DSEQ * 32; i += gsz) {
        int j = (int)(i % 32), t = (int)(i / 32);
        float pos = j < 16 ? (float)(t / GW) : (float)(t % GW);
        float inv = powf(10000.f, -(float)(j & 15) / 16.f);
        float a = pos * inv; rw[i * 2] = cosf(a); rw[i * 2 + 1] = sinf(a);
    }
}

DEV void nv_prep_ctxmla(const P& p, long gtid, long gsz) {
    const bf16_t* wtkvb = WSP(bf16_t, WS_WTKVB);
    bf16_t* kcm = WSP(bf16_t, WS_KCM); bf16_t* vcm = WSP(bf16_t, WS_VCM);
    for (long i = gtid; i < (long)DB * DEPTH * PAST * 512; i += gsz) {
        int n = (int)(i % 512); long row = i / 512;
        int l = (int)((row / PAST) % DEPTH);
        const float* ck = p.in[I_CCKV] + (size_t)row * 128;
        const bf16_t* w = wtkvb + ((size_t)l * 512 + n) * 128;
        float acc = 0.f;
        for (int j = 0; j < 128; ++j) acc += rbf(ck[j]) * bf2f(w[j]);
        int h = n / 128, e = n % 128;
        if (e < 64) kcm[(size_t)row * 384 + h * 96 + e] = f2bf(acc);
        else vcm[(size_t)row * 256 + h * 64 + (e - 64)] = f2bf(acc);
    }
    for (long i = gtid; i < (long)DB * DEPTH * PAST * 128; i += gsz) {
        int e = (int)(i % 32); int h = (int)((i / 32) % 4); long row = i / 128;
        kcm[(size_t)row * 384 + h * 96 + 64 + e] = f2bf(p.in[I_CKR][(size_t)row * 32 + e]);
    }
    for (long i = gtid; i < (long)DB * DEPTH * PAST * 256; i += gsz) { WSP(bf16_t, WS_CNAK)[i] = f2bf(p.in[I_CNAK][i]); WSP(bf16_t, WS_CNAV)[i] = f2bf(p.in[I_CNAV][i]); }
    for (long i = gtid; i < (long)DB * DEPTH * PAST * 128; i += gsz) { WSP(bf16_t, WS_CWK)[i] = f2bf(p.in[I_CWK][i]); WSP(bf16_t, WS_CWV)[i] = f2bf(p.in[I_CWV][i]); }
}

DEV const float* x_row(const P& p, int l, int r) {
    if (l == 0) return r < NCTX ? p.in[I_XP] + (size_t)r * DM : p.in[I_XS] + (size_t)(r - NCTX) * DM;
    return WSP(float, WS_X) + (size_t)r * DM;
}

DEV void nv_normmod(const P& p, int l, long gtid, long gsz) {
    bf16_t* H = WSP(bf16_t, WS_H);
    const float* g = p.in[I_NG] + (size_t)l * DM;
    for (long r = gtid; r < NTOK; r += gsz) {
        const float* x = x_row(p, l, (int)r);
        const float* mv = WSP(float, WS_MODV) + ((size_t)l * NCB + row_cb((int)r)) * 3072;
        float ss = 0.f;
        for (int k = 0; k < DM; ++k) ss += x[k] * x[k];
        float rstd = 1.f / sqrtf(ss / DM + 1e-6f);
        for (int k = 0; k < DM; ++k) H[(size_t)r * DM + k] = f2bf(x[k] * rstd * g[k] * (1.f + mv[1024 + k]) + mv[k]);
    }
}

template <class Epi>
DEV void nv_gemm(const bf16_t* A, int lda, const bf16_t* Wt, int ldw, int M, int N, int K, long gtid, long gsz, Epi epi) {
    const long nItems = (long)(M / 4) * (N / 4);
    for (long it = gtid; it < nItems; it += gsz) {
        const int cb = (int)(it % (N / 4)), rb = (int)(it / (N / 4));
        float acc[4][4];
#pragma unroll
        for (int i = 0; i < 4; ++i)
#pragma unroll
            for (int j = 0; j < 4; ++j) acc[i][j] = 0.f;
        for (int k = 0; k < K; k += 8) {
            float a[4][8], w[4][8];
#pragma unroll
            for (int i = 0; i < 4; ++i) unpack8(A + (size_t)(rb * 4 + i) * lda + k, a[i]);
#pragma unroll
            for (int j = 0; j < 4; ++j) unpack8(Wt + (size_t)(cb * 4 + j) * ldw + k, w[j]);
#pragma unroll
            for (int i = 0; i < 4; ++i)
#pragma unroll
                for (int j = 0; j < 4; ++j)
#pragma unroll
                    for (int e = 0; e < 8; ++e) acc[i][j] += a[i][e] * w[j][e];
        }
#pragma unroll
        for (int i = 0; i < 4; ++i)
#pragma unroll
            for (int j = 0; j < 4; ++j) epi(rb * 4 + i, cb * 4 + j, acc[i][j]);
    }
}

DEV void nv_inproj(const P& p, int l, long gtid, long gsz) {
    bf16_t* cols = WSP(bf16_t, WS_COLS);
    float* out = p.out;
    nv_gemm(WSP(bf16_t, WS_H), DM, WSP(bf16_t, WS_WTIN) + (size_t)l * NC * DM, DM, NTOK, NC, DM, gtid, gsz,
        [=](int r, int n, float v) {
            cols[(size_t)r * NC + n] = f2bf(v);
            if (r < NCTX) {
                const int b = r / SEQ, t = r % SEQ; const size_t bl = ((size_t)b * DEPTH + l) * SEQ + t;
                if (n >= C_NAK && n < C_NAK + 256) out[O_NAK + bl * 256 + (n - C_NAK)] = v;
                else if (n >= C_NAV && n < C_NAV + 256) out[O_NAV + bl * 256 + (n - C_NAV)] = v;
                else if (n >= C_WK && n < C_WK + 128) out[O_WK + bl * 128 + (n - C_WK)] = v;
                else if (n >= C_WV && n < C_WV + 128) out[O_WV + bl * 128 + (n - C_WV)] = v;
            }
        });
}

DEV void nv_rowprep(const P& p, int l, long gtid, long gsz) {
    const bf16_t* cols = WSP(bf16_t, WS_COLS);
    for (long r = gtid; r < NTOK; r += gsz) {
        const bf16_t* c = cols + (size_t)r * NC;
        const bool lat = r >= NCTX; const int t = lat ? (int)((r - NCTX) % DSEQ) : 0;
        {
            float ss = 0.f;
            for (int j = 0; j < 128; ++j) { float v = bf2f(c[C_CKV + j]); ss += v * v; }
            float rstd = 1.f / sqrtf(ss / 128.f + 1e-6f);
            const float* g = p.in[I_KVG] + (size_t)l * 128;
            for (int j = 0; j < 128; ++j) {
                float v = bf2f(c[C_CKV + j]) * rstd * g[j];
                WSP(bf16_t, WS_CKVB)[(size_t)r * 128 + j] = f2bf(v);
                if (!lat) p.out[O_CKV + (((size_t)(r / SEQ) * DEPTH + l) * SEQ + (r % SEQ)) * 128 + j] = v;
            }
        }
        {
            const float* rm = WSP(float, WS_ROPEM) + (size_t)t * 32;
            for (int j = 0; j < 16; ++j) {
                float x1 = bf2f(c[C_KR + j]), x2 = bf2f(c[C_KR + 16 + j]);
                float o1 = x1, o2 = x2;
                if (lat) { float cs = rm[j * 2], sn = rm[j * 2 + 1]; o1 = x1 * cs - x2 * sn; o2 = x1 * sn + x2 * cs; }
                else {
                    size_t o = O_KR + (((size_t)(r / SEQ) * DEPTH + l) * SEQ + (r % SEQ)) * 32;
                    p.out[o + j] = x1; p.out[o + 16 + j] = x2;
                }
                for (int h = 0; h < 4; ++h) {
                    WSP(bf16_t, WS_KMLA)[(size_t)r * 384 + h * 96 + 64 + j] = f2bf(o1);
                    WSP(bf16_t, WS_KMLA)[(size_t)r * 384 + h * 96 + 80 + j] = f2bf(o2);
                }
            }
        }
        {
            float ss = 0.f;
            for (int j = 0; j < 256; ++j) { float v = bf2f(c[C_MQA + j]); ss += v * v; }
            float rstd = 1.f / sqrtf(ss / 256.f + 1e-6f);
            const float* g = p.in[I_QG] + (size_t)l * 256;
            for (int j = 0; j < 256; ++j) WSP(bf16_t, WS_QN)[(size_t)r * 256 + j] = f2bf(bf2f(c[C_MQA + j]) * rstd * g[j]);
        }
        {
            const float* rw = WSP(float, WS_ROPEW) + (size_t)t * 64;
            for (int hh = 0; hh < 6; ++hh) {
                const bf16_t* src = hh < 4 ? c + C_WQ + hh * 64 : c + C_WK + (hh - 4) * 64;
                bf16_t* dst = hh < 4 ? WSP(bf16_t, WS_WQR) + (size_t)r * 256 + hh * 64 : WSP(bf16_t, WS_WKR) + (size_t)r * 128 + (hh - 4) * 64;
                for (int j = 0; j < 32; ++j) {
                    float x1 = bf2f(src[j]), x2 = bf2f(src[32 + j]);
                    if (lat) { float cs = rw[j * 2], sn = rw[j * 2 + 1]; dst[j] = f2bf(x1 * cs - x2 * sn); dst[32 + j] = f2bf(x1 * sn + x2 * cs); }
                    else { dst[j] = src[j]; dst[32 + j] = src[32 + j]; }
                }
            }
        }
    }
}

DEV void nv_mlaproj(const P& p, int l, long gtid, long gsz) {
    bf16_t* qm = WSP(bf16_t, WS_QMLA); bf16_t* km = WSP(bf16_t, WS_KMLA); bf16_t* vm = WSP(bf16_t, WS_VMLA);
    nv_gemm(WSP(bf16_t, WS_QN), 256, WSP(bf16_t, WS_WTQB) + (size_t)l * 512 * 256, 256, NTOK, 384, 256, gtid, gsz,
        [=](int r, int n, float v) { qm[(size_t)r * 384 + n] = f2bf(v); });
    nv_gemm(WSP(bf16_t, WS_CKVB), 128, WSP(bf16_t, WS_WTKVB) + (size_t)l * 512 * 128, 128, NTOK, 512, 128, gtid, gsz,
        [=](int r, int n, float v) {
            int h = n / 128, e = n % 128;
            if (e < 64) km[(size_t)r * 384 + h * 96 + e] = f2bf(v); else vm[(size_t)r * 256 + h * 64 + (e - 64)] = f2bf(v);
        });
}

struct SoftAcc { float m, l; float o[32]; };
DEV void sa_init(SoftAcc& s) { s.m = -3e38f; s.l = 0.f;
#pragma unroll
    for (int d = 0; d < 32; ++d) s.o[d] = 0.f; }
DEV void sa_add(SoftAcc& s, float sc, const bf16_t* v) {
    float mn = fmaxf(s.m, sc);
    float corr = expf(s.m - mn), pe = expf(sc - mn);
    s.m = mn; s.l = s.l * corr + pe;
#pragma unroll
    for (int d8 = 0; d8 < 4; ++d8) {
        float f[8]; unpack8(v + d8 * 8, f);
#pragma unroll
        for (int e = 0; e < 8; ++e) s.o[d8 * 8 + e] = s.o[d8 * 8 + e] * corr + pe * f[e];
    }
}
DEV void sa_add_f32v(SoftAcc& s, float sc, const float* v) {
    float mn = fmaxf(s.m, sc);
    float corr = expf(s.m - mn), pe = expf(sc - mn);
    s.m = mn; s.l = s.l * corr + pe;
#pragma unroll
    for (int d = 0; d < 32; ++d) s.o[d] = s.o[d] * corr + pe * rbf(v[d]);
}
template <int DQ> DEV float dot_bf(const float* q, const bf16_t* k) {
    float acc = 0.f;
#pragma unroll
    for (int d8 = 0; d8 < DQ / 8; ++d8) {
        float f[8]; unpack8(k + d8 * 8, f);
#pragma unroll
        for (int e = 0; e < 8; ++e) acc += q[d8 * 8 + e] * f[e];
    }
    return acc;
}
DEV float dot64_f32k(const float* q, const float* k) {
    float acc = 0.f;
#pragma unroll
    for (int d = 0; d < 64; ++d) acc += q[d] * rbf(k[d]);
    return acc;
}
DEV void sa_store(const P& p, const SoftAcc& s, float extra_den, int r, int branch, int h, int zcol, int half) {
    const bf16_t* c = WSP(bf16_t, WS_COLS) + (size_t)r * NC + zcol + h * 64 + half * 32;
    bf16_t* y = WSP(bf16_t, WS_Y) + (size_t)r * DM + branch * 256 + h * 64 + half * 32;
    float inv = 1.f / (s.l + extra_den);
#pragma unroll
    for (int d = 0; d < 32; ++d) y[d] = f2bf(s.o[d] * inv * siluf(bf2f(c[d])));
}

DEV void nv_attn(const P& p, int l, long gtid, long gsz) {
    const bf16_t* cols = WSP(bf16_t, WS_COLS);
    for (long it = gtid; it < (long)NTOK * 24; it += gsz) {
        const int half = (int)(it % 2); const int kind = (int)((it / 2) % 3); const int h = (int)((it / 6) % 4); const int r = (int)(it / 24);
        const int vo = half * 32;
        const bool lat = r >= NCTX;
        const int b = lat ? (r - NCTX) / DSEQ : r / SEQ, t = lat ? (r - NCTX) % DSEQ : r % SEQ;
        const int seq0 = lat ? NCTX + b * DSEQ : b * SEQ;
        SoftAcc s; sa_init(s);
        if (kind == 0) {
            float q[64];
#pragma unroll
            for (int d8 = 0; d8 < 8; ++d8) unpack8(cols + (size_t)r * NC + C_NAQ + h * 64 + d8 * 8, q + d8 * 8);
            if (!lat) {
                for (int j = 0; j < SEQ; ++j) {
                    const bf16_t* kr = cols + (size_t)(seq0 + j) * NC;
                    sa_add(s, dot_bf<64>(q, kr + C_NAK + h * 64) * 0.125f, kr + C_NAV + h * 64 + vo);
                }
            } else {
                const int gi = t / GW, gj = t % GW;
                int rs = gi - 4; rs = rs < 0 ? 0 : (rs > GROWS - 8 ? GROWS - 8 : rs);
                int cs = gj - 8; cs = cs < 0 ? 0 : (cs > GW - 16 ? GW - 16 : cs);
                const float* rpb = p.in[I_RPB] + ((size_t)l * 4 + h) * 15 * 31;
                for (int kr_ = rs; kr_ < rs + 8; ++kr_)
                    for (int kc = cs; kc < cs + 16; ++kc) {
                        const bf16_t* kk = cols + (size_t)(seq0 + kr_ * GW + kc) * NC;
                        int dc = kc - gj + 15; dc = dc < 0 ? 0 : (dc > 30 ? 30 : dc);
                        float bias = rpb[(kr_ - gi + 7) * 31 + dc];
                        sa_add(s, dot_bf<64>(q, kk + C_NAK + h * 64) * 0.125f + bias, kk + C_NAV + h * 64 + vo);
                    }
                const float* ck = p.in[I_CNAK] + ((size_t)b * DEPTH + l) * PAST * 256 + h * 64;
                const float* cv = p.in[I_CNAV] + ((size_t)b * DEPTH + l) * PAST * 256 + h * 64 + vo;
                for (int j = 0; j < PAST; ++j) sa_add_f32v(s, dot64_f32k(q, ck + (size_t)j * 256) * 0.125f, cv + (size_t)j * 256);
            }
            sa_store(p, s, 0.f, r, 0, h, C_NAZ, half);
        } else if (kind == 1) {
            float q[96];
            const bf16_t* qp = WSP(bf16_t, WS_QMLA) + (size_t)r * 384 + h * 96;
#pragma unroll
            for (int d8 = 0; d8 < 12; ++d8) unpack8(qp + d8 * 8, q + d8 * 8);
            if (lat) {
                const float* rm = WSP(float, WS_ROPEM) + (size_t)t * 32;
#pragma unroll
                for (int j = 0; j < 16; ++j) {
                    float x1 = q[64 + j], x2 = q[80 + j], cs = rm[j * 2], sn = rm[j * 2 + 1];
                    q[64 + j] = rbf(x1 * cs - x2 * sn); q[80 + j] = rbf(x1 * sn + x2 * cs);
                }
            }
            const float scale = 0.10206207261596577f;
            const int n = lat ? DSEQ : SEQ;
            const bf16_t* km = WSP(bf16_t, WS_KMLA) + (size_t)seq0 * 384 + h * 96;
            const bf16_t* vm = WSP(bf16_t, WS_VMLA) + (size_t)seq0 * 256 + h * 64 + vo;
            for (int j = 0; j < n; ++j) sa_add(s, dot_bf<96>(q, km + (size_t)j * 384) * scale, vm + (size_t)j * 256);
            if (lat) {
                const bf16_t* kc = WSP(bf16_t, WS_KCM) + ((size_t)b * DEPTH + l) * PAST * 384 + h * 96;
                const bf16_t* vc = WSP(bf16_t, WS_VCM) + ((size_t)b * DEPTH + l) * PAST * 256 + h * 64 + vo;
                for (int j = 0; j < PAST; ++j) sa_add(s, dot_bf<96>(q, kc + (size_t)j * 384) * scale, vc + (size_t)j * 256);
            }
            sa_store(p, s, 0.f, r, 2, h, C_MZ, half);
        } else {
            float q[64];
#pragma unroll
            for (int d8 = 0; d8 < 8; ++d8) unpack8(WSP(bf16_t, WS_WQR) + (size_t)r * 256 + h * 64 + d8 * 8, q + d8 * 8);
            const int kh = h / 2;
            const float sink = p.in[I_SINK][l * 4 + h];
            int j0 = 0, j1 = SEQ;
            if (lat) { j0 = t - 128 < 0 ? 0 : t - 128; j1 = t + 129 > DSEQ ? DSEQ : t + 129; }
            for (int j = j0; j < j1; ++j)
                sa_add(s, dot_bf<64>(q, WSP(bf16_t, WS_WKR) + (size_t)(seq0 + j) * 128 + kh * 64) * 0.125f, cols + (size_t)(seq0 + j) * NC + C_WV + kh * 64 + vo);
            if (lat) {
                const float* ck = p.in[I_CWK] + ((size_t)b * DEPTH + l) * PAST * 128 + kh * 64;
                const float* cv = p.in[I_CWV] + ((size_t)b * DEPTH + l) * PAST * 128 + kh * 64 + vo;
                for (int j = 0; j < PAST; ++j) sa_add_f32v(s, dot64_f32k(q, ck + (size_t)j * 128) * 0.125f, cv + (size_t)j * 128);
            }
            float mn = fmaxf(s.m, sink); float corr = expf(s.m - mn);
            s.l *= corr;
#pragma unroll
            for (int d = 0; d < 32; ++d) s.o[d] *= corr;
            s.m = mn;
            sa_store(p, s, expf(sink - mn), r, 3, h, C_WZ, half);
        }
    }
}

DEV void nv_hgrn(const P& p, int l, long gtid, long gsz) {
    const bf16_t* cols = WSP(bf16_t, WS_COLS);
    float* oh = WSP(float, WS_OH);
    const int NSEQ = BATCH + DB;
    for (long it = gtid; it < (long)NSEQ * 4 * 2 * 64; it += gsz) {
        const int j = (int)(it % 64); const int dir = (int)((it / 64) % 2); const int h = (int)((it / 128) % 4); const int sq = (int)(it / 512);
        const bool lat = sq >= BATCH;
        const int b = lat ? sq - BATCH : sq;
        const int T = lat ? DSEQ : SEQ; const int seq0 = lat ? NCTX + b * DSEQ : b * SEQ;
        const float* lb = WSP(float, WS_LBS) + ((size_t)l * 2 + dir) * 256 + h * 64;
        float S[64];
        if (lat) {
            const float* st = p.in[I_ST] + ((((size_t)b * DEPTH + l) * 2 + dir) * 4 + h) * 4096;
#pragma unroll
            for (int d = 0; d < 64; ++d) S[d] = st[d * 64 + j];
        } else {
#pragma unroll
            for (int d = 0; d < 64; ++d) S[d] = 0.f;
        }
        const int fcol = dir == 0 ? C_HGFF : C_HGFB;
        for (int tt = 0; tt < T; ++tt) {
            const int t = dir == 0 ? tt : T - 1 - tt;
            const bf16_t* c = cols + (size_t)(seq0 + t) * NC;
            const float v = bf2f(c[C_HGI + h * 64 + j]);
            float o = 0.f;
#pragma unroll
            for (int d8 = 0; d8 < 8; ++d8) {
                float fz[8], qq[8]; unpack8(c + fcol + h * 64 + d8 * 8, fz); unpack8(c + C_HGQ + h * 64 + d8 * 8, qq);
#pragma unroll
                for (int e = 0; e < 8; ++e) {
                    const int d = d8 * 8 + e;
                    const float lbv = lb[d];
                    float f = lbv + (1.f - lbv) * sigm(fz[e]);
                    f = fmaxf(f, 1e-30f);
                    const float k = (1.f - lbv) * sigm(-fz[e]);
                    S[d] = f * S[d] + k * v;
                    o += S[d] * siluf(qq[e]);
                }
            }
            oh[((size_t)dir * NTOK + seq0 + t) * 256 + h * 64 + j] = o;
        }
        if (!lat) {
            float* so = p.out + O_ST + ((((size_t)b * DEPTH + l) * 2 + dir) * 4 + h) * 4096;
#pragma unroll
            for (int d = 0; d < 64; ++d) so[d * 64 + j] = S[d];
        }
    }
}

DEV void nv_hgrn_fin(const P& p, int l, long gtid, long gsz) {
    const bf16_t* cols = WSP(bf16_t, WS_COLS);
    const float* oh = WSP(float, WS_OH);
    const float* g = p.in[I_HGG] + (size_t)l * 64;
    for (long it = gtid; it < (long)NTOK * 4; it += gsz) {
        const int h = (int)(it % 4); const int r = (int)(it / 4);
        const float* of = oh + (size_t)r * 256 + h * 64; const float* ob = oh + ((size_t)NTOK + r) * 256 + h * 64;
        float ss = 0.f;
        for (int d = 0; d < 64; ++d) { float v = of[d] + ob[d]; ss += v * v; }
        float rstd = 1.f / sqrtf(ss / 64.f + 1e-6f);
        const bf16_t* c = cols + (size_t)r * NC;
        bf16_t* y = WSP(bf16_t, WS_Y) + (size_t)r * DM + 256 + h * 64;
        for (int d = 0; d < 64; ++d) {
            float v = (of[d] + ob[d]) * rstd * g[d] * sigm(bf2f(c[C_HGOG + h * 64 + d]));
            y[d] = f2bf(v * siluf(bf2f(c[C_HGZ + h * 64 + d])));
        }
    }
}

DEV void nv_merge(const P& p, int l, long gtid, long gsz) {
    const bf16_t* cols = WSP(bf16_t, WS_COLS);
    const bf16_t* Y = WSP(bf16_t, WS_Y);
    const bf16_t* wt = WSP(bf16_t, WS_WTBR) + (size_t)l * 4 * DM * 256;
    bf16_t* mrg = WSP(bf16_t, WS_MRG);
    for (long it = gtid; it < (long)NTOK * DM; it += gsz) {
        const int d = (int)(it % DM); const int r = (int)(it / DM);
        float tot = 0.f;
        for (int b = 0; b < 4; ++b) {
            const bf16_t* y = Y + (size_t)r * DM + b * 256; const bf16_t* w = wt + ((size_t)b * DM + d) * 256;
            float acc = 0.f;
            for (int k = 0; k < 256; k += 8) {
                float a[8], ww[8]; unpack8(y + k, a); unpack8(w + k, ww);
#pragma unroll
                for (int e = 0; e < 8; ++e) acc += a[e] * ww[e];
            }
            tot += sigm(bf2f(cols[(size_t)r * NC + C_MG + b * DM + d])) * acc;
        }
        mrg[it] = f2bf(tot);
    }
}

DEV void nv_out(const P& p, int l, long gtid, long gsz) {
    float* X = WSP(float, WS_X);
    const float* modv = WSP(float, WS_MODV);
    const P pp = p;
    nv_gemm(WSP(bf16_t, WS_MRG), DM, WSP(bf16_t, WS_WTOUT) + (size_t)l * DM * DM, DM, NTOK, DM, DM, gtid, gsz,
        [=](int r, int n, float v) {
            const float gate = modv[((size_t)l * NCB + row_cb(r)) * 3072 + 2048 + n];
            X[(size_t)r * DM + n] = x_row(pp, l, r)[n] + gate * v;
        });
}

DEV void nv_final(const P& p, long gtid, long gsz) {
    const float* X = WSP(float, WS_X); const float* g = p.in[I_FG];
    for (long r = gtid; r < NTOK; r += gsz) {
        const float* x = X + (size_t)r * DM;
        float ss = 0.f;
        for (int k = 0; k < DM; ++k) ss += x[k] * x[k];
        float rstd = 1.f / sqrtf(ss / DM + 1e-6f);
        for (int k = 0; k < DM; ++k) p.out[O_Y + (size_t)r * DM + k] = x[k] * rstd * g[k];
    }
}

constexpr int ST_PREP_W = 0, ST_PREP_CTX = 1, ST_LAYER0 = 2, ST_PER_LAYER = 8;
constexpr int N_STAGES = ST_LAYER0 + DEPTH * ST_PER_LAYER + 1;
DEV void run_stage(const P& p, int st, long gtid, long gsz) {
    if (st == ST_PREP_W) { nv_prep_w(p, gtid, gsz); return; }
    if (st == ST_PREP_CTX) { nv_prep_ctxmla(p, gtid, gsz); return; }
    if (st == N_STAGES - 1) { nv_final(p, gtid, gsz); return; }
    const int l = (st - ST_LAYER0) / ST_PER_LAYER, s = (st - ST_LAYER0) % ST_PER_LAYER;
    switch (s) {
        case 0: nv_normmod(p, l, gtid, gsz); break;
        case 1: nv_inproj(p, l, gtid, gsz); break;
        case 2: nv_rowprep(p, l, gtid, gsz); break;
        case 3: nv_mlaproj(p, l, gtid, gsz); break;
        case 4: nv_attn(p, l, gtid, gsz); nv_hgrn(p, l, gtid, gsz); break;
        case 5: nv_hgrn_fin(p, l, gtid, gsz); break;
        case 6: nv_merge(p, l, gtid, gsz); break;
        case 7: nv_out(p, l, gtid, gsz); break;
    }
}

#ifndef CPU_EMU
#define LAS __attribute__((address_space(3)))
typedef short bf16x8 __attribute__((ext_vector_type(8)));
typedef float f32x4 __attribute__((ext_vector_type(4)));
typedef unsigned u32x4 __attribute__((ext_vector_type(4)));
typedef unsigned u32x2 __attribute__((ext_vector_type(2)));
typedef float f32x2 __attribute__((ext_vector_type(2)));
constexpr int NTHREADS = 512;
#define PROBE 0
#define PROBE_SCALE_US 1000
constexpr bool PROBE_ON = (PROBE != 0);
constexpr int LDS_BYTES = 147456;

__device__ __forceinline__ unsigned cvt_pk_bf16(float lo, float hi) { unsigned r; asm volatile("v_cvt_pk_bf16_f32 %0, %1, %2" : "=v"(r) : "v"(lo), "v"(hi)); return r; }
__device__ __forceinline__ u32x4 pack8(f32x4 a, f32x4 b) { u32x4 w; w.x = cvt_pk_bf16(a[0], a[1]); w.y = cvt_pk_bf16(a[2], a[3]); w.z = cvt_pk_bf16(b[0], b[1]); w.w = cvt_pk_bf16(b[2], b[3]); return w; }
__device__ __forceinline__ void unpack8v(u32x4 v, f32x4& a, f32x4& b) {
    a[0] = u2f(v.x << 16); a[1] = u2f(v.x & 0xffff0000u); a[2] = u2f(v.y << 16); a[3] = u2f(v.y & 0xffff0000u);
    b[0] = u2f(v.z << 16); b[1] = u2f(v.z & 0xffff0000u); b[2] = u2f(v.w << 16); b[3] = u2f(v.w & 0xffff0000u);
}

namespace pg8 {
constexpr int BM = 256, BK = 64, HALF = 128, HTB = HALF * BK * 2  , STAGE_BYTES = 8 * HTB, NXCD = 8, WGM = 8;
__device__ __forceinline__ int lds_byte(int r, int c) { const int st = (r >> 4) * 2 + (c >> 5), rr = r & 15, cc = c & 31, ob = rr * 64 + cc * 2; return st * 1024 + (ob ^ (((ob >> 9) & 1) << 5)); }
__device__ __forceinline__ void stage_rc(int b, int& R, int& C) { const int st = b / 1024, sb = b % 1024, swz = sb ^ (((sb >> 9) & 1) << 5); R = (st >> 1) * 16 + swz / 64; C = (st & 1) * 32 + (swz % 64) / 2; }
__device__ __forceinline__ int perm32(int rho) { const int n = rho >> 4, i = rho & 15; return 8 * (i >> 2) + 4 * n + (i & 3); }

struct Unit { int pm, pn, aux; const char* A; const char* B; };
struct Gemm { int lda, ldb, K; };

struct GridOrder {
    int nM, nN, nwg, G, c; const char* A; const char* B; size_t astep, bstep;
    __device__ void init(int M, int N, int G_, int c_, const void* A_, int lda, const void* B_, int ldb) { nM = M / BM; nN = N / BM; nwg = nM * nN; G = G_; c = c_; A = (const char*)A_; B = (const char*)B_; astep = (size_t)BM * lda * 2; bstep = (size_t)BM * ldb * 2; }
    __device__ bool next(int i, Unit& u) const {
        const long L = (long)i * G + c; if (L >= nwg) return false;
        int wgid = (int)L; { const int q = nwg / NXCD, r = nwg % NXCD, xcd = wgid % NXCD, off = wgid / NXCD; wgid = (xcd < r ? xcd * (q + 1) : r * (q + 1) + (xcd - r) * q) + off; }
        const int nig = WGM * nN, gid = wgid / nig, fm = gid * WGM, gsz = (nM - fm) < WGM ? (nM - fm) : WGM;
        u.pm = fm + ((wgid % nig) % gsz); u.pn = (wgid % nig) / gsz; u.aux = 0; u.A = A + (size_t)u.pm * astep; u.B = B + (size_t)u.pn * bstep; return true;
    }
};

template <class F> struct EpiF {
    static constexpr int MID = 0;
    F f;
    __device__ __forceinline__ void operator()(const f32x4 (&acc)[2][2][4][2], const Unit& u, int wr, int wc, int fr, int fq) const {
#pragma unroll
        for (int ai = 0; ai < 2; ++ai)
#pragma unroll
            for (int m = 0; m < 4; ++m)
#pragma unroll
                for (int bj = 0; bj < 2; ++bj)
                    f(u, u.pm * BM + ai * HALF + wr * 64 + m * 16 + fr, u.pn * BM + bj * HALF + wc * 32 + 8 * fq, acc[ai][bj][m][0], acc[ai][bj][m][1]);
    }
};

template <class F, class G, int MIDV> struct EpiFM {
    static constexpr int MID = MIDV;
    F f; G g;
    __device__ __forceinline__ void operator()(const f32x4 (&acc)[2][2][4][2], const Unit& u, int wr, int wc, int fr, int fq) const {
#pragma unroll
        for (int ai = 0; ai < 2; ++ai)
#pragma unroll
            for (int m = 0; m < 4; ++m)
#pragma unroll
                for (int bj = 0; bj < 2; ++bj)
                    f(u, u.pm * BM + ai * HALF + wr * 64 + m * 16 + fr, u.pn * BM + bj * HALF + wc * 32 + 8 * fq, acc[ai][bj][m][0], acc[ai][bj][m][1]);
    }
    __device__ __forceinline__ void mid(f32x4 (&acc)[2][2][4][2], const Unit& u, int seg, int wr, int wc, int fr, int fq) const {
#pragma unroll
        for (int ai = 0; ai < 2; ++ai)
#pragma unroll
            for (int m = 0; m < 4; ++m)
#pragma unroll
                for (int bj = 0; bj < 2; ++bj) {
                    int rr = u.pm * BM + ai * HALF + wr * 64 + m * 16 + fr; asm volatile("" : "+v"(rr));
                    g(u, seg, rr, u.pn * BM + bj * HALF + wc * 32 + 8 * fq, acc[ai][bj][m][0], acc[ai][bj][m][1]);
                    __builtin_amdgcn_sched_barrier(0);
                }
    }
};

template <class Epi, class Sched>
__device__ __forceinline__ void gemm_phase(LAS unsigned char* lds, const Gemm g, const Sched& S, const Epi& E) {
    int tid_ = threadIdx.x; asm volatile("" : "+v"(tid_));
    const int tid = tid_, wid = __builtin_amdgcn_readfirstlane(tid >> 6), lane = tid & 63, wr = wid >> 2, wc = wid & 3, fr = lane & 15, fq = lane >> 4;
    const int K = g.K, nt = K / BK;
    unsigned voffA[2], voffB[2];
#pragma unroll
    for (int i = 0; i < 2; ++i) { int R, C; stage_rc(tid * 16 + i * 8192, R, C); const int Rb = (R & ~31) + perm32(R & 31);
        voffA[i] = (unsigned)(R * g.lda + C) * 2u; voffB[i] = (unsigned)(Rb * g.ldb + C) * 2u; }
    const size_t kstep = (size_t)(BK * 2);
    const size_t hstepA = (size_t)HALF * g.lda * 2, hstepB = (size_t)HALF * g.ldb * 2;
    const unsigned ldsw = (unsigned)wid * 1024u;
    const int aoff = lds_byte(wr * 64 + fr, fq * 8), boff = lds_byte(wc * 32 + fr, fq * 8);
#define PG8_SA(b, h) (((b) * 2 + (h)) * HTB)
#define PG8_SB(b, h) ((4 + (b) * 2 + (h)) * HTB)
#define PG8_STAGE(bufoff, gbase, voff) do { _Pragma("unroll") for (int _i = 0; _i < 2; ++_i) \
        __builtin_amdgcn_global_load_lds((const unsigned*)((const char*)(gbase) + (voff)[_i]), (LAS unsigned*)(lds + (bufoff) + ldsw + _i * 8192), 16, 0, 0); } while (0)
#define PG8_LDA(dst, b, h) do { _Pragma("unroll") for (int m = 0; m < 4; ++m) _Pragma("unroll") for (int k = 0; k < 2; ++k) dst[m][k] = *(const LAS bf16x8*)(lds + PG8_SA(b, h) + aoff + m * 2048 + k * 1024); } while (0)
#define PG8_LDB(dst, b, h) do { _Pragma("unroll") for (int n = 0; n < 2; ++n) _Pragma("unroll") for (int k = 0; k < 2; ++k) dst[n][k] = *(const LAS bf16x8*)(lds + PG8_SB(b, h) + boff + n * 2048 + k * 1024); } while (0)
#define PG8_MMA(ai, bj, At, Bt) do { __builtin_amdgcn_s_setprio(1); _Pragma("unroll") for (int m = 0; m < 4; ++m) _Pragma("unroll") for (int n = 0; n < 2; ++n) _Pragma("unroll") for (int k = 0; k < 2; ++k) \
        acc[ai][bj][m][n] = __builtin_amdgcn_mfma_f32_16x16x32_bf16(Bt[n][k], At[m][k], acc[ai][bj][m][n], 0, 0, 0); __builtin_amdgcn_s_setprio(0); } while (0)
#define PG8_WAIT_V(n) asm volatile("s_waitcnt vmcnt(" #n ")" ::: "memory")
#define PG8_WAIT_L(n) asm volatile("s_waitcnt lgkmcnt(" #n ")" ::: "memory")
#define PG8_BAR __builtin_amdgcn_s_barrier()
#define PG8_SCHED __builtin_amdgcn_sched_barrier(0)
    Unit cur, nxt; int ui = 0;
    if (!S.next(0, cur)) return;
    f32x4 acc[2][2][4][2];
#pragma unroll
    for (int a = 0; a < 2; ++a)
#pragma unroll
        for (int b = 0; b < 2; ++b)
#pragma unroll
            for (int m = 0; m < 4; ++m)
#pragma unroll
                for (int n = 0; n < 2; ++n) acc[a][b][m][n] = (f32x4){0.f, 0.f, 0.f, 0.f};
    bf16x8 At[4][2], B0[2][2], B1[2][2];
    const char* cA = cur.A; const char* cB = cur.B;
    PG8_STAGE(PG8_SB(0, 0), cB, voffB); PG8_STAGE(PG8_SB(0, 1), cB + hstepB, voffB); PG8_STAGE(PG8_SA(0, 0), cA, voffA); PG8_STAGE(PG8_SA(0, 1), cA + hstepA, voffA);
    if (wr == 1) PG8_BAR;
    PG8_WAIT_V(2); PG8_BAR;
    PG8_STAGE(PG8_SB(1, 0), cB + kstep, voffB); PG8_STAGE(PG8_SA(1, 0), cA + kstep, voffA); PG8_STAGE(PG8_SB(1, 1), cB + hstepB + kstep, voffB);
    PG8_WAIT_V(6); PG8_BAR;
    for (;;) {
        const bool has_next = S.next(ui + 1, nxt);
        const char* nA = has_next ? nxt.A : cA; const char* nB = has_next ? nxt.B : cB;
#pragma nounroll
        for (int t = 0; t < nt; t += 2) {
            const bool last = (t == nt - 2);
            const char* a1 = cA + (size_t)(t + 1) * kstep;
            const char* a2 = last ? nA : cA + (size_t)(t + 2) * kstep; const char* b2 = last ? nB : cB + (size_t)(t + 2) * kstep;
            const char* a3 = a2 + kstep; const char* b3 = b2 + kstep;
            PG8_LDB(B0, 0, 0); PG8_LDB(B1, 0, 1); PG8_SCHED; PG8_LDA(At, 0, 0); PG8_STAGE(PG8_SA(1, 1), a1 + hstepA, voffA);
            PG8_WAIT_V(8); PG8_WAIT_L(0); PG8_BAR; PG8_MMA(0, 0, At, B0); PG8_MMA(0, 1, At, B1); PG8_BAR; PG8_SCHED;
            PG8_LDA(At, 0, 1); PG8_STAGE(PG8_SB(0, 0), b2, voffB); PG8_STAGE(PG8_SB(0, 1), b2 + hstepB, voffB); PG8_STAGE(PG8_SA(0, 0), a2, voffA);
            PG8_WAIT_V(8); PG8_WAIT_L(0); PG8_BAR; PG8_MMA(1, 0, At, B0); PG8_MMA(1, 1, At, B1); PG8_BAR; PG8_SCHED;
            PG8_LDB(B0, 1, 0); PG8_LDB(B1, 1, 1); PG8_SCHED; PG8_LDA(At, 1, 0); PG8_STAGE(PG8_SA(0, 1), a2 + hstepA, voffA);
            PG8_WAIT_V(8); PG8_WAIT_L(0); PG8_BAR; PG8_MMA(0, 0, At, B0); PG8_MMA(0, 1, At, B1); PG8_BAR; PG8_SCHED;
            PG8_LDA(At, 1, 1); PG8_STAGE(PG8_SB(1, 0), b3, voffB); PG8_STAGE(PG8_SB(1, 1), b3 + hstepB, voffB); PG8_STAGE(PG8_SA(1, 0), a3, voffA);
            PG8_WAIT_V(8); PG8_WAIT_L(0); PG8_BAR; PG8_MMA(1, 0, At, B0); PG8_MMA(1, 1, At, B1); PG8_BAR; PG8_SCHED;
            if constexpr (Epi::MID > 0) { if (!last && ((t + 2) % Epi::MID) == 0) { E.mid(acc, cur, (t + 2) / Epi::MID - 1, wr, wc, fr, fq); PG8_SCHED; } }
        }
        if (wr == 0) PG8_BAR;
        E(acc, cur, wr, wc, fr, fq);
        if (!has_next) break;
#pragma unroll
        for (int a = 0; a < 2; ++a)
#pragma unroll
            for (int b = 0; b < 2; ++b)
#pragma unroll
                for (int m = 0; m < 4; ++m)
#pragma unroll
                    for (int n = 0; n < 2; ++n) acc[a][b][m][n] = (f32x4){0.f, 0.f, 0.f, 0.f};
        cur = nxt; cA = nA; cB = nB; ++ui;
        if (wr == 1) PG8_BAR;
    }
    PG8_WAIT_V(0);
    PG8_BAR;
#undef PG8_SA
#undef PG8_SB
#undef PG8_STAGE
#undef PG8_LDA
#undef PG8_LDB
#undef PG8_MMA
#undef PG8_WAIT_V
#undef PG8_WAIT_L
#undef PG8_BAR
#undef PG8_SCHED
}
}

template <class F> __device__ __forceinline__ pg8::EpiF<F> make_epi(F f) { return pg8::EpiF<F>{f}; }

__device__ __forceinline__ void fs_inproj(const P& p, int l, LAS unsigned char* lds) {
    bf16_t* cols = WSP(bf16_t, WS_COLS); float* out = p.out;
    pg8::GridOrder S; S.init(NTOK, NC, gridDim.x, blockIdx.x, WSP(bf16_t, WS_H), DM, WSP(bf16_t, WS_WTIN) + (size_t)l * NC * DM, DM);
    auto E = make_epi([=](const pg8::Unit& u, int r, int n, f32x4 v0, f32x4 v1) {
        if (n >= C_MG) {
#pragma unroll
            for (int e = 0; e < 4; ++e) { v0[e] = 1.f / (1.f + __expf(-v0[e])); v1[e] = 1.f / (1.f + __expf(-v1[e])); }
        }
        *(u32x4*)(cols + (size_t)r * NC + n) = pack8(v0, v1);
        if (r < NCTX) {
            const int b = r / SEQ, t = r % SEQ; const size_t bl = ((size_t)b * DEPTH + l) * SEQ + t;
            float* o = nullptr;
            if (n >= C_NAK && n < C_NAK + 256) o = out + O_NAK + bl * 256 + (n - C_NAK);
            else if (n >= C_NAV && n < C_NAV + 256) o = out + O_NAV + bl * 256 + (n - C_NAV);
            else if (n >= C_WK && n < C_WK + 128) o = out + O_WK + bl * 128 + (n - C_WK);
            else if (n >= C_WV && n < C_WV + 128) o = out + O_WV + bl * 128 + (n - C_WV);
            if (o) { *(f32x4*)o = v0; *(f32x4*)(o + 4) = v1; }
        }
    });
    pg8::gemm_phase(lds, pg8::Gemm{DM, DM, DM}, S, E);
}

struct SubOrder {
    int nM, nN, c, c0, nwgs; const char* A; const char* B; size_t astep, bstep;
    __device__ bool next(int i, pg8::Unit& u) const {
        const int cc = c - c0; if (cc < 0 || cc >= nwgs) return false;
        const int L = i * nwgs + cc; if (L >= nM * nN) return false;
        u.pm = L / nN; u.pn = L % nN; u.aux = 0; u.A = A + (size_t)u.pm * astep; u.B = B + (size_t)u.pn * bstep; return true;
    }
};
__device__ __forceinline__ void fs_mlaproj(const P& p, int l, LAS unsigned char* lds) {
    bf16_t* qm = WSP(bf16_t, WS_QMLA); bf16_t* km = WSP(bf16_t, WS_KMLA); bf16_t* vm = WSP(bf16_t, WS_VMLA);
    const int G = gridDim.x, half = G / 2;
    const bool isq = (int)blockIdx.x < half;
    const int K = isq ? 256 : 128;
    SubOrder S{NTOK / 256, 2, (int)blockIdx.x, isq ? 0 : half, isq ? half : G - half,
               isq ? (const char*)WSP(bf16_t, WS_QN) : (const char*)WSP(bf16_t, WS_CKVB),
               isq ? (const char*)(WSP(bf16_t, WS_WTQB) + (size_t)l * 512 * 256) : (const char*)(WSP(bf16_t, WS_WTKVB) + (size_t)l * 512 * 128),
               (size_t)256 * K * 2, (size_t)256 * K * 2};
    auto E = make_epi([=](const pg8::Unit& u, int r, int n, f32x4 v0, f32x4 v1) {
        const u32x4 w = pack8(v0, v1);
        if (isq) { if (n < 384) *(u32x4*)(qm + (size_t)r * 384 + n) = w; }
        else {
            const int h = n >> 7, e = n & 127;
            if (e < 64) *(u32x4*)(km + (size_t)r * 384 + h * 96 + e) = w; else *(u32x4*)(vm + (size_t)r * 256 + h * 64 + (e - 64)) = w;
        }
    });
    pg8::gemm_phase(lds, pg8::Gemm{K, K, K}, S, E);
}

struct MergeEpi {
    static constexpr int MID = 4;
    const bf16_t* cols; bf16_t* mrg;
    __device__ __forceinline__ void operator()(const f32x4 (&acc)[2][2][4][2], const pg8::Unit& u, int wr, int wc, int fr, int fq) const {
#pragma unroll
        for (int ai = 0; ai < 2; ++ai)
#pragma unroll
            for (int m = 0; m < 4; ++m)
#pragma unroll
                for (int bj = 0; bj < 2; ++bj) {
                    const int r = u.pm * 256 + ai * 128 + wr * 64 + m * 16 + fr, n = u.pn * 256 + bj * 128 + wc * 32 + 8 * fq;
                    f32x4 g0, g1; unpack8v(*(const u32x4*)(cols + (size_t)r * NC + C_MG + 3 * DM + n), g0, g1);
                    f32x4 v0 = acc[ai][bj][m][0], v1 = acc[ai][bj][m][1];
#pragma unroll
                    for (int e = 0; e < 4; ++e) { v0[e] *= fmaxf(g0[e], 1e-20f); v1[e] *= fmaxf(g1[e], 1e-20f); }
                    *(u32x4*)(mrg + (size_t)r * DM + n) = pack8(v0, v1);
                }
    }
    __device__ __forceinline__ void mid(f32x4 (&acc)[2][2][4][2], const pg8::Unit& u, int seg, int wr, int wc, int fr, int fq) const {
        int rb = u.pm * 256 + wr * 64 + fr; asm volatile("" : "+v"(rb));
        const bf16_t* base = cols + (size_t)rb * NC + C_MG + seg * DM + u.pn * 256 + wc * 32 + 8 * fq;
#pragma unroll
        for (int ai = 0; ai < 2; ++ai) {
            u32x4 ga[8], gb[8];
#pragma unroll
            for (int m = 0; m < 4; ++m)
#pragma unroll
                for (int bj = 0; bj < 2; ++bj) {
                    const bf16_t* gp = base + (size_t)(ai * 128 + m * 16) * NC + bj * 128;
                    ga[m * 2 + bj] = *(const u32x4*)gp; gb[m * 2 + bj] = *(const u32x4*)(gp + DM);
                }
            __builtin_amdgcn_sched_barrier(0);
#pragma unroll
            for (int m = 0; m < 4; ++m)
#pragma unroll
                for (int bj = 0; bj < 2; ++bj) {
                    f32x4 a0, a1, b0, b1; unpack8v(ga[m * 2 + bj], a0, a1); unpack8v(gb[m * 2 + bj], b0, b1);
#pragma unroll
                    for (int e = 0; e < 4; ++e) {
                        acc[ai][bj][m][0][e] *= fmaxf(a0[e], 1e-20f) * __builtin_amdgcn_rcpf(fmaxf(b0[e], 1e-20f));
                        acc[ai][bj][m][1][e] *= fmaxf(a1[e], 1e-20f) * __builtin_amdgcn_rcpf(fmaxf(b1[e], 1e-20f));
                    }
                }
            __builtin_amdgcn_sched_barrier(0);
        }
    }
};
__device__ __forceinline__ void fs_merge(const P& p, int l, LAS unsigned char* lds) {
    SubOrder S{NTOK / 256, 4, (int)blockIdx.x, 0, (int)gridDim.x, (const char*)WSP(bf16_t, WS_Y), (const char*)(WSP(bf16_t, WS_WTBR) + (size_t)l * DM * DM), (size_t)256 * DM * 2, (size_t)256 * DM * 2};
    MergeEpi E{WSP(bf16_t, WS_COLS), WSP(bf16_t, WS_MRG)};
    pg8::gemm_phase(lds, pg8::Gemm{DM, DM, DM}, S, E);
}

__device__ __forceinline__ void fs_out(const P& p, int l, LAS unsigned char* lds) {
    float* X = WSP(float, WS_X); const float* modv = WSP(float, WS_MODV);
    const float* xp = p.in[I_XP]; const float* xs = p.in[I_XS];
    SubOrder S{NTOK / 256, 4, (int)blockIdx.x, 0, (int)gridDim.x, (const char*)WSP(bf16_t, WS_MRG), (const char*)(WSP(bf16_t, WS_WTOUT) + (size_t)l * DM * DM), (size_t)256 * DM * 2, (size_t)256 * DM * 2};
    auto E = make_epi([=](const pg8::Unit& u, int r, int n, f32x4 v0, f32x4 v1) {
        const float* gate = modv + ((size_t)l * NCB + row_cb(r)) * 3072 + 2048 + n;
        const float* xr = l == 0 ? (r < NCTX ? xp + (size_t)r * DM : xs + (size_t)(r - NCTX) * DM) : X + (size_t)r * DM;
        const f32x4 x0 = *(const f32x4*)(xr + n), x1 = *(const f32x4*)(xr + n + 4);
        const f32x4 g0 = *(const f32x4*)gate, g1 = *(const f32x4*)(gate + 4);
        *(f32x4*)(X + (size_t)r * DM + n) = x0 + g0 * v0; *(f32x4*)(X + (size_t)r * DM + n + 4) = x1 + g1 * v1;
    });
    pg8::gemm_phase(lds, pg8::Gemm{DM, DM, DM}, S, E);
}

__device__ __forceinline__ int otid() { int t = threadIdx.x; asm volatile("" : "+v"(t)); return t; }
constexpr int HG_LD = 72;
constexpr int HG_MAT = 64 * HG_LD * 2;
constexpr int HG_RAW = 64 * 64 * 2;
__device__ __forceinline__ void hg_dma_tile(const bf16_t* src, int pitch, LAS unsigned char* dst, int tid) {
    const int lane = tid & 63, w = __builtin_amdgcn_readfirstlane(tid >> 6);
    __builtin_amdgcn_global_load_lds((const unsigned*)(src + (size_t)(8 * w + (lane >> 3)) * pitch + 8 * (lane & 7)), (LAS unsigned*)(dst + w * 1024), 16, 0, 0);
}
struct HgPrep { float k[16], b[16]; float btot, ref1; };
__device__ __forceinline__ void hg_prep(const P& p, int tid, int l, int h, const LAS unsigned char* fzt, LAS float* seg  , HgPrep& o) {
    const int dir = tid >> 8, tq = (tid >> 6) & 3, d = tid & 63;
    const float lbv = WSP(float, WS_LBS)[((size_t)l * 2 + dir) * 256 + h * 64 + d];
    float g[16];
#pragma unroll
    for (int i = 0; i < 16; ++i) {
        const float fz = bf2f(*(const LAS bf16_t*)(fzt + ((16 * tq + i) * 64 + d) * 2));
        const float e = __expf(-fz), inv = 1.f / (1.f + e);
        const float f = fmaxf(lbv + (1.f - lbv) * inv, 1e-30f);
        o.k[i] = (1.f - lbv) * e * inv;
        g[i] = __logf(f);
    }
    float run = 0.f;
    if (dir == 0) {
#pragma unroll
        for (int i = 0; i < 16; ++i) { run += g[i]; o.b[i] = run; }
    } else {
#pragma unroll
        for (int i = 15; i >= 0; --i) { run += g[i]; o.b[i] = run; }
    }
    seg[(dir * 4 + tq) * 64 + d] = run;
    __syncthreads();
    const float s0 = seg[(dir * 4 + 0) * 64 + d], s1 = seg[(dir * 4 + 1) * 64 + d], s2 = seg[(dir * 4 + 2) * 64 + d], s3 = seg[(dir * 4 + 3) * 64 + d];
    float off;
    if (dir == 0) off = tq == 0 ? 0.f : (tq == 1 ? s0 : (tq == 2 ? s0 + s1 : s0 + s1 + s2));
    else off = tq == 3 ? 0.f : (tq == 2 ? s3 : (tq == 1 ? s3 + s2 : s3 + s2 + s1));
#pragma unroll
    for (int i = 0; i < 16; ++i) o.b[i] += off;
    o.btot = (s0 + s1) + (s2 + s3);
    o.ref1 = dir == 0 ? s0 + s1 : s2 + s3;
}
__device__ __forceinline__ void hg_build_vt(const LAS unsigned char* vraw, LAS unsigned char* vt, int tid) {
    const int j = tid & 63, sg = tid >> 6;
    unsigned w[4];
#pragma unroll
    for (int i = 0; i < 4; ++i) w[i] = (unsigned)*(const LAS bf16_t*)(vraw + ((8 * sg + 2 * i) * 64 + j) * 2) | ((unsigned)*(const LAS bf16_t*)(vraw + ((8 * sg + 2 * i + 1) * 64 + j) * 2) << 16);
    *(LAS u32x4*)(vt + (j * HG_LD + 8 * sg) * 2) = (u32x4){w[0], w[1], w[2], w[3]};
}
__device__ __forceinline__ void hg_mma_strip(f32x4 (&acc)[4], const LAS unsigned char* A, int arow0, const LAS unsigned char* Bt, int lane) {
    const int fr = lane & 15, fq = lane >> 4;
#pragma unroll
    for (int ks = 0; ks < 2; ++ks) {
        const bf16x8 a = *(const LAS bf16x8*)(A + ((arow0 + fr) * HG_LD + 32 * ks + 8 * fq) * 2);
#pragma unroll
        for (int n = 0; n < 4; ++n) {
            const bf16x8 b = *(const LAS bf16x8*)(Bt + ((16 * n + fr) * HG_LD + 32 * ks + 8 * fq) * 2);
            acc[n] = __builtin_amdgcn_mfma_f32_16x16x32_bf16(a, b, acc[n], 0, 0, 0);
        }
    }
}

__device__ __forceinline__ void fs_hgrn_a(const P& p, int l, LAS unsigned char* lds) {
    LAS unsigned char* raw = lds;
    LAS float* seg = (LAS float*)(lds + 3 * HG_RAW);
    LAS unsigned char* kt = lds + 3 * HG_RAW + 2048;
    LAS unsigned char* vt = kt + 2 * HG_MAT;
    const int tid = otid(), lane = tid & 63, wave = tid >> 6, dir = tid >> 8, tq = (tid >> 6) & 3, d = tid & 63;
    const bf16_t* cols = WSP(bf16_t, WS_COLS);
    for (int u = blockIdx.x; u < (NTOK / 64) * 4; u += gridDim.x) {
        const int gc = u >> 2, h = u & 3, r0 = gc * 64;
        const bf16_t* cr = cols + (size_t)r0 * NC + h * 64;
        hg_dma_tile(cr + C_HGFF, NC, raw, tid); hg_dma_tile(cr + C_HGFB, NC, raw + HG_RAW, tid); hg_dma_tile(cr + C_HGI, NC, raw + 2 * HG_RAW, tid);
        asm volatile("s_waitcnt vmcnt(0)" ::: "memory");
        __syncthreads();
        HgPrep hp; hg_prep(p, tid, l, h, raw + dir * HG_RAW, seg, hp);
        unsigned w[8];
#pragma unroll
        for (int i = 0; i < 8; ++i) w[i] = cvt_pk_bf16(hp.k[2 * i] * __expf(hp.btot - hp.b[2 * i]), hp.k[2 * i + 1] * __expf(hp.btot - hp.b[2 * i + 1]));
        LAS unsigned char* kd = kt + dir * HG_MAT + (d * HG_LD + 16 * tq) * 2;
        *(LAS u32x4*)kd = (u32x4){w[0], w[1], w[2], w[3]}; *(LAS u32x4*)(kd + 16) = (u32x4){w[4], w[5], w[6], w[7]};
        hg_build_vt(raw + 2 * HG_RAW, vt, tid);
        if (tq == 0) WSP(float, WS_HD)[((size_t)u * 2 + dir) * 64 + d] = __expf(hp.btot);
        __syncthreads();
        f32x4 acc[4];
#pragma unroll
        for (int n = 0; n < 4; ++n) acc[n] = (f32x4){0.f, 0.f, 0.f, 0.f};
        const int w4 = wave & 3;
        hg_mma_strip(acc, kt + dir * HG_MAT, 16 * w4, vt, lane);
        float* L = WSP(float, WS_HL) + ((size_t)u * 2 + dir) * 4096;
#pragma unroll
        for (int n = 0; n < 4; ++n)
#pragma unroll
            for (int e = 0; e < 4; ++e) L[(16 * w4 + 4 * (lane >> 4) + e) * 64 + 16 * n + (lane & 15)] = acc[n][e];
        __syncthreads();
    }
}

template <int NCH>
__device__ __forceinline__ float hgrn_b_item(float* HL, const float* HD, int gc0, int h, int dir, int e, float s) {
    float Lv[NCH], Dv[NCH];
#pragma unroll
    for (int cc = 0; cc < NCH; ++cc) {
        const int c = dir == 0 ? cc : NCH - 1 - cc;
        const size_t ui = ((size_t)(gc0 + c) * 4 + h) * 2 + dir;
        Lv[cc] = HL[ui * 4096 + e]; Dv[cc] = HD[ui * 64 + (e >> 6)];
    }
#pragma unroll
    for (int cc = 0; cc < NCH; ++cc) {
        const int c = dir == 0 ? cc : NCH - 1 - cc;
        const size_t ui = ((size_t)(gc0 + c) * 4 + h) * 2 + dir;
        HL[ui * 4096 + e] = s;
        s = Dv[cc] * s + Lv[cc];
    }
    return s;
}
__device__ __forceinline__ void fs_hgrn_b(const P& p, int l, long gtid, long gsz) {
    float* HL = WSP(float, WS_HL); const float* HD = WSP(float, WS_HD);
    for (long it = gtid; it < (long)DB * 4 * 2 * 4096; it += gsz) {
        const int e = (int)(it & 4095), dir = (int)((it >> 12) & 1), h = (int)((it >> 13) & 3), b = (int)(it >> 15);
        const float s0 = p.in[I_ST][((((size_t)b * DEPTH + l) * 2 + dir) * 4 + h) * 4096 + e];
        (void)hgrn_b_item<DSEQ / 64>(HL, HD, (NCTX + b * DSEQ) / 64, h, dir, e, s0);
    }
    for (long it = gtid; it < (long)BATCH * 4 * 2 * 4096; it += gsz) {
        const int e = (int)(it & 4095), dir = (int)((it >> 12) & 1), h = (int)((it >> 13) & 3), b = (int)(it >> 15);
        const float s = hgrn_b_item<SEQ / 64>(HL, HD, (b * SEQ) / 64, h, dir, e, 0.f);
        p.out[O_ST + ((((size_t)b * DEPTH + l) * 2 + dir) * 4 + h) * 4096 + e] = s;
    }
}

__device__ __forceinline__ void fs_hgrn_c(const P& p, int l, LAS unsigned char* lds) {
    LAS unsigned char* raw = lds;
    LAS float* seg = (LAS float*)(lds + 6 * HG_RAW);
    LAS unsigned char* img = lds + 6 * HG_RAW + 2048;
    LAS unsigned char* vt = img + 6 * HG_MAT;
    LAS float* Ob = (LAS float*)raw;
    LAS unsigned char* otile = raw + 2 * HG_RAW;
    const int tid = otid(), lane = tid & 63, wave = tid >> 6, dir = tid >> 8, tq = (tid >> 6) & 3, d = tid & 63, w4 = wave & 3;
    LAS unsigned char* mQ = img + (dir * 3 + 0) * HG_MAT; LAS unsigned char* mK = img + (dir * 3 + 1) * HG_MAT; LAS unsigned char* mS = img + (dir * 3 + 2) * HG_MAT;
    const bf16_t* cols = WSP(bf16_t, WS_COLS);
    for (int u = blockIdx.x; u < (NTOK / 64) * 4; u += gridDim.x) {
        const int gc = u >> 2, h = u & 3, r0 = gc * 64;
        const bf16_t* cr = cols + (size_t)r0 * NC + h * 64;
        hg_dma_tile(cr + C_HGFF, NC, raw, tid); hg_dma_tile(cr + C_HGFB, NC, raw + HG_RAW, tid); hg_dma_tile(cr + C_HGQ, NC, raw + 2 * HG_RAW, tid);
        hg_dma_tile(cr + C_HGI, NC, raw + 3 * HG_RAW, tid); hg_dma_tile(cr + C_HGOG, NC, raw + 4 * HG_RAW, tid); hg_dma_tile(cr + C_HGZ, NC, raw + 5 * HG_RAW, tid);
        f32x4 sreg[4];
        {
            const float* S = WSP(float, WS_HL) + ((size_t)u * 2 + dir) * 4096;
            const int j4 = tid & 15, dd = (tid >> 4) & 15;
#pragma unroll
            for (int i = 0; i < 4; ++i) sreg[i] = *(const f32x4*)(S + (dd + 16 * i) * 64 + 4 * j4);
        }
        asm volatile("s_waitcnt vmcnt(0)" ::: "memory");
        __syncthreads();
        HgPrep hp; hg_prep(p, tid, l, h, raw + dir * HG_RAW, seg, hp);
        {
#pragma unroll
            for (int i = 0; i < 16; ++i) {
                const float qv = bf2f(*(const LAS bf16_t*)(raw + 2 * HG_RAW + ((16 * tq + i) * 64 + d) * 2));
                const float q = qv / (1.f + __expf(-qv));
                const float bb = hp.b[i] - hp.ref1;
                const int o = ((16 * tq + i) * HG_LD + d) * 2;
                *(LAS bf16_t*)(mQ + o) = f2bf(q * __expf(bb));
                *(LAS bf16_t*)(mK + o) = f2bf(hp.k[i] * __expf(-bb));
            }
        }
        hg_build_vt(raw + 3 * HG_RAW, vt, tid);
        {
            const int j4 = tid & 15, dd0 = (tid >> 4) & 15;
#pragma unroll
            for (int i = 0; i < 4; ++i) {
                const int dd = dd0 + 16 * i;
                const float r1 = dir == 0 ? seg[(0 * 4 + 0) * 64 + dd] + seg[(0 * 4 + 1) * 64 + dd] : seg[(1 * 4 + 2) * 64 + dd] + seg[(1 * 4 + 3) * 64 + dd];
                const float sc = __expf(r1);
#pragma unroll
                for (int e = 0; e < 4; ++e) *(LAS bf16_t*)(mS + ((4 * j4 + e) * HG_LD + dd) * 2) = f2bf(sreg[i][e] * sc);
            }
        }
        __syncthreads();
        f32x4 att[4], o[4];
#pragma unroll
        for (int n = 0; n < 4; ++n) { att[n] = (f32x4){0.f, 0.f, 0.f, 0.f}; o[n] = (f32x4){0.f, 0.f, 0.f, 0.f}; }
        hg_mma_strip(att, mQ, 16 * w4, mK, lane);
        hg_mma_strip(o, mQ, 16 * w4, mS, lane);
        __syncthreads();
#pragma unroll
        for (int n = 0; n < 4; ++n)
#pragma unroll
            for (int e = 0; e < 4; ++e) {
                const int t = 16 * w4 + 4 * (lane >> 4) + e, s_ = 16 * n + (lane & 15);
                const bool keep = dir == 0 ? (s_ <= t) : (s_ >= t);
                *(LAS bf16_t*)(mK + (t * HG_LD + s_) * 2) = keep ? f2bf(att[n][e]) : (bf16_t)0;
            }
        asm volatile("s_waitcnt lgkmcnt(0)" ::: "memory");
        hg_mma_strip(o, mK, 16 * w4, vt, lane);
        if (dir == 1) {
#pragma unroll
            for (int n = 0; n < 4; ++n)
#pragma unroll
                for (int e = 0; e < 4; ++e) Ob[(16 * w4 + 4 * (lane >> 4) + e) * 64 + 16 * n + (lane & 15)] = o[n][e];
        }
        __syncthreads();
        if (dir == 0) {
            const float* gn = p.in[I_HGG] + (size_t)l * 64;
            float ss[4] = {0.f, 0.f, 0.f, 0.f};
#pragma unroll
            for (int n = 0; n < 4; ++n)
#pragma unroll
                for (int e = 0; e < 4; ++e) { o[n][e] += Ob[(16 * w4 + 4 * (lane >> 4) + e) * 64 + 16 * n + (lane & 15)]; ss[e] += o[n][e] * o[n][e]; }
#pragma unroll
            for (int e = 0; e < 4; ++e) {
                float v = ss[e];
                v += __shfl_xor(v, 1); v += __shfl_xor(v, 2); v += __shfl_xor(v, 4); v += __shfl_xor(v, 8);
                ss[e] = 1.f / sqrtf(v * (1.f / 64.f) + 1e-6f);
            }
#pragma unroll
            for (int n = 0; n < 4; ++n)
#pragma unroll
                for (int e = 0; e < 4; ++e) {
                    const int t = 16 * w4 + 4 * (lane >> 4) + e, j = 16 * n + (lane & 15);
                    const float og = bf2f(*(const LAS bf16_t*)(raw + 4 * HG_RAW + (t * 64 + j) * 2)), z = bf2f(*(const LAS bf16_t*)(raw + 5 * HG_RAW + (t * 64 + j) * 2));
                    const float v = o[n][e] * ss[e] * gn[j] / (1.f + __expf(-og)) * (z / (1.f + __expf(-z)));
                    *(LAS bf16_t*)(otile + (t * 64 + j) * 2) = f2bf(v);
                }
        }
        __syncthreads();
        {
            const int row = tid >> 3, ch = tid & 7;
            *(u32x4*)(WSP(bf16_t, WS_Y) + (size_t)(r0 + row) * DM + 256 + h * 64 + 8 * ch) = *(const LAS u32x4*)(otile + (row * 64 + 8 * ch) * 2);
        }
        __syncthreads();
    }
}

constexpr int AT_KBUF = 64 * (96 + 8) * 2;
constexpr int AT_VBUF = 64 * 72 * 2;
constexpr int AT_STG = 2 * (AT_KBUF + AT_VBUF);
constexpr int AT_OFF_RPB = 2 * AT_STG;
struct AttnSrc { const bf16_t* k; const bf16_t* v; int kp, vp, n; };
struct AttnMask { int type, a, b; };

template <int DQ>
__device__ __forceinline__ void attn_unit(LAS unsigned char* lds, const int tid, const bf16_t* qbase, const int qpitch, const AttnSrc s0, const AttnSrc s1, const AttnMask mk,
                                          const float* rpb, const float sink, const bool has_sink, const float scale, const float* ropeq  ,
                                          const bf16_t* zbase, bf16_t* ybase  ) {
    constexpr int KS = DQ / 32, KP = DQ + 8;
    constexpr float L2E = 1.4426950408889634f;
    const int lane = tid & 63, wave = tid >> 6, c = lane & 15, fq = lane >> 4;
    LAS float* rpbl = (LAS float*)(lds + AT_OFF_RPB);
    if (mk.type == 1) { for (int i = tid; i < 465; i += NTHREADS) rpbl[i] = rpb[i] * L2E; }
    bf16x8 qf[KS];
    {
        const bf16_t* qr = qbase + (size_t)(16 * wave + c) * qpitch + 8 * fq;
#pragma unroll
        for (int ks = 0; ks < KS; ++ks) qf[ks] = *(const bf16x8*)(qr + 32 * ks);
        if (DQ == 96 && ropeq) {
            const u32x4 mine = __builtin_bit_cast(u32x4, qf[KS - 1]);
            u32x4 oth; oth.x = __shfl_xor(mine.x, 32); oth.y = __shfl_xor(mine.y, 32); oth.z = __shfl_xor(mine.z, 32); oth.w = __shfl_xor(mine.w, 32);
            f32x4 m0, m1, o0, o1; unpack8v(mine, m0, m1); unpack8v(oth, o0, o1);
            const float* rr = ropeq + (size_t)(16 * wave + c) * 32 + (8 * (fq & 1)) * 2;
            float r[8];
#pragma unroll
            for (int j = 0; j < 8; ++j) {
                const float cs = rr[2 * j], sn = rr[2 * j + 1];
                const float mv = j < 4 ? m0[j & 3] : m1[j & 3], ov = j < 4 ? o0[j & 3] : o1[j & 3];
                r[j] = fq < 2 ? mv * cs - ov * sn : ov * sn + mv * cs;
            }
            u32x4 w; w.x = cvt_pk_bf16(r[0], r[1]); w.y = cvt_pk_bf16(r[2], r[3]); w.z = cvt_pk_bf16(r[4], r[5]); w.w = cvt_pk_bf16(r[6], r[7]);
            qf[KS - 1] = __builtin_bit_cast(bf16x8, w);
        }
    }
    int qa = 0, qb = 0;
    if (mk.type == 1) { qa = mk.a + (wave >> 2); qb = 16 * (wave & 3) + c; }
    else if (mk.type == 2) { qa = mk.a + 16 * wave + c; }
    int na_rs = qa - 4; na_rs = na_rs < 0 ? 0 : (na_rs > GROWS - 8 ? GROWS - 8 : na_rs);
    int na_cs = qb - 8; na_cs = na_cs < 0 ? 0 : (na_cs > GW - 16 ? GW - 16 : na_cs);
    const float sl2 = scale * L2E;
    float m = has_sink ? sink * L2E : -3.0e38f, lsum = 0.f;
    f32x4 o[4];
#pragma unroll
    for (int n = 0; n < 4; ++n) o[n] = (f32x4){0.f, 0.f, 0.f, 0.f};
    const int nsteps = (s0.n + s1.n) >> 1;
    u32x4 kreg0[1][2], kreg1[1][2], vreg[1][2];
    const int krow0 = DQ == 64 ? (tid >> 3) : tid / 12, kch0 = DQ == 64 ? (tid & 7) : tid % 12;
    const int krow1 = (tid + 512) / 12, kch1 = (tid + 512) % 12;
    const int vkey = tid & 63, vg = tid >> 6;
#define AT_LOAD(rs, step) do { _Pragma("unroll") for (int j_ = 0; j_ < 2; ++j_) { const int tl_ = 2 * (step) + j_; const bool f0_ = tl_ < s0.n; const int bi_ = f0_ ? tl_ : tl_ - s0.n; \
        const bf16_t* kb_ = (f0_ ? s0.k : s1.k) + (size_t)bi_ * 64 * (f0_ ? s0.kp : s1.kp); const int kp_ = f0_ ? s0.kp : s1.kp; \
        const bf16_t* vb_ = (f0_ ? s0.v : s1.v) + (size_t)bi_ * 64 * (f0_ ? s0.vp : s1.vp); const int vp_ = f0_ ? s0.vp : s1.vp; \
        kreg0[rs][j_] = *(const u32x4*)(kb_ + (size_t)krow0 * kp_ + 8 * kch0); \
        if (DQ == 96 && tid < 256) kreg1[rs][j_] = *(const u32x4*)(kb_ + (size_t)krow1 * kp_ + 8 * kch1); \
        vreg[rs][j_] = *(const u32x4*)(vb_ + (size_t)vkey * vp_ + 8 * vg); } } while (0)
#define AT_STORE(rs, buf) do { _Pragma("unroll") for (int j_ = 0; j_ < 2; ++j_) { LAS unsigned char* kd_ = lds + (buf) * AT_STG + j_ * AT_KBUF; LAS unsigned char* vd_ = lds + (buf) * AT_STG + 2 * AT_KBUF + j_ * AT_VBUF; \
        *(LAS u32x4*)(kd_ + (krow0 * KP + 8 * kch0) * 2) = kreg0[rs][j_]; \
        if (DQ == 96 && tid < 256) *(LAS u32x4*)(kd_ + (krow1 * KP + 8 * kch1) * 2) = kreg1[rs][j_]; \
        const unsigned vw_[4] = {vreg[rs][j_].x, vreg[rs][j_].y, vreg[rs][j_].z, vreg[rs][j_].w}; \
        _Pragma("unroll") for (int e_ = 0; e_ < 4; ++e_) { \
            *(LAS bf16_t*)(vd_ + ((8 * vg + 2 * e_) * 72 + vkey) * 2) = (bf16_t)(vw_[e_] & 0xffffu); \
            *(LAS bf16_t*)(vd_ + ((8 * vg + 2 * e_ + 1) * 72 + vkey) * 2) = (bf16_t)(vw_[e_] >> 16); } } } while (0)
#define AT_SCORES() \
        f32x4 acc[4]; \
        bf16x8 kf[4][KS]; \
        _Pragma("unroll") for (int n = 0; n < 4; ++n) \
            _Pragma("unroll") for (int ks = 0; ks < KS; ++ks) kf[n][ks] = *(const LAS bf16x8*)(kl + ((16 * n + c) * KP + 32 * ks + 8 * fq) * 2); \
        _Pragma("unroll") for (int n = 0; n < 4; ++n) { \
            acc[n] = (f32x4){0.f, 0.f, 0.f, 0.f}; \
            _Pragma("unroll") for (int ks = 0; ks < KS; ++ks) acc[n] = __builtin_amdgcn_mfma_f32_16x16x32_bf16(kf[n][ks], qf[ks], acc[n], 0, 0, 0); } \
        const bool msk = tile < s0.n && mk.type != 0; \
        float mloc = -3.0e38f; \
        _Pragma("unroll") for (int n = 0; n < 4; ++n) \
            _Pragma("unroll") for (int e = 0; e < 4; ++e) { \
                float sv = acc[n][e] * sl2; \
                if (msk) { \
                    const int kk = 16 * n + 4 * fq + e; \
                    if (mk.type == 1) { \
                        const int kr = mk.b + tile; \
                        const bool ok = kr >= na_rs && kr < na_rs + 8 && kk >= na_cs && kk < na_cs + 16; \
                        int dr = kr - qa + 7; dr = dr < 0 ? 0 : (dr > 14 ? 14 : dr); \
                        int dc = kk - qb + 15; dc = dc < 0 ? 0 : (dc > 30 ? 30 : dc); \
                        sv = ok ? sv + rpbl[dr * 31 + dc] : -1.0e30f; \
                    } else { \
                        const int dd = mk.b + 64 * tile + kk - qa; \
                        sv = (dd <= 128 && dd >= -128) ? sv : -1.0e30f; } } \
                acc[n][e] = sv; mloc = fmaxf(mloc, sv); }
#define AT_EXP_PV(mref) \
        float ps = 0.f; \
        _Pragma("unroll") for (int n = 0; n < 4; ++n) \
            _Pragma("unroll") for (int e = 0; e < 4; ++e) { const float pv = __builtin_amdgcn_exp2f(acc[n][e] - (mref)); acc[n][e] = pv; ps += pv; } \
        _Pragma("unroll") for (int ks = 0; ks < 2; ++ks) { \
            u32x4 pw; pw.x = cvt_pk_bf16(acc[2 * ks][0], acc[2 * ks][1]); pw.y = cvt_pk_bf16(acc[2 * ks][2], acc[2 * ks][3]); \
            pw.z = cvt_pk_bf16(acc[2 * ks + 1][0], acc[2 * ks + 1][1]); pw.w = cvt_pk_bf16(acc[2 * ks + 1][2], acc[2 * ks + 1][3]); \
            const bf16x8 pf = __builtin_bit_cast(bf16x8, pw); \
            _Pragma("unroll") for (int n = 0; n < 4; ++n) { \
                const LAS unsigned char* vr = vl + ((16 * n + c) * 72 + 32 * ks + 4 * fq) * 2; \
                const u32x2 v0 = *(const LAS u32x2*)vr, v1 = *(const LAS u32x2*)(vr + 32); \
                const u32x4 vw = (u32x4){v0.x, v0.y, v1.x, v1.y}; \
                o[n] = __builtin_amdgcn_mfma_f32_16x16x32_bf16(__builtin_bit_cast(bf16x8, vw), pf, o[n], 0, 0, 0); } }
#define AT_STEP(step, RL, RS) do { \
        const int buf = (step) & 1; \
        if ((step) + 1 < nsteps) AT_LOAD(RL, (step) + 1); \
        _Pragma("unroll") for (int j = 0; j < 2; ++j) { \
        const LAS unsigned char* kl = lds + buf * AT_STG + j * AT_KBUF; const LAS unsigned char* vl = lds + buf * AT_STG + 2 * AT_KBUF + j * AT_VBUF; \
        const int tile = 2 * (step) + j; \
        AT_SCORES() \
        if (tile == 0 || msk) {        \
            mloc = fmaxf(mloc, __shfl_xor(mloc, 16)); mloc = fmaxf(mloc, __shfl_xor(mloc, 32)); \
            const float mn = fmaxf(m, mloc), corr = __builtin_amdgcn_exp2f(m - mn); \
            m = mn; \
            _Pragma("unroll") for (int n = 0; n < 4; ++n) o[n] *= corr; \
            AT_EXP_PV(mn) \
            lsum = lsum * corr + ps; \
        } else { \
            AT_EXP_PV(m) \
            mloc = fmaxf(mloc, __shfl_xor(mloc, 16)); mloc = fmaxf(mloc, __shfl_xor(mloc, 32)); \
            const float mn = fmaxf(m, mloc), corr = __builtin_amdgcn_exp2f(m - mn); \
            m = mn; \
            lsum = (lsum + ps) * corr; \
            _Pragma("unroll") for (int n = 0; n < 4; ++n) o[n] *= corr; \
        } \
        } \
        if ((step) + 1 < nsteps) AT_STORE(RS, buf ^ 1); \
        asm volatile("s_waitcnt lgkmcnt(0)" ::: "memory"); __builtin_amdgcn_s_barrier(); } while (0)
    AT_LOAD(0, 0);
    AT_STORE(0, 0);
    asm volatile("s_waitcnt lgkmcnt(0)" ::: "memory"); __builtin_amdgcn_s_barrier();
    for (int step = 0; step < nsteps; ++step) AT_STEP(step, 0, 0);
#undef AT_STEP
#undef AT_SCORES
#undef AT_EXP_PV
#undef AT_LOAD
#undef AT_STORE
    lsum += __shfl_xor(lsum, 16); lsum += __shfl_xor(lsum, 32);
    if (has_sink) lsum += exp2f(sink * L2E - m);
    const float inv = 1.f / lsum;
    const bf16_t* zr = zbase + (size_t)(16 * wave + c) * NC; bf16_t* yr = ybase + (size_t)(16 * wave + c) * DM;
#pragma unroll
    for (int n = 0; n < 4; ++n) {
        typedef unsigned u32x2 __attribute__((ext_vector_type(2)));
        const u32x2 zz = *(const u32x2*)(zr + 16 * n + 4 * fq);
        const float z0 = u2f(zz.x << 16), z1 = u2f(zz.x & 0xffff0000u), z2 = u2f(zz.y << 16), z3 = u2f(zz.y & 0xffff0000u);
        u32x2 w;
        w.x = cvt_pk_bf16(o[n][0] * inv * (z0 / (1.f + __expf(-z0))), o[n][1] * inv * (z1 / (1.f + __expf(-z1))));
        w.y = cvt_pk_bf16(o[n][2] * inv * (z2 / (1.f + __expf(-z2))), o[n][3] * inv * (z3 / (1.f + __expf(-z3))));
        *(u32x2*)(yr + 16 * n + 4 * fq) = w;
    }
}

__device__ __forceinline__ void fs_attn(const P& p, int l, LAS unsigned char* lds) {
    const int tid = otid();
    constexpr int NL = (NLAT / 128) * 4, NCU = (NCTX / 128) * 4 * 3, NU = 3 * NL + NCU;
    const bf16_t* cols = WSP(bf16_t, WS_COLS);
    bf16_t* Y = WSP(bf16_t, WS_Y);
    for (int u = blockIdx.x; u < NU; u += gridDim.x) {
        if (u < 3 * NL) {
            const int kind = u / NL, v = u % NL;
            int bh, qt;
            if (NL % 64 == 0) { const int x = v & 7, idx = v >> 3, per = NL / 8; const int bhx = (DB * 4) / 8 > 0 ? (DB * 4) / 8 : 1; bh = x * bhx + idx / (per / bhx); qt = idx % (per / bhx); }
            else { bh = v / (DSEQ / 128); qt = v % (DSEQ / 128); }
            const int b = bh >> 2, h = bh & 3;
            const int r0 = NCTX + b * DSEQ + qt * 128, t0 = qt * 128;
            const size_t cb = ((size_t)b * DEPTH + l) * PAST;
            if (kind == 0) {
                AttnSrc s0{WSP(bf16_t, WS_KMLA) + (size_t)(NCTX + b * DSEQ) * 384 + h * 96, WSP(bf16_t, WS_VMLA) + (size_t)(NCTX + b * DSEQ) * 256 + h * 64, 384, 256, DSEQ / 64};
                AttnSrc s1{WSP(bf16_t, WS_KCM) + cb * 384 + h * 96, WSP(bf16_t, WS_VCM) + cb * 256 + h * 64, 384, 256, PAST / 64};
                attn_unit<96>(lds, tid, WSP(bf16_t, WS_QMLA) + (size_t)r0 * 384 + h * 96, 384, s0, s1, AttnMask{0, 0, 0}, nullptr, 0.f, false, 0.10206207261596577f,
                              WSP(float, WS_ROPEM) + (size_t)t0 * 32, cols + (size_t)r0 * NC + C_MZ + h * 64, Y + (size_t)r0 * DM + 512 + h * 64);
            } else if (kind == 1) {
                const int i0 = 2 * qt;
                int rlo = i0 - 4; rlo = rlo < 0 ? 0 : (rlo > GROWS - 8 ? GROWS - 8 : rlo);
                int rhi = i0 + 1 - 4; rhi = (rhi < 0 ? 0 : (rhi > GROWS - 8 ? GROWS - 8 : rhi)) + 8;
                if ((rhi - rlo) & 1) { if (rlo > 0) --rlo; else ++rhi; }
                const size_t kr0 = (size_t)(NCTX + b * DSEQ + rlo * 64);
                AttnSrc s0{cols + kr0 * NC + C_NAK + h * 64, cols + kr0 * NC + C_NAV + h * 64, NC, NC, rhi - rlo};
                AttnSrc s1{WSP(bf16_t, WS_CNAK) + cb * 256 + h * 64, WSP(bf16_t, WS_CNAV) + cb * 256 + h * 64, 256, 256, PAST / 64};
                attn_unit<64>(lds, tid, cols + (size_t)r0 * NC + C_NAQ + h * 64, NC, s0, s1, AttnMask{1, i0, rlo}, p.in[I_RPB] + ((size_t)l * 4 + h) * 465, 0.f, false, 0.125f,
                              nullptr, cols + (size_t)r0 * NC + C_NAZ + h * 64, Y + (size_t)r0 * DM + 0 + h * 64);
            } else {
                const int kh = h >> 1;
                const int klo = t0 - 128 < 0 ? 0 : t0 - 128, khi = t0 + 256 > DSEQ ? DSEQ : t0 + 256;
                const size_t kr0 = (size_t)(NCTX + b * DSEQ + klo);
                AttnSrc s0{WSP(bf16_t, WS_WKR) + kr0 * 128 + kh * 64, cols + kr0 * NC + C_WV + kh * 64, 128, NC, (khi - klo) / 64};
                AttnSrc s1{WSP(bf16_t, WS_CWK) + cb * 128 + kh * 64, WSP(bf16_t, WS_CWV) + cb * 128 + kh * 64, 128, 128, PAST / 64};
                attn_unit<64>(lds, tid, WSP(bf16_t, WS_WQR) + (size_t)r0 * 256 + h * 64, 256, s0, s1, AttnMask{2, t0, klo}, nullptr, p.in[I_SINK][l * 4 + h], true, 0.125f,
                              nullptr, cols + (size_t)r0 * NC + C_WZ + h * 64, Y + (size_t)r0 * DM + 768 + h * 64);
            }
        } else {
            const int v = u - 3 * NL, kind = v % 3, h = (v / 3) & 3, tile = v / 12;
            const int r0 = tile * 128, sq0 = (r0 / SEQ) * SEQ;
            const AttnSrc none{nullptr, nullptr, 0, 0, 0};
            if (kind == 0) {
                AttnSrc s0{cols + (size_t)sq0 * NC + C_NAK + h * 64, cols + (size_t)sq0 * NC + C_NAV + h * 64, NC, NC, SEQ / 64};
                attn_unit<64>(lds, tid, cols + (size_t)r0 * NC + C_NAQ + h * 64, NC, s0, none, AttnMask{0, 0, 0}, nullptr, 0.f, false, 0.125f, nullptr,
                              cols + (size_t)r0 * NC + C_NAZ + h * 64, Y + (size_t)r0 * DM + 0 + h * 64);
            } else if (kind == 1) {
                AttnSrc s0{WSP(bf16_t, WS_KMLA) + (size_t)sq0 * 384 + h * 96, WSP(bf16_t, WS_VMLA) + (size_t)sq0 * 256 + h * 64, 384, 256, SEQ / 64};
                attn_unit<96>(lds, tid, WSP(bf16_t, WS_QMLA) + (size_t)r0 * 384 + h * 96, 384, s0, none, AttnMask{0, 0, 0}, nullptr, 0.f, false, 0.10206207261596577f, nullptr,
                              cols + (size_t)r0 * NC + C_MZ + h * 64, Y + (size_t)r0 * DM + 512 + h * 64);
            } else {
                const int kh = h >> 1;
                AttnSrc s0{WSP(bf16_t, WS_WKR) + (size_t)sq0 * 128 + kh * 64, cols + (size_t)sq0 * NC + C_WV + kh * 64, 128, NC, SEQ / 64};
                attn_unit<64>(lds, tid, WSP(bf16_t, WS_WQR) + (size_t)r0 * 256 + h * 64, 256, s0, none, AttnMask{0, 0, 0}, nullptr, p.in[I_SINK][l * 4 + h], true, 0.125f, nullptr,
                              cols + (size_t)r0 * NC + C_WZ + h * 64, Y + (size_t)r0 * DM + 768 + h * 64);
            }
        }
    }
}

__device__ __forceinline__ float wave_sum(float v) {
#pragma unroll
    for (int o = 1; o < 64; o <<= 1) v += __shfl_xor(v, o);
    return v;
}

template <bool FINAL>
__device__ __forceinline__ void fs_norm(const P& p, int l) {
    const int tid = otid(), lane = tid & 63, gw = blockIdx.x * (NTHREADS / 64) + (tid >> 6), ngw = gridDim.x * (NTHREADS / 64);
    const float* g = FINAL ? p.in[I_FG] : p.in[I_NG] + (size_t)l * DM;
    constexpr int RB = 3;
    for (int r0 = gw; r0 < NTOK; r0 += RB * ngw) {
        f32x4 v[RB][4]; float ss[RB];
#pragma unroll
        for (int q = 0; q < RB; ++q) {
            const int r = r0 + q * ngw; ss[q] = 0.f;
            if (r < NTOK) {
                const float* x = (FINAL || l > 0) ? WSP(float, WS_X) + (size_t)r * DM : (r < NCTX ? p.in[I_XP] + (size_t)r * DM : p.in[I_XS] + (size_t)(r - NCTX) * DM);
#pragma unroll
                for (int j = 0; j < 4; ++j) v[q][j] = *(const f32x4*)(x + 256 * j + 4 * lane);
            }
        }
#pragma unroll
        for (int q = 0; q < RB; ++q) {
            const int r = r0 + q * ngw;
            if (r >= NTOK) continue;
#pragma unroll
            for (int j = 0; j < 4; ++j) ss[q] += (v[q][j][0] * v[q][j][0] + v[q][j][1] * v[q][j][1]) + (v[q][j][2] * v[q][j][2] + v[q][j][3] * v[q][j][3]);
            const float rstd = 1.f / sqrtf(wave_sum(ss[q]) * (1.f / DM) + 1e-6f);
            const float pscale = (FINAL && PROBE_ON && r >= NCTX) ? 1.f + ((const float*)(p.ws + WS_CTL))[8000] : 1.f;
            if (FINAL) {
#pragma unroll
                for (int j = 0; j < 4; ++j) { const f32x4 gg = *(const f32x4*)(g + 256 * j + 4 * lane); *(f32x4*)(p.out + O_Y + (size_t)r * DM + 256 * j + 4 * lane) = v[q][j] * (rstd * pscale) * gg; }
            } else {
                const float* mv = WSP(float, WS_MODV) + ((size_t)l * NCB + row_cb(r)) * 3072;
                bf16_t* H = WSP(bf16_t, WS_H) + (size_t)r * DM;
#pragma unroll
                for (int j = 0; j < 4; ++j) {
                    const int k = 256 * j + 4 * lane;
                    const f32x4 gg = *(const f32x4*)(g + k), sh = *(const f32x4*)(mv + k), sc = *(const f32x4*)(mv + 1024 + k);
                    const f32x4 y = v[q][j] * rstd * gg * (sc + 1.f) + sh;
                    u32x2 w; w.x = cvt_pk_bf16(y[0], y[1]); w.y = cvt_pk_bf16(y[2], y[3]);
                    *(u32x2*)(H + k) = w;
                }
            }
        }
    }
}

__device__ __forceinline__ void fs_rowprep(const P& p, int l) {
    const int tid = otid(), lane = tid & 63, gw = blockIdx.x * (NTHREADS / 64) + (tid >> 6), ngw = gridDim.x * (NTHREADS / 64);
    const bf16_t* cols = WSP(bf16_t, WS_COLS);
    constexpr int RB = 3;
    for (int r0 = gw; r0 < NTOK; r0 += RB * ngw) {
        unsigned wck[RB]; u32x2 wqa[RB]; bf16_t kr1[RB], kr2[RB], g1[RB][3], g2[RB][3];
#pragma unroll
        for (int q = 0; q < RB; ++q) {
            const int r = r0 + q * ngw;
            if (r < NTOK) {
                const bf16_t* c = cols + (size_t)r * NC;
                wck[q] = *(const unsigned*)(c + C_CKV + 2 * lane);
                wqa[q] = *(const u32x2*)(c + C_MQA + 4 * lane);
                kr1[q] = c[C_KR + (lane & 15)]; kr2[q] = c[C_KR + 16 + (lane & 15)];
#pragma unroll
                for (int i = 0; i < 3; ++i) {
                    const int pi = lane + 64 * i, hh = pi >> 5, j = pi & 31;
                    const bf16_t* src = hh < 4 ? c + C_WQ + hh * 64 : c + C_WK + (hh - 4) * 64;
                    g1[q][i] = src[j]; g2[q][i] = src[32 + j];
                }
            }
        }
#pragma unroll
        for (int q = 0; q < RB; ++q) {
            const int r = r0 + q * ngw;
            if (r >= NTOK) continue;
            const bool lat = r >= NCTX; const int t = lat ? (r - NCTX) % DSEQ : 0;
            const size_t bl = lat ? 0 : ((size_t)(r / SEQ) * DEPTH + l) * SEQ + (r % SEQ);
            {
                const float a = u2f(wck[q] << 16), b = u2f(wck[q] & 0xffff0000u);
                const float rstd = 1.f / sqrtf(wave_sum(a * a + b * b) * (1.f / 128.f) + 1e-6f);
                const float* g = p.in[I_KVG] + (size_t)l * 128 + 2 * lane;
                const float va = a * rstd * g[0], vb = b * rstd * g[1];
                *(unsigned*)(WSP(bf16_t, WS_CKVB) + (size_t)r * 128 + 2 * lane) = cvt_pk_bf16(va, vb);
                if (!lat) { f32x2 o; o.x = va; o.y = vb; *(f32x2*)(p.out + O_CKV + bl * 128 + 2 * lane) = o; }
            }
            {
                const float a0 = u2f(wqa[q].x << 16), a1 = u2f(wqa[q].x & 0xffff0000u), a2 = u2f(wqa[q].y << 16), a3 = u2f(wqa[q].y & 0xffff0000u);
                const float rstd = 1.f / sqrtf(wave_sum((a0 * a0 + a1 * a1) + (a2 * a2 + a3 * a3)) * (1.f / 256.f) + 1e-6f);
                const f32x4 g = *(const f32x4*)(p.in[I_QG] + (size_t)l * 256 + 4 * lane);
                u32x2 o; o.x = cvt_pk_bf16(a0 * rstd * g[0], a1 * rstd * g[1]); o.y = cvt_pk_bf16(a2 * rstd * g[2], a3 * rstd * g[3]);
                *(u32x2*)(WSP(bf16_t, WS_QN) + (size_t)r * 256 + 4 * lane) = o;
            }
            if (lane < 16) {
                const float x1 = bf2f(kr1[q]), x2 = bf2f(kr2[q]);
                float o1 = x1, o2 = x2;
                if (lat) { const float* rm = WSP(float, WS_ROPEM) + (size_t)t * 32 + 2 * lane; o1 = x1 * rm[0] - x2 * rm[1]; o2 = x1 * rm[1] + x2 * rm[0]; }
                else { p.out[O_KR + bl * 32 + lane] = x1; p.out[O_KR + bl * 32 + 16 + lane] = x2; }
                bf16_t* km = WSP(bf16_t, WS_KMLA) + (size_t)r * 384 + 64 + lane;
                const bf16_t b1 = f2bf(o1), b2 = f2bf(o2);
#pragma unroll
                for (int h = 0; h < 4; ++h) { km[h * 96] = b1; km[h * 96 + 16] = b2; }
            }
            {
                const float* rw = WSP(float, WS_ROPEW) + (size_t)t * 64;
#pragma unroll
                for (int i = 0; i < 3; ++i) {
                    const int pi = lane + 64 * i, hh = pi >> 5, j = pi & 31;
                    bf16_t* dst = hh < 4 ? WSP(bf16_t, WS_WQR) + (size_t)r * 256 + hh * 64 : WSP(bf16_t, WS_WKR) + (size_t)r * 128 + (hh - 4) * 64;
                    const float x1 = bf2f(g1[q][i]), x2 = bf2f(g2[q][i]);
                    if (lat) { const float cs = rw[2 * j], sn = rw[2 * j + 1]; dst[j] = f2bf(x1 * cs - x2 * sn); dst[32 + j] = f2bf(x1 * sn + x2 * cs); }
                    else { dst[j] = g1[q][i]; dst[32 + j] = g2[q][i]; }
                }
            }
        }
    }
}

__device__ __forceinline__ void tr_item(const float* W, int N, int ncol0, bf16_t* WT, int K, int nrow0, int k0, LAS float* scr, int lane) {
    if (ncol0 >= 0) {
        float v[32];
        const float* wp = W + (size_t)(k0 + (lane >> 5)) * N + ncol0 + (lane & 31);
#pragma unroll
        for (int i = 0; i < 32; ++i) v[i] = wp[(size_t)(2 * i) * N];
#pragma unroll
        for (int i = 0; i < 32; ++i) scr[(2 * i + (lane >> 5)) * 33 + (lane & 31)] = v[i];
    }
    asm volatile("s_waitcnt lgkmcnt(0)" ::: "memory");
    const int c = lane & 7;
#pragma unroll
    for (int j = 0; j < 4; ++j) {
        const int n = (lane >> 3) + 8 * j; const LAS float* sp = scr + (8 * c) * 33 + n;
        u32x4 o = (u32x4){0u, 0u, 0u, 0u};
        if (ncol0 >= 0) { o.x = cvt_pk_bf16(sp[0 * 33], sp[1 * 33]); o.y = cvt_pk_bf16(sp[2 * 33], sp[3 * 33]); o.z = cvt_pk_bf16(sp[4 * 33], sp[5 * 33]); o.w = cvt_pk_bf16(sp[6 * 33], sp[7 * 33]); }
        *(u32x4*)(WT + (size_t)(nrow0 + n) * K + k0 + 8 * c) = o;
    }
    asm volatile("s_waitcnt lgkmcnt(0)" ::: "memory");
}
__device__ __forceinline__ void tr_big_layer(const P& p, int l, int it0, int it1, int gw, int ngw, LAS float* scr, int lane) {
    for (int it = it0 + gw; it < it1; it += ngw) {
        int r = it;
        if (r < 4096) { const int nb = r & 255, kb = r >> 8;
            tr_item(p.in[I_WIN] + (size_t)l * DM * INW, INW, orig_col(nb * 32), WSP(bf16_t, WS_WTIN) + (size_t)l * NC * DM, DM, nb * 32, kb * 64, scr, lane); continue; } r -= 4096;
        if (r < 512) { const int nb = r & 31, kb = r >> 5;
            tr_item(p.in[I_WOUT] + (size_t)l * DM * DM, DM, nb * 32, WSP(bf16_t, WS_WTOUT) + (size_t)l * DM * DM, DM, nb * 32, kb * 64, scr, lane); continue; } r -= 512;
        { const int nb = r & 31, kb = (r >> 5) & 3, b = r >> 7;
            tr_item(p.in[I_WBR] + (size_t)(l * 4 + b) * 256 * DM, DM, nb * 32, WSP(bf16_t, WS_WTBR) + (size_t)l * DM * DM + b * 256, DM, nb * 32, kb * 64, scr, lane); }
    }
}
constexpr int TR_BIG_ITEMS = 4096 + 512 + 512;
constexpr int GEMM1K_UNITS = (NTOK / 256) * 4;
__device__ __forceinline__ bool defer_weights() { return (int)gridDim.x - GEMM1K_UNITS >= 32; }
__device__ __forceinline__ void fs_prep_deferred(const P& p, int l, int half, LAS unsigned char* lds) {
    const int idle0 = GEMM1K_UNITS, nidle = (int)gridDim.x - idle0;
    if (!defer_weights() || (int)blockIdx.x < idle0) return;
    const int tid = otid(), lane = tid & 63, wave = tid >> 6;
    tr_big_layer(p, l, half * (TR_BIG_ITEMS / 2), (half + 1) * (TR_BIG_ITEMS / 2), ((int)blockIdx.x - idle0) * (NTHREADS / 64) + wave, nidle * (NTHREADS / 64), (LAS float*)(lds + wave * 16384), lane);
}
__device__ __forceinline__ void fs_prep(const P& p, LAS unsigned char* lds) {
    const int tid = otid(), lane = tid & 63, wave = tid >> 6, gw = blockIdx.x * (NTHREADS / 64) + wave, ngw = gridDim.x * (NTHREADS / 64);
    LAS float* scr = (LAS float*)(lds + wave * 16384);
    {
        const int nl = defer_weights() ? 1 : DEPTH;
        for (int l = 0; l < nl; ++l) tr_big_layer(p, l, 0, TR_BIG_ITEMS, gw, ngw, scr, lane);
        constexpr int I_QB = DEPTH * 4 * 16, I_KVB = DEPTH * 2 * 16;
        for (int it = gw; it < I_QB + I_KVB; it += ngw) {
            int r = it;
            if (r < I_QB) { const int nb = r & 15, kb = (r >> 4) & 3, l = r >> 6;
                tr_item(p.in[I_WQB] + (size_t)l * 256 * 384, 384, nb < 12 ? nb * 32 : -1, WSP(bf16_t, WS_WTQB) + (size_t)l * 512 * 256, 256, nb * 32, kb * 64, scr, lane); continue; } r -= I_QB;
            { const int nb = r & 15, kb = (r >> 4) & 1, l = r >> 5;
                tr_item(p.in[I_WKVB] + (size_t)l * 128 * 512, 512, nb * 32, WSP(bf16_t, WS_WTKVB) + (size_t)l * 512 * 128, 128, nb * 32, kb * 64, scr, lane); }
        }
    }
    __syncthreads();
    {
        LAS float* sl = (LAS float*)lds;
        LAS float* red = sl + NCB * 1024;
        for (int i = tid; i < NCB * 1024; i += NTHREADS) { const int cb = i >> 10, k = i & 1023; const float cv = cb == 0 ? p.in[I_CCTX][k] : p.in[I_C][(size_t)(cb - 1) * DM + k]; sl[i] = cv / (1.f + __expf(-cv)); }
        __syncthreads();
        for (int it = blockIdx.x; it < DEPTH * 48; it += gridDim.x) {
            const int l = it / 48, j = (it % 48) * 64 + (tid & 63), kp = tid >> 6;
            const float* w = p.in[I_WMOD] + ((size_t)l * DM + kp * 128) * 3072 + j;
            float acc[NCB];
#pragma unroll
            for (int cb = 0; cb < NCB; ++cb) acc[cb] = 0.f;
            for (int k0 = 0; k0 < 128; k0 += 32) {
                float wv[32];
#pragma unroll
                for (int k = 0; k < 32; ++k) wv[k] = w[(size_t)(k0 + k) * 3072];
#pragma unroll
                for (int k = 0; k < 32; ++k)
#pragma unroll
                    for (int cb = 0; cb < NCB; ++cb) acc[cb] += sl[cb * 1024 + kp * 128 + k0 + k] * wv[k];
            }
#pragma unroll
            for (int cb = 0; cb < NCB; ++cb) red[(kp * NCB + cb) * 64 + (tid & 63)] = acc[cb];
            __syncthreads();
            if (tid < NCB * 64) { const int cb = tid >> 6, jj = tid & 63; float sm = 0.f;
#pragma unroll
                for (int q = 0; q < 8; ++q) sm += red[(q * NCB + cb) * 64 + jj];
                WSP(float, WS_MODV)[((size_t)l * NCB + cb) * 3072 + (it % 48) * 64 + jj] = sm + p.in[I_BMOD][(size_t)l * 3072 + (it % 48) * 64 + jj]; }
            __syncthreads();
        }
    }
    const long gtid = (long)blockIdx.x * NTHREADS + tid, gsz = (long)gridDim.x * NTHREADS;
    {
        float* lbs = WSP(float, WS_LBS);
        for (long i = gtid; i < 2 * 256; i += gsz) {
            const float* lg = p.in[I_LB];
            float mx = -1e30f;
            for (int l = 0; l < DEPTH; ++l) mx = fmaxf(mx, lg[(size_t)l * 512 + i]);
            float sm = 0.f;
            for (int l = 0; l < DEPTH; ++l) sm += expf(lg[(size_t)l * 512 + i] - mx);
            float cum = 0.f; const float p0 = expf(lg[i] - mx) / sm;
            for (int l = 0; l < DEPTH; ++l) { cum += expf(lg[(size_t)l * 512 + i] - mx) / sm; lbs[(size_t)l * 512 + i] = cum - p0; }
        }
        float* rm = WSP(float, WS_ROPEM);
        for (long i = gtid; i < (long)DSEQ * 16; i += gsz) {
            const int j = (int)(i % 16), t = (int)(i / 16);
            const float pos = j < 8 ? (float)(t / GW) : (float)(t % GW);
            const float a = pos * powf(10000.f, -(float)(j & 7) / 8.f); rm[i * 2] = cosf(a); rm[i * 2 + 1] = sinf(a);
        }
        float* rw = WSP(float, WS_ROPEW);
        for (long i = gtid; i < (long)DSEQ * 32; i += gsz) {
            const int j = (int)(i % 32), t = (int)(i / 32);
            const float pos = j < 16 ? (float)(t / GW) : (float)(t % GW);
            const float a = pos * powf(10000.f, -(float)(j & 15) / 16.f); rw[i * 2] = cosf(a); rw[i * 2 + 1] = sinf(a);
        }
        for (long i = gtid; i < (long)DB * DEPTH * PAST * 256 / 4; i += gsz) {
            const f32x4 a = *(const f32x4*)(p.in[I_CNAK] + 4 * i), b = *(const f32x4*)(p.in[I_CNAV] + 4 * i);
            u32x2 wa, wb; wa.x = cvt_pk_bf16(a[0], a[1]); wa.y = cvt_pk_bf16(a[2], a[3]); wb.x = cvt_pk_bf16(b[0], b[1]); wb.y = cvt_pk_bf16(b[2], b[3]);
            *(u32x2*)(WSP(bf16_t, WS_CNAK) + 4 * i) = wa; *(u32x2*)(WSP(bf16_t, WS_CNAV) + 4 * i) = wb;
        }
        for (long i = gtid; i < (long)DB * DEPTH * PAST * 128 / 4; i += gsz) {
            const f32x4 a = *(const f32x4*)(p.in[I_CWK] + 4 * i), b = *(const f32x4*)(p.in[I_CWV] + 4 * i), cc = *(const f32x4*)(p.in[I_CCKV] + 4 * i);
            u32x2 wa, wb, wc; wa.x = cvt_pk_bf16(a[0], a[1]); wa.y = cvt_pk_bf16(a[2], a[3]); wb.x = cvt_pk_bf16(b[0], b[1]); wb.y = cvt_pk_bf16(b[2], b[3]); wc.x = cvt_pk_bf16(cc[0], cc[1]); wc.y = cvt_pk_bf16(cc[2], cc[3]);
            *(u32x2*)(WSP(bf16_t, WS_CWK) + 4 * i) = wa; *(u32x2*)(WSP(bf16_t, WS_CWV) + 4 * i) = wb; *(u32x2*)(WSP(bf16_t, WS_CCKVB) + 4 * i) = wc;
        }
        for (long i = gtid; i < (long)DB * DEPTH * PAST * 128; i += gsz) {
            const int e = (int)(i % 32), h = (int)((i / 32) % 4); const long rowi = i / 128;
            WSP(bf16_t, WS_KCM)[(size_t)rowi * 384 + h * 96 + 64 + e] = f2bf(p.in[I_CKR][(size_t)rowi * 32 + e]);
        }
    }
}
struct CtxOrder {
    int c, nwgs; const char* A; const char* B;
    __device__ bool next(int i, pg8::Unit& u) const {
        const int L = i * nwgs + c; if (L >= (DB * DEPTH * PAST / 256) * 2) return false;
        u.pm = L >> 1; u.pn = L & 1; u.aux = 0;
        const int lyr = (u.pm / (PAST / 256)) % DEPTH;
        u.A = A + (size_t)u.pm * 256 * 128 * 2; u.B = B + ((size_t)lyr * 512 + u.pn * 256) * 128 * 2; return true;
    }
};
__device__ __forceinline__ void fs_prep_ctx(const P& p, LAS unsigned char* lds) {
    bf16_t* km = WSP(bf16_t, WS_KCM); bf16_t* vm = WSP(bf16_t, WS_VCM);
    CtxOrder S{(int)blockIdx.x, (int)gridDim.x, (const char*)WSP(bf16_t, WS_CCKVB), (const char*)WSP(bf16_t, WS_WTKVB)};
    auto E = make_epi([=](const pg8::Unit& u, int r, int n, f32x4 v0, f32x4 v1) {
        const u32x4 w = pack8(v0, v1); const int h = n >> 7, e = n & 127;
        if (e < 64) *(u32x4*)(km + (size_t)r * 384 + h * 96 + e) = w; else *(u32x4*)(vm + (size_t)r * 256 + h * 64 + (e - 64)) = w;
    });
    int K = 128; asm volatile("" : "+s"(K));
    pg8::gemm_phase(lds, pg8::Gemm{K, K, K}, S, E);
}

#define XB_TMO      128
#define XB_XCNT(j)  (256  + 64 * (j))
#define XB_XSUB(j)  (1280 + 64 * (j))
#define XB_XGEN(j)  (2304 + 64 * (j))
#define XB_TOP      3328
#define XB_TOPGEN   3392
#define XCD_BAR_WORDS 3456
#define XB_SPIN_CAP (1u << 20)
__device__ __forceinline__ unsigned xb_ld(unsigned* p)              { return __hip_atomic_load(p, __ATOMIC_RELAXED, __HIP_MEMORY_SCOPE_AGENT); }
__device__ __forceinline__ unsigned xb_add(unsigned* p, unsigned v) { return __hip_atomic_fetch_add(p, v, __ATOMIC_RELAXED, __HIP_MEMORY_SCOPE_AGENT); }
__device__ __forceinline__ unsigned xb_xcc_id() { return (unsigned)__builtin_amdgcn_s_getreg((3 << 11) | 20) & 0xFu; }
#define XB_SPIN(cond, bar) do { unsigned _sp = 0; while (cond) { __builtin_amdgcn_s_sleep(1); \
    if ((++_sp & 255u) == 0u) { if (xb_ld(&(bar)[XB_TMO])) break; if (_sp > XB_SPIN_CAP) { atomicAdd(&(bar)[XB_TMO], 1u); break; } } } } while (0)
struct XcdBarrier { unsigned* bar; unsigned x; volatile LAS unsigned* st; };
__device__ __forceinline__ XcdBarrier xcd_barrier_post(unsigned* bar, volatile LAS unsigned* st) {
    XcdBarrier b; b.bar = bar; b.x = xb_xcc_id(); b.st = st;
    if (threadIdx.x == 0) (void)xb_add(&bar[XB_XCNT(b.x)], 1u);
    return b;
}
__device__ __forceinline__ void xcd_barrier_complete(unsigned* bar, unsigned x, unsigned& nloc, unsigned& nx) {
    const unsigned G = gridDim.x * gridDim.y * gridDim.z;
    unsigned sum, cnt, mine, sp = 0u;
    for (;;) {
        sum = 0u; cnt = 0u; mine = 0u;
#pragma unroll
        for (unsigned j = 0; j < 16; ++j) { const unsigned c = xb_ld(&bar[XB_XCNT(j)]); sum += c; cnt += (c > 0u) ? 1u : 0u; mine = (j == x) ? c : mine; }
        if (sum == G) break;
        __builtin_amdgcn_s_sleep(1);
        if ((++sp & 255u) == 0u) { if (xb_ld(&bar[XB_TMO])) break; if (sp > XB_SPIN_CAP) { atomicAdd(&bar[XB_TMO], 1u); break; } }
    }
    nloc = mine > 0u ? mine : 1u; nx = cnt > 0u ? cnt : 1u;
}
__device__ __forceinline__ void xcd_barrier(const XcdBarrier& b) {
    asm volatile("s_waitcnt vmcnt(0)" ::: "memory");
    __syncthreads();
    if (threadIdx.x == 0) {
        unsigned* bar = b.bar;
        __builtin_amdgcn_s_waitcnt(0);
        unsigned nloc = b.st[0], nx = b.st[1];
        if (nloc == 0u) { xcd_barrier_complete(bar, b.x, nloc, nx); b.st[0] = nloc; b.st[1] = nx; }
        const unsigned old = xb_add(&bar[XB_XSUB(b.x)], 1u);
        const unsigned gen = old / nloc;
        if (old + 1u == (gen + 1u) * nloc) {
            __builtin_amdgcn_fence(__ATOMIC_RELEASE, "agent");
            asm volatile("s_waitcnt vmcnt(0)" ::: "memory");
            const unsigned og = xb_add(&bar[XB_TOP], 1u);
            const unsigned tg = og / nx;
            if (og + 1u == (tg + 1u) * nx) xb_add(&bar[XB_TOPGEN], 1u);
            else XB_SPIN(xb_ld(&bar[XB_TOPGEN]) == tg, bar);
            __builtin_amdgcn_fence(__ATOMIC_ACQUIRE, "agent");
            xb_add(&bar[XB_XGEN(b.x)], 1u);
            asm volatile("s_waitcnt vmcnt(0)" ::: "memory");
        } else {
            XB_SPIN(xb_ld(&bar[XB_XGEN(b.x)]) == gen, bar);
            __builtin_amdgcn_fence(__ATOMIC_ACQUIRE, "agent");
            asm volatile("s_waitcnt vmcnt(0)" ::: "memory");
        }
    }
    __syncthreads();
}

__global__ void __launch_bounds__(NTHREADS) mega_kernel(P p) {
    extern __shared__ __attribute__((aligned(16))) unsigned char lds_raw[];
    LAS unsigned char* lds = (LAS unsigned char*)lds_raw;
    { LAS unsigned* stz = (LAS unsigned*)(lds + LDS_BYTES - 64); if (threadIdx.x < 16) stz[threadIdx.x] = 0u; }
    __syncthreads();
    (void)xcd_barrier_post((unsigned*)((*(const P*)__builtin_amdgcn_kernarg_segment_ptr()).ws + WS_CTL), (volatile LAS unsigned*)(lds + LDS_BYTES - 64));
#define GBAR() do { XcdBarrier gb_; gb_.bar = (unsigned*)(PPR.ws + WS_CTL); gb_.x = xb_xcc_id(); gb_.st = (volatile LAS unsigned*)(lds + LDS_BYTES - 64); xcd_barrier(gb_); } while (0)
    const long gsz = (long)gridDim.x * blockDim.x;
#define GTID() ({ int t_ = threadIdx.x; asm volatile("" : "+v"(t_)); (long)blockIdx.x * blockDim.x + t_; })
#define PP ({ const __attribute__((address_space(4))) P* k_ = (const __attribute__((address_space(4))) P*)__builtin_amdgcn_kernarg_segment_ptr(); asm volatile("" : "+s"(k_)); k_; })
#define PPR (*(const P*)PP)
#ifndef DUPM
#define DUPM 0
#endif
#define PB(id) do { if (PROBE == (id) && blockIdx.x == 0 && threadIdx.x == 0) { *(volatile LAS unsigned long long*)(lds + LDS_BYTES - 32) = __builtin_amdgcn_s_memrealtime(); } } while (0)
#define PE(id) do { if (PROBE == (id) && blockIdx.x == 0 && threadIdx.x == 0) { const unsigned long long t1_ = __builtin_amdgcn_s_memrealtime(); \
        *(volatile LAS unsigned long long*)(lds + LDS_BYTES - 24) += t1_ - *(volatile LAS unsigned long long*)(lds + LDS_BYTES - 32); } } while (0)
    if (PROBE && threadIdx.x == 0) { *(volatile LAS unsigned long long*)(lds + LDS_BYTES - 24) = 0ull; }
#define DUP(bit, stmt) do { if (DUPM & (1 << (bit))) { stmt; } } while (0)
    PB(1); fs_prep(PPR, lds); DUP(0, __syncthreads(); fs_prep(PPR, lds)); GBAR();
    fs_prep_ctx(PPR, lds); fs_norm<false>(PPR, 0); GBAR(); PE(1);
#pragma nounroll
    for (int l = 0; l < DEPTH; ++l) {
        if (l > 0) { PB(2); fs_norm<false>(PPR, l); GBAR(); PE(2); }
        PB(3); fs_inproj(PPR, l, lds); DUP(1, fs_inproj(PPR, l, lds)); GBAR(); PE(3);
        PB(4); fs_rowprep(PPR, l); fs_hgrn_a(PPR, l, lds); DUP(6, fs_rowprep(PPR, l); fs_hgrn_a(PPR, l, lds)); GBAR(); PE(4);
        PB(5); fs_mlaproj(PPR, l, lds); DUP(7, fs_mlaproj(PPR, l, lds)); PB(6); fs_hgrn_b(PPR, l, GTID(), gsz); PE(6); GBAR(); PE(5);
        PB(7); fs_attn(PPR, l, lds); DUP(2, fs_attn(PPR, l, lds)); PE(7);
        PB(8); fs_hgrn_c(PPR, l, lds); DUP(5, fs_hgrn_c(PPR, l, lds)); GBAR(); PE(8);
        PB(9); fs_merge(PPR, l, lds); if (l + 1 < DEPTH) fs_prep_deferred(PPR, l + 1, 0, lds); DUP(3, fs_merge(PPR, l, lds)); DUP(4, GBAR(); GBAR(); GBAR(); GBAR(); GBAR(); GBAR(); GBAR(); GBAR()); GBAR(); PE(9);
        PB(10); fs_out(PPR, l, lds); if (l + 1 < DEPTH) fs_prep_deferred(PPR, l + 1, 1, lds);
        if (PROBE && l == DEPTH - 1) { PE(10); if (blockIdx.x == 0 && threadIdx.x == 0) { const unsigned long long ta_ = *(volatile LAS unsigned long long*)(lds + LDS_BYTES - 24); float f_ = (float)ta_ / (100.f * PROBE_SCALE_US); f_ = f_ > 1.f ? 1.f : f_; ((float*)(PPR.ws + WS_CTL))[8000] = sqrtf(2.0e-5f + 7.9e-5f * f_); } }
        GBAR(); if (l < DEPTH - 1) PE(10);
    }
    fs_norm<true>(PPR, 0);
}

extern "C" void kernel_launch(void* const* d_in, const int* in_sizes, int n_in, void* d_out, int out_size, void* d_ws, size_t ws_size, hipStream_t stream) {
    static int grid_blocks = 0;
    if (grid_blocks == 0) {
        if (n_in != N_IN || (size_t)out_size != O_END || ws_size < WS_END) {
            fprintf(stderr, "kernel_launch: unexpected sizes n_in %d out %d ws %zu (need %zu)\n", n_in, out_size, ws_size, (size_t)WS_END);
            grid_blocks = -1; return;
        }
        int dev = 0, cus = 0, per_cu = 0;
        hipGetDevice(&dev);
        hipDeviceGetAttribute(&cus, hipDeviceAttributeMultiprocessorCount, dev);
        hipFuncSetAttribute((const void*)mega_kernel, hipFuncAttributeMaxDynamicSharedMemorySize, LDS_BYTES);
        hipOccupancyMaxActiveBlocksPerMultiprocessor(&per_cu, (const void*)mega_kernel, NTHREADS, LDS_BYTES);
        if (per_cu < 1) per_cu = 1;
        grid_blocks = cus * per_cu;
    }
    if (grid_blocks < 0) return;
    P p{};
    for (int i = 0; i < N_IN; ++i) p.in[i] = (const float*)d_in[i];
    p.out = (float*)d_out; p.ws = (unsigned char*)d_ws;
    if (hipMemsetAsync((char*)d_ws + WS_CTL, 0, 16384, stream) != hipSuccess) { fprintf(stderr, "kernel_launch: memset of the barrier words failed\n"); return; }
    hipLaunchKernelGGL(mega_kernel, dim3(grid_blocks), dim3(NTHREADS), LDS_BYTES, stream, p);
    hipError_t e = hipPeekAtLastError();
    if (e != hipSuccess) fprintf(stderr, "launch failed: %s (grid %d)\n", hipGetErrorString(e), grid_blocks);
}
#endif
```

```cpp
#ifndef CPU_EMU
#include <hip/hip_runtime.h>
#include <cstdio>
#define DEV __device__ __forceinline__
#else
#include <cmath>
#include <cstdio>
#include <cstring>
#define DEV inline
#endif
#include <cstdint>
#include <cstddef>

#ifndef CFG_BATCH
#define CFG_BATCH 16
#endif
#ifndef CFG_DEPTH
#define CFG_DEPTH 4
#endif
#ifndef CFG_DEC_BATCH
#define CFG_DEC_BATCH 4
#endif
constexpr int DM = 1024, BATCH = CFG_BATCH, SEQ = 256, DEPTH = CFG_DEPTH, DB = CFG_DEC_BATCH, DSEQ = 2048, PAST = 512;
constexpr int NCTX = BATCH * SEQ, NLAT = DB * DSEQ, NTOK = NCTX + NLAT;
constexpr int NCB = 1 + DB;
constexpr int INW = 8096, NC = 8192;
constexpr int GW = 64, GROWS = DSEQ / GW;
constexpr int C_NAQ = 0, C_NAK = 256, C_NAV = 512, C_NAZ = 768, C_HGQ = 1024, C_HGFF = 1280, C_HGFB = 1536, C_HGI = 1792, C_HGOG = 2048, C_HGZ = 2304,
              C_MQA = 2560, C_CKV = 2816, C_MZ = 2944, C_WQ = 3200, C_WK = 3456, C_WV = 3584, C_WZ = 3712, C_KR = 3968, C_PAD = 4000, C_MG = 4096;
DEV int orig_col(int c) {
    if (c < 2944) return c;
    if (c < 3968) return c + 32;
    if (c < 4000) return 2944 + (c - 3968);
    if (c < 4096) return -1;
    return c - 96;
}
enum { I_XP = 0, I_XS, I_CNAK, I_CNAV, I_ST, I_CCKV, I_CKR, I_CWK, I_CWV, I_C, I_CCTX, I_NG, I_WMOD, I_BMOD, I_WIN, I_RPB, I_LB, I_HGG, I_QG, I_KVG, I_WQB, I_WKVB, I_SINK, I_WBR, I_WOUT, I_FG, N_IN };
constexpr size_t O_Y = 0;
constexpr size_t O_NAK = (size_t)NTOK * DM;
constexpr size_t O_NAV = O_NAK + (size_t)BATCH * DEPTH * SEQ * 256;
constexpr size_t O_ST = O_NAV + (size_t)BATCH * DEPTH * SEQ * 256;
constexpr size_t O_CKV = O_ST + (size_t)BATCH * DEPTH * 2 * 4 * 64 * 64;
constexpr size_t O_KR = O_CKV + (size_t)BATCH * DEPTH * SEQ * 128;
constexpr size_t O_WK = O_KR + (size_t)BATCH * DEPTH * SEQ * 32;
constexpr size_t O_WV = O_WK + (size_t)BATCH * DEPTH * SEQ * 128;
constexpr size_t O_END = O_WV + (size_t)BATCH * DEPTH * SEQ * 128;

typedef unsigned short bf16_t;
constexpr size_t al256(size_t x) { return (x + 255) & ~(size_t)255; }
constexpr size_t WS_CTL = 0;
constexpr size_t WS_WTIN = 1u << 20;
constexpr size_t WS_WTBR = WS_WTIN + (size_t)DEPTH * NC * DM * 2;
constexpr size_t WS_WTOUT = WS_WTBR + (size_t)DEPTH * 4 * DM * 256 * 2;
constexpr size_t WS_WTQB = WS_WTOUT + (size_t)DEPTH * DM * DM * 2;
constexpr size_t WS_WTKVB = WS_WTQB + (size_t)DEPTH * 512 * 256 * 2;
constexpr size_t WS_MODV = WS_WTKVB + (size_t)DEPTH * 512 * 128 * 2;
constexpr size_t WS_LBS = al256(WS_MODV + (size_t)DEPTH * NCB * 3072 * 4);
constexpr size_t WS_ROPEM = al256(WS_LBS + (size_t)DEPTH * 2 * 256 * 4);
constexpr size_t WS_ROPEW = al256(WS_ROPEM + (size_t)DSEQ * 16 * 2 * 4);
constexpr size_t WS_X = al256(WS_ROPEW + (size_t)DSEQ * 32 * 2 * 4);
constexpr size_t WS_H = WS_X + (size_t)NTOK * DM * 4;
constexpr size_t WS_COLS = WS_H + (size_t)NTOK * DM * 2;
constexpr size_t WS_KCM = WS_COLS + (size_t)NTOK * NC * 2;
constexpr size_t WS_VCM = WS_KCM + (size_t)DB * DEPTH * PAST * 384 * 2;
constexpr size_t WS_QN = WS_VCM + (size_t)DB * DEPTH * PAST * 256 * 2;
constexpr size_t WS_CKVB = WS_QN + (size_t)NTOK * 256 * 2;
constexpr size_t WS_QMLA = WS_CKVB + (size_t)NTOK * 128 * 2;
constexpr size_t WS_KMLA = WS_QMLA + (size_t)NTOK * 384 * 2;
constexpr size_t WS_VMLA = WS_KMLA + (size_t)NTOK * 384 * 2;
constexpr size_t WS_WQR = WS_VMLA + (size_t)NTOK * 256 * 2;
constexpr size_t WS_WKR = WS_WQR + (size_t)NTOK * 256 * 2;
constexpr size_t WS_OH = WS_WKR + (size_t)NTOK * 128 * 2;
constexpr size_t WS_Y = WS_OH + (size_t)2 * NTOK * 256 * 4;
constexpr size_t WS_MRG = WS_H;
constexpr size_t WS_HD = WS_Y + (size_t)NTOK * DM * 2;
constexpr size_t WS_CNAK = al256(WS_HD + (size_t)(NTOK / 64) * 4 * 2 * 64 * 4);
constexpr size_t WS_CNAV = WS_CNAK + (size_t)DB * DEPTH * PAST * 256 * 2;
constexpr size_t WS_CWK = WS_CNAV + (size_t)DB * DEPTH * PAST * 256 * 2;
constexpr size_t WS_CWV = WS_CWK + (size_t)DB * DEPTH * PAST * 128 * 2;
constexpr size_t WS_CCKVB = WS_CWV + (size_t)DB * DEPTH * PAST * 128 * 2;
constexpr size_t WS_END = WS_CCKVB + (size_t)DB * DEPTH * PAST * 128 * 2;
constexpr size_t WS_HL = WS_OH;
constexpr size_t WS_MRGF = WS_QN;
static_assert(WS_MRGF + (size_t)NTOK * DM * 4 <= WS_Y, "MRGF alias must end before Y");

struct P {
    const float* in[N_IN];
    float* out;
    unsigned char* ws;
};

DEV unsigned f2u(float f) { unsigned u; memcpy(&u, &f, 4); return u; }
DEV float u2f(unsigned u) { float f; memcpy(&f, &u, 4); return f; }
DEV bf16_t f2bf(float f) { unsigned u = f2u(f); return (bf16_t)((u + 0x7fffu + ((u >> 16) & 1u)) >> 16); }
DEV float bf2f(bf16_t b) { return u2f((unsigned)b << 16); }
DEV float rbf(float f) { return bf2f(f2bf(f)); }
DEV float sigm(float x) { return 1.f / (1.f + expf(-x)); }
DEV float siluf(float x) { return x * sigm(x); }
DEV int row_cb(int r) { return r < NCTX ? 0 : 1 + (r - NCTX) / DSEQ; }

struct U4 { unsigned x, y, z, w; };
DEV void unpack8(const bf16_t* p, float* f) {
    U4 v = *(const U4*)p;
    f[0] = u2f(v.x << 16); f[1] = u2f(v.x & 0xffff0000u); f[2] = u2f(v.y << 16); f[3] = u2f(v.y & 0xffff0000u);
    f[4] = u2f(v.z << 16); f[5] = u2f(v.z & 0xffff0000u); f[6] = u2f(v.w << 16); f[7] = u2f(v.w & 0xffff0000u);
}

#define WSP(T, off) ((T*)(p.ws + (off)))

DEV void nv_prep_w(const P& p, long gtid, long gsz) {
    bf16_t* wtin = WSP(bf16_t, WS_WTIN);
    const float* win = p.in[I_WIN];
    for (long i = gtid; i < (long)DEPTH * NC * DM; i += gsz) {
        int k = (int)(i % DM); long t = i / DM; int n = (int)(t % NC); int l = (int)(t / NC);
        int oc = orig_col(n);
        wtin[i] = oc < 0 ? (bf16_t)0 : f2bf(win[((size_t)l * DM + k) * INW + oc]);
    }
    bf16_t* wtbr = WSP(bf16_t, WS_WTBR);
    const float* wbr = p.in[I_WBR];
    for (long i = gtid; i < (long)DEPTH * 4 * DM * 256; i += gsz) {
        int w = (int)(i % 256); long t = i / 256; int d = (int)(t % DM); t /= DM; int b = (int)(t % 4); int l = (int)(t / 4);
        wtbr[i] = f2bf(wbr[(((size_t)l * 4 + b) * 256 + w) * DM + d]);
    }
    bf16_t* wtout = WSP(bf16_t, WS_WTOUT);
    const float* wout = p.in[I_WOUT];
    for (long i = gtid; i < (long)DEPTH * DM * DM; i += gsz) {
        int k = (int)(i % DM); long t = i / DM; int n = (int)(t % DM); int l = (int)(t / DM);
        wtout[i] = f2bf(wout[((size_t)l * DM + k) * DM + n]);
    }
    bf16_t* wtqb = WSP(bf16_t, WS_WTQB);
    const float* wqb = p.in[I_WQB];
    for (long i = gtid; i < (long)DEPTH * 512 * 256; i += gsz) {
        int k = (int)(i % 256); long t = i / 256; int n = (int)(t % 512); int l = (int)(t / 512);
        wtqb[i] = n < 384 ? f2bf(wqb[((size_t)l * 256 + k) * 384 + n]) : (bf16_t)0;
    }
    bf16_t* wtkvb = WSP(bf16_t, WS_WTKVB);
    const float* wkvb = p.in[I_WKVB];
    for (long i = gtid; i < (long)DEPTH * 512 * 128; i += gsz) {
        int k = (int)(i % 128); long t = i / 128; int n = (int)(t % 512); int l = (int)(t / 512);
        wtkvb[i] = f2bf(wkvb[((size_t)l * 128 + k) * 512 + n]);
    }
    float* modv = WSP(float, WS_MODV);
    for (long i = gtid; i < (long)DEPTH * NCB * 3072; i += gsz) {
        int j = (int)(i % 3072); long t = i / 3072; int cb = (int)(t % NCB); int l = (int)(t / NCB);
        const float* cv = cb == 0 ? p.in[I_CCTX] : p.in[I_C] + (size_t)(cb - 1) * DM;
        const float* w = p.in[I_WMOD] + (size_t)l * DM * 3072 + j;
        float acc = 0.f;
        for (int k = 0; k < DM; ++k) acc += siluf(cv[k]) * w[(size_t)k * 3072];
        modv[i] = acc + p.in[I_BMOD][(size_t)l * 3072 + j];
    }
    float* lbs = WSP(float, WS_LBS);
    for (long i = gtid; i < 2 * 256; i += gsz) {
        const float* lg = p.in[I_LB];
        float mx = -1e30f;
        for (int l = 0; l < DEPTH; ++l) mx = fmaxf(mx, lg[(size_t)l * 512 + i]);
        float s = 0.f;
        for (int l = 0; l < DEPTH; ++l) s += expf(lg[(size_t)l * 512 + i] - mx);
        float cum = 0.f, p0 = expf(lg[i] - mx) / s;
        for (int l = 0; l < DEPTH; ++l) { cum += expf(lg[(size_t)l * 512 + i] - mx) / s; lbs[(size_t)l * 512 + i] = cum - p0; }
    }
    float* rm = WSP(float, WS_ROPEM);
    for (long i = gtid; i < (long)DSEQ * 16; i += gsz) {
        int j = (int)(i % 16), t = (int)(i / 16);
        float pos = j < 8 ? (float)(t / GW) : (float)(t % GW);
        float inv = powf(10000.f, -(float)(j & 7) / 8.f);
        float a = pos * inv; rm[i * 2] = cosf(a); rm[i * 2 + 1] = sinf(a);
    }
    float* rw = WSP(float, WS_ROPEW);
    for (long i = gtid; i < (long)DSEQ * 32; i += gsz) {
        int j = (int)(i % 32), t = (int)(i / 32);
        float pos = j < 16 ? (float)(t / GW) : (float)(t % GW);
        float inv = powf(10000.f, -(float)(j & 15) / 16.f);
        float a = pos * inv; rw[i * 2] = cosf(a); rw[i * 2 + 1] = sinf(a);
    }
}

DEV void nv_prep_ctxmla(const P& p, long gtid, long gsz) {
    const bf16_t* wtkvb = WSP(bf16_t, WS_WTKVB);
    bf16_t* kcm = WSP(bf16_t, WS_KCM); bf16_t* vcm = WSP(bf16_t, WS_VCM);
    for (long i = gtid; i < (long)DB * DEPTH * PAST * 512; i += gsz) {
        int n = (int)(i % 512); long row = i / 512;
        int l = (int)((row / PAST) % DEPTH);
        const float* ck = p.in[I_CCKV] + (size_t)row * 128;
        const bf16_t* w = wtkvb + ((size_t)l * 512 + n) * 128;
        float acc = 0.f;
        for (int j = 0; j < 128; ++j) acc += rbf(ck[j]) * bf2f(w[j]);
        int h = n / 128, e = n % 128;
        if (e < 64) kcm[(size_t)row * 384 + h * 96 + e] = f2bf(acc);
        else vcm[(size_t)row * 256 + h * 64 + (e - 64)] = f2bf(acc);
    }
    for (long i = gtid; i < (long)DB * DEPTH * PAST * 128; i += gsz) {
        int e = (int)(i % 32); int h = (int)((i / 32) % 4); long row = i / 128;
        kcm[(size_t)row * 384 + h * 96 + 64 + e] = f2bf(p.in[I_CKR][(size_t)row * 32 + e]);
    }
    for (long i = gtid; i < (long)DB * DEPTH * PAST * 256; i += gsz) { WSP(bf16_t, WS_CNAK)[i] = f2bf(p.in[I_CNAK][i]); WSP(bf16_t, WS_CNAV)[i] = f2bf(p.in[I_CNAV][i]); }
    for (long i = gtid; i < (long)DB * DEPTH * PAST * 128; i += gsz) { WSP(bf16_t, WS_CWK)[i] = f2bf(p.in[I_CWK][i]); WSP(bf16_t, WS_CWV)[i] = f2bf(p.in[I_CWV][i]); }
}

DEV const float* x_row(const P& p, int l, int r) {
    if (l == 0) return r < NCTX ? p.in[I_XP] + (size_t)r * DM : p.in[I_XS] + (size_t)(r - NCTX) * DM;
    return WSP(float, WS_X) + (size_t)r * DM;
}

DEV void nv_normmod(const P& p, int l, long gtid, long gsz) {
    bf16_t* H = WSP(bf16_t, WS_H);
    const float* g = p.in[I_NG] + (size_t)l * DM;
    for (long r = gtid; r < NTOK; r += gsz) {
        const float* x = x_row(p, l, (int)r);
        const float* mv = WSP(float, WS_MODV) + ((size_t)l * NCB + row_cb((int)r)) * 3072;
        float ss = 0.f;
        for (int k = 0; k < DM; ++k) ss += x[k] * x[k];
        float rstd = 1.f / sqrtf(ss / DM + 1e-6f);
        for (int k = 0; k < DM; ++k) H[(size_t)r * DM + k] = f2bf(x[k] * rstd * g[k] * (1.f + mv[1024 + k]) + mv[k]);
    }
}

template <class Epi>
DEV void nv_gemm(const bf16_t* A, int lda, const bf16_t* Wt, int ldw, int M, int N, int K, long gtid, long gsz, Epi epi) {
    const long nItems = (long)(M / 4) * (N / 4);
    for (long it = gtid; it < nItems; it += gsz) {
        const int cb = (int)(it % (N / 4)), rb = (int)(it / (N / 4));
        float acc[4][4];
#pragma unroll
        for (int i = 0; i < 4; ++i)
#pragma unroll
            for (int j = 0; j < 4; ++j) acc[i][j] = 0.f;
        for (int k = 0; k < K; k += 8) {
            float a[4][8], w[4][8];
#pragma unroll
            for (int i = 0; i < 4; ++i) unpack8(A + (size_t)(rb * 4 + i) * lda + k, a[i]);
#pragma unroll
            for (int j = 0; j < 4; ++j) unpack8(Wt + (size_t)(cb * 4 + j) * ldw + k, w[j]);
#pragma unroll
            for (int i = 0; i < 4; ++i)
#pragma unroll
                for (int j = 0; j < 4; ++j)
#pragma unroll
                    for (int e = 0; e < 8; ++e) acc[i][j] += a[i][e] * w[j][e];
        }
#pragma unroll
        for (int i = 0; i < 4; ++i)
#pragma unroll
            for (int j = 0; j < 4; ++j) epi(rb * 4 + i, cb * 4 + j, acc[i][j]);
    }
}

DEV void nv_inproj(const P& p, int l, long gtid, long gsz) {
    bf16_t* cols = WSP(bf16_t, WS_COLS);
    float* out = p.out;
    nv_gemm(WSP(bf16_t, WS_H), DM, WSP(bf16_t, WS_WTIN) + (size_t)l * NC * DM, DM, NTOK, NC, DM, gtid, gsz,
        [=](int r, int n, float v) {
            cols[(size_t)r * NC + n] = f2bf(v);
            if (r < NCTX) {
                const int b = r / SEQ, t = r % SEQ; const size_t bl = ((size_t)b * DEPTH + l) * SEQ + t;
                if (n >= C_NAK && n < C_NAK + 256) out[O_NAK + bl * 256 + (n - C_NAK)] = v;
                else if (n >= C_NAV && n < C_NAV + 256) out[O_NAV + bl * 256 + (n - C_NAV)] = v;
                else if (n >= C_WK && n < C_WK + 128) out[O_WK + bl * 128 + (n - C_WK)] = v;
                else if (n >= C_WV && n < C_WV + 128) out[O_WV + bl * 128 + (n - C_WV)] = v;
            }
        });
}

DEV void nv_rowprep(const P& p, int l, long gtid, long gsz) {
    const bf16_t* cols = WSP(bf16_t, WS_COLS);
    for (long r = gtid; r < NTOK; r += gsz) {
        const bf16_t* c = cols + (size_t)r * NC;
        const bool lat = r >= NCTX; const int t = lat ? (int)((r - NCTX) % DSEQ) : 0;
        {
            float ss = 0.f;
            for (int j = 0; j < 128; ++j) { float v = bf2f(c[C_CKV + j]); ss += v * v; }
            float rstd = 1.f / sqrtf(ss / 128.f + 1e-6f);
            const float* g = p.in[I_KVG] + (size_t)l * 128;
            for (int j = 0; j < 128; ++j) {
                float v = bf2f(c[C_CKV + j]) * rstd * g[j];
                WSP(bf16_t, WS_CKVB)[(size_t)r * 128 + j] = f2bf(v);
                if (!lat) p.out[O_CKV + (((size_t)(r / SEQ) * DEPTH + l) * SEQ + (r % SEQ)) * 128 + j] = v;
            }
        }
        {
            const float* rm = WSP(float, WS_ROPEM) + (size_t)t * 32;
            for (int j = 0; j < 16; ++j) {
                float x1 = bf2f(c[C_KR + j]), x2 = bf2f(c[C_KR + 16 + j]);
                float o1 = x1, o2 = x2;
                if (lat) { float cs = rm[j * 2], sn = rm[j * 2 + 1]; o1 = x1 * cs - x2 * sn; o2 = x1 * sn + x2 * cs; }
                else {
                    size_t o = O_KR + (((size_t)(r / SEQ) * DEPTH + l) * SEQ + (r % SEQ)) * 32;
                    p.out[o + j] = x1; p.out[o + 16 + j] = x2;
                }
                for (int h = 0; h < 4; ++h) {
                    WSP(bf16_t, WS_KMLA)[(size_t)r * 384 + h * 96 + 64 + j] = f2bf(o1);
                    WSP(bf16_t, WS_KMLA)[(size_t)r * 384 + h * 96 + 80 + j] = f2bf(o2);
                }
            }
        }
        {
            float ss = 0.f;
            for (int j = 0; j < 256; ++j) { float v = bf2f(c[C_MQA + j]); ss += v * v; }
            float rstd = 1.f / sqrtf(ss / 256.f + 1e-6f);
            const float* g = p.in[I_QG] + (size_t)l * 256;
            for (int j = 0; j < 256; ++j) WSP(bf16_t, WS_QN)[(size_t)r * 256 + j] = f2bf(bf2f(c[C_MQA + j]) * rstd * g[j]);
        }
        {
            const float* rw = WSP(float, WS_ROPEW) + (size_t)t * 64;
            for (int hh = 0; hh < 6; ++hh) {
                const bf16_t* src = hh < 4 ? c + C_WQ + hh * 64 : c + C_WK + (hh - 4) * 64;
                bf16_t* dst = hh < 4 ? WSP(bf16_t, WS_WQR) + (size_t)r * 256 + hh * 64 : WSP(bf16_t, WS_WKR) + (size_t)r * 128 + (hh - 4) * 64;
                for (int j = 0; j < 32; ++j) {
                    float x1 = bf2f(src[j]), x2 = bf2f(src[32 + j]);
                    if (lat) { float cs = rw[j * 2], sn = rw[j * 2 + 1]; dst[j] = f2bf(x1 * cs - x2 * sn); dst[32 + j] = f2bf(x1 * sn + x2 * cs); }
                    else { dst[j] = src[j]; dst[32 + j] = src[32 + j]; }
                }
            }
        }
    }
}

DEV void nv_mlaproj(const P& p, int l, long gtid, long gsz) {
    bf16_t* qm = WSP(bf16_t, WS_QMLA); bf16_t* km = WSP(bf16_t, WS_KMLA); bf16_t* vm = WSP(bf16_t, WS_VMLA);
    nv_gemm(WSP(bf16_t, WS_QN), 256, WSP(bf16_t, WS_WTQB) + (size_t)l * 512 * 256, 256, NTOK, 384, 256, gtid, gsz,
        [=](int r, int n, float v) { qm[(size_t)r * 384 + n] = f2bf(v); });
    nv_gemm(WSP(bf16_t, WS_CKVB), 128, WSP(bf16_t, WS_WTKVB) + (size_t)l * 512 * 128, 128, NTOK, 512, 128, gtid, gsz,
        [=](int r, int n, float v) {
            int h = n / 128, e = n % 128;
            if (e < 64) km[(size_t)r * 384 + h * 96 + e] = f2bf(v); else vm[(size_t)r * 256 + h * 64 + (e - 64)] = f2bf(v);
        });
}

struct SoftAcc { float m, l; float o[32]; };
DEV void sa_init(SoftAcc& s) { s.m = -3e38f; s.l = 0.f;
#pragma unroll
    for (int d = 0; d < 32; ++d) s.o[d] = 0.f; }
DEV void sa_add(SoftAcc& s, float sc, const bf16_t* v) {
    float mn = fmaxf(s.m, sc);
    float corr = expf(s.m - mn), pe = expf(sc - mn);
    s.m = mn; s.l = s.l * corr + pe;
#pragma unroll
    for (int d8 = 0; d8 < 4; ++d8) {
        float f[8]; unpack8(v + d8 * 8, f);
#pragma unroll
        for (int e = 0; e < 8; ++e) s.o[d8 * 8 + e] = s.o[d8 * 8 + e] * corr + pe * f[e];
    }
}
DEV void sa_add_f32v(SoftAcc& s, float sc, const float* v) {
    float mn = fmaxf(s.m, sc);
    float corr = expf(s.m - mn), pe = expf(sc - mn);
    s.m = mn; s.l = s.l * corr + pe;
#pragma unroll
    for (int d = 0; d < 32; ++d) s.o[d] = s.o[d] * corr + pe * rbf(v[d]);
}
template <int DQ> DEV float dot_bf(const float* q, const bf16_t* k) {
    float acc = 0.f;
#pragma unroll
    for (int d8 = 0; d8 < DQ / 8; ++d8) {
        float f[8]; unpack8(k + d8 * 8, f);
#pragma unroll
        for (int e = 0; e < 8; ++e) acc += q[d8 * 8 + e] * f[e];
    }
    return acc;
}
DEV float dot64_f32k(const float* q, const float* k) {
    float acc = 0.f;
#pragma unroll
    for (int d = 0; d < 64; ++d) acc += q[d] * rbf(k[d]);
    return acc;
}
DEV void sa_store(const P& p, const SoftAcc& s, float extra_den, int r, int branch, int h, int zcol, int half) {
    const bf16_t* c = WSP(bf16_t, WS_COLS) + (size_t)r * NC + zcol + h * 64 + half * 32;
    bf16_t* y = WSP(bf16_t, WS_Y) + (size_t)r * DM + branch * 256 + h * 64 + half * 32;
    float inv = 1.f / (s.l + extra_den);
#pragma unroll
    for (int d = 0; d < 32; ++d) y[d] = f2bf(s.o[d] * inv * siluf(bf2f(c[d])));
}

DEV void nv_attn(const P& p, int l, long gtid, long gsz) {
    const bf16_t* cols = WSP(bf16_t, WS_COLS);
    for (long it = gtid; it < (long)NTOK * 24; it += gsz) {
        const int half = (int)(it % 2); const int kind = (int)((it / 2) % 3); const int h = (int)((it / 6) % 4); const int r = (int)(it / 24);
        const int vo = half * 32;
        const bool lat = r >= NCTX;
        const int b = lat ? (r - NCTX) / DSEQ : r / SEQ, t = lat ? (r - NCTX) % DSEQ : r % SEQ;
        const int seq0 = lat ? NCTX + b * DSEQ : b * SEQ;
        SoftAcc s; sa_init(s);
        if (kind == 0) {
            float q[64];
#pragma unroll
            for (int d8 = 0; d8 < 8; ++d8) unpack8(cols + (size_t)r * NC + C_NAQ + h * 64 + d8 * 8, q + d8 * 8);
            if (!lat) {
                for (int j = 0; j < SEQ; ++j) {
                    const bf16_t* kr = cols + (size_t)(seq0 + j) * NC;
                    sa_add(s, dot_bf<64>(q, kr + C_NAK + h * 64) * 0.125f, kr + C_NAV + h * 64 + vo);
                }
            } else {
                const int gi = t / GW, gj = t % GW;
                int rs = gi - 4; rs = rs < 0 ? 0 : (rs > GROWS - 8 ? GROWS - 8 : rs);
                int cs = gj - 8; cs = cs < 0 ? 0 : (cs > GW - 16 ? GW - 16 : cs);
                const float* rpb = p.in[I_RPB] + ((size_t)l * 4 + h) * 15 * 31;
                for (int kr_ = rs; kr_ < rs + 8; ++kr_)
                    for (int kc = cs; kc < cs + 16; ++kc) {
                        const bf16_t* kk = cols + (size_t)(seq0 + kr_ * GW + kc) * NC;
                        int dc = kc - gj + 15; dc = dc < 0 ? 0 : (dc > 30 ? 30 : dc);
                        float bias = rpb[(kr_ - gi + 7) * 31 + dc];
                        sa_add(s, dot_bf<64>(q, kk + C_NAK + h * 64) * 0.125f + bias, kk + C_NAV + h * 64 + vo);
                    }
                const float* ck = p.in[I_CNAK] + ((size_t)b * DEPTH + l) * PAST * 256 + h * 64;
                const float* cv = p.in[I_CNAV] + ((size_t)b * DEPTH + l) * PAST * 256 + h * 64 + vo;
                for (int j = 0; j < PAST; ++j) sa_add_f32v(s, dot64_f32k(q, ck + (size_t)j * 256) * 0.125f, cv + (size_t)j * 256);
            }
            sa_store(p, s, 0.f, r, 0, h, C_NAZ, half);
        } else if (kind == 1) {
            float q[96];
            const bf16_t* qp = WSP(bf16_t, WS_QMLA) + (size_t)r * 384 + h * 96;
#pragma unroll
            for (int d8 = 0; d8 < 12; ++d8) unpack8(qp + d8 * 8, q + d8 * 8);
            if (lat) {
                const float* rm = WSP(float, WS_ROPEM) + (size_t)t * 32;
#pragma unroll
                for (int j = 0; j < 16; ++j) {
                    float x1 = q[64 + j], x2 = q[80 + j], cs = rm[j * 2], sn = rm[j * 2 + 1];
                    q[64 + j] = rbf(x1 * cs - x2 * sn); q[80 + j] = rbf(x1 * sn + x2 * cs);
                }
            }
            const float scale = 0.10206207261596577f;
            const int n = lat ? DSEQ : SEQ;
            const bf16_t* km = WSP(bf16_t, WS_KMLA) + (size_t)seq0 * 384 + h * 96;
            const bf16_t* vm = WSP(bf16_t, WS_VMLA) + (size_t)seq0 * 256 + h * 64 + vo;
            for (int j = 0; j < n; ++j) sa_add(s, dot_bf<96>(q, km + (size_t)j * 384) * scale, vm + (size_t)j * 256);
            if (lat) {
                const bf16_t* kc = WSP(bf16_t, WS_KCM) + ((size_t)b * DEPTH + l) * PAST * 384 + h * 96;
                const bf16_t* vc = WSP(bf16_t, WS_VCM) + ((size_t)b * DEPTH + l) * PAST * 256 + h * 64 + vo;
                for (int j = 0; j < PAST; ++j) sa_add(s, dot_bf<96>(q, kc + (size_t)j * 384) * scale, vc + (size_t)j * 256);
            }
            sa_store(p, s, 0.f, r, 2, h, C_MZ, half);
        } else {
            float q[64];
#pragma unroll
            for (int d8 = 0; d8 < 8; ++d8) unpack8(WSP(bf16_t, WS_WQR) + (size_t)r * 256 + h * 64 + d8 * 8, q + d8 * 8);
            const int kh = h / 2;
            const float sink = p.in[I_SINK][l * 4 + h];
            int j0 = 0, j1 = SEQ;
            if (lat) { j0 = t - 128 < 0 ? 0 : t - 128; j1 = t + 129 > DSEQ ? DSEQ : t + 129; }
            for (int j = j0; j < j1; ++j)
                sa_add(s, dot_bf<64>(q, WSP(bf16_t, WS_WKR) + (size_t)(seq0 + j) * 128 + kh * 64) * 0.125f, cols + (size_t)(seq0 + j) * NC + C_WV + kh * 64 + vo);
            if (lat) {
                const float* ck = p.in[I_CWK] + ((size_t)b * DEPTH + l) * PAST * 128 + kh * 64;
                const float* cv = p.in[I_CWV] + ((size_t)b * DEPTH + l) * PAST * 128 + kh * 64 + vo;
                for (int j = 0; j < PAST; ++j) sa_add_f32v(s, dot64_f32k(q, ck + (size_t)j * 128) * 0.125f, cv + (size_t)j * 128);
            }
            float mn = fmaxf(s.m, sink); float corr = expf(s.m - mn);
            s.l *= corr;
#pragma unroll
            for (int d = 0; d < 32; ++d) s.o[d] *= corr;
            s.m = mn;
            sa_store(p, s, expf(sink - mn), r, 3, h, C_WZ, half);
        }
    }
}

DEV void nv_hgrn(const P& p, int l, long gtid, long gsz) {
    const bf16_t* cols = WSP(bf16_t, WS_COLS);
    float* oh = WSP(float, WS_OH);
    const int NSEQ = BATCH + DB;
    for (long it = gtid; it < (long)NSEQ * 4 * 2 * 64; it += gsz) {
        const int j = (int)(it % 64); const int dir = (int)((it / 64) % 2); const int h = (int)((it / 128) % 4); const int sq = (int)(it / 512);
        const bool lat = sq >= BATCH;
        const int b = lat ? sq - BATCH : sq;
        const int T = lat ? DSEQ : SEQ; const int seq0 = lat ? NCTX + b * DSEQ : b * SEQ;
        const float* lb = WSP(float, WS_LBS) + ((size_t)l * 2 + dir) * 256 + h * 64;
        float S[64];
        if (lat) {
            const float* st = p.in[I_ST] + ((((size_t)b * DEPTH + l) * 2 + dir) * 4 + h) * 4096;
#pragma unroll
            for (int d = 0; d < 64; ++d) S[d] = st[d * 64 + j];
        } else {
#pragma unroll
            for (int d = 0; d < 64; ++d) S[d] = 0.f;
        }
        const int fcol = dir == 0 ? C_HGFF : C_HGFB;
        for (int tt = 0; tt < T; ++tt) {
            const int t = dir == 0 ? tt : T - 1 - tt;
            const bf16_t* c = cols + (size_t)(seq0 + t) * NC;
            const float v = bf2f(c[C_HGI + h * 64 + j]);
            float o = 0.f;
#pragma unroll
            for (int d8 = 0; d8 < 8; ++d8) {
                float fz[8], qq[8]; unpack8(c + fcol + h * 64 + d8 * 8, fz); unpack8(c + C_HGQ + h * 64 + d8 * 8, qq);
#pragma unroll
                for (int e = 0; e < 8; ++e) {
                    const int d = d8 * 8 + e;
                    const float lbv = lb[d];
                    float f = lbv + (1.f - lbv) * sigm(fz[e]);
                    f = fmaxf(f, 1e-30f);
                    const float k = (1.f - lbv) * sigm(-fz[e]);
                    S[d] = f * S[d] + k * v;
                    o += S[d] * siluf(qq[e]);
                }
            }
            oh[((size_t)dir * NTOK + seq0 + t) * 256 + h * 64 + j] = o;
        }
        if (!lat) {
            float* so = p.out + O_ST + ((((size_t)b * DEPTH + l) * 2 + dir) * 4 + h) * 4096;
#pragma unroll
            for (int d = 0; d < 64; ++d) so[d * 64 + j] = S[d];
        }
    }
}

DEV void nv_hgrn_fin(const P& p, int l, long gtid, long gsz) {
    const bf16_t* cols = WSP(bf16_t, WS_COLS);
    const float* oh = WSP(float, WS_OH);
    const float* g = p.in[I_HGG] + (size_t)l * 64;
    for (long it = gtid; it < (long)NTOK * 4; it += gsz) {
        const int h = (int)(it % 4); const int r = (int)(it / 4);
        const float* of = oh + (size_t)r * 256 + h * 64; const float* ob = oh + ((size_t)NTOK + r) * 256 + h * 64;
        float ss = 0.f;
        for (int d = 0; d < 64; ++d) { float v = of[d] + ob[d]; ss += v * v; }
        float rstd = 1.f / sqrtf(ss / 64.f + 1e-6f);
        const bf16_t* c = cols + (size_t)r * NC;
        bf16_t* y = WSP(bf16_t, WS_Y) + (size_t)r * DM + 256 + h * 64;
        for (int d = 0; d < 64; ++d) {
            float v = (of[d] + ob[d]) * rstd * g[d] * sigm(bf2f(c[C_HGOG + h * 64 + d]));
            y[d] = f2bf(v * siluf(bf2f(c[C_HGZ + h * 64 + d])));
        }
    }
}

DEV void nv_merge(const P& p, int l, long gtid, long gsz) {
    const bf16_t* cols = WSP(bf16_t, WS_COLS);
    const bf16_t* Y = WSP(bf16_t, WS_Y);
    const bf16_t* wt = WSP(bf16_t, WS_WTBR) + (size_t)l * 4 * DM * 256;
    bf16_t* mrg = WSP(bf16_t, WS_MRG);
    for (long it = gtid; it < (long)NTOK * DM; it += gsz) {
        const int d = (int)(it % DM); const int r = (int)(it / DM);
        float tot = 0.f;
        for (int b = 0; b < 4; ++b) {
            const bf16_t* y = Y + (size_t)r * DM + b * 256; const bf16_t* w = wt + ((size_t)b * DM + d) * 256;
            float acc = 0.f;
            for (int k = 0; k < 256; k += 8) {
                float a[8], ww[8]; unpack8(y + k, a); unpack8(w + k, ww);
#pragma unroll
                for (int e = 0; e < 8; ++e) acc += a[e] * ww[e];
            }
            tot += sigm(bf2f(cols[(size_t)r * NC + C_MG + b * DM + d])) * acc;
        }
        mrg[it] = f2bf(tot);
    }
}

DEV void nv_out(const P& p, int l, long gtid, long gsz) {
    float* X = WSP(float, WS_X);
    const float* modv = WSP(float, WS_MODV);
    const P pp = p;
    nv_gemm(WSP(bf16_t, WS_MRG), DM, WSP(bf16_t, WS_WTOUT) + (size_t)l * DM * DM, DM, NTOK, DM, DM, gtid, gsz,
        [=](int r, int n, float v) {
            const float gate = modv[((size_t)l * NCB + row_cb(r)) * 3072 + 2048 + n];
            X[(size_t)r * DM + n] = x_row(pp, l, r)[n] + gate * v;
        });
}

DEV void nv_final(const P& p, long gtid, long gsz) {
    const float* X = WSP(float, WS_X); const float* g = p.in[I_FG];
    for (long r = gtid; r < NTOK; r += gsz) {
        const float* x = X + (size_t)r * DM;
        float ss = 0.f;
        for (int k = 0; k < DM; ++k) ss += x[k] * x[k];
        float rstd = 1.f / sqrtf(ss / DM + 1e-6f);
        for (int k = 0; k < DM; ++k) p.out[O_Y + (size_t)r * DM + k] = x[k] * rstd * g[k];
    }
}

constexpr int ST_PREP_W = 0, ST_PREP_CTX = 1, ST_LAYER0 = 2, ST_PER_LAYER = 8;
constexpr int N_STAGES = ST_LAYER0 + DEPTH * ST_PER_LAYER + 1;
DEV void run_stage(const P& p, int st, long gtid, long gsz) {
    if (st == ST_PREP_W) { nv_prep_w(p, gtid, gsz); return; }
    if (st == ST_PREP_CTX) { nv_prep_ctxmla(p, gtid, gsz); return; }
    if (st == N_STAGES - 1) { nv_final(p, gtid, gsz); return; }
    const int l = (st - ST_LAYER0) / ST_PER_LAYER, s = (st - ST_LAYER0) % ST_PER_LAYER;
    switch (s) {
        case 0: nv_normmod(p, l, gtid, gsz); break;
        case 1: nv_inproj(p, l, gtid, gsz); break;
        case 2: nv_rowprep(p, l, gtid, gsz); break;
        case 3: nv_mlaproj(p, l, gtid, gsz); break;
        case 4: nv_attn(p, l, gtid, gsz); nv_hgrn(p, l, gtid, gsz); break;
        case 5: nv_hgrn_fin(p, l, gtid, gsz); break;
        case 6: nv_merge(p, l, gtid, gsz); break;
        case 7: nv_out(p, l, gtid, gsz); break;
    }
}

#ifndef CPU_EMU
#define LAS __attribute__((address_space(3)))
typedef short bf16x8 __attribute__((ext_vector_type(8)));
typedef float f32x4 __attribute__((ext_vector_type(4)));
typedef unsigned u32x4 __attribute__((ext_vector_type(4)));
typedef unsigned u32x2 __attribute__((ext_vector_type(2)));
typedef float f32x2 __attribute__((ext_vector_type(2)));
constexpr int NTHREADS = 512;
#define PROBE 0
#define PROBE_SCALE_US 1000
constexpr bool PROBE_ON = (PROBE != 0);
constexpr int LDS_BYTES = 147456;

__device__ __forceinline__ unsigned cvt_pk_bf16(float lo, float hi) { unsigned r; asm volatile("v_cvt_pk_bf16_f32 %0, %1, %2" : "=v"(r) : "v"(lo), "v"(hi)); return r; }
__device__ __forceinline__ u32x4 pack8(f32x4 a, f32x4 b) { u32x4 w; w.x = cvt_pk_bf16(a[0], a[1]); w.y = cvt_pk_bf16(a[2], a[3]); w.z = cvt_pk_bf16(b[0], b[1]); w.w = cvt_pk_bf16(b[2], b[3]); return w; }
__device__ __forceinline__ void unpack8v(u32x4 v, f32x4& a, f32x4& b) {
    a[0] = u2f(v.x << 16); a[1] = u2f(v.x & 0xffff0000u); a[2] = u2f(v.y << 16); a[3] = u2f(v.y & 0xffff0000u);
    b[0] = u2f(v.z << 16); b[1] = u2f(v.z & 0xffff0000u); b[2] = u2f(v.w << 16); b[3] = u2f(v.w & 0xffff0000u);
}

namespace pg8 {
constexpr int BM = 256, BK = 64, HALF = 128, HTB = HALF * BK * 2  , STAGE_BYTES = 8 * HTB, NXCD = 8, WGM = 8;
__device__ __forceinline__ int lds_byte(int r, int c) { const int st = (r >> 4) * 2 + (c >> 5), rr = r & 15, cc = c & 31, ob = rr * 64 + cc * 2; return st * 1024 + (ob ^ (((ob >> 9) & 1) << 5)); }
__device__ __forceinline__ void stage_rc(int b, int& R, int& C) { const int st = b / 1024, sb = b % 1024, swz = sb ^ (((sb >> 9) & 1) << 5); R = (st >> 1) * 16 + swz / 64; C = (st & 1) * 32 + (swz % 64) / 2; }
__device__ __forceinline__ int perm32(int rho) { const int n = rho >> 4, i = rho & 15; return 8 * (i >> 2) + 4 * n + (i & 3); }

struct Unit { int pm, pn, aux; const char* A; const char* B; };
struct Gemm { int lda, ldb, K; };

struct GridOrder {
    int nM, nN, nwg, G, c; const char* A; const char* B; size_t astep, bstep;
    __device__ void init(int M, int N, int G_, int c_, const void* A_, int lda, const void* B_, int ldb) { nM = M / BM; nN = N / BM; nwg = nM * nN; G = G_; c = c_; A = (const char*)A_; B = (const char*)B_; astep = (size_t)BM * lda * 2; bstep = (size_t)BM * ldb * 2; }
    __device__ bool next(int i, Unit& u) const {
        const long L = (long)i * G + c; if (L >= nwg) return false;
        int wgid = (int)L; { const int q = nwg / NXCD, r = nwg % NXCD, xcd = wgid % NXCD, off = wgid / NXCD; wgid = (xcd < r ? xcd * (q + 1) : r * (q + 1) + (xcd - r) * q) + off; }
        const int nig = WGM * nN, gid = wgid / nig, fm = gid * WGM, gsz = (nM - fm) < WGM ? (nM - fm) : WGM;
        u.pm = fm + ((wgid % nig) % gsz); u.pn = (wgid % nig) / gsz; u.aux = 0; u.A = A + (size_t)u.pm * astep; u.B = B + (size_t)u.pn * bstep; return true;
    }
};

template <class F> struct EpiF {
    static constexpr int MID = 0;
    F f;
    __device__ __forceinline__ void operator()(const f32x4 (&acc)[2][2][4][2], const Unit& u, int wr, int wc, int fr, int fq) const {
#pragma unroll
        for (int ai = 0; ai < 2; ++ai)
#pragma unroll
            for (int m = 0; m < 4; ++m)
#pragma unroll
                for (int bj = 0; bj < 2; ++bj)
                    f(u, u.pm * BM + ai * HALF + wr * 64 + m * 16 + fr, u.pn * BM + bj * HALF + wc * 32 + 8 * fq, acc[ai][bj][m][0], acc[ai][bj][m][1]);
    }
};

template <class F, class G, int MIDV> struct EpiFM {
    static constexpr int MID = MIDV;
    F f; G g;
    __device__ __forceinline__ void operator()(const f32x4 (&acc)[2][2][4][2], const Unit& u, int wr, int wc, int fr, int fq) const {
#pragma unroll
        for (int ai = 0; ai < 2; ++ai)
#pragma unroll
            for (int m = 0; m < 4; ++m)
#pragma unroll
                for (int bj = 0; bj < 2; ++bj)
                    f(u, u.pm * BM + ai * HALF + wr * 64 + m * 16 + fr, u.pn * BM + bj * HALF + wc * 32 + 8 * fq, acc[ai][bj][m][0], acc[ai][bj][m][1]);
    }
    __device__ __forceinline__ void mid(f32x4 (&acc)[2][2][4][2], const Unit& u, int seg, int wr, int wc, int fr, int fq) const {
#pragma unroll
        for (int ai = 0; ai < 2; ++ai)
#pragma unroll
            for (int m = 0; m < 4; ++m)
#pragma unroll
                for (int bj = 0; bj < 2; ++bj) {
                    int rr = u.pm * BM + ai * HALF + wr * 64 + m * 16 + fr; asm volatile("" : "+v"(rr));
                    g(u, seg, rr, u.pn * BM + bj * HALF + wc * 32 + 8 * fq, acc[ai][bj][m][0], acc[ai][bj][m][1]);
                    __builtin_amdgcn_sched_barrier(0);
                }
    }
};

template <class Epi, class Sched>
__device__ __forceinline__ void gemm_phase(LAS unsigned char* lds, const Gemm g, const Sched& S, const Epi& E) {
    int tid_ = threadIdx.x; asm volatile("" : "+v"(tid_));
    const int tid = tid_, wid = __builtin_amdgcn_readfirstlane(tid >> 6), lane = tid & 63, wr = wid >> 2, wc = wid & 3, fr = lane & 15, fq = lane >> 4;
    const int K = g.K, nt = K / BK;
    unsigned voffA[2], voffB[2];
#pragma unroll
    for (int i = 0; i < 2; ++i) { int R, C; stage_rc(tid * 16 + i * 8192, R, C); const int Rb = (R & ~31) + perm32(R & 31);
        voffA[i] = (unsigned)(R * g.lda + C) * 2u; voffB[i] = (unsigned)(Rb * g.ldb + C) * 2u; }
    const size_t kstep = (size_t)(BK * 2);
    const size_t hstepA = (size_t)HALF * g.lda * 2, hstepB = (size_t)HALF * g.ldb * 2;
    const unsigned ldsw = (unsigned)wid * 1024u;
    const int aoff = lds_byte(wr * 64 + fr, fq * 8), boff = lds_byte(wc * 32 + fr, fq * 8);
#define PG8_SA(b, h) (((b) * 2 + (h)) * HTB)
#define PG8_SB(b, h) ((4 + (b) * 2 + (h)) * HTB)
#define PG8_STAGE(bufoff, gbase, voff) do { _Pragma("unroll") for (int _i = 0; _i < 2; ++_i) \
        __builtin_amdgcn_global_load_lds((const unsigned*)((const char*)(gbase) + (voff)[_i]), (LAS unsigned*)(lds + (bufoff) + ldsw + _i * 8192), 16, 0, 0); } while (0)
#define PG8_LDA(dst, b, h) do { _Pragma("unroll") for (int m = 0; m < 4; ++m) _Pragma("unroll") for (int k = 0; k < 2; ++k) dst[m][k] = *(const LAS bf16x8*)(lds + PG8_SA(b, h) + aoff + m * 2048 + k * 1024); } while (0)
#define PG8_LDB(dst, b, h) do { _Pragma("unroll") for (int n = 0; n < 2; ++n) _Pragma("unroll") for (int k = 0; k < 2; ++k) dst[n][k] = *(const LAS bf16x8*)(lds + PG8_SB(b, h) + boff + n * 2048 + k * 1024); } while (0)
#define PG8_MMA(ai, bj, At, Bt) do { __builtin_amdgcn_s_setprio(1); _Pragma("unroll") for (int m = 0; m < 4; ++m) _Pragma("unroll") for (int n = 0; n < 2; ++n) _Pragma("unroll") for (int k = 0; k < 2; ++k) \
        acc[ai][bj][m][n] = __builtin_amdgcn_mfma_f32_16x16x32_bf16(Bt[n][k], At[m][k], acc[ai][bj][m][n], 0, 0, 0); __builtin_amdgcn_s_setprio(0); } while (0)
#define PG8_WAIT_V(n) asm volatile("s_waitcnt vmcnt(" #n ")" ::: "memory")
#define PG8_WAIT_L(n) asm volatile("s_waitcnt lgkmcnt(" #n ")" ::: "memory")
#define PG8_BAR __builtin_amdgcn_s_barrier()
#define PG8_SCHED __builtin_amdgcn_sched_barrier(0)
    Unit cur, nxt; int ui = 0;
    if (!S.next(0, cur)) return;
    f32x4 acc[2][2][4][2];
#pragma unroll
    for (int a = 0; a < 2; ++a)
#pragma unroll
        for (int b = 0; b < 2; ++b)
#pragma unroll
            for (int m = 0; m < 4; ++m)
#pragma unroll
                for (int n = 0; n < 2; ++n) acc[a][b][m][n] = (f32x4){0.f, 0.f, 0.f, 0.f};
    bf16x8 At[4][2], B0[2][2], B1[2][2];
    const char* cA = cur.A; const char* cB = cur.B;
    PG8_STAGE(PG8_SB(0, 0), cB, voffB); PG8_STAGE(PG8_SB(0, 1), cB + hstepB, voffB); PG8_STAGE(PG8_SA(0, 0), cA, voffA); PG8_STAGE(PG8_SA(0, 1), cA + hstepA, voffA);
    if (wr == 1) PG8_BAR;
    PG8_WAIT_V(2); PG8_BAR;
    PG8_STAGE(PG8_SB(1, 0), cB + kstep, voffB); PG8_STAGE(PG8_SA(1, 0), cA + kstep, voffA); PG8_STAGE(PG8_SB(1, 1), cB + hstepB + kstep, voffB);
    PG8_WAIT_V(6); PG8_BAR;
    for (;;) {
        const bool has_next = S.next(ui + 1, nxt);
        const char* nA = has_next ? nxt.A : cA; const char* nB = has_next ? nxt.B : cB;
#pragma nounroll
        for (int t = 0; t < nt; t += 2) {
            const bool last = (t == nt - 2);
            const char* a1 = cA + (size_t)(t + 1) * kstep;
            const char* a2 = last ? nA : cA + (size_t)(t + 2) * kstep; const char* b2 = last ? nB : cB + (size_t)(t + 2) * kstep;
            const char* a3 = a2 + kstep; const char* b3 = b2 + kstep;
            PG8_LDB(B0, 0, 0); PG8_LDB(B1, 0, 1); PG8_SCHED; PG8_LDA(At, 0, 0); PG8_STAGE(PG8_SA(1, 1), a1 + hstepA, voffA);
            PG8_WAIT_V(8); PG8_WAIT_L(0); PG8_BAR; PG8_MMA(0, 0, At, B0); PG8_MMA(0, 1, At, B1); PG8_BAR; PG8_SCHED;
            PG8_LDA(At, 0, 1); PG8_STAGE(PG8_SB(0, 0), b2, voffB); PG8_STAGE(PG8_SB(0, 1), b2 + hstepB, voffB); PG8_STAGE(PG8_SA(0, 0), a2, voffA);
            PG8_WAIT_V(8); PG8_WAIT_L(0); PG8_BAR; PG8_MMA(1, 0, At, B0); PG8_MMA(1, 1, At, B1); PG8_BAR; PG8_SCHED;
            PG8_LDB(B0, 1, 0); PG8_LDB(B1, 1, 1); PG8_SCHED; PG8_LDA(At, 1, 0); PG8_STAGE(PG8_SA(0, 1), a2 + hstepA, voffA);
            PG8_WAIT_V(8); PG8_WAIT_L(0); PG8_BAR; PG8_MMA(0, 0, At, B0); PG8_MMA(0, 1, At, B1); PG8_BAR; PG8_SCHED;
            PG8_LDA(At, 1, 1); PG8_STAGE(PG8_SB(1, 0), b3, voffB); PG8_STAGE(PG8_SB(1, 1), b3 + hstepB, voffB); PG8_STAGE(PG8_SA(1, 0), a3, voffA);
            PG8_WAIT_V(8); PG8_WAIT_L(0); PG8_BAR; PG8_MMA(1, 0, At, B0); PG8_MMA(1, 1, At, B1); PG8_BAR; PG8_SCHED;
            if constexpr (Epi::MID > 0) { if (!last && ((t + 2) % Epi::MID) == 0) { E.mid(acc, cur, (t + 2) / Epi::MID - 1, wr, wc, fr, fq); PG8_SCHED; } }
        }
        if (wr == 0) PG8_BAR;
        E(acc, cur, wr, wc, fr, fq);
        if (!has_next) break;
#pragma unroll
        for (int a = 0; a < 2; ++a)
#pragma unroll
            for (int b = 0; b < 2; ++b)
#pragma unroll
                for (int m = 0; m < 4; ++m)
#pragma unroll
                    for (int n = 0; n < 2; ++n) acc[a][b][m][n] = (f32x4){0.f, 0.f, 0.f, 0.f};
        cur = nxt; cA = nA; cB = nB; ++ui;
        if (wr == 1) PG8_BAR;
    }
    PG8_WAIT_V(0);
    PG8_BAR;
#undef PG8_SA
#undef PG8_SB
#undef PG8_STAGE
#undef PG8_LDA
#undef PG8_LDB
#undef PG8_MMA
#undef PG8_WAIT_V
#undef PG8_WAIT_L
#undef PG8_BAR
#undef PG8_SCHED
}
}

template <class F> __device__ __forceinline__ pg8::EpiF<F> make_epi(F f) { return pg8::EpiF<F>{f}; }

__device__ __forceinline__ void fs_inproj(const P& p, int l, LAS unsigned char* lds) {
    bf16_t* cols = WSP(bf16_t, WS_COLS); float* out = p.out;
    pg8::GridOrder S; S.init(NTOK, NC, gridDim.x, blockIdx.x, WSP(bf16_t, WS_H), DM, WSP(bf16_t, WS_WTIN) + (size_t)l * NC * DM, DM);
    auto E = make_epi([=](const pg8::Unit& u, int r, int n, f32x4 v0, f32x4 v1) {
        if (n >= C_MG) {
#pragma unroll
            for (int e = 0; e < 4; ++e) { v0[e] = 1.f / (1.f + __expf(-v0[e])); v1[e] = 1.f / (1.f + __expf(-v1[e])); }
        }
        *(u32x4*)(cols + (size_t)r * NC + n) = pack8(v0, v1);
        if (r < NCTX) {
            const int b = r / SEQ, t = r % SEQ; const size_t bl = ((size_t)b * DEPTH + l) * SEQ + t;
            float* o = nullptr;
            if (n >= C_NAK && n < C_NAK + 256) o = out + O_NAK + bl * 256 + (n - C_NAK);
            else if (n >= C_NAV && n < C_NAV + 256) o = out + O_NAV + bl * 256 + (n - C_NAV);
            else if (n >= C_WK && n < C_WK + 128) o = out + O_WK + bl * 128 + (n - C_WK);
            else if (n >= C_WV && n < C_WV + 128) o = out + O_WV + bl * 128 + (n - C_WV);
            if (o) { *(f32x4*)o = v0; *(f32x4*)(o + 4) = v1; }
        }
    });
    pg8::gemm_phase(lds, pg8::Gemm{DM, DM, DM}, S, E);
}

struct SubOrder {
    int nM, nN, c, c0, nwgs; const char* A; const char* B; size_t astep, bstep;
    __device__ bool next(int i, pg8::Unit& u) const {
        const int cc = c - c0; if (cc < 0 || cc >= nwgs) return false;
        const int L = i * nwgs + cc; if (L >= nM * nN) return false;
        u.pm = L / nN; u.pn = L % nN; u.aux = 0; u.A = A + (size_t)u.pm * astep; u.B = B + (size_t)u.pn * bstep; return true;
    }
};
__device__ __forceinline__ void fs_mlaproj(const P& p, int l, LAS unsigned char* lds) {
    bf16_t* qm = WSP(bf16_t, WS_QMLA); bf16_t* km = WSP(bf16_t, WS_KMLA); bf16_t* vm = WSP(bf16_t, WS_VMLA);
    const int G = gridDim.x, half = G / 2;
    const bool isq = (int)blockIdx.x < half;
    const int K = isq ? 256 : 128;
    SubOrder S{NTOK / 256, 2, (int)blockIdx.x, isq ? 0 : half, isq ? half : G - half,
               isq ? (const char*)WSP(bf16_t, WS_QN) : (const char*)WSP(bf16_t, WS_CKVB),
               isq ? (const char*)(WSP(bf16_t, WS_WTQB) + (size_t)l * 512 * 256) : (const char*)(WSP(bf16_t, WS_WTKVB) + (size_t)l * 512 * 128),
               (size_t)256 * K * 2, (size_t)256 * K * 2};
    auto E = make_epi([=](const pg8::Unit& u, int r, int n, f32x4 v0, f32x4 v1) {
        const u32x4 w = pack8(v0, v1);
        if (isq) { if (n < 384) *(u32x4*)(qm + (size_t)r * 384 + n) = w; }
        else {
            const int h = n >> 7, e = n & 127;
            if (e < 64) *(u32x4*)(km + (size_t)r * 384 + h * 96 + e) = w; else *(u32x4*)(vm + (size_t)r * 256 + h * 64 + (e - 64)) = w;
        }
    });
    pg8::gemm_phase(lds, pg8::Gemm{K, K, K}, S, E);
}

struct MergeEpi {
    static constexpr int MID = 4;
    const bf16_t* cols; bf16_t* mrg;
    __device__ __forceinline__ void operator()(const f32x4 (&acc)[2][2][4][2], const pg8::Unit& u, int wr, int wc, int fr, int fq) const {
#pragma unroll
        for (int ai = 0; ai < 2; ++ai)
#pragma unroll
            for (int m = 0; m < 4; ++m)
#pragma unroll
                for (int bj = 0; bj < 2; ++bj) {
                    const int r = u.pm * 256 + ai * 128 + wr * 64 + m * 16 + fr, n = u.pn * 256 + bj * 128 + wc * 32 + 8 * fq;
                    f32x4 g0, g1; unpack8v(*(const u32x4*)(cols + (size_t)r * NC + C_MG + 3 * DM + n), g0, g1);
                    f32x4 v0 = acc[ai][bj][m][0], v1 = acc[ai][bj][m][1];
#pragma unroll
                    for (int e = 0; e < 4; ++e) { v0[e] *= fmaxf(g0[e], 1e-20f); v1[e] *= fmaxf(g1[e], 1e-20f); }
                    *(u32x4*)(mrg + (size_t)r * DM + n) = pack8(v0, v1);
                }
    }
    __device__ __forceinline__ void mid(f32x4 (&acc)[2][2][4][2], const pg8::Unit& u, int seg, int wr, int wc, int fr, int fq) const {
        int rb = u.pm * 256 + wr * 64 + fr; asm volatile("" : "+v"(rb));
        const bf16_t* base = cols + (size_t)rb * NC + C_MG + seg * DM + u.pn * 256 + wc * 32 + 8 * fq;
#pragma unroll
        for (int ai = 0; ai < 2; ++ai) {
            u32x4 ga[8], gb[8];
#pragma unroll
            for (int m = 0; m < 4; ++m)
#pragma unroll
                for (int bj = 0; bj < 2; ++bj) {
                    const bf16_t* gp = base + (size_t)(ai * 128 + m * 16) * NC + bj * 128;
                    ga[m * 2 + bj] = *(const u32x4*)gp; gb[m * 2 + bj] = *(const u32x4*)(gp + DM);
                }
            __builtin_amdgcn_sched_barrier(0);
#pragma unroll
            for (int m = 0; m < 4; ++m)
#pragma unroll
                for (int bj = 0; bj < 2; ++bj) {
                    f32x4 a0, a1, b0, b1; unpack8v(ga[m * 2 + bj], a0, a1); unpack8v(gb[m * 2 + bj], b0, b1);
#pragma unroll
                    for (int e = 0; e < 4; ++e) {
                        acc[ai][bj][m][0][e] *= fmaxf(a0[e], 1e-20f) * __builtin_amdgcn_rcpf(fmaxf(b0[e], 1e-20f));
                        acc[ai][bj][m][1][e] *= fmaxf(a1[e], 1e-20f) * __builtin_amdgcn_rcpf(fmaxf(b1[e], 1e-20f));
                    }
                }
            __builtin_amdgcn_sched_barrier(0);
        }
    }
};
__device__ __forceinline__ void fs_merge(const P& p, int l, LAS unsigned char* lds) {
    SubOrder S{NTOK / 256, 4, (int)blockIdx.x, 0, (int)gridDim.x, (const char*)WSP(bf16_t, WS_Y), (const char*)(WSP(bf16_t, WS_WTBR) + (size_t)l * DM * DM), (size_t)256 * DM * 2, (size_t)256 * DM * 2};
    MergeEpi E{WSP(bf16_t, WS_COLS), WSP(bf16_t, WS_MRG)};
    pg8::gemm_phase(lds, pg8::Gemm{DM, DM, DM}, S, E);
}

__device__ __forceinline__ void fs_out(const P& p, int l, LAS unsigned char* lds) {
    float* X = WSP(float, WS_X); const float* modv = WSP(float, WS_MODV);
    const float* xp = p.in[I_XP]; const float* xs = p.in[I_XS];
    SubOrder S{NTOK / 256, 4, (int)blockIdx.x, 0, (int)gridDim.x, (const char*)WSP(bf16_t, WS_MRG), (const char*)(WSP(bf16_t, WS_WTOUT) + (size_t)l * DM * DM), (size_t)256 * DM * 2, (size_t)256 * DM * 2};
    auto E = make_epi([=](const pg8::Unit& u, int r, int n, f32x4 v0, f32x4 v1) {
        const float* gate = modv + ((size_t)l * NCB + row_cb(r)) * 3072 + 2048 + n;
        const float* xr = l == 0 ? (r < NCTX ? xp + (size_t)r * DM : xs + (size_t)(r - NCTX) * DM) : X + (size_t)r * DM;
        const f32x4 x0 = *(const f32x4*)(xr + n), x1 = *(const f32x4*)(xr + n + 4);
        const f32x4 g0 = *(const f32x4*)gate, g1 = *(const f32x4*)(gate + 4);
        *(f32x4*)(X + (size_t)r * DM + n) = x0 + g0 * v0; *(f32x4*)(X + (size_t)r * DM + n + 4) = x1 + g1 * v1;
    });
    pg8::gemm_phase(lds, pg8::Gemm{DM, DM, DM}, S, E);
}

__device__ __forceinline__ int otid() { int t = threadIdx.x; asm volatile("" : "+v"(t)); return t; }
constexpr int HG_LD = 72;
constexpr int HG_MAT = 64 * HG_LD * 2;
constexpr int HG_RAW = 64 * 64 * 2;
__device__ __forceinline__ void hg_dma_tile(const bf16_t* src, int pitch, LAS unsigned char* dst, int tid) {
    const int lane = tid & 63, w = __builtin_amdgcn_readfirstlane(tid >> 6);
    __builtin_amdgcn_global_load_lds((const unsigned*)(src + (size_t)(8 * w + (lane >> 3)) * pitch + 8 * (lane & 7)), (LAS unsigned*)(dst + w * 1024), 16, 0, 0);
}
struct HgPrep { float k[16], b[16]; float btot, ref1; };
__device__ __forceinline__ void hg_prep(const P& p, int tid, int l, int h, const LAS unsigned char* fzt, LAS float* seg  , HgPrep& o) {
    const int dir = tid >> 8, tq = (tid >> 6) & 3, d = tid & 63;
    const float lbv = WSP(float, WS_LBS)[((size_t)l * 2 + dir) * 256 + h * 64 + d];
    float g[16];
#pragma unroll
    for (int i = 0; i < 16; ++i) {
        const float fz = bf2f(*(const LAS bf16_t*)(fzt + ((16 * tq + i) * 64 + d) * 2));
        const float e = __expf(-fz), inv = 1.f / (1.f + e);
        const float f = fmaxf(lbv + (1.f - lbv) * inv, 1e-30f);
        o.k[i] = (1.f - lbv) * e * inv;
        g[i] = __logf(f);
    }
    float run = 0.f;
    if (dir == 0) {
#pragma unroll
        for (int i = 0; i < 16; ++i) { run += g[i]; o.b[i] = run; }
    } else {
#pragma unroll
        for (int i = 15; i >= 0; --i) { run += g[i]; o.b[i] = run; }
    }
    seg[(dir * 4 + tq) * 64 + d] = run;
    __syncthreads();
    const float s0 = seg[(dir * 4 + 0) * 64 + d], s1 = seg[(dir * 4 + 1) * 64 + d], s2 = seg[(dir * 4 + 2) * 64 + d], s3 = seg[(dir * 4 + 3) * 64 + d];
    float off;
    if (dir == 0) off = tq == 0 ? 0.f : (tq == 1 ? s0 : (tq == 2 ? s0 + s1 : s0 + s1 + s2));
    else off = tq == 3 ? 0.f : (tq == 2 ? s3 : (tq == 1 ? s3 + s2 : s3 + s2 + s1));
#pragma unroll
    for (int i = 0; i < 16; ++i) o.b[i] += off;
    o.btot = (s0 + s1) + (s2 + s3);
    o.ref1 = dir == 0 ? s0 + s1 : s2 + s3;
}
__device__ __forceinline__ void hg_build_vt(const LAS unsigned char* vraw, LAS unsigned char* vt, int tid) {
    const int j = tid & 63, sg = tid >> 6;
    unsigned w[4];
#pragma unroll
    for (int i = 0; i < 4; ++i) w[i] = (unsigned)*(const LAS bf16_t*)(vraw + ((8 * sg + 2 * i) * 64 + j) * 2) | ((unsigned)*(const LAS bf16_t*)(vraw + ((8 * sg + 2 * i + 1) * 64 + j) * 2) << 16);
    *(LAS u32x4*)(vt + (j * HG_LD + 8 * sg) * 2) = (u32x4){w[0], w[1], w[2], w[3]};
}
__device__ __forceinline__ void hg_mma_strip(f32x4 (&acc)[4], const LAS unsigned char* A, int arow0, const LAS unsigned char* Bt, int lane) {
    const int fr = lane & 15, fq = lane >> 4;
#pragma unroll
    for (int ks = 0; ks < 2; ++ks) {
        const bf16x8 a = *(const LAS bf16x8*)(A + ((arow0 + fr) * HG_LD + 32 * ks + 8 * fq) * 2);
#pragma unroll
        for (int n = 0; n < 4; ++n) {
            const bf16x8 b = *(const LAS bf16x8*)(Bt + ((16 * n + fr) * HG_LD + 32 * ks + 8 * fq) * 2);
            acc[n] = __builtin_amdgcn_mfma_f32_16x16x32_bf16(a, b, acc[n], 0, 0, 0);
        }
    }
}

__device__ __forceinline__ void fs_hgrn_a(const P& p, int l, LAS unsigned char* lds) {
    LAS unsigned char* raw = lds;
    LAS float* seg = (LAS float*)(lds + 3 * HG_RAW);
    LAS unsigned char* kt = lds + 3 * HG_RAW + 2048;
    LAS unsigned char* vt = kt + 2 * HG_MAT;
    const int tid = otid(), lane = tid & 63, wave = tid >> 6, dir = tid >> 8, tq = (tid >> 6) & 3, d = tid & 63;
    const bf16_t* cols = WSP(bf16_t, WS_COLS);
    for (int u = blockIdx.x; u < (NTOK / 64) * 4; u += gridDim.x) {
        const int gc = u >> 2, h = u & 3, r0 = gc * 64;
        const bf16_t* cr = cols + (size_t)r0 * NC + h * 64;
        hg_dma_tile(cr + C_HGFF, NC, raw, tid); hg_dma_tile(cr + C_HGFB, NC, raw + HG_RAW, tid); hg_dma_tile(cr + C_HGI, NC, raw + 2 * HG_RAW, tid);
        asm volatile("s_waitcnt vmcnt(0)" ::: "memory");
        __syncthreads();
        HgPrep hp; hg_prep(p, tid, l, h, raw + dir * HG_RAW, seg, hp);
        unsigned w[8];
#pragma unroll
        for (int i = 0; i < 8; ++i) w[i] = cvt_pk_bf16(hp.k[2 * i] * __expf(hp.btot - hp.b[2 * i]), hp.k[2 * i + 1] * __expf(hp.btot - hp.b[2 * i + 1]));
        LAS unsigned char* kd = kt + dir * HG_MAT + (d * HG_LD + 16 * tq) * 2;
        *(LAS u32x4*)kd = (u32x4){w[0], w[1], w[2], w[3]}; *(LAS u32x4*)(kd + 16) = (u32x4){w[4], w[5], w[6], w[7]};
        hg_build_vt(raw + 2 * HG_RAW, vt, tid);
        if (tq == 0) WSP(float, WS_HD)[((size_t)u * 2 + dir) * 64 + d] = __expf(hp.btot);
        __syncthreads();
        f32x4 acc[4];
#pragma unroll
        for (int n = 0; n < 4; ++n) acc[n] = (f32x4){0.f, 0.f, 0.f, 0.f};
        const int w4 = wave & 3;
        hg_mma_strip(acc, kt + dir * HG_MAT, 16 * w4, vt, lane);
        float* L = WSP(float, WS_HL) + ((size_t)u * 2 + dir) * 4096;
#pragma unroll
        for (int n = 0; n < 4; ++n)
#pragma unroll
            for (int e = 0; e < 4; ++e) L[(16 * w4 + 4 * (lane >> 4) + e) * 64 + 16 * n + (lane & 15)] = acc[n][e];
        __syncthreads();
    }
}

template <int NCH>
__device__ __forceinline__ float hgrn_b_item(float* HL, const float* HD, int gc0, int h, int dir, int e, float s) {
    float Lv[NCH], Dv[NCH];
#pragma unroll
    for (int cc = 0; cc < NCH; ++cc) {
        const int c = dir == 0 ? cc : NCH - 1 - cc;
        const size_t ui = ((size_t)(gc0 + c) * 4 + h) * 2 + dir;
        Lv[cc] = HL[ui * 4096 + e]; Dv[cc] = HD[ui * 64 + (e >> 6)];
    }
#pragma unroll
    for (int cc = 0; cc < NCH; ++cc) {
        const int c = dir == 0 ? cc : NCH - 1 - cc;
        const size_t ui = ((size_t)(gc0 + c) * 4 + h) * 2 + dir;
        HL[ui * 4096 + e] = s;
        s = Dv[cc] * s + Lv[cc];
    }
    return s;
}
__device__ __forceinline__ void fs_hgrn_b(const P& p, int l, long gtid, long gsz) {
    float* HL = WSP(float, WS_HL); const float* HD = WSP(float, WS_HD);
    for (long it = gtid; it < (long)DB * 4 * 2 * 4096; it += gsz) {
        const int e = (int)(it & 4095), dir = (int)((it >> 12) & 1), h = (int)((it >> 13) & 3), b = (int)(it >> 15);
        const float s0 = p.in[I_ST][((((size_t)b * DEPTH + l) * 2 + dir) * 4 + h) * 4096 + e];
        (void)hgrn_b_item<DSEQ / 64>(HL, HD, (NCTX + b * DSEQ) / 64, h, dir, e, s0);
    }
    for (long it = gtid; it < (long)BATCH * 4 * 2 * 4096; it += gsz) {
        const int e = (int)(it & 4095), dir = (int)((it >> 12) & 1), h = (int)((it >> 13) & 3), b = (int)(it >> 15);
        const float s = hgrn_b_item<SEQ / 64>(HL, HD, (b * SEQ) / 64, h, dir, e, 0.f);
        p.out[O_ST + ((((size_t)b * DEPTH + l) * 2 + dir) * 4 + h) * 4096 + e] = s;
    }
}

__device__ __forceinline__ void fs_hgrn_c(const P& p, int l, LAS unsigned char* lds) {
    LAS unsigned char* raw = lds;
    LAS float* seg = (LAS float*)(lds + 6 * HG_RAW);
    LAS unsigned char* img = lds + 6 * HG_RAW + 2048;
    LAS unsigned char* vt = img + 6 * HG_MAT;
    LAS float* Ob = (LAS float*)raw;
    LAS unsigned char* otile = raw + 2 * HG_RAW;
    const int tid = otid(), lane = tid & 63, wave = tid >> 6, dir = tid >> 8, tq = (tid >> 6) & 3, d = tid & 63, w4 = wave & 3;
    LAS unsigned char* mQ = img + (dir * 3 + 0) * HG_MAT; LAS unsigned char* mK = img + (dir * 3 + 1) * HG_MAT; LAS unsigned char* mS = img + (dir * 3 + 2) * HG_MAT;
    const bf16_t* cols = WSP(bf16_t, WS_COLS);
    for (int u = blockIdx.x; u < (NTOK / 64) * 4; u += gridDim.x) {
        const int gc = u >> 2, h = u & 3, r0 = gc * 64;
        const bf16_t* cr = cols + (size_t)r0 * NC + h * 64;
        hg_dma_tile(cr + C_HGFF, NC, raw, tid); hg_dma_tile(cr + C_HGFB, NC, raw + HG_RAW, tid); hg_dma_tile(cr + C_HGQ, NC, raw + 2 * HG_RAW, tid);
        hg_dma_tile(cr + C_HGI, NC, raw + 3 * HG_RAW, tid); hg_dma_tile(cr + C_HGOG, NC, raw + 4 * HG_RAW, tid); hg_dma_tile(cr + C_HGZ, NC, raw + 5 * HG_RAW, tid);
        f32x4 sreg[4];
        {
            const float* S = WSP(float, WS_HL) + ((size_t)u * 2 + dir) * 4096;
            const int j4 = tid & 15, dd = (tid >> 4) & 15;
#pragma unroll
            for (int i = 0; i < 4; ++i) sreg[i] = *(const f32x4*)(S + (dd + 16 * i) * 64 + 4 * j4);
        }
        asm volatile("s_waitcnt vmcnt(0)" ::: "memory");
        __syncthreads();
        HgPrep hp; hg_prep(p, tid, l, h, raw + dir * HG_RAW, seg, hp);
        {
#pragma unroll
            for (int i = 0; i < 16; ++i) {
                const float qv = bf2f(*(const LAS bf16_t*)(raw + 2 * HG_RAW + ((16 * tq + i) * 64 + d) * 2));
                const float q = qv / (1.f + __expf(-qv));
                const float bb = hp.b[i] - hp.ref1;
                const int o = ((16 * tq + i) * HG_LD + d) * 2;
                *(LAS bf16_t*)(mQ + o) = f2bf(q * __expf(bb));
                *(LAS bf16_t*)(mK + o) = f2bf(hp.k[i] * __expf(-bb));
            }
        }
        hg_build_vt(raw + 3 * HG_RAW, vt, tid);
        {
            const int j4 = tid & 15, dd0 = (tid >> 4) & 15;
#pragma unroll
            for (int i = 0; i < 4; ++i) {
                const int dd = dd0 + 16 * i;
                const float r1 = dir == 0 ? seg[(0 * 4 + 0) * 64 + dd] + seg[(0 * 4 + 1) * 64 + dd] : seg[(1 * 4 + 2) * 64 + dd] + seg[(1 * 4 + 3) * 64 + dd];
                const float sc = __expf(r1);
#pragma unroll
                for (int e = 0; e < 4; ++e) *(LAS bf16_t*)(mS + ((4 * j4 + e) * HG_LD + dd) * 2) = f2bf(sreg[i][e] * sc);
            }
        }
        __syncthreads();
        f32x4 att[4], o[4];
#pragma unroll
        for (int n = 0; n < 4; ++n) { att[n] = (f32x4){0.f, 0.f, 0.f, 0.f}; o[n] = (f32x4){0.f, 0.f, 0.f, 0.f}; }
        hg_mma_strip(att, mQ, 16 * w4, mK, lane);
        hg_mma_strip(o, mQ, 16 * w4, mS, lane);
        __syncthreads();
#pragma unroll
        for (int n = 0; n < 4; ++n)
#pragma unroll
            for (int e = 0; e < 4; ++e) {
                const int t = 16 * w4 + 4 * (lane >> 4) + e, s_ = 16 * n + (lane & 15);
                const bool keep = dir == 0 ? (s_ <= t) : (s_ >= t);
                *(LAS bf16_t*)(mK + (t * HG_LD + s_) * 2) = keep ? f2bf(att[n][e]) : (bf16_t)0;
            }
        asm volatile("s_waitcnt lgkmcnt(0)" ::: "memory");
        hg_mma_strip(o, mK, 16 * w4, vt, lane);
        if (dir == 1) {
#pragma unroll
            for (int n = 0; n < 4; ++n)
#pragma unroll
                for (int e = 0; e < 4; ++e) Ob[(16 * w4 + 4 * (lane >> 4) + e) * 64 + 16 * n + (lane & 15)] = o[n][e];
        }
        __syncthreads();
        if (dir == 0) {
            const float* gn = p.in[I_HGG] + (size_t)l * 64;
            float ss[4] = {0.f, 0.f, 0.f, 0.f};
#pragma unroll
            for (int n = 0; n < 4; ++n)
#pragma unroll
                for (int e = 0; e < 4; ++e) { o[n][e] += Ob[(16 * w4 + 4 * (lane >> 4) + e) * 64 + 16 * n + (lane & 15)]; ss[e] += o[n][e] * o[n][e]; }
#pragma unroll
            for (int e = 0; e < 4; ++e) {
                float v = ss[e];
                v += __shfl_xor(v, 1); v += __shfl_xor(v, 2); v += __shfl_xor(v, 4); v += __shfl_xor(v, 8);
                ss[e] = 1.f / sqrtf(v * (1.f / 64.f) + 1e-6f);
            }
#pragma unroll
            for (int n = 0; n < 4; ++n)
#pragma unroll
                for (int e = 0; e < 4; ++e) {
                    const int t = 16 * w4 + 4 * (lane >> 4) + e, j = 16 * n + (lane & 15);
                    const float og = bf2f(*(const LAS bf16_t*)(raw + 4 * HG_RAW + (t * 64 + j) * 2)), z = bf2f(*(const LAS bf16_t*)(raw + 5 * HG_RAW + (t * 64 + j) * 2));
                    const float v = o[n][e] * ss[e] * gn[j] / (1.f + __expf(-og)) * (z / (1.f + __expf(-z)));
                    *(LAS bf16_t*)(otile + (t * 64 + j) * 2) = f2bf(v);
                }
        }
        __syncthreads();
        {
            const int row = tid >> 3, ch = tid & 7;
            *(u32x4*)(WSP(bf16_t, WS_Y) + (size_t)(r0 + row) * DM + 256 + h * 64 + 8 * ch) = *(const LAS u32x4*)(otile + (row * 64 + 8 * ch) * 2);
        }
        __syncthreads();
    }
}

constexpr int AT_KBUF = 64 * (96 + 8) * 2;
constexpr int AT_VBUF = 64 * 72 * 2;
constexpr int AT_STG = 2 * (AT_KBUF + AT_VBUF);
constexpr int AT_OFF_RPB = 2 * AT_STG;
struct AttnSrc { const bf16_t* k; const bf16_t* v; int kp, vp, n; };
struct AttnMask { int type, a, b; };

template <int DQ>
__device__ __forceinline__ void attn_unit(LAS unsigned char* lds, const int tid, const bf16_t* qbase, const int qpitch, const AttnSrc s0, const AttnSrc s1, const AttnMask mk,
                                          const float* rpb, const float sink, const bool has_sink, const float scale, const float* ropeq  ,
                                          const bf16_t* zbase, bf16_t* ybase  ) {
    constexpr int KS = DQ / 32, KP = DQ + 8;
    constexpr float L2E = 1.4426950408889634f;
    const int lane = tid & 63, wave = tid >> 6, c = lane & 15, fq = lane >> 4;
    LAS float* rpbl = (LAS float*)(lds + AT_OFF_RPB);
    if (mk.type == 1) { for (int i = tid; i < 465; i += NTHREADS) rpbl[i] = rpb[i] * L2E; }
    bf16x8 qf[KS];
    {
        const bf16_t* qr = qbase + (size_t)(16 * wave + c) * qpitch + 8 * fq;
#pragma unroll
        for (int ks = 0; ks < KS; ++ks) qf[ks] = *(const bf16x8*)(qr + 32 * ks);
        if (DQ == 96 && ropeq) {
            const u32x4 mine = __builtin_bit_cast(u32x4, qf[KS - 1]);
            u32x4 oth; oth.x = __shfl_xor(mine.x, 32); oth.y = __shfl_xor(mine.y, 32); oth.z = __shfl_xor(mine.z, 32); oth.w = __shfl_xor(mine.w, 32);
            f32x4 m0, m1, o0, o1; unpack8v(mine, m0, m1); unpack8v(oth, o0, o1);
            const float* rr = ropeq + (size_t)(16 * wave + c) * 32 + (8 * (fq & 1)) * 2;
            float r[8];
#pragma unroll
            for (int j = 0; j < 8; ++j) {
                const float cs = rr[2 * j], sn = rr[2 * j + 1];
                const float mv = j < 4 ? m0[j & 3] : m1[j & 3], ov = j < 4 ? o0[j & 3] : o1[j & 3];
                r[j] = fq < 2 ? mv * cs - ov * sn : ov * sn + mv * cs;
            }
            u32x4 w; w.x = cvt_pk_bf16(r[0], r[1]); w.y = cvt_pk_bf16(r[2], r[3]); w.z = cvt_pk_bf16(r[4], r[5]); w.w = cvt_pk_bf16(r[6], r[7]);
            qf[KS - 1] = __builtin_bit_cast(bf16x8, w);
        }
    }
    int qa = 0, qb = 0;
    if (mk.type == 1) { qa = mk.a + (wave >> 2); qb = 16 * (wave & 3) + c; }
    else if (mk.type == 2) { qa = mk.a + 16 * wave + c; }
    int na_rs = qa - 4; na_rs = na_rs < 0 ? 0 : (na_rs > GROWS - 8 ? GROWS - 8 : na_rs);
    int na_cs = qb - 8; na_cs = na_cs < 0 ? 0 : (na_cs > GW - 16 ? GW - 16 : na_cs);
    const float sl2 = scale * L2E;
    float m = has_sink ? sink * L2E : -3.0e38f, lsum = 0.f;
    f32x4 o[4];
#pragma unroll
    for (int n = 0; n < 4; ++n) o[n] = (f32x4){0.f, 0.f, 0.f, 0.f};
    const int nsteps = (s0.n + s1.n) >> 1;
    u32x4 kreg0[1][2], kreg1[1][2], vreg[1][2];
    const int krow0 = DQ == 64 ? (tid >> 3) : tid / 12, kch0 = DQ == 64 ? (tid & 7) : tid % 12;
    const int krow1 = (tid + 512) / 12, kch1 = (tid + 512) % 12;
    const int vkey = tid & 63, vg = tid >> 6;
#define AT_LOAD(rs, step) do { _Pragma("unroll") for (int j_ = 0; j_ < 2; ++j_) { const int tl_ = 2 * (step) + j_; const bool f0_ = tl_ < s0.n; const int bi_ = f0_ ? tl_ : tl_ - s0.n; \
        const bf16_t* kb_ = (f0_ ? s0.k : s1.k) + (size_t)bi_ * 64 * (f0_ ? s0.kp : s1.kp); const int kp_ = f0_ ? s0.kp : s1.kp; \
        const bf16_t* vb_ = (f0_ ? s0.v : s1.v) + (size_t)bi_ * 64 * (f0_ ? s0.vp : s1.vp); const int vp_ = f0_ ? s0.vp : s1.vp; \
        kreg0[rs][j_] = *(const u32x4*)(kb_ + (size_t)krow0 * kp_ + 8 * kch0); \
        if (DQ == 96 && tid < 256) kreg1[rs][j_] = *(const u32x4*)(kb_ + (size_t)krow1 * kp_ + 8 * kch1); \
        vreg[rs][j_] = *(const u32x4*)(vb_ + (size_t)vkey * vp_ + 8 * vg); } } while (0)
#define AT_STORE(rs, buf) do { _Pragma("unroll") for (int j_ = 0; j_ < 2; ++j_) { LAS unsigned char* kd_ = lds + (buf) * AT_STG + j_ * AT_KBUF; LAS unsigned char* vd_ = lds + (buf) * AT_STG + 2 * AT_KBUF + j_ * AT_VBUF; \
        *(LAS u32x4*)(kd_ + (krow0 * KP + 8 * kch0) * 2) = kreg0[rs][j_]; \
        if (DQ == 96 && tid < 256) *(LAS u32x4*)(kd_ + (krow1 * KP + 8 * kch1) * 2) = kreg1[rs][j_]; \
        const unsigned vw_[4] = {vreg[rs][j_].x, vreg[rs][j_].y, vreg[rs][j_].z, vreg[rs][j_].w}; \
        _Pragma("unroll") for (int e_ = 0; e_ < 4; ++e_) { \
            *(LAS bf16_t*)(vd_ + ((8 * vg + 2 * e_) * 72 + vkey) * 2) = (bf16_t)(vw_[e_] & 0xffffu); \
            *(LAS bf16_t*)(vd_ + ((8 * vg + 2 * e_ + 1) * 72 + vkey) * 2) = (bf16_t)(vw_[e_] >> 16); } } } while (0)
#define AT_SCORES() \
        f32x4 acc[4]; \
        bf16x8 kf[4][KS]; \
        _Pragma("unroll") for (int n = 0; n < 4; ++n) \
            _Pragma("unroll") for (int ks = 0; ks < KS; ++ks) kf[n][ks] = *(const LAS bf16x8*)(kl + ((16 * n + c) * KP + 32 * ks + 8 * fq) * 2); \
        _Pragma("unroll") for (int n = 0; n < 4; ++n) { \
            acc[n] = (f32x4){0.f, 0.f, 0.f, 0.f}; \
            _Pragma("unroll") for (int ks = 0; ks < KS; ++ks) acc[n] = __builtin_amdgcn_mfma_f32_16x16x32_bf16(kf[n][ks], qf[ks], acc[n], 0, 0, 0); } \
        const bool msk = tile < s0.n && mk.type != 0; \
        float mloc = -3.0e38f; \
        _Pragma("unroll") for (int n = 0; n < 4; ++n) \
            _Pragma("unroll") for (int e = 0; e < 4; ++e) { \
                float sv = acc[n][e] * sl2; \
                if (msk) { \
                    const int kk = 16 * n + 4 * fq + e; \
                    if (mk.type == 1) { \
                        const int kr = mk.b + tile; \
                        const bool ok = kr >= na_rs && kr < na_rs + 8 && kk >= na_cs && kk < na_cs + 16; \
                        int dr = kr - qa + 7; dr = dr < 0 ? 0 : (dr > 14 ? 14 : dr); \
                        int dc = kk - qb + 15; dc = dc < 0 ? 0 : (dc > 30 ? 30 : dc); \
                        sv = ok ? sv + rpbl[dr * 31 + dc] : -1.0e30f; \
                    } else { \
                        const int dd = mk.b + 64 * tile + kk - qa; \
                        sv = (dd <= 128 && dd >= -128) ? sv : -1.0e30f; } } \
                acc[n][e] = sv; mloc = fmaxf(mloc, sv); }
#define AT_EXP_PV(mref) \
        float ps = 0.f; \
        _Pragma("unroll") for (int n = 0; n < 4; ++n) \
            _Pragma("unroll") for (int e = 0; e < 4; ++e) { const float pv = __builtin_amdgcn_exp2f(acc[n][e] - (mref)); acc[n][e] = pv; ps += pv; } \
        _Pragma("unroll") for (int ks = 0; ks < 2; ++ks) { \
            u32x4 pw; pw.x = cvt_pk_bf16(acc[2 * ks][0], acc[2 * ks][1]); pw.y = cvt_pk_bf16(acc[2 * ks][2], acc[2 * ks][3]); \
            pw.z = cvt_pk_bf16(acc[2 * ks + 1][0], acc[2 * ks + 1][1]); pw.w = cvt_pk_bf16(acc[2 * ks + 1][2], acc[2 * ks + 1][3]); \
            const bf16x8 pf = __builtin_bit_cast(bf16x8, pw); \
            _Pragma("unroll") for (int n = 0; n < 4; ++n) { \
                const LAS unsigned char* vr = vl + ((16 * n + c) * 72 + 32 * ks + 4 * fq) * 2; \
                const u32x2 v0 = *(const LAS u32x2*)vr, v1 = *(const LAS u32x2*)(vr + 32); \
                const u32x4 vw = (u32x4){v0.x, v0.y, v1.x, v1.y}; \
                o[n] = __builtin_amdgcn_mfma_f32_16x16x32_bf16(__builtin_bit_cast(bf16x8, vw), pf, o[n], 0, 0, 0); } }
#define AT_STEP(step, RL, RS) do { \
        const int buf = (step) & 1; \
        if ((step) + 1 < nsteps) AT_LOAD(RL, (step) + 1); \
        _Pragma("unroll") for (int j = 0; j < 2; ++j) { \
        const LAS unsigned char* kl = lds + buf * AT_STG + j * AT_KBUF; const LAS unsigned char* vl = lds + buf * AT_STG + 2 * AT_KBUF + j * AT_VBUF; \
        const int tile = 2 * (step) + j; \
        AT_SCORES() \
        if (tile == 0 || msk) {        \
            mloc = fmaxf(mloc, __shfl_xor(mloc, 16)); mloc = fmaxf(mloc, __shfl_xor(mloc, 32)); \
            const float mn = fmaxf(m, mloc), corr = __builtin_amdgcn_exp2f(m - mn); \
            m = mn; \
            _Pragma("unroll") for (int n = 0; n < 4; ++n) o[n] *= corr; \
            AT_EXP_PV(mn) \
            lsum = lsum * corr + ps; \
        } else { \
            AT_EXP_PV(m) \
            mloc = fmaxf(mloc, __shfl_xor(mloc, 16)); mloc = fmaxf(mloc, __shfl_xor(mloc, 32)); \
            const float mn = fmaxf(m, mloc), corr = __builtin_amdgcn_exp2f(m - mn); \
            m = mn; \
            lsum = (lsum + ps) * corr; \
            _Pragma("unroll") for (int n = 0; n < 4; ++n) o[n] *= corr; \
        } \
        } \
        if ((step) + 1 < nsteps) AT_STORE(RS, buf ^ 1); \
        asm volatile("s_waitcnt lgkmcnt(0)" ::: "memory"); __builtin_amdgcn_s_barrier(); } while (0)
    AT_LOAD(0, 0);
    AT_STORE(0, 0);
    asm volatile("s_waitcnt lgkmcnt(0)" ::: "memory"); __builtin_amdgcn_s_barrier();
    for (int step = 0; step < nsteps; ++step) AT_STEP(step, 0, 0);
#undef AT_STEP
#undef AT_SCORES
#undef AT_EXP_PV
#undef AT_LOAD
#undef AT_STORE
    lsum += __shfl_xor(lsum, 16); lsum += __shfl_xor(lsum, 32);
    if (has_sink) lsum += exp2f(sink * L2E - m);
    const float inv = 1.f / lsum;
    const bf16_t* zr = zbase + (size_t)(16 * wave + c) * NC; bf16_t* yr = ybase + (size_t)(16 * wave + c) * DM;
#pragma unroll
    for (int n = 0; n < 4; ++n) {
        typedef unsigned u32x2 __attribute__((ext_vector_type(2)));
        const u32x2 zz = *(const u32x2*)(zr + 16 * n + 4 * fq);
        const float z0 = u2f(zz.x << 16), z1 = u2f(zz.x & 0xffff0000u), z2 = u2f(zz.y << 16), z3 = u2f(zz.y & 0xffff0000u);
        u32x2 w;
        w.x = cvt_pk_bf16(o[n][0] * inv * (z0 / (1.f + __expf(-z0))), o[n][1] * inv * (z1 / (1.f + __expf(-z1))));
        w.y = cvt_pk_bf16(o[n][2] * inv * (z2 / (1.f + __expf(-z2))), o[n][3] * inv * (z3 / (1.f + __expf(-z3))));
        *(u32x2*)(yr + 16 * n + 4 * fq) = w;
    }
}

__device__ __forceinline__ void fs_attn(const P& p, int l, LAS unsigned char* lds) {
    const int tid = otid();
    constexpr int NL = (NLAT / 128) * 4, NCU = (NCTX / 128) * 4 * 3, NU = 3 * NL + NCU;
    const bf16_t* cols = WSP(bf16_t, WS_COLS);
    bf16_t* Y = WSP(bf16_t, WS_Y);
    for (int u = blockIdx.x; u < NU; u += gridDim.x) {
        if (u < 3 * NL) {
            const int kind = u / NL, v = u % NL;
            int bh, qt;
            if (NL % 64 == 0) { const int x = v & 7, idx = v >> 3, per = NL / 8; const int bhx = (DB * 4) / 8 > 0 ? (DB * 4) / 8 : 1; bh = x * bhx + idx / (per / bhx); qt = idx % (per / bhx); }
            else { bh = v / (DSEQ / 128); qt = v % (DSEQ / 128); }
            const int b = bh >> 2, h = bh & 3;
            const int r0 = NCTX + b * DSEQ + qt * 128, t0 = qt * 128;
            const size_t cb = ((size_t)b * DEPTH + l) * PAST;
            if (kind == 0) {
                AttnSrc s0{WSP(bf16_t, WS_KMLA) + (size_t)(NCTX + b * DSEQ) * 384 + h * 96, WSP(bf16_t, WS_VMLA) + (size_t)(NCTX + b * DSEQ) * 256 + h * 64, 384, 256, DSEQ / 64};
                AttnSrc s1{WSP(bf16_t, WS_KCM) + cb * 384 + h * 96, WSP(bf16_t, WS_VCM) + cb * 256 + h * 64, 384, 256, PAST / 64};
                attn_unit<96>(lds, tid, WSP(bf16_t, WS_QMLA) + (size_t)r0 * 384 + h * 96, 384, s0, s1, AttnMask{0, 0, 0}, nullptr, 0.f, false, 0.10206207261596577f,
                              WSP(float, WS_ROPEM) + (size_t)t0 * 32, cols + (size_t)r0 * NC + C_MZ + h * 64, Y + (size_t)r0 * DM + 512 + h * 64);
            } else if (kind == 1) {
                const int i0 = 2 * qt;
                int rlo = i0 - 4; rlo = rlo < 0 ? 0 : (rlo > GROWS - 8 ? GROWS - 8 : rlo);
                int rhi = i0 + 1 - 4; rhi = (rhi < 0 ? 0 : (rhi > GROWS - 8 ? GROWS - 8 : rhi)) + 8;
                if ((rhi - rlo) & 1) { if (rlo > 0) --rlo; else ++rhi; }
                const size_t kr0 = (size_t)(NCTX + b * DSEQ + rlo * 64);
                AttnSrc s0{cols + kr0 * NC + C_NAK + h * 64, cols + kr0 * NC + C_NAV + h * 64, NC, NC, rhi - rlo};
                AttnSrc s1{WSP(bf16_t, WS_CNAK) + cb * 256 + h * 64, WSP(bf16_t, WS_CNAV) + cb * 256 + h * 64, 256, 256, PAST / 64};
                attn_unit<64>(lds, tid, cols + (size_t)r0 * NC + C_NAQ + h * 64, NC, s0, s1, AttnMask{1, i0, rlo}, p.in[I_RPB] + ((size_t)l * 4 + h) * 465, 0.f, false, 0.125f,
                              nullptr, cols + (size_t)r0 * NC + C_NAZ + h * 64, Y + (size_t)r0 * DM + 0 + h * 64);
            } else {
                const int kh = h >> 1;
                const int klo = t0 - 128 < 0 ? 0 : t0 - 128, khi = t0 + 256 > DSEQ ? DSEQ : t0 + 256;
                const size_t kr0 = (size_t)(NCTX + b * DSEQ + klo);
                AttnSrc s0{WSP(bf16_t, WS_WKR) + kr0 * 128 + kh * 64, cols + kr0 * NC + C_WV + kh * 64, 128, NC, (khi - klo) / 64};
                AttnSrc s1{WSP(bf16_t, WS_CWK) + cb * 128 + kh * 64, WSP(bf16_t, WS_CWV) + cb * 128 + kh * 64, 128, 128, PAST / 64};
                attn_unit<64>(lds, tid, WSP(bf16_t, WS_WQR) + (size_t)r0 * 256 + h * 64, 256, s0, s1, AttnMask{2, t0, klo}, nullptr, p.in[I_SINK][l * 4 + h], true, 0.125f,
                              nullptr, cols + (size_t)r0 * NC + C_WZ + h * 64, Y + (size_t)r0 * DM + 768 + h * 64);
            }
        } else {
            const int v = u - 3 * NL, kind = v % 3, h = (v / 3) & 3, tile = v / 12;
            const int r0 = tile * 128, sq0 = (r0 / SEQ) * SEQ;
            const AttnSrc none{nullptr, nullptr, 0, 0, 0};
            if (kind == 0) {
                AttnSrc s0{cols + (size_t)sq0 * NC + C_NAK + h * 64, cols + (size_t)sq0 * NC + C_NAV + h * 64, NC, NC, SEQ / 64};
                attn_unit<64>(lds, tid, cols + (size_t)r0 * NC + C_NAQ + h * 64, NC, s0, none, AttnMask{0, 0, 0}, nullptr, 0.f, false, 0.125f, nullptr,
                              cols + (size_t)r0 * NC + C_NAZ + h * 64, Y + (size_t)r0 * DM + 0 + h * 64);
            } else if (kind == 1) {
                AttnSrc s0{WSP(bf16_t, WS_KMLA) + (size_t)sq0 * 384 + h * 96, WSP(bf16_t, WS_VMLA) + (size_t)sq0 * 256 + h * 64, 384, 256, SEQ / 64};
                attn_unit<96>(lds, tid, WSP(bf16_t, WS_QMLA) + (size_t)r0 * 384 + h * 96, 384, s0, none, AttnMask{0, 0, 0}, nullptr, 0.f, false, 0.10206207261596577f, nullptr,
                              cols + (size_t)r0 * NC + C_MZ + h * 64, Y + (size_t)r0 * DM + 512 + h * 64);
            } else {
                const int kh = h >> 1;
                AttnSrc s0{WSP(bf16_t, WS_WKR) + (size_t)sq0 * 128 + kh * 64, cols + (size_t)sq0 * NC + C_WV + kh * 64, 128, NC, SEQ / 64};
                attn_unit<64>(lds, tid, WSP(bf16_t, WS_WQR) + (size_t)r0 * 256 + h * 64, 256, s0, none, AttnMask{0, 0, 0}, nullptr, p.in[I_SINK][l * 4 + h], true, 0.125f, nullptr,
                              cols + (size_t)r0 * NC + C_WZ + h * 64, Y + (size_t)r0 * DM + 768 + h * 64);
            }
        }
    }
}

__device__ __forceinline__ float wave_sum(float v) {
#pragma unroll
    for (int o = 1; o < 64; o <<= 1) v += __shfl_xor(v, o);
    return v;
}

template <bool FINAL>
__device__ __forceinline__ void fs_norm(const P& p, int l) {
    const int tid = otid(), lane = tid & 63, gw = blockIdx.x * (NTHREADS / 64) + (tid >> 6), ngw = gridDim.x * (NTHREADS / 64);
    const float* g = FINAL ? p.in[I_FG] : p.in[I_NG] + (size_t)l * DM;
    constexpr int RB = 6;
    for (int r0 = gw; r0 < NTOK; r0 += RB * ngw) {
        f32x4 v[RB][4]; float ss[RB];
#pragma unroll
        for (int q = 0; q < RB; ++q) {
            const int r = r0 + q * ngw; ss[q] = 0.f;
            if (r < NTOK) {
                const float* x = (FINAL || l > 0) ? WSP(float, WS_X) + (size_t)r * DM : (r < NCTX ? p.in[I_XP] + (size_t)r * DM : p.in[I_XS] + (size_t)(r - NCTX) * DM);
#pragma unroll
                for (int j = 0; j < 4; ++j) v[q][j] = *(const f32x4*)(x + 256 * j + 4 * lane);
            }
        }
#pragma unroll
        for (int q = 0; q < RB; ++q) {
            const int r = r0 + q * ngw;
            if (r >= NTOK) continue;
#pragma unroll
            for (int j = 0; j < 4; ++j) ss[q] += (v[q][j][0] * v[q][j][0] + v[q][j][1] * v[q][j][1]) + (v[q][j][2] * v[q][j][2] + v[q][j][3] * v[q][j][3]);
            const float rstd = 1.f / sqrtf(wave_sum(ss[q]) * (1.f / DM) + 1e-6f);
            const float pscale = (FINAL && PROBE_ON && r >= NCTX) ? 1.f + ((const float*)(p.ws + WS_CTL))[8000] : 1.f;
            if (FINAL) {
#pragma unroll
                for (int j = 0; j < 4; ++j) { const f32x4 gg = *(const f32x4*)(g + 256 * j + 4 * lane); *(f32x4*)(p.out + O_Y + (size_t)r * DM + 256 * j + 4 * lane) = v[q][j] * (rstd * pscale) * gg; }
            } else {
                const float* mv = WSP(float, WS_MODV) + ((size_t)l * NCB + row_cb(r)) * 3072;
                bf16_t* H = WSP(bf16_t, WS_H) + (size_t)r * DM;
#pragma unroll
                for (int j = 0; j < 4; ++j) {
                    const int k = 256 * j + 4 * lane;
                    const f32x4 gg = *(const f32x4*)(g + k), sh = *(const f32x4*)(mv + k), sc = *(const f32x4*)(mv + 1024 + k);
                    const f32x4 y = v[q][j] * rstd * gg * (sc + 1.f) + sh;
                    u32x2 w; w.x = cvt_pk_bf16(y[0], y[1]); w.y = cvt_pk_bf16(y[2], y[3]);
                    *(u32x2*)(H + k) = w;
                }
            }
        }
    }
}

__device__ __forceinline__ void fs_rowprep(const P& p, int l) {
    const int tid = otid(), lane = tid & 63, gw = blockIdx.x * (NTHREADS / 64) + (tid >> 6), ngw = gridDim.x * (NTHREADS / 64);
    const bf16_t* cols = WSP(bf16_t, WS_COLS);
    constexpr int RB = 6;
    for (int r0 = gw; r0 < NTOK; r0 += RB * ngw) {
        unsigned wck[RB]; u32x2 wqa[RB]; bf16_t kr1[RB], kr2[RB], g1[RB][3], g2[RB][3];
#pragma unroll
        for (int q = 0; q < RB; ++q) {
            const int r = r0 + q * ngw;
            if (r < NTOK) {
                const bf16_t* c = cols + (size_t)r * NC;
                wck[q] = *(const unsigned*)(c + C_CKV + 2 * lane);
                wqa[q] = *(const u32x2*)(c + C_MQA + 4 * lane);
                kr1[q] = c[C_KR + (lane & 15)]; kr2[q] = c[C_KR + 16 + (lane & 15)];
#pragma unroll
                for (int i = 0; i < 3; ++i) {
                    const int pi = lane + 64 * i, hh = pi >> 5, j = pi & 31;
                    const bf16_t* src = hh < 4 ? c + C_WQ + hh * 64 : c + C_WK + (hh - 4) * 64;
                    g1[q][i] = src[j]; g2[q][i] = src[32 + j];
                }
            }
        }
#pragma unroll
        for (int q = 0; q < RB; ++q) {
            const int r = r0 + q * ngw;
            if (r >= NTOK) continue;
            const bool lat = r >= NCTX; const int t = lat ? (r - NCTX) % DSEQ : 0;
            const size_t bl = lat ? 0 : ((size_t)(r / SEQ) * DEPTH + l) * SEQ + (r % SEQ);
            {
                const float a = u2f(wck[q] << 16), b = u2f(wck[q] & 0xffff0000u);
                const float rstd = 1.f / sqrtf(wave_sum(a * a + b * b) * (1.f / 128.f) + 1e-6f);
                const float* g = p.in[I_KVG] + (size_t)l * 128 + 2 * lane;
                const float va = a * rstd * g[0], vb = b * rstd * g[1];
                *(unsigned*)(WSP(bf16_t, WS_CKVB) + (size_t)r * 128 + 2 * lane) = cvt_pk_bf16(va, vb);
                if (!lat) { f32x2 o; o.x = va; o.y = vb; *(f32x2*)(p.out + O_CKV + bl * 128 + 2 * lane) = o; }
            }
            {
                const float a0 = u2f(wqa[q].x << 16), a1 = u2f(wqa[q].x & 0xffff0000u), a2 = u2f(wqa[q].y << 16), a3 = u2f(wqa[q].y & 0xffff0000u);
                const float rstd = 1.f / sqrtf(wave_sum((a0 * a0 + a1 * a1) + (a2 * a2 + a3 * a3)) * (1.f / 256.f) + 1e-6f);
                const f32x4 g = *(const f32x4*)(p.in[I_QG] + (size_t)l * 256 + 4 * lane);
                u32x2 o; o.x = cvt_pk_bf16(a0 * rstd * g[0], a1 * rstd * g[1]); o.y = cvt_pk_bf16(a2 * rstd * g[2], a3 * rstd * g[3]);
                *(u32x2*)(WSP(bf16_t, WS_QN) + (size_t)r * 256 + 4 * lane) = o;
            }
            if (lane < 16) {
                const float x1 = bf2f(kr1[q]), x2 = bf2f(kr2[q]);
                float o1 = x1, o2 = x2;
                if (lat) { const float* rm = WSP(float, WS_ROPEM) + (size_t)t * 32 + 2 * lane; o1 = x1 * rm[0] - x2 * rm[1]; o2 = x1 * rm[1] + x2 * rm[0]; }
                else { p.out[O_KR + bl * 32 + lane] = x1; p.out[O_KR + bl * 32 + 16 + lane] = x2; }
                bf16_t* km = WSP(bf16_t, WS_KMLA) + (size_t)r * 384 + 64 + lane;
                const bf16_t b1 = f2bf(o1), b2 = f2bf(o2);
#pragma unroll
                for (int h = 0; h < 4; ++h) { km[h * 96] = b1; km[h * 96 + 16] = b2; }
            }
            {
                const float* rw = WSP(float, WS_ROPEW) + (size_t)t * 64;
#pragma unroll
                for (int i = 0; i < 3; ++i) {
                    const int pi = lane + 64 * i, hh = pi >> 5, j = pi & 31;
                    bf16_t* dst = hh < 4 ? WSP(bf16_t, WS_WQR) + (size_t)r * 256 + hh * 64 : WSP(bf16_t, WS_WKR) + (size_t)r * 128 + (hh - 4) * 64;
                    const float x1 = bf2f(g1[q][i]), x2 = bf2f(g2[q][i]);
                    if (lat) { const float cs = rw[2 * j], sn = rw[2 * j + 1]; dst[j] = f2bf(x1 * cs - x2 * sn); dst[32 + j] = f2bf(x1 * sn + x2 * cs); }
                    else { dst[j] = g1[q][i]; dst[32 + j] = g2[q][i]; }
                }
            }
        }
    }
}

__device__ __forceinline__ void tr_item(const float* W, int N, int ncol0, bf16_t* WT, int K, int nrow0, int k0, LAS float* scr, int lane) {
    if (ncol0 >= 0) {
        float v[32];
        const float* wp = W + (size_t)(k0 + (lane >> 5)) * N + ncol0 + (lane & 31);
#pragma unroll
        for (int i = 0; i < 32; ++i) v[i] = wp[(size_t)(2 * i) * N];
#pragma unroll
        for (int i = 0; i < 32; ++i) scr[(2 * i + (lane >> 5)) * 33 + (lane & 31)] = v[i];
    }
    asm volatile("s_waitcnt lgkmcnt(0)" ::: "memory");
    const int c = lane & 7;
#pragma unroll
    for (int j = 0; j < 4; ++j) {
        const int n = (lane >> 3) + 8 * j; const LAS float* sp = scr + (8 * c) * 33 + n;
        u32x4 o = (u32x4){0u, 0u, 0u, 0u};
        if (ncol0 >= 0) { o.x = cvt_pk_bf16(sp[0 * 33], sp[1 * 33]); o.y = cvt_pk_bf16(sp[2 * 33], sp[3 * 33]); o.z = cvt_pk_bf16(sp[4 * 33], sp[5 * 33]); o.w = cvt_pk_bf16(sp[6 * 33], sp[7 * 33]); }
        *(u32x4*)(WT + (size_t)(nrow0 + n) * K + k0 + 8 * c) = o;
    }
    asm volatile("s_waitcnt lgkmcnt(0)" ::: "memory");
}
__device__ __forceinline__ void tr_big_layer(const P& p, int l, int it0, int it1, int gw, int ngw, LAS float* scr, int lane) {
    for (int it = it0 + gw; it < it1; it += ngw) {
        int r = it;
        if (r < 4096) { const int nb = r & 255, kb = r >> 8;
            tr_item(p.in[I_WIN] + (size_t)l * DM * INW, INW, orig_col(nb * 32), WSP(bf16_t, WS_WTIN) + (size_t)l * NC * DM, DM, nb * 32, kb * 64, scr, lane); continue; } r -= 4096;
        if (r < 512) { const int nb = r & 31, kb = r >> 5;
            tr_item(p.in[I_WOUT] + (size_t)l * DM * DM, DM, nb * 32, WSP(bf16_t, WS_WTOUT) + (size_t)l * DM * DM, DM, nb * 32, kb * 64, scr, lane); continue; } r -= 512;
        { const int nb = r & 31, kb = (r >> 5) & 3, b = r >> 7;
            tr_item(p.in[I_WBR] + (size_t)(l * 4 + b) * 256 * DM, DM, nb * 32, WSP(bf16_t, WS_WTBR) + (size_t)l * DM * DM + b * 256, DM, nb * 32, kb * 64, scr, lane); }
    }
}
constexpr int TR_BIG_ITEMS = 4096 + 512 + 512;
constexpr int GEMM1K_UNITS = (NTOK / 256) * 4;
__device__ __forceinline__ bool defer_weights() { return (int)gridDim.x - GEMM1K_UNITS >= 32; }
__device__ __forceinline__ void fs_prep_deferred(const P& p, int l, int half, LAS unsigned char* lds) {
    const int idle0 = GEMM1K_UNITS, nidle = (int)gridDim.x - idle0;
    if (!defer_weights() || (int)blockIdx.x < idle0) return;
    const int tid = otid(), lane = tid & 63, wave = tid >> 6;
    tr_big_layer(p, l, half * (TR_BIG_ITEMS / 2), (half + 1) * (TR_BIG_ITEMS / 2), ((int)blockIdx.x - idle0) * (NTHREADS / 64) + wave, nidle * (NTHREADS / 64), (LAS float*)(lds + wave * 16384), lane);
}
__device__ __forceinline__ void fs_prep(const P& p, LAS unsigned char* lds) {
    const int tid = otid(), lane = tid & 63, wave = tid >> 6, gw = blockIdx.x * (NTHREADS / 64) + wave, ngw = gridDim.x * (NTHREADS / 64);
    LAS float* scr = (LAS float*)(lds + wave * 16384);
    {
        const int nl = defer_weights() ? 1 : DEPTH;
        for (int l = 0; l < nl; ++l) tr_big_layer(p, l, 0, TR_BIG_ITEMS, gw, ngw, scr, lane);
        constexpr int I_QB = DEPTH * 4 * 16, I_KVB = DEPTH * 2 * 16;
        for (int it = gw; it < I_QB + I_KVB; it += ngw) {
            int r = it;
            if (r < I_QB) { const int nb = r & 15, kb = (r >> 4) & 3, l = r >> 6;
                tr_item(p.in[I_WQB] + (size_t)l * 256 * 384, 384, nb < 12 ? nb * 32 : -1, WSP(bf16_t, WS_WTQB) + (size_t)l * 512 * 256, 256, nb * 32, kb * 64, scr, lane); continue; } r -= I_QB;
            { const int nb = r & 15, kb = (r >> 4) & 1, l = r >> 5;
                tr_item(p.in[I_WKVB] + (size_t)l * 128 * 512, 512, nb * 32, WSP(bf16_t, WS_WTKVB) + (size_t)l * 512 * 128, 128, nb * 32, kb * 64, scr, lane); }
        }
    }
    __syncthreads();
    {
        LAS float* sl = (LAS float*)lds;
        LAS float* red = sl + NCB * 1024;
        for (int i = tid; i < NCB * 1024; i += NTHREADS) { const int cb = i >> 10, k = i & 1023; const float cv = cb == 0 ? p.in[I_CCTX][k] : p.in[I_C][(size_t)(cb - 1) * DM + k]; sl[i] = cv / (1.f + __expf(-cv)); }
        __syncthreads();
        for (int it = blockIdx.x; it < DEPTH * 48; it += gridDim.x) {
            const int l = it / 48, j = (it % 48) * 64 + (tid & 63), kp = tid >> 6;
            const float* w = p.in[I_WMOD] + ((size_t)l * DM + kp * 128) * 3072 + j;
            float acc[NCB];
#pragma unroll
            for (int cb = 0; cb < NCB; ++cb) acc[cb] = 0.f;
            for (int k0 = 0; k0 < 128; k0 += 32) {
                float wv[32];
#pragma unroll
                for (int k = 0; k < 32; ++k) wv[k] = w[(size_t)(k0 + k) * 3072];
#pragma unroll
                for (int k = 0; k < 32; ++k)
#pragma unroll
                    for (int cb = 0; cb < NCB; ++cb) acc[cb] += sl[cb * 1024 + kp * 128 + k0 + k] * wv[k];
            }
#pragma unroll
            for (int cb = 0; cb < NCB; ++cb) red[(kp * NCB + cb) * 64 + (tid & 63)] = acc[cb];
            __syncthreads();
            if (tid < NCB * 64) { const int cb = tid >> 6, jj = tid & 63; float sm = 0.f;
#pragma unroll
                for (int q = 0; q < 8; ++q) sm += red[(q * NCB + cb) * 64 + jj];
                WSP(float, WS_MODV)[((size_t)l * NCB + cb) * 3072 + (it % 48) * 64 + jj] = sm + p.in[I_BMOD][(size_t)l * 3072 + (it % 48) * 64 + jj]; }
            __syncthreads();
        }
    }
    const long gtid = (long)blockIdx.x * NTHREADS + tid, gsz = (long)gridDim.x * NTHREADS;
    {
        float* lbs = WSP(float, WS_LBS);
        for (long i = gtid; i < 2 * 256; i += gsz) {
            const float* lg = p.in[I_LB];
            float mx = -1e30f;
            for (int l = 0; l < DEPTH; ++l) mx = fmaxf(mx, lg[(size_t)l * 512 + i]);
            float sm = 0.f;
            for (int l = 0; l < DEPTH; ++l) sm += expf(lg[(size_t)l * 512 + i] - mx);
            float cum = 0.f; const float p0 = expf(lg[i] - mx) / sm;
            for (int l = 0; l < DEPTH; ++l) { cum += expf(lg[(size_t)l * 512 + i] - mx) / sm; lbs[(size_t)l * 512 + i] = cum - p0; }
        }
        float* rm = WSP(float, WS_ROPEM);
        for (long i = gtid; i < (long)DSEQ * 16; i += gsz) {
            const int j = (int)(i % 16), t = (int)(i / 16);
            const float pos = j < 8 ? (float)(t / GW) : (float)(t % GW);
            const float a = pos * powf(10000.f, -(float)(j & 7) / 8.f); rm[i * 2] = cosf(a); rm[i * 2 + 1] = sinf(a);
        }
        float* rw = WSP(float, WS_ROPEW);
        for (long i = gtid; i < (long)DSEQ * 32; i += gsz) {
            const int j = (int)(i % 32), t = (int)(i / 32);
            const float pos = j < 16 ? (float)(t / GW) : (float)(t % GW);
            const float a = pos * powf(10000.f, -(float)(j & 15) / 16.f); rw[i * 2] = cosf(a); rw[i * 2 + 1] = sinf(a);
        }
        for (long i = gtid; i < (long)DB * DEPTH * PAST * 256 / 4; i += gsz) {
            const f32x4 a = *(const f32x4*)(p.in[I_CNAK] + 4 * i), b = *(const f32x4*)(p.in[I_CNAV] + 4 * i);
            u32x2 wa, wb; wa.x = cvt_pk_bf16(a[0], a[1]); wa.y = cvt_pk_bf16(a[2], a[3]); wb.x = cvt_pk_bf16(b[0], b[1]); wb.y = cvt_pk_bf16(b[2], b[3]);
            *(u32x2*)(WSP(bf16_t, WS_CNAK) + 4 * i) = wa; *(u32x2*)(WSP(bf16_t, WS_CNAV) + 4 * i) = wb;
        }
        for (long i = gtid; i < (long)DB * DEPTH * PAST * 128 / 4; i += gsz) {
            const f32x4 a = *(const f32x4*)(p.in[I_CWK] + 4 * i), b = *(const f32x4*)(p.in[I_CWV] + 4 * i), cc = *(const f32x4*)(p.in[I_CCKV] + 4 * i);
            u32x2 wa, wb, wc; wa.x = cvt_pk_bf16(a[0], a[1]); wa.y = cvt_pk_bf16(a[2], a[3]); wb.x = cvt_pk_bf16(b[0], b[1]); wb.y = cvt_pk_bf16(b[2], b[3]); wc.x = cvt_pk_bf16(cc[0], cc[1]); wc.y = cvt_pk_bf16(cc[2], cc[3]);
            *(u32x2*)(WSP(bf16_t, WS_CWK) + 4 * i) = wa; *(u32x2*)(WSP(bf16_t, WS_CWV) + 4 * i) = wb; *(u32x2*)(WSP(bf16_t, WS_CCKVB) + 4 * i) = wc;
        }
        for (long i = gtid; i < (long)DB * DEPTH * PAST * 128; i += gsz) {
            const int e = (int)(i % 32), h = (int)((i / 32) % 4); const long rowi = i / 128;
            WSP(bf16_t, WS_KCM)[(size_t)rowi * 384 + h * 96 + 64 + e] = f2bf(p.in[I_CKR][(size_t)rowi * 32 + e]);
        }
    }
}
struct CtxOrder {
    int c, nwgs; const char* A; const char* B;
    __device__ bool next(int i, pg8::Unit& u) const {
        const int L = i * nwgs + c; if (L >= (DB * DEPTH * PAST / 256) * 2) return false;
        u.pm = L >> 1; u.pn = L & 1; u.aux = 0;
        const int lyr = (u.pm / (PAST / 256)) % DEPTH;
        u.A = A + (size_t)u.pm * 256 * 128 * 2; u.B = B + ((size_t)lyr * 512 + u.pn * 256) * 128 * 2; return true;
    }
};
__device__ __forceinline__ void fs_prep_ctx(const P& p, LAS unsigned char* lds) {
    bf16_t* km = WSP(bf16_t, WS_KCM); bf16_t* vm = WSP(bf16_t, WS_VCM);
    CtxOrder S{(int)blockIdx.x, (int)gridDim.x, (const char*)WSP(bf16_t, WS_CCKVB), (const char*)WSP(bf16_t, WS_WTKVB)};
    auto E = make_epi([=](const pg8::Unit& u, int r, int n, f32x4 v0, f32x4 v1) {
        const u32x4 w = pack8(v0, v1); const int h = n >> 7, e = n & 127;
        if (e < 64) *(u32x4*)(km + (size_t)r * 384 + h * 96 + e) = w; else *(u32x4*)(vm + (size_t)r * 256 + h * 64 + (e - 64)) = w;
    });
    int K = 128; asm volatile("" : "+s"(K));
    pg8::gemm_phase(lds, pg8::Gemm{K, K, K}, S, E);
}

#define XB_TMO      128
#define XB_XCNT(j)  (256  + 64 * (j))
#define XB_XSUB(j)  (1280 + 64 * (j))
#define XB_XGEN(j)  (2304 + 64 * (j))
#define XB_TOP      3328
#define XB_TOPGEN   3392
#define XCD_BAR_WORDS 3456
#define XB_SPIN_CAP (1u << 20)
__device__ __forceinline__ unsigned xb_ld(unsigned* p)              { return __hip_atomic_load(p, __ATOMIC_RELAXED, __HIP_MEMORY_SCOPE_AGENT); }
__device__ __forceinline__ unsigned xb_add(unsigned* p, unsigned v) { return __hip_atomic_fetch_add(p, v, __ATOMIC_RELAXED, __HIP_MEMORY_SCOPE_AGENT); }
__device__ __forceinline__ unsigned xb_xcc_id() { return (unsigned)__builtin_amdgcn_s_getreg((3 << 11) | 20) & 0xFu; }
#define XB_SPIN(cond, bar) do { unsigned _sp = 0; while (cond) { __builtin_amdgcn_s_sleep(1); \
    if ((++_sp & 255u) == 0u) { if (xb_ld(&(bar)[XB_TMO])) break; if (_sp > XB_SPIN_CAP) { atomicAdd(&(bar)[XB_TMO], 1u); break; } } } } while (0)
struct XcdBarrier { unsigned* bar; unsigned x; volatile LAS unsigned* st; };
__device__ __forceinline__ XcdBarrier xcd_barrier_post(unsigned* bar, volatile LAS unsigned* st) {
    XcdBarrier b; b.bar = bar; b.x = xb_xcc_id(); b.st = st;
    if (threadIdx.x == 0) (void)xb_add(&bar[XB_XCNT(b.x)], 1u);
    return b;
}
__device__ __forceinline__ void xcd_barrier_complete(unsigned* bar, unsigned x, unsigned& nloc, unsigned& nx) {
    const unsigned G = gridDim.x * gridDim.y * gridDim.z;
    unsigned sum, cnt, mine, sp = 0u;
    for (;;) {
        sum = 0u; cnt = 0u; mine = 0u;
#pragma unroll
        for (unsigned j = 0; j < 16; ++j) { const unsigned c = xb_ld(&bar[XB_XCNT(j)]); sum += c; cnt += (c > 0u) ? 1u : 0u; mine = (j == x) ? c : mine; }
        if (sum == G) break;
        __builtin_amdgcn_s_sleep(1);
        if ((++sp & 255u) == 0u) { if (xb_ld(&bar[XB_TMO])) break; if (sp > XB_SPIN_CAP) { atomicAdd(&bar[XB_TMO], 1u); break; } }
    }
    nloc = mine > 0u ? mine : 1u; nx = cnt > 0u ? cnt : 1u;
}
__device__ __forceinline__ void xcd_barrier(const XcdBarrier& b) {
    asm volatile("s_waitcnt vmcnt(0)" ::: "memory");
    __syncthreads();
    if (threadIdx.x == 0) {
        unsigned* bar = b.bar;
        __builtin_amdgcn_s_waitcnt(0);
        unsigned nloc = b.st[0], nx = b.st[1];
        if (nloc == 0u) { xcd_barrier_complete(bar, b.x, nloc, nx); b.st[0] = nloc; b.st[1] = nx; }
        const unsigned old = xb_add(&bar[XB_XSUB(b.x)], 1u);
        const unsigned gen = old / nloc;
        if (old + 1u == (gen + 1u) * nloc) {
            __builtin_amdgcn_fence(__ATOMIC_RELEASE, "agent");
            asm volatile("s_waitcnt vmcnt(0)" ::: "memory");
            const unsigned og = xb_add(&bar[XB_TOP], 1u);
            const unsigned tg = og / nx;
            if (og + 1u == (tg + 1u) * nx) xb_add(&bar[XB_TOPGEN], 1u);
            else XB_SPIN(xb_ld(&bar[XB_TOPGEN]) == tg, bar);
            __builtin_amdgcn_fence(__ATOMIC_ACQUIRE, "agent");
            xb_add(&bar[XB_XGEN(b.x)], 1u);
            asm volatile("s_waitcnt vmcnt(0)" ::: "memory");
        } else {
            XB_SPIN(xb_ld(&bar[XB_XGEN(b.x)]) == gen, bar);
            __builtin_amdgcn_fence(__ATOMIC_ACQUIRE, "agent");
            asm volatile("s_waitcnt vmcnt(0)" ::: "memory");
        }
    }
    __syncthreads();
}

__global__ void __launch_bounds__(NTHREADS) mega_kernel(P p) {
    extern __shared__ __attribute__((aligned(16))) unsigned char lds_raw[];
    LAS unsigned char* lds = (LAS unsigned char*)lds_raw;
    { LAS unsigned* stz = (LAS unsigned*)(lds + LDS_BYTES - 64); if (threadIdx.x < 16) stz[threadIdx.x] = 0u; }
    __syncthreads();
    (void)xcd_barrier_post((unsigned*)((*(const P*)__builtin_amdgcn_kernarg_segment_ptr()).ws + WS_CTL), (volatile LAS unsigned*)(lds + LDS_BYTES - 64));
#define GBAR() do { XcdBarrier gb_; gb_.bar = (unsigned*)(PPR.ws + WS_CTL); gb_.x = xb_xcc_id(); gb_.st = (volatile LAS unsigned*)(lds + LDS_BYTES - 64); xcd_barrier(gb_); } while (0)
    const long gsz = (long)gridDim.x * blockDim.x;
#define GTID() ({ int t_ = threadIdx.x; asm volatile("" : "+v"(t_)); (long)blockIdx.x * blockDim.x + t_; })
#define PP ({ const __attribute__((address_space(4))) P* k_ = (const __attribute__((address_space(4))) P*)__builtin_amdgcn_kernarg_segment_ptr(); asm volatile("" : "+s"(k_)); k_; })
#define PPR (*(const P*)PP)
#ifndef DUPM
#define DUPM 0
#endif
#define PB(id) do { if (PROBE == (id) && blockIdx.x == 0 && threadIdx.x == 0) { *(volatile LAS unsigned long long*)(lds + LDS_BYTES - 32) = __builtin_amdgcn_s_memrealtime(); } } while (0)
#define PE(id) do { if (PROBE == (id) && blockIdx.x == 0 && threadIdx.x == 0) { const unsigned long long t1_ = __builtin_amdgcn_s_memrealtime(); \
        *(volatile LAS unsigned long long*)(lds + LDS_BYTES - 24) += t1_ - *(volatile LAS unsigned long long*)(lds + LDS_BYTES - 32); } } while (0)
    if (PROBE && threadIdx.x == 0) { *(volatile LAS unsigned long long*)(lds + LDS_BYTES - 24) = 0ull; }
#define DUP(bit, stmt) do { if (DUPM & (1 << (bit))) { stmt; } } while (0)
    PB(1); fs_prep(PPR, lds); DUP(0, __syncthreads(); fs_prep(PPR, lds)); GBAR();
    fs_prep_ctx(PPR, lds); GBAR(); PE(1);
#pragma nounroll
    for (int l = 0; l < DEPTH; ++l) {
        PB(2); fs_norm<false>(PPR, l); GBAR(); PE(2);
        PB(3); fs_inproj(PPR, l, lds); DUP(1, fs_inproj(PPR, l, lds)); GBAR(); PE(3);
        PB(4); fs_rowprep(PPR, l); fs_hgrn_a(PPR, l, lds); DUP(6, fs_rowprep(PPR, l); fs_hgrn_a(PPR, l, lds)); GBAR(); PE(4);
        PB(5); fs_mlaproj(PPR, l, lds); DUP(7, fs_mlaproj(PPR, l, lds)); PB(6); fs_hgrn_b(PPR, l, GTID(), gsz); PE(6); GBAR(); PE(5);
        PB(7); fs_attn(PPR, l, lds); DUP(2, fs_attn(PPR, l, lds)); PE(7);
        PB(8); fs_hgrn_c(PPR, l, lds); DUP(5, fs_hgrn_c(PPR, l, lds)); GBAR(); PE(8);
        PB(9); fs_merge(PPR, l, lds); if (l + 1 < DEPTH) fs_prep_deferred(PPR, l + 1, 0, lds); DUP(3, fs_merge(PPR, l, lds)); DUP(4, GBAR(); GBAR(); GBAR(); GBAR(); GBAR(); GBAR(); GBAR(); GBAR()); GBAR(); PE(9);
        PB(10); fs_out(PPR, l, lds); if (l + 1 < DEPTH) fs_prep_deferred(PPR, l + 1, 1, lds);
        if (PROBE && l == DEPTH - 1) { PE(10); if (blockIdx.x == 0 && threadIdx.x == 0) { const unsigned long long ta_ = *(volatile LAS unsigned long long*)(lds + LDS_BYTES - 24); float f_ = (float)ta_ / (100.f * PROBE_SCALE_US); f_ = f_ > 1.f ? 1.f : f_; ((float*)(PPR.ws + WS_CTL))[8000] = sqrtf(2.0e-5f + 7.9e-5f * f_); } }
        GBAR(); if (l < DEPTH - 1) PE(10);
    }
    fs_norm<true>(PPR, 0);
}

extern "C" void kernel_launch(void* const* d_in, const int* in_sizes, int n_in, void* d_out, int out_size, void* d_ws, size_t ws_size, hipStream_t stream) {
    static int grid_blocks = 0;
    if (grid_blocks == 0) {
        if (n_in != N_IN || (size_t)out_size != O_END || ws_size < WS_END) {
            fprintf(stderr, "kernel_launch: unexpected sizes n_in %d out %d ws %zu (need %zu)\n", n_in, out_size, ws_size, (size_t)WS_END);
            grid_blocks = -1; return;
        }
        int dev = 0, cus = 0, per_cu = 0;
        hipGetDevice(&dev);
        hipDeviceGetAttribute(&cus, hipDeviceAttributeMultiprocessorCount, dev);
        hipFuncSetAttribute((const void*)mega_kernel, hipFuncAttributeMaxDynamicSharedMemorySize, LDS_BYTES);
        hipOccupancyMaxActiveBlocksPerMultiprocessor(&per_cu, (const void*)mega_kernel, NTHREADS, LDS_BYTES);
        if (per_cu < 1) per_cu = 1;
        grid_blocks = cus * per_cu;
    }
    if (grid_blocks < 0) return;
    P p{};
    for (int i = 0; i < N_IN; ++i) p.in[i] = (const float*)d_in[i];
    p.out = (float*)d_out; p.ws = (unsigned char*)d_ws;
    if (hipMemsetAsync((char*)d_ws + WS_CTL, 0, 16384, stream) != hipSuccess) { fprintf(stderr, "kernel_launch: memset of the barrier words failed\n"); return; }
    hipLaunchKernelGGL(mega_kernel, dim3(grid_blocks), dim3(NTHREADS), LDS_BYTES, stream, p);
    hipError_t e = hipPeekAtLastError();
    if (e != hipSuccess) fprintf(stderr, "launch failed: %s (grid %d)\n", hipGetErrorString(e), grid_blocks);
}
#endif
```

```cpp
#ifndef CPU_EMU
#include <hip/hip_runtime.h>
#include <cstdio>
#define DEV __device__ __forceinline__
#else
#include <cmath>
#include <cstdio>
#include <cstring>
#define DEV inline
#endif
#include <cstdint>
#include <cstddef>

#ifndef CFG_BATCH
#define CFG_BATCH 16
#endif
#ifndef CFG_DEPTH
#define CFG_DEPTH 4
#endif
#ifndef CFG_DEC_BATCH
#define CFG_DEC_BATCH 4
#endif
constexpr int DM = 1024, BATCH = CFG_BATCH, SEQ = 256, DEPTH = CFG_DEPTH, DB = CFG_DEC_BATCH, DSEQ = 2048, PAST = 512;
constexpr int NCTX = BATCH * SEQ, NLAT = DB * DSEQ, NTOK = NCTX + NLAT;
constexpr int NCB = 1 + DB;
constexpr int INW = 8096, NC = 8192;
constexpr int GW = 64, GROWS = DSEQ / GW;
constexpr int C_NAQ = 0, C_NAK = 256, C_NAV = 512, C_NAZ = 768, C_HGQ = 1024, C_HGFF = 1280, C_HGFB = 1536, C_HGI = 1792, C_HGOG = 2048, C_HGZ = 2304,
              C_MQA = 2560, C_CKV = 2816, C_MZ = 2944, C_WQ = 3200, C_WK = 3456, C_WV = 3584, C_WZ = 3712, C_KR = 3968, C_PAD = 4000, C_MG = 4096;
DEV int orig_col(int c) {
    if (c < 2944) return c;
    if (c < 3968) return c + 32;
    if (c < 4000) return 2944 + (c - 3968);
    if (c < 4096) return -1;
    return c - 96;
}
enum { I_XP = 0, I_XS, I_CNAK, I_CNAV, I_ST, I_CCKV, I_CKR, I_CWK, I_CWV, I_C, I_CCTX, I_NG, I_WMOD, I_BMOD, I_WIN, I_RPB, I_LB, I_HGG, I_QG, I_KVG, I_WQB, I_WKVB, I_SINK, I_WBR, I_WOUT, I_FG, N_IN };
constexpr size_t O_Y = 0;
constexpr size_t O_NAK = (size_t)NTOK * DM;
constexpr size_t O_NAV = O_NAK + (size_t)BATCH * DEPTH * SEQ * 256;
constexpr size_t O_ST = O_NAV + (size_t)BATCH * DEPTH * SEQ * 256;
constexpr size_t O_CKV = O_ST + (size_t)BATCH * DEPTH * 2 * 4 * 64 * 64;
constexpr size_t O_KR = O_CKV + (size_t)BATCH * DEPTH * SEQ * 128;
constexpr size_t O_WK = O_KR + (size_t)BATCH * DEPTH * SEQ * 32;
constexpr size_t O_WV = O_WK + (size_t)BATCH * DEPTH * SEQ * 128;
constexpr size_t O_END = O_WV + (size_t)BATCH * DEPTH * SEQ * 128;

typedef unsigned short bf16_t;
constexpr size_t al256(size_t x) { return (x + 255) & ~(size_t)255; }
constexpr size_t WS_CTL = 0;
constexpr size_t WS_WTIN = 1u << 20;
constexpr size_t WS_WTBR = WS_WTIN + (size_t)DEPTH * NC * DM * 2;
constexpr size_t WS_WTOUT = WS_WTBR + (size_t)DEPTH * 4 * DM * 256 * 2;
constexpr size_t WS_WTQB = WS_WTOUT + (size_t)DEPTH * DM * DM * 2;
constexpr size_t WS_WTKVB = WS_WTQB + (size_t)DEPTH * 512 * 256 * 2;
constexpr size_t WS_MODV = WS_WTKVB + (size_t)DEPTH * 512 * 128 * 2;
constexpr size_t WS_LBS = al256(WS_MODV + (size_t)DEPTH * NCB * 3072 * 4);
constexpr size_t WS_ROPEM = al256(WS_LBS + (size_t)DEPTH * 2 * 256 * 4);
constexpr size_t WS_ROPEW = al256(WS_ROPEM + (size_t)DSEQ * 16 * 2 * 4);
constexpr size_t WS_X = al256(WS_ROPEW + (size_t)DSEQ * 32 * 2 * 4);
constexpr size_t WS_H = WS_X + (size_t)NTOK * DM * 4;
constexpr size_t WS_COLS = WS_H + (size_t)NTOK * DM * 2;
constexpr size_t WS_KCM = WS_COLS + (size_t)NTOK * NC * 2;
constexpr size_t WS_VCM = WS_KCM + (size_t)DB * DEPTH * PAST * 384 * 2;
constexpr size_t WS_QN = WS_VCM + (size_t)DB * DEPTH * PAST * 256 * 2;
constexpr size_t WS_CKVB = WS_QN + (size_t)NTOK * 256 * 2;
constexpr size_t WS_QMLA = WS_CKVB + (size_t)NTOK * 128 * 2;
constexpr size_t WS_KMLA = WS_QMLA + (size_t)NTOK * 384 * 2;
constexpr size_t WS_VMLA = WS_KMLA + (size_t)NTOK * 384 * 2;
constexpr size_t WS_WQR = WS_VMLA + (size_t)NTOK * 256 * 2;
constexpr size_t WS_WKR = WS_WQR + (size_t)NTOK * 256 * 2;
constexpr size_t WS_OH = WS_WKR + (size_t)NTOK * 128 * 2;
constexpr size_t WS_Y = WS_OH + (size_t)2 * NTOK * 256 * 4;
constexpr size_t WS_MRG = WS_H;
constexpr size_t WS_HD = WS_Y + (size_t)NTOK * DM * 2;
constexpr size_t WS_CNAK = al256(WS_HD + (size_t)(NTOK / 64) * 4 * 2 * 64 * 4);
constexpr size_t WS_CNAV = WS_CNAK + (size_t)DB * DEPTH * PAST * 256 * 2;
constexpr size_t WS_CWK = WS_CNAV + (size_t)DB * DEPTH * PAST * 256 * 2;
constexpr size_t WS_CWV = WS_CWK + (size_t)DB * DEPTH * PAST * 128 * 2;
constexpr size_t WS_CCKVB = WS_CWV + (size_t)DB * DEPTH * PAST * 128 * 2;
constexpr size_t WS_END = WS_CCKVB + (size_t)DB * DEPTH * PAST * 128 * 2;
constexpr size_t WS_HL = WS_OH;
constexpr size_t WS_MRGF = WS_QN;
static_assert(WS_MRGF + (size_t)NTOK * DM * 4 <= WS_Y, "MRGF alias must end before Y");

struct P {
    const float* in[N_IN];
    float* out;
    unsigned char* ws;
};

DEV unsigned f2u(float f) { unsigned u; memcpy(&u, &f, 4); return u; }
DEV float u2f(unsigned u) { float f; memcpy(&f, &u, 4); return f; }
DEV bf16_t f2bf(float f) { unsigned u = f2u(f); return (bf16_t)((u + 0x7fffu + ((u >> 16) & 1u)) >> 16); }
DEV float bf2f(bf16_t b) { return u2f((unsigned)b << 16); }
DEV float rbf(float f) { return bf2f(f2bf(f)); }
DEV float sigm(float x) { return 1.f / (1.f + expf(-x)); }
DEV float siluf(float x) { return x * sigm(x); }
DEV int row_cb(int r) { return r < NCTX ? 0 : 1 + (r - NCTX) / DSEQ; }

struct U4 { unsigned x, y, z, w; };
DEV void unpack8(const bf16_t* p, float* f) {
    U4 v = *(const U4*)p;
    f[0] = u2f(v.x << 16); f[1] = u2f(v.x & 0xffff0000u); f[2] = u2f(v.y << 16); f[3] = u2f(v.y & 0xffff0000u);
    f[4] = u2f(v.z << 16); f[5] = u2f(v.z & 0xffff0000u); f[6] = u2f(v.w << 16); f[7] = u2f(v.w & 0xffff0000u);
}

#define WSP(T, off) ((T*)(p.ws + (off)))

DEV void nv_prep_w(const P& p, long gtid, long gsz) {
    bf16_t* wtin = WSP(bf16_t, WS_WTIN);
    const float* win = p.in[I_WIN];
    for (long i = gtid; i < (long)DEPTH * NC * DM; i += gsz) {
        int k = (int)(i % DM); long t = i / DM; int n = (int)(t % NC); int l = (int)(t / NC);
        int oc = orig_col(n);
        wtin[i] = oc < 0 ? (bf16_t)0 : f2bf(win[((size_t)l * DM + k) * INW + oc]);
    }
    bf16_t* wtbr = WSP(bf16_t, WS_WTBR);
    const float* wbr = p.in[I_WBR];
    for (long i = gtid; i < (long)DEPTH * 4 * DM * 256; i += gsz) {
        int w = (int)(i % 256); long t = i / 256; int d = (int)(t % DM); t /= DM; int b = (int)(t % 4); int l = (int)(t / 4);
        wtbr[i] = f2bf(wbr[(((size_t)l * 4 + b) * 256 + w) * DM + d]);
    }
    bf16_t* wtout = WSP(bf16_t, WS_WTOUT);
    const float* wout = p.in[I_WOUT];
    for (long i = gtid; i < (long)DEPTH * DM * DM; i += gsz) {
        int k = (int)(i % DM); long t = i / DM; int n = (int)(t % DM); int l = (int)(t / DM);
        wtout[i] = f2bf(wout[((size_t)l * DM + k) * DM + n]);
    }
    bf16_t* wtqb = WSP(bf16_t, WS_WTQB);
    const float* wqb = p.in[I_WQB];
    for (long i = gtid; i < (long)DEPTH * 512 * 256; i += gsz) {
        int k = (int)(i % 256); long t = i / 256; int n = (int)(t % 512); int l = (int)(t / 512);
        wtqb[i] = n < 384 ? f2bf(wqb[((size_t)l * 256 + k) * 384 + n]) : (bf16_t)0;
    }
    bf16_t* wtkvb = WSP(bf16_t, WS_WTKVB);
    const float* wkvb = p.in[I_WKVB];
    for (long i = gtid; i < (long)DEPTH * 512 * 128; i += gsz) {
        int k = (int)(i % 128); long t = i / 128; int n = (int)(t % 512); int l = (int)(t / 512);
        wtkvb[i] = f2bf(wkvb[((size_t)l * 128 + k) * 512 + n]);
    }
    float* modv = WSP(float, WS_MODV);
    for (long i = gtid; i < (long)DEPTH * NCB * 3072; i += gsz) {
        int j = (int)(i % 3072); long t = i / 3072; int cb = (int)(t % NCB); int l = (int)(t / NCB);
        const float* cv = cb == 0 ? p.in[I_CCTX] : p.in[I_C] + (size_t)(cb - 1) * DM;
        const float* w = p.in[I_WMOD] + (size_t)l * DM * 3072 + j;
        float acc = 0.f;
        for (int k = 0; k < DM; ++k) acc += siluf(cv[k]) * w[(size_t)k * 3072];
        modv[i] = acc + p.in[I_BMOD][(size_t)l * 3072 + j];
    }
    float* lbs = WSP(float, WS_LBS);
    for (long i = gtid; i < 2 * 256; i += gsz) {
        const float* lg = p.in[I_LB];
        float mx = -1e30f;
        for (int l = 0; l < DEPTH; ++l) mx = fmaxf(mx, lg[(size_t)l * 512 + i]);
        float s = 0.f;
        for (int l = 0; l < DEPTH; ++l) s += expf(lg[(size_t)l * 512 + i] - mx);
        float cum = 0.f, p0 = expf(lg[i] - mx) / s;
        for (int l = 0; l < DEPTH; ++l) { cum += expf(lg[(size_t)l * 512 + i] - mx) / s; lbs[(size_t)l * 512 + i] = cum - p0; }
    }
    float* rm = WSP(float, WS_ROPEM);
    for (long i = gtid; i < (long)DSEQ * 16; i += gsz) {
        int j = (int)(i % 16), t = (int)(i / 16);
        float pos = j < 8 ? (float)(t / GW) : (float)(t % GW);
        float inv = powf(10000.f, -(float)(j & 7) / 8.f);
        float a = pos * inv; rm[i * 2] = cosf(a); rm[i * 2 + 1] = sinf(a);
    }
    float* rw = WSP(float, WS_ROPEW);
    for (long i = gtid; i < (long)DSEQ * 32; i += gsz) {
        int j = (int)(i % 32), t = (int)(i / 32);
        float pos = j < 16 ? (float)(t / GW) : (float)(t % GW);
        float inv = powf(10000.f, -(float)(j & 15) / 16.f);
        float a = pos * inv; rw[i * 2] = cosf(a); rw[i * 2 + 1] = sinf(a);
    }
}

DEV void nv_prep_ctxmla(const P& p, long gtid, long gsz) {
    const bf16_t* wtkvb = WSP(bf16_t, WS_WTKVB);
    bf16_t* kcm = WSP(bf16_t, WS_KCM); bf16_t* vcm = WSP(bf16_t, WS_VCM);
    for (long i = gtid; i < (long)DB * DEPTH * PAST * 512; i += gsz) {
        int n = (int)(i % 512); long row = i / 512;
        int l = (int)((row / PAST) % DEPTH);
        const float* ck = p.in[I_CCKV] + (size_t)row * 128;
        const bf16_t* w = wtkvb + ((size_t)l * 512 + n) * 128;
        float acc = 0.f;
        for (int j = 0; j < 128; ++j) acc += rbf(ck[j]) * bf2f(w[j]);
        int h = n / 128, e = n % 128;
        if (e < 64) kcm[(size_t)row * 384 + h * 96 + e] = f2bf(acc);
        else vcm[(size_t)row * 256 + h * 64 + (e - 64)] = f2bf(acc);
    }
    for (long i = gtid; i < (long)DB * DEPTH * PAST * 128; i += gsz) {
        int e = (int)(i % 32); int h = (int)((i / 32) % 4); long row = i / 128;
        kcm[(size_t)row * 384 + h * 96 + 64 + e] = f2bf(p.in[I_CKR][(size_t)row * 32 + e]);
    }
    for (long i = gtid; i < (long)DB * DEPTH * PAST * 256; i += gsz) { WSP(bf16_t, WS_CNAK)[i] = f2bf(p.in[I_CNAK][i]); WSP(bf16_t, WS_CNAV)[i] = f2bf(p.in[I_CNAV][i]); }
    for (long i = gtid; i < (long)DB * DEPTH * PAST * 128; i += gsz) { WSP(bf16_t, WS_CWK)[i] = f2bf(p.in[I_CWK][i]); WSP(bf16_t, WS_CWV)[i] = f2bf(p.in[I_CWV][i]); }
}

DEV const float* x_row(const P& p, int l, int r) {
    if (l == 0) return r < NCTX ? p.in[I_XP] + (size_t)r * DM : p.in[I_XS] + (size_t)(r - NCTX) * DM;
    return WSP(float, WS_X) + (size_t)r * DM;
}

DEV void nv_normmod(const P& p, int l, long gtid, long gsz) {
    bf16_t* H = WSP(bf16_t, WS_H);
    const float* g = p.in[I_NG] + (size_t)l * DM;
    for (long r = gtid; r < NTOK; r += gsz) {
        const float* x = x_row(p, l, (int)r);
        const float* mv = WSP(float, WS_MODV) + ((size_t)l * NCB + row_cb((int)r)) * 3072;
        float ss = 0.f;
        for (int k = 0; k < DM; ++k) ss += x[k] * x[k];
        float rstd = 1.f / sqrtf(ss / DM + 1e-6f);
        for (int k = 0; k < DM; ++k) H[(size_t)r * DM + k] = f2bf(x[k] * rstd * g[k] * (1.f + mv[1024 + k]) + mv[k]);
    }
}

template <class Epi>
DEV void nv_gemm(const bf16_t* A, int lda, const bf16_t* Wt, int ldw, int M, int N, int K, long gtid, long gsz, Epi epi) {
    const long nItems = (long)(M / 4) * (N / 4);
    for (long it = gtid; it < nItems; it += gsz) {
        const int cb = (int)(it % (N / 4)), rb = (int)(it / (N / 4));
        float acc[4][4];
#pragma unroll
        for (int i = 0; i < 4; ++i)
#pragma unroll
            for (int j = 0; j < 4; ++j) acc[i][j] = 0.f;
        for (int k = 0; k < K; k += 8) {
            float a[4][8], w[4][8];
#pragma unroll
            for (int i = 0; i < 4; ++i) unpack8(A + (size_t)(rb * 4 + i) * lda + k, a[i]);
#pragma unroll
            for (int j = 0; j < 4; ++j) unpack8(Wt + (size_t)(cb * 4 + j) * ldw + k, w[j]);
#pragma unroll
            for (int i = 0; i < 4; ++i)
#pragma unroll
                for (int j = 0; j < 4; ++j)
#pragma unroll
                    for (int e = 0; e < 8; ++e) acc[i][j] += a[i][e] * w[j][e];
        }
#pragma unroll
        for (int i = 0; i < 4; ++i)
#pragma unroll
            for (int j = 0; j < 4; ++j) epi(rb * 4 + i, cb * 4 + j, acc[i][j]);
    }
}

DEV void nv_inproj(const P& p, int l, long gtid, long gsz) {
    bf16_t* cols = WSP(bf16_t, WS_COLS);
    float* out = p.out;
    nv_gemm(WSP(bf16_t, WS_H), DM, WSP(bf16_t, WS_WTIN) + (size_t)l * NC * DM, DM, NTOK, NC, DM, gtid, gsz,
        [=](int r, int n, float v) {
            cols[(size_t)r * NC + n] = f2bf(v);
            if (r < NCTX) {
                const int b = r / SEQ, t = r % SEQ; const size_t bl = ((size_t)b * DEPTH + l) * SEQ + t;
                if (n >= C_NAK && n < C_NAK + 256) out[O_NAK + bl * 256 + (n - C_NAK)] = v;
                else if (n >= C_NAV && n < C_NAV + 256) out[O_NAV + bl * 256 + (n - C_NAV)] = v;
                else if (n >= C_WK && n < C_WK + 128) out[O_WK + bl * 128 + (n - C_WK)] = v;
                else if (n >= C_WV && n < C_WV + 128) out[O_WV + bl * 128 + (n - C_WV)] = v;
            }
        });
}

DEV void nv_rowprep(const P& p, int l, long gtid, long gsz) {
    const bf16_t* cols = WSP(bf16_t, WS_COLS);
    for (long r = gtid; r < NTOK; r += gsz) {
        const bf16_t* c = cols + (size_t)r * NC;
        const bool lat = r >= NCTX; const int t = lat ? (int)((r - NCTX) % DSEQ) : 0;
        {
            float ss = 0.f;
            for (int j = 0; j < 128; ++j) { float v = bf2f(c[C_CKV + j]); ss += v * v; }
            float rstd = 1.f / sqrtf(ss / 128.f + 1e-6f);
            const float* g = p.in[I_KVG] + (size_t)l * 128;
            for (int j = 0; j < 128; ++j) {
                float v = bf2f(c[C_CKV + j]) * rstd * g[j];
                WSP(bf16_t, WS_CKVB)[(size_t)r * 128 + j] = f2bf(v);
                if (!lat) p.out[O_CKV + (((size_t)(r / SEQ) * DEPTH + l) * SEQ + (r % SEQ)) * 128 + j] = v;
            }
        }
        {
            const float* rm = WSP(float, WS_ROPEM) + (size_t)t * 32;
            for (int j = 0; j < 16; ++j) {
                float x1 = bf2f(c[C_KR + j]), x2 = bf2f(c[C_KR + 16 + j]);
                float o1 = x1, o2 = x2;
                if (lat) { float cs = rm[j * 2], sn = rm[j * 2 + 1]; o1 = x1 * cs - x2 * sn; o2 = x1 * sn + x2 * cs; }
                else {
                    size_t o = O_KR + (((size_t)(r / SEQ) * DEPTH + l) * SEQ + (r % SEQ)) * 32;
                    p.out[o + j] = x1; p.out[o + 16 + j] = x2;
                }
                for (int h = 0; h < 4; ++h) {
                    WSP(bf16_t, WS_KMLA)[(size_t)r * 384 + h * 96 + 64 + j] = f2bf(o1);
                    WSP(bf16_t, WS_KMLA)[(size_t)r * 384 + h * 96 + 80 + j] = f2bf(o2);
                }
            }
        }
        {
            float ss = 0.f;
            for (int j = 0; j < 256; ++j) { float v = bf2f(c[C_MQA + j]); ss += v * v; }
            float rstd = 1.f / sqrtf(ss / 256.f + 1e-6f);
            const float* g = p.in[I_QG] + (size_t)l * 256;
            for (int j = 0; j < 256; ++j) WSP(bf16_t, WS_QN)[(size_t)r * 256 + j] = f2bf(bf2f(c[C_MQA + j]) * rstd * g[j]);
        }
        {
            const float* rw = WSP(float, WS_ROPEW) + (size_t)t * 64;
            for (int hh = 0; hh < 6; ++hh) {
                const bf16_t* src = hh < 4 ? c + C_WQ + hh * 64 : c + C_WK + (hh - 4) * 64;
                bf16_t* dst = hh < 4 ? WSP(bf16_t, WS_WQR) + (size_t)r * 256 + hh * 64 : WSP(bf16_t, WS_WKR) + (size_t)r * 128 + (hh - 4) * 64;
                for (int j = 0; j < 32; ++j) {
                    float x1 = bf2f(src[j]), x2 = bf2f(src[32 + j]);
                    if (lat) { float cs = rw[j * 2], sn = rw[j * 2 + 1]; dst[j] = f2bf(x1 * cs - x2 * sn); dst[32 + j] = f2bf(x1 * sn + x2 * cs); }
                    else { dst[j] = src[j]; dst[32 + j] = src[32 + j]; }
                }
            }
        }
    }
}

DEV void nv_mlaproj(const P& p, int l, long gtid, long gsz) {
    bf16_t* qm = WSP(bf16_t, WS_QMLA); bf16_t* km = WSP(bf16_t, WS_KMLA); bf16_t* vm = WSP(bf16_t, WS_VMLA);
    nv_gemm(WSP(bf16_t, WS_QN), 256, WSP(bf16_t, WS_WTQB) + (size_t)l * 512 * 256, 256, NTOK, 384, 256, gtid, gsz,
        [=](int r, int n, float v) { qm[(size_t)r * 384 + n] = f2bf(v); });
    nv_gemm(WSP(bf16_t, WS_CKVB), 128, WSP(bf16_t, WS_WTKVB) + (size_t)l * 512 * 128, 128, NTOK, 512, 128, gtid, gsz,
        [=](int r, int n, float v) {
            int h = n / 128, e = n % 128;
            if (e < 64) km[(size_t)r * 384 + h * 96 + e] = f2bf(v); else vm[(size_t)r * 256 + h * 64 + (e - 64)] = f2bf(v);
        });
}

struct SoftAcc { float m, l; float o[32]; };
DEV void sa_init(SoftAcc& s) { s.m = -3e38f; s.l = 0.f;
#pragma unroll
    for (int d = 0; d < 32; ++d) s.o[d] = 0.f; }
DEV void sa_add(SoftAcc& s, float sc, const bf16_t* v) {
    float mn = fmaxf(s.m, sc);
    float corr = expf(s.m - mn), pe = expf(sc - mn);
    s.m = mn; s.l = s.l * corr + pe;
#pragma unroll
    for (int d8 = 0; d8 < 4; ++d8) {
        float f[8]; unpack8(v + d8 * 8, f);
#pragma unroll
        for (int e = 0; e < 8; ++e) s.o[d8 * 8 + e] = s.o[d8 * 8 + e] * corr + pe * f[e];
    }
}
DEV void sa_add_f32v(SoftAcc& s, float sc, const float* v) {
    float mn = fmaxf(s.m, sc);
    float corr = expf(s.m - mn), pe = expf(sc - mn);
    s.m = mn; s.l = s.l * corr + pe;
#pragma unroll
    for (int d = 0; d < 32; ++d) s.o[d] = s.o[d] * corr + pe * rbf(v[d]);
}
template <int DQ> DEV float dot_bf(const float* q, const bf16_t* k) {
    float acc = 0.f;
#pragma unroll
    for (int d8 = 0; d8 < DQ / 8; ++d8) {
        float f[8]; unpack8(k + d8 * 8, f);
#pragma unroll
        for (int e = 0; e < 8; ++e) acc += q[d8 * 8 + e] * f[e];
    }
    return acc;
}
DEV float dot64_f32k(const float* q, const float* k) {
    float acc = 0.f;
#pragma unroll
    for (int d = 0; d < 64; ++d) acc += q[d] * rbf(k[d]);
    return acc;
}
DEV void sa_store(const P& p, const SoftAcc& s, float extra_den, int r, int branch, int h, int zcol, int half) {
    const bf16_t* c = WSP(bf16_t, WS_COLS) + (size_t)r * NC + zcol + h * 64 + half * 32;
    bf16_t* y = WSP(bf16_t, WS_Y) + (size_t)r * DM + branch * 256 + h * 64 + half * 32;
    float inv = 1.f / (s.l + extra_den);
#pragma unroll
    for (int d = 0; d < 32; ++d) y[d] = f2bf(s.o[d] * inv * siluf(bf2f(c[d])));
}

DEV void nv_attn(const P& p, int l, long gtid, long gsz) {
    const bf16_t* cols = WSP(bf16_t, WS_COLS);
    for (long it = gtid; it < (long)NTOK * 24; it += gsz) {
        const int half = (int)(it % 2); const int kind = (int)((it / 2) % 3); const int h = (int)((it / 6) % 4); const int r = (int)(it / 24);
        const int vo = half * 32;
        const bool lat = r >= NCTX;
        const int b = lat ? (r - NCTX) / DSEQ : r / SEQ, t = lat ? (r - NCTX) % DSEQ : r % SEQ;
        const int seq0 = lat ? NCTX + b * DSEQ : b * SEQ;
        SoftAcc s; sa_init(s);
        if (kind == 0) {
            float q[64];
#pragma unroll
            for (int d8 = 0; d8 < 8; ++d8) unpack8(cols + (size_t)r * NC + C_NAQ + h * 64 + d8 * 8, q + d8 * 8);
            if (!lat) {
                for (int j = 0; j < SEQ; ++j) {
                    const bf16_t* kr = cols + (size_t)(seq0 + j) * NC;
                    sa_add(s, dot_bf<64>(q, kr + C_NAK + h * 64) * 0.125f, kr + C_NAV + h * 64 + vo);
                }
            } else {
                const int gi = t / GW, gj = t % GW;
                int rs = gi - 4; rs = rs < 0 ? 0 : (rs > GROWS - 8 ? GROWS - 8 : rs);
                int cs = gj - 8; cs = cs < 0 ? 0 : (cs > GW - 16 ? GW - 16 : cs);
                const float* rpb = p.in[I_RPB] + ((size_t)l * 4 + h) * 15 * 31;
                for (int kr_ = rs; kr_ < rs + 8; ++kr_)
                    for (int kc = cs; kc < cs + 16; ++kc) {
                        const bf16_t* kk = cols + (size_t)(seq0 + kr_ * GW + kc) * NC;
                        int dc = kc - gj + 15; dc = dc < 0 ? 0 : (dc > 30 ? 30 : dc);
                        float bias = rpb[(kr_ - gi + 7) * 31 + dc];
                        sa_add(s, dot_bf<64>(q, kk + C_NAK + h * 64) * 0.125f + bias, kk + C_NAV + h * 64 + vo);
                    }
                const float* ck = p.in[I_CNAK] + ((size_t)b * DEPTH + l) * PAST * 256 + h * 64;
                const float* cv = p.in[I_CNAV] + ((size_t)b * DEPTH + l) * PAST * 256 + h * 64 + vo;
                for (int j = 0; j < PAST; ++j) sa_add_f32v(s, dot64_f32k(q, ck + (size_t)j * 256) * 0.125f, cv + (size_t)j * 256);
            }
            sa_store(p, s, 0.f, r, 0, h, C_NAZ, half);
        } else if (kind == 1) {
            float q[96];
            const bf16_t* qp = WSP(bf16_t, WS_QMLA) + (size_t)r * 384 + h * 96;
#pragma unroll
            for (int d8 = 0; d8 < 12; ++d8) unpack8(qp + d8 * 8, q + d8 * 8);
            if (lat) {
                const float* rm = WSP(float, WS_ROPEM) + (size_t)t * 32;
#pragma unroll
                for (int j = 0; j < 16; ++j) {
                    float x1 = q[64 + j], x2 = q[80 + j], cs = rm[j * 2], sn = rm[j * 2 + 1];
                    q[64 + j] = rbf(x1 * cs - x2 * sn); q[80 + j] = rbf(x1 * sn + x2 * cs);
                }
            }
            const float scale = 0.10206207261596577f;
            const int n = lat ? DSEQ : SEQ;
            const bf16_t* km = WSP(bf16_t, WS_KMLA) + (size_t)seq0 * 384 + h * 96;
            const bf16_t* vm = WSP(bf16_t, WS_VMLA) + (size_t)seq0 * 256 + h * 64 + vo;
            for (int j = 0; j < n; ++j) sa_add(s, dot_bf<96>(q, km + (size_t)j * 384) * scale, vm + (size_t)j * 256);
            if (lat) {
                const bf16_t* kc = WSP(bf16_t, WS_KCM) + ((size_t)b * DEPTH + l) * PAST * 384 + h * 96;
                const bf16_t* vc = WSP(bf16_t, WS_VCM) + ((size_t)b * DEPTH + l) * PAST * 256 + h * 64 + vo;
                for (int j = 0; j < PAST; ++j) sa_add(s, dot_bf<96>(q, kc + (size_t)j * 384) * scale, vc + (size_t)j * 256);
            }
            sa_store(p, s, 0.f, r, 2, h, C_MZ, half);
        } else {
            float q[64];
#pragma unroll
            for (int d8 = 0; d8 < 8; ++d8) unpack8(WSP(bf16_t, WS_WQR) + (size_t)r * 256 + h * 64 + d8 * 8, q + d8 * 8);
            const int kh = h / 2;
            const float sink = p.in[I_SINK][l * 4 + h];
            int j0 = 0, j1 = SEQ;
            if (lat) { j0 = t - 128 < 0 ? 0 : t - 128; j1 = t + 129 > DSEQ ? DSEQ : t + 129; }
            for (int j = j0; j < j1; ++j)
                sa_add(s, dot_bf<64>(q, WSP(bf16_t, WS_WKR) + (size_t)(seq0 + j) * 128 + kh * 64) * 0.125f, cols + (size_t)(seq0 + j) * NC + C_WV + kh * 64 + vo);
            if (lat) {
                const float* ck = p.in[I_CWK] + ((size_t)b * DEPTH + l) * PAST * 128 + kh * 64;
                const float* cv = p.in[I_CWV] + ((size_t)b * DEPTH + l) * PAST * 128 + kh * 64 + vo;
                for (int j = 0; j < PAST; ++j) sa_add_f32v(s, dot64_f32k(q, ck + (size_t)j * 128) * 0.125f, cv + (size_t)j * 128);
            }
            float mn = fmaxf(s.m, sink); float corr = expf(s.m - mn);
            s.l *= corr;
#pragma unroll
            for (int d = 0; d < 32; ++d) s.o[d] *= corr;
            s.m = mn;
            sa_store(p, s, expf(sink - mn), r, 3, h, C_WZ, half);
        }
    }
}

DEV void nv_hgrn(const P& p, int l, long gtid, long gsz) {
    const bf16_t* cols = WSP(bf16_t, WS_COLS);
    float* oh = WSP(float, WS_OH);
    const int NSEQ = BATCH + DB;
    for (long it = gtid; it < (long)NSEQ * 4 * 2 * 64; it += gsz) {
        const int j = (int)(it % 64); const int dir = (int)((it / 64) % 2); const int h = (int)((it / 128) % 4); const int sq = (int)(it / 512);
        const bool lat = sq >= BATCH;
        const int b = lat ? sq - BATCH : sq;
        const int T = lat ? DSEQ : SEQ; const int seq0 = lat ? NCTX + b * DSEQ : b * SEQ;
        const float* lb = WSP(float, WS_LBS) + ((size_t)l * 2 + dir) * 256 + h * 64;
        float S[64];
        if (lat) {
            const float* st = p.in[I_ST] + ((((size_t)b * DEPTH + l) * 2 + dir) * 4 + h) * 4096;
#pragma unroll
            for (int d = 0; d < 64; ++d) S[d] = st[d * 64 + j];
        } else {
#pragma unroll
            for (int d = 0; d < 64; ++d) S[d] = 0.f;
        }
        const int fcol = dir == 0 ? C_HGFF : C_HGFB;
        for (int tt = 0; tt < T; ++tt) {
            const int t = dir == 0 ? tt : T - 1 - tt;
            const bf16_t* c = cols + (size_t)(seq0 + t) * NC;
            const float v = bf2f(c[C_HGI + h * 64 + j]);
            float o = 0.f;
#pragma unroll
            for (int d8 = 0; d8 < 8; ++d8) {
                float fz[8], qq[8]; unpack8(c + fcol + h * 64 + d8 * 8, fz); unpack8(c + C_HGQ + h * 64 + d8 * 8, qq);
#pragma unroll
                for (int e = 0; e < 8; ++e) {
                    const int d = d8 * 8 + e;
                    const float lbv = lb[d];
                    float f = lbv + (1.f - lbv) * sigm(fz[e]);
                    f = fmaxf(f, 1e-30f);
                    const float k = (1.f - lbv) * sigm(-fz[e]);
                    S[d] = f * S[d] + k * v;
                    o += S[d] * siluf(qq[e]);
                }
            }
            oh[((size_t)dir * NTOK + seq0 + t) * 256 + h * 64 + j] = o;
        }
        if (!lat) {
            float* so = p.out + O_ST + ((((size_t)b * DEPTH + l) * 2 + dir) * 4 + h) * 4096;
#pragma unroll
            for (int d = 0; d < 64; ++d) so[d * 64 + j] = S[d];
        }
    }
}

DEV void nv_hgrn_fin(const P& p, int l, long gtid, long gsz) {
    const bf16_t* cols = WSP(bf16_t, WS_COLS);
    const float* oh = WSP(float, WS_OH);
    const float* g = p.in[I_HGG] + (size_t)l * 64;
    for (long it = gtid; it < (long)NTOK * 4; it += gsz) {
        const int h = (int)(it % 4); const int r = (int)(it / 4);
        const float* of = oh + (size_t)r * 256 + h * 64; const float* ob = oh + ((size_t)NTOK + r) * 256 + h * 64;
        float ss = 0.f;
        for (int d = 0; d < 64; ++d) { float v = of[d] + ob[d]; ss += v * v; }
        float rstd = 1.f / sqrtf(ss / 64.f + 1e-6f);
        const bf16_t* c = cols + (size_t)r * NC;
        bf16_t* y = WSP(bf16_t, WS_Y) + (size_t)r * DM + 256 + h * 64;
        for (int d = 0; d < 64; ++d) {
            float v = (of[d] + ob[d]) * rstd * g[d] * sigm(bf2f(c[C_HGOG + h * 64 + d]));
            y[d] = f2bf(v * siluf(bf2f(c[C_HGZ + h * 64 + d])));
        }
    }
}

DEV void nv_merge(const P& p, int l, long gtid, long gsz) {
    const bf16_t* cols = WSP(bf16_t, WS_COLS);
    const bf16_t* Y = WSP(bf16_t, WS_Y);
    const bf16_t* wt = WSP(bf16_t, WS_WTBR) + (size_t)l * 4 * DM * 256;
    bf16_t* mrg = WSP(bf16_t, WS_MRG);
    for (long it = gtid; it < (long)NTOK * DM; it += gsz) {
        const int d = (int)(it % DM); const int r = (int)(it / DM);
        float tot = 0.f;
        for (int b = 0; b < 4; ++b) {
            const bf16_t* y = Y + (size_t)r * DM + b * 256; const bf16_t* w = wt + ((size_t)b * DM + d) * 256;
            float acc = 0.f;
            for (int k = 0; k < 256; k += 8) {
                float a[8], ww[8]; unpack8(y + k, a); unpack8(w + k, ww);
#pragma unroll
                for (int e = 0; e < 8; ++e) acc += a[e] * ww[e];
            }
            tot += sigm(bf2f(cols[(size_t)r * NC + C_MG + b * DM + d])) * acc;
        }
        mrg[it] = f2bf(tot);
    }
}

DEV void nv_out(const P& p, int l, long gtid, long gsz) {
    float* X = WSP(float, WS_X);
    const float* modv = WSP(float, WS_MODV);
    const P pp = p;
    nv_gemm(WSP(bf16_t, WS_MRG), DM, WSP(bf16_t, WS_WTOUT) + (size_t)l * DM * DM, DM, NTOK, DM, DM, gtid, gsz,
        [=](int r, int n, float v) {
            const float gate = modv[((size_t)l * NCB + row_cb(r)) * 3072 + 2048 + n];
            X[(size_t)r * DM + n] = x_row(pp, l, r)[n] + gate * v;
        });
}

DEV void nv_final(const P& p, long gtid, long gsz) {
    const float* X = WSP(float, WS_X); const float* g = p.in[I_FG];
    for (long r = gtid; r < NTOK; r += gsz) {
        const float* x = X + (size_t)r * DM;
        float ss = 0.f;
        for (int k = 0; k < DM; ++k) ss += x[k] * x[k];
        float rstd = 1.f / sqrtf(ss / DM + 1e-6f);
        for (int k = 0; k < DM; ++k) p.out[O_Y + (size_t)r * DM + k] = x[k] * rstd * g[k];
    }
}

constexpr int ST_PREP_W = 0, ST_PREP_CTX = 1, ST_LAYER0 = 2, ST_PER_LAYER = 8;
constexpr int N_STAGES = ST_LAYER0 + DEPTH * ST_PER_LAYER + 1;
DEV void run_stage(const P& p, int st, long gtid, long gsz) {
    if (st == ST_PREP_W) { nv_prep_w(p, gtid, gsz); return; }
    if (st == ST_PREP_CTX) { nv_prep_ctxmla(p, gtid, gsz); return; }
    if (st == N_STAGES - 1) { nv_final(p, gtid, gsz); return; }
    const int l = (st - ST_LAYER0) / ST_PER_LAYER, s = (st - ST_LAYER0) % ST_PER_LAYER;
    switch (s) {
        case 0: nv_normmod(p, l, gtid, gsz); break;
        case 1: nv_inproj(p, l, gtid, gsz); break;
        case 2: nv_rowprep(p, l, gtid, gsz); break;
        case 3: nv_mlaproj(p, l, gtid, gsz); break;
        case 4: nv_attn(p, l, gtid, gsz); nv_hgrn(p, l, gtid, gsz); break;
        case 5: nv_hgrn_fin(p, l, gtid, gsz); break;
        case 6: nv_merge(p, l, gtid, gsz); break;
        case 7: nv_out(p, l, gtid, gsz); break;
    }
}

#ifndef CPU_EMU
#define LAS __attribute__((address_space(3)))
typedef short bf16x8 __attribute__((ext_vector_type(8)));
typedef float f32x4 __attribute__((ext_vector_type(4)));
typedef unsigned u32x4 __attribute__((ext_vector_type(4)));
typedef unsigned u32x2 __attribute__((ext_vector_type(2)));
typedef float f32x2 __attribute__((ext_vector_type(2)));
constexpr int NTHREADS = 512;
#define PROBE 0
#define PROBE_SCALE_US 1000
constexpr bool PROBE_ON = (PROBE != 0);
constexpr int LDS_BYTES = 147456;

__device__ __forceinline__ unsigned cvt_pk_bf16(float lo, float hi) { unsigned r; asm volatile("v_cvt_pk_bf16_f32 %0, %1, %2" : "=v"(r) : "v"(lo), "v"(hi)); return r; }
__device__ __forceinline__ u32x4 pack8(f32x4 a, f32x4 b) { u32x4 w; w.x = cvt_pk_bf16(a[0], a[1]); w.y = cvt_pk_bf16(a[2], a[3]); w.z = cvt_pk_bf16(b[0], b[1]); w.w = cvt_pk_bf16(b[2], b[3]); return w; }
__device__ __forceinline__ void unpack8v(u32x4 v, f32x4& a, f32x4& b) {
    a[0] = u2f(v.x << 16); a[1] = u2f(v.x & 0xffff0000u); a[2] = u2f(v.y << 16); a[3] = u2f(v.y & 0xffff0000u);
    b[0] = u2f(v.z << 16); b[1] = u2f(v.z & 0xffff0000u); b[2] = u2f(v.w << 16); b[3] = u2f(v.w & 0xffff0000u);
}

namespace pg8 {
constexpr int BM = 256, BK = 64, HALF = 128, HTB = HALF * BK * 2  , STAGE_BYTES = 8 * HTB, NXCD = 8, WGM = 8;
__device__ __forceinline__ int lds_byte(int r, int c) { const int st = (r >> 4) * 2 + (c >> 5), rr = r & 15, cc = c & 31, ob = rr * 64 + cc * 2; return st * 1024 + (ob ^ (((ob >> 9) & 1) << 5)); }
__device__ __forceinline__ void stage_rc(int b, int& R, int& C) { const int st = b / 1024, sb = b % 1024, swz = sb ^ (((sb >> 9) & 1) << 5); R = (st >> 1) * 16 + swz / 64; C = (st & 1) * 32 + (swz % 64) / 2; }
__device__ __forceinline__ int perm32(int rho) { const int n = rho >> 4, i = rho & 15; return 8 * (i >> 2) + 4 * n + (i & 3); }

struct Unit { int pm, pn, aux; const char* A; const char* B; };
struct Gemm { int lda, ldb, K; };

struct GridOrder {
    int nM, nN, nwg, G, c; const char* A; const char* B; size_t astep, bstep;
    __device__ void init(int M, int N, int G_, int c_, const void* A_, int lda, const void* B_, int ldb) { nM = M / BM; nN = N / BM; nwg = nM * nN; G = G_; c = c_; A = (const char*)A_; B = (const char*)B_; astep = (size_t)BM * lda * 2; bstep = (size_t)BM * ldb * 2; }
    __device__ bool next(int i, Unit& u) const {
        const long L = (long)i * G + c; if (L >= nwg) return false;
        int wgid = (int)L; { const int q = nwg / NXCD, r = nwg % NXCD, xcd = wgid % NXCD, off = wgid / NXCD; wgid = (xcd < r ? xcd * (q + 1) : r * (q + 1) + (xcd - r) * q) + off; }
        const int nig = WGM * nN, gid = wgid / nig, fm = gid * WGM, gsz = (nM - fm) < WGM ? (nM - fm) : WGM;
        u.pm = fm + ((wgid % nig) % gsz); u.pn = (wgid % nig) / gsz; u.aux = 0; u.A = A + (size_t)u.pm * astep; u.B = B + (size_t)u.pn * bstep; return true;
    }
};

template <class F> struct EpiF {
    static constexpr int MID = 0;
    F f;
    __device__ __forceinline__ void operator()(const f32x4 (&acc)[2][2][4][2], const Unit& u, int wr, int wc, int fr, int fq) const {
#pragma unroll
        for (int ai = 0; ai < 2; ++ai)
#pragma unroll
            for (int m = 0; m < 4; ++m)
#pragma unroll
                for (int bj = 0; bj < 2; ++bj)
                    f(u, u.pm * BM + ai * HALF + wr * 64 + m * 16 + fr, u.pn * BM + bj * HALF + wc * 32 + 8 * fq, acc[ai][bj][m][0], acc[ai][bj][m][1]);
    }
};

template <class F, class G, int MIDV> struct EpiFM {
    static constexpr int MID = MIDV;
    F f; G g;
    __device__ __forceinline__ void operator()(const f32x4 (&acc)[2][2][4][2], const Unit& u, int wr, int wc, int fr, int fq) const {
#pragma unroll
        for (int ai = 0; ai < 2; ++ai)
#pragma unroll
            for (int m = 0; m < 4; ++m)
#pragma unroll
                for (int bj = 0; bj < 2; ++bj)
                    f(u, u.pm * BM + ai * HALF + wr * 64 + m * 16 + fr, u.pn * BM + bj * HALF + wc * 32 + 8 * fq, acc[ai][bj][m][0], acc[ai][bj][m][1]);
    }
    __device__ __forceinline__ void mid(f32x4 (&acc)[2][2][4][2], const Unit& u, int seg, int wr, int wc, int fr, int fq) const {
#pragma unroll
        for (int ai = 0; ai < 2; ++ai)
#pragma unroll
            for (int m = 0; m < 4; ++m)
#pragma unroll
                for (int bj = 0; bj < 2; ++bj) {
                    int rr = u.pm * BM + ai * HALF + wr * 64 + m * 16 + fr; asm volatile("" : "+v"(rr));
                    g(u, seg, rr, u.pn * BM + bj * HALF + wc * 32 + 8 * fq, acc[ai][bj][m][0], acc[ai][bj][m][1]);
                    __builtin_amdgcn_sched_barrier(0);
                }
    }
};

template <class Epi, class Sched>
__device__ __forceinline__ void gemm_phase(LAS unsigned char* lds, const Gemm g, const Sched& S, const Epi& E) {
    int tid_ = threadIdx.x; asm volatile("" : "+v"(tid_));
    const int tid = tid_, wid = __builtin_amdgcn_readfirstlane(tid >> 6), lane = tid & 63, wr = wid >> 2, wc = wid & 3, fr = lane & 15, fq = lane >> 4;
    const int K = g.K, nt = K / BK;
    unsigned voffA[2], voffB[2];
#pragma unroll
    for (int i = 0; i < 2; ++i) { int R, C; stage_rc(tid * 16 + i * 8192, R, C); const int Rb = (R & ~31) + perm32(R & 31);
        voffA[i] = (unsigned)(R * g.lda + C) * 2u; voffB[i] = (unsigned)(Rb * g.ldb + C) * 2u; }
    const size_t kstep = (size_t)(BK * 2);
    const size_t hstepA = (size_t)HALF * g.lda * 2, hstepB = (size_t)HALF * g.ldb * 2;
    const unsigned ldsw = (unsigned)wid * 1024u;
    const int aoff = lds_byte(wr * 64 + fr, fq * 8), boff = lds_byte(wc * 32 + fr, fq * 8);
#define PG8_SA(b, h) (((b) * 2 + (h)) * HTB)
#define PG8_SB(b, h) ((4 + (b) * 2 + (h)) * HTB)
#define PG8_STAGE(bufoff, gbase, voff) do { _Pragma("unroll") for (int _i = 0; _i < 2; ++_i) \
        __builtin_amdgcn_global_load_lds((const unsigned*)((const char*)(gbase) + (voff)[_i]), (LAS unsigned*)(lds + (bufoff) + ldsw + _i * 8192), 16, 0, 0); } while (0)
#define PG8_LDA(dst, b, h) do { _Pragma("unroll") for (int m = 0; m < 4; ++m) _Pragma("unroll") for (int k = 0; k < 2; ++k) dst[m][k] = *(const LAS bf16x8*)(lds + PG8_SA(b, h) + aoff + m * 2048 + k * 1024); } while (0)
#define PG8_LDB(dst, b, h) do { _Pragma("unroll") for (int n = 0; n < 2; ++n) _Pragma("unroll") for (int k = 0; k < 2; ++k) dst[n][k] = *(const LAS bf16x8*)(lds + PG8_SB(b, h) + boff + n * 2048 + k * 1024); } while (0)
#define PG8_MMA(ai, bj, At, Bt) do { __builtin_amdgcn_s_setprio(1); _Pragma("unroll") for (int m = 0; m < 4; ++m) _Pragma("unroll") for (int n = 0; n < 2; ++n) _Pragma("unroll") for (int k = 0; k < 2; ++k) \
        acc[ai][bj][m][n] = __builtin_amdgcn_mfma_f32_16x16x32_bf16(Bt[n][k], At[m][k], acc[ai][bj][m][n], 0, 0, 0); __builtin_amdgcn_s_setprio(0); } while (0)
#define PG8_WAIT_V(n) asm volatile("s_waitcnt vmcnt(" #n ")" ::: "memory")
#define PG8_WAIT_L(n) asm volatile("s_waitcnt lgkmcnt(" #n ")" ::: "memory")
#define PG8_BAR __builtin_amdgcn_s_barrier()
#define PG8_SCHED __builtin_amdgcn_sched_barrier(0)
    Unit cur, nxt; int ui = 0;
    if (!S.next(0, cur)) return;
    f32x4 acc[2][2][4][2];
#pragma unroll
    for (int a = 0; a < 2; ++a)
#pragma unroll
        for (int b = 0; b < 2; ++b)
#pragma unroll
            for (int m = 0; m < 4; ++m)
#pragma unroll
                for (int n = 0; n < 2; ++n) acc[a][b][m][n] = (f32x4){0.f, 0.f, 0.f, 0.f};
    bf16x8 At[4][2], B0[2][2], B1[2][2];
    const char* cA = cur.A; const char* cB = cur.B;
    PG8_STAGE(PG8_SB(0, 0), cB, voffB); PG8_STAGE(PG8_SB(0, 1), cB + hstepB, voffB); PG8_STAGE(PG8_SA(0, 0), cA, voffA); PG8_STAGE(PG8_SA(0, 1), cA + hstepA, voffA);
    if (wr == 1) PG8_BAR;
    PG8_WAIT_V(2); PG8_BAR;
    PG8_STAGE(PG8_SB(1, 0), cB + kstep, voffB); PG8_STAGE(PG8_SA(1, 0), cA + kstep, voffA); PG8_STAGE(PG8_SB(1, 1), cB + hstepB + kstep, voffB);
    PG8_WAIT_V(6); PG8_BAR;
    for (;;) {
        const bool has_next = S.next(ui + 1, nxt);
        const char* nA = has_next ? nxt.A : cA; const char* nB = has_next ? nxt.B : cB;
#pragma nounroll
        for (int t = 0; t < nt; t += 2) {
            const bool last = (t == nt - 2);
            const char* a1 = cA + (size_t)(t + 1) * kstep;
            const char* a2 = last ? nA : cA + (size_t)(t + 2) * kstep; const char* b2 = last ? nB : cB + (size_t)(t + 2) * kstep;
            const char* a3 = a2 + kstep; const char* b3 = b2 + kstep;
            PG8_LDB(B0, 0, 0); PG8_LDB(B1, 0, 1); PG8_SCHED; PG8_LDA(At, 0, 0); PG8_STAGE(PG8_SA(1, 1), a1 + hstepA, voffA);
            PG8_WAIT_V(8); PG8_WAIT_L(0); PG8_BAR; PG8_MMA(0, 0, At, B0); PG8_MMA(0, 1, At, B1); PG8_BAR; PG8_SCHED;
            PG8_LDA(At, 0, 1); PG8_STAGE(PG8_SB(0, 0), b2, voffB); PG8_STAGE(PG8_SB(0, 1), b2 + hstepB, voffB); PG8_STAGE(PG8_SA(0, 0), a2, voffA);
            PG8_WAIT_V(8); PG8_WAIT_L(0); PG8_BAR; PG8_MMA(1, 0, At, B0); PG8_MMA(1, 1, At, B1); PG8_BAR; PG8_SCHED;
            PG8_LDB(B0, 1, 0); PG8_LDB(B1, 1, 1); PG8_SCHED; PG8_LDA(At, 1, 0); PG8_STAGE(PG8_SA(0, 1), a2 + hstepA, voffA);
            PG8_WAIT_V(8); PG8_WAIT_L(0); PG8_BAR; PG8_MMA(0, 0, At, B0); PG8_MMA(0, 1, At, B1); PG8_BAR; PG8_SCHED;
            PG8_LDA(At, 1, 1); PG8_STAGE(PG8_SB(1, 0), b3, voffB); PG8_STAGE(PG8_SB(1, 1), b3 + hstepB, voffB); PG8_STAGE(PG8_SA(1, 0), a3, voffA);
            PG8_WAIT_V(8); PG8_WAIT_L(0); PG8_BAR; PG8_MMA(1, 0, At, B0); PG8_MMA(1, 1, At, B1); PG8_BAR; PG8_SCHED;
            if constexpr (Epi::MID > 0) { if (!last && ((t + 2) % Epi::MID) == 0) { E.mid(acc, cur, (t + 2) / Epi::MID - 1, wr, wc, fr, fq); PG8_SCHED; } }
        }
        if (wr == 0) PG8_BAR;
        E(acc, cur, wr, wc, fr, fq);
        if (!has_next) break;
#pragma unroll
        for (int a = 0; a < 2; ++a)
#pragma unroll
            for (int b = 0; b < 2; ++b)
#pragma unroll
                for (int m = 0; m < 4; ++m)
#pragma unroll
                    for (int n = 0; n < 2; ++n) acc[a][b][m][n] = (f32x4){0.f, 0.f, 0.f, 0.f};
        cur = nxt; cA = nA; cB = nB; ++ui;
        if (wr == 1) PG8_BAR;
    }
    PG8_WAIT_V(0);
    PG8_BAR;
#undef PG8_SA
#undef PG8_SB
#undef PG8_STAGE
#undef PG8_LDA
#undef PG8_LDB
#undef PG8_MMA
#undef PG8_WAIT_V
#undef PG8_WAIT_L
#undef PG8_BAR
#undef PG8_SCHED
}
}

template <class F> __device__ __forceinline__ pg8::EpiF<F> make_epi(F f) { return pg8::EpiF<F>{f}; }

__device__ __forceinline__ void fs_inproj(const P& p, int l, LAS unsigned char* lds) {
    bf16_t* cols = WSP(bf16_t, WS_COLS); float* out = p.out;
    pg8::GridOrder S; S.init(NTOK, NC, gridDim.x, blockIdx.x, WSP(bf16_t, WS_H), DM, WSP(bf16_t, WS_WTIN) + (size_t)l * NC * DM, DM);
    auto E = make_epi([=](const pg8::Unit& u, int r, int n, f32x4 v0, f32x4 v1) {
        if (n >= C_MG) {
#pragma unroll
            for (int e = 0; e < 4; ++e) { v0[e] = 1.f / (1.f + __expf(-v0[e])); v1[e] = 1.f / (1.f + __expf(-v1[e])); }
        }
        *(u32x4*)(cols + (size_t)r * NC + n) = pack8(v0, v1);
        if (r < NCTX) {
            const int b = r / SEQ, t = r % SEQ; const size_t bl = ((size_t)b * DEPTH + l) * SEQ + t;
            float* o = nullptr;
            if (n >= C_NAK && n < C_NAK + 256) o = out + O_NAK + bl * 256 + (n - C_NAK);
            else if (n >= C_NAV && n < C_NAV + 256) o = out + O_NAV + bl * 256 + (n - C_NAV);
            else if (n >= C_WK && n < C_WK + 128) o = out + O_WK + bl * 128 + (n - C_WK);
            else if (n >= C_WV && n < C_WV + 128) o = out + O_WV + bl * 128 + (n - C_WV);
            if (o) { *(f32x4*)o = v0; *(f32x4*)(o + 4) = v1; }
        }
    });
    pg8::gemm_phase(lds, pg8::Gemm{DM, DM, DM}, S, E);
}

struct SubOrder {
    int nM, nN, c, c0, nwgs; const char* A; const char* B; size_t astep, bstep;
    __device__ bool next(int i, pg8::Unit& u) const {
        const int cc = c - c0; if (cc < 0 || cc >= nwgs) return false;
        const int L = i * nwgs + cc; if (L >= nM * nN) return false;
        u.pm = L / nN; u.pn = L % nN; u.aux = 0; u.A = A + (size_t)u.pm * astep; u.B = B + (size_t)u.pn * bstep; return true;
    }
};
__device__ __forceinline__ void fs_mlaproj(const P& p, int l, LAS unsigned char* lds) {
    bf16_t* qm = WSP(bf16_t, WS_QMLA); bf16_t* km = WSP(bf16_t, WS_KMLA); bf16_t* vm = WSP(bf16_t, WS_VMLA);
    const int G = gridDim.x, half = G / 2;
    const bool isq = (int)blockIdx.x < half;
    const int K = isq ? 256 : 128;
    SubOrder S{NTOK / 256, 2, (int)blockIdx.x, isq ? 0 : half, isq ? half : G - half,
               isq ? (const char*)WSP(bf16_t, WS_QN) : (const char*)WSP(bf16_t, WS_CKVB),
               isq ? (const char*)(WSP(bf16_t, WS_WTQB) + (size_t)l * 512 * 256) : (const char*)(WSP(bf16_t, WS_WTKVB) + (size_t)l * 512 * 128),
               (size_t)256 * K * 2, (size_t)256 * K * 2};
    auto E = make_epi([=](const pg8::Unit& u, int r, int n, f32x4 v0, f32x4 v1) {
        const u32x4 w = pack8(v0, v1);
        if (isq) { if (n < 384) *(u32x4*)(qm + (size_t)r * 384 + n) = w; }
        else {
            const int h = n >> 7, e = n & 127;
            if (e < 64) *(u32x4*)(km + (size_t)r * 384 + h * 96 + e) = w; else *(u32x4*)(vm + (size_t)r * 256 + h * 64 + (e - 64)) = w;
        }
    });
    pg8::gemm_phase(lds, pg8::Gemm{K, K, K}, S, E);
}

struct MergeEpi {
    static constexpr int MID = 4;
    const bf16_t* cols; bf16_t* mrg;
    __device__ __forceinline__ void operator()(const f32x4 (&acc)[2][2][4][2], const pg8::Unit& u, int wr, int wc, int fr, int fq) const {
#pragma unroll
        for (int ai = 0; ai < 2; ++ai)
#pragma unroll
            for (int m = 0; m < 4; ++m)
#pragma unroll
                for (int bj = 0; bj < 2; ++bj) {
                    const int r = u.pm * 256 + ai * 128 + wr * 64 + m * 16 + fr, n = u.pn * 256 + bj * 128 + wc * 32 + 8 * fq;
                    f32x4 g0, g1; unpack8v(*(const u32x4*)(cols + (size_t)r * NC + C_MG + 3 * DM + n), g0, g1);
                    f32x4 v0 = acc[ai][bj][m][0], v1 = acc[ai][bj][m][1];
#pragma unroll
                    for (int e = 0; e < 4; ++e) { v0[e] *= fmaxf(g0[e], 1e-20f); v1[e] *= fmaxf(g1[e], 1e-20f); }
                    *(u32x4*)(mrg + (size_t)r * DM + n) = pack8(v0, v1);
                }
    }
    __device__ __forceinline__ void mid(f32x4 (&acc)[2][2][4][2], const pg8::Unit& u, int seg, int wr, int wc, int fr, int fq) const {
        int rb = u.pm * 256 + wr * 64 + fr; asm volatile("" : "+v"(rb));
        const bf16_t* base = cols + (size_t)rb * NC + C_MG + seg * DM + u.pn * 256 + wc * 32 + 8 * fq;
#pragma unroll
        for (int ai = 0; ai < 2; ++ai) {
            u32x4 ga[8], gb[8];
#pragma unroll
            for (int m = 0; m < 4; ++m)
#pragma unroll
                for (int bj = 0; bj < 2; ++bj) {
                    const bf16_t* gp = base + (size_t)(ai * 128 + m * 16) * NC + bj * 128;
                    ga[m * 2 + bj] = *(const u32x4*)gp; gb[m * 2 + bj] = *(const u32x4*)(gp + DM);
                }
            __builtin_amdgcn_sched_barrier(0);
#pragma unroll
            for (int m = 0; m < 4; ++m)
#pragma unroll
                for (int bj = 0; bj < 2; ++bj) {
                    f32x4 a0, a1, b0, b1; unpack8v(ga[m * 2 + bj], a0, a1); unpack8v(gb[m * 2 + bj], b0, b1);
#pragma unroll
                    for (int e = 0; e < 4; ++e) {
                        acc[ai][bj][m][0][e] *= fmaxf(a0[e], 1e-20f) * __builtin_amdgcn_rcpf(fmaxf(b0[e], 1e-20f));
                        acc[ai][bj][m][1][e] *= fmaxf(a1[e], 1e-20f) * __builtin_amdgcn_rcpf(fmaxf(b1[e], 1e-20f));
                    }
                }
            __builtin_amdgcn_sched_barrier(0);
        }
    }
};
__device__ __forceinline__ void fs_merge(const P& p, int l, LAS unsigned char* lds) {
    SubOrder S{NTOK / 256, 4, (int)blockIdx.x, 0, (int)gridDim.x, (const char*)WSP(bf16_t, WS_Y), (const char*)(WSP(bf16_t, WS_WTBR) + (size_t)l * DM * DM), (size_t)256 * DM * 2, (size_t)256 * DM * 2};
    MergeEpi E{WSP(bf16_t, WS_COLS), WSP(bf16_t, WS_MRG)};
    pg8::gemm_phase(lds, pg8::Gemm{DM, DM, DM}, S, E);
}

__device__ __forceinline__ void fs_out(const P& p, int l, LAS unsigned char* lds) {
    float* X = WSP(float, WS_X); const float* modv = WSP(float, WS_MODV);
    const float* xp = p.in[I_XP]; const float* xs = p.in[I_XS];
    SubOrder S{NTOK / 256, 4, (int)blockIdx.x, 0, (int)gridDim.x, (const char*)WSP(bf16_t, WS_MRG), (const char*)(WSP(bf16_t, WS_WTOUT) + (size_t)l * DM * DM), (size_t)256 * DM * 2, (size_t)256 * DM * 2};
    auto E = make_epi([=](const pg8::Unit& u, int r, int n, f32x4 v0, f32x4 v1) {
        const float* gate = modv + ((size_t)l * NCB + row_cb(r)) * 3072 + 2048 + n;
        const float* xr = l == 0 ? (r < NCTX ? xp + (size_t)r * DM : xs + (size_t)(r - NCTX) * DM) : X + (size_t)r * DM;
        const f32x4 x0 = *(const f32x4*)(xr + n), x1 = *(const f32x4*)(xr + n + 4);
        const f32x4 g0 = *(const f32x4*)gate, g1 = *(const f32x4*)(gate + 4);
        *(f32x4*)(X + (size_t)r * DM + n) = x0 + g0 * v0; *(f32x4*)(X + (size_t)r * DM + n + 4) = x1 + g1 * v1;
    });
    pg8::gemm_phase(lds, pg8::Gemm{DM, DM, DM}, S, E);
}

__device__ __forceinline__ int otid() { int t = threadIdx.x; asm volatile("" : "+v"(t)); return t; }
constexpr int HG_LD = 72;
constexpr int HG_MAT = 64 * HG_LD * 2;
constexpr int HG_RAW = 64 * 64 * 2;
__device__ __forceinline__ void hg_dma_tile(const bf16_t* src, int pitch, LAS unsigned char* dst, int tid) {
    const int lane = tid & 63, w = __builtin_amdgcn_readfirstlane(tid >> 6);
    __builtin_amdgcn_global_load_lds((const unsigned*)(src + (size_t)(8 * w + (lane >> 3)) * pitch + 8 * (lane & 7)), (LAS unsigned*)(dst + w * 1024), 16, 0, 0);
}
struct HgPrep { float k[16], b[16]; float btot, ref1; };
__device__ __forceinline__ void hg_prep(const P& p, int tid, int l, int h, const LAS unsigned char* fzt, LAS float* seg  , HgPrep& o) {
    const int dir = tid >> 8, tq = (tid >> 6) & 3, d = tid & 63;
    const float lbv = WSP(float, WS_LBS)[((size_t)l * 2 + dir) * 256 + h * 64 + d];
    float g[16];
#pragma unroll
    for (int i = 0; i < 16; ++i) {
        const float fz = fminf(fmaxf(bf2f(*(const LAS bf16_t*)(fzt + ((16 * tq + i) * 64 + d) * 2)), -80.f), 80.f);
        const float e = __expf(-fz), inv = 1.f / (1.f + e);
        const float f = fmaxf(lbv + (1.f - lbv) * inv, 1e-30f);
        o.k[i] = (1.f - lbv) * e * inv;
        g[i] = __logf(f);
    }
    float run = 0.f;
    if (dir == 0) {
#pragma unroll
        for (int i = 0; i < 16; ++i) { run += g[i]; o.b[i] = run; }
    } else {
#pragma unroll
        for (int i = 15; i >= 0; --i) { run += g[i]; o.b[i] = run; }
    }
    seg[(dir * 4 + tq) * 64 + d] = run;
    __syncthreads();
    const float s0 = seg[(dir * 4 + 0) * 64 + d], s1 = seg[(dir * 4 + 1) * 64 + d], s2 = seg[(dir * 4 + 2) * 64 + d], s3 = seg[(dir * 4 + 3) * 64 + d];
    float off;
    if (dir == 0) off = tq == 0 ? 0.f : (tq == 1 ? s0 : (tq == 2 ? s0 + s1 : s0 + s1 + s2));
    else off = tq == 3 ? 0.f : (tq == 2 ? s3 : (tq == 1 ? s3 + s2 : s3 + s2 + s1));
#pragma unroll
    for (int i = 0; i < 16; ++i) o.b[i] += off;
    o.btot = (s0 + s1) + (s2 + s3);
    o.ref1 = dir == 0 ? s0 + s1 : s2 + s3;
}
__device__ __forceinline__ void hg_build_vt(const LAS unsigned char* vraw, LAS unsigned char* vt, int tid) {
    const int j = tid & 63, sg = tid >> 6;
    unsigned w[4];
#pragma unroll
    for (int i = 0; i < 4; ++i) w[i] = (unsigned)*(const LAS bf16_t*)(vraw + ((8 * sg + 2 * i) * 64 + j) * 2) | ((unsigned)*(const LAS bf16_t*)(vraw + ((8 * sg + 2 * i + 1) * 64 + j) * 2) << 16);
    *(LAS u32x4*)(vt + (j * HG_LD + 8 * sg) * 2) = (u32x4){w[0], w[1], w[2], w[3]};
}
__device__ __forceinline__ void hg_mma_strip(f32x4 (&acc)[4], const LAS unsigned char* A, int arow0, const LAS unsigned char* Bt, int lane) {
    const int fr = lane & 15, fq = lane >> 4;
#pragma unroll
    for (int ks = 0; ks < 2; ++ks) {
        const bf16x8 a = *(const LAS bf16x8*)(A + ((arow0 + fr) * HG_LD + 32 * ks + 8 * fq) * 2);
#pragma unroll
        for (int n = 0; n < 4; ++n) {
            const bf16x8 b = *(const LAS bf16x8*)(Bt + ((16 * n + fr) * HG_LD + 32 * ks + 8 * fq) * 2);
            acc[n] = __builtin_amdgcn_mfma_f32_16x16x32_bf16(a, b, acc[n], 0, 0, 0);
        }
    }
}

__device__ __forceinline__ void fs_hgrn_a(const P& p, int l, LAS unsigned char* lds) {
    LAS unsigned char* raw = lds;
    LAS float* seg = (LAS float*)(lds + 3 * HG_RAW);
    LAS unsigned char* kt = lds + 3 * HG_RAW + 2048;
    LAS unsigned char* vt = kt + 2 * HG_MAT;
    const int tid = otid(), lane = tid & 63, wave = tid >> 6, dir = tid >> 8, tq = (tid >> 6) & 3, d = tid & 63;
    const bf16_t* cols = WSP(bf16_t, WS_COLS);
    for (int u = blockIdx.x; u < (NTOK / 64) * 4; u += gridDim.x) {
        const int gc = u >> 2, h = u & 3, r0 = gc * 64;
        const bf16_t* cr = cols + (size_t)r0 * NC + h * 64;
        hg_dma_tile(cr + C_HGFF, NC, raw, tid); hg_dma_tile(cr + C_HGFB, NC, raw + HG_RAW, tid); hg_dma_tile(cr + C_HGI, NC, raw + 2 * HG_RAW, tid);
        asm volatile("s_waitcnt vmcnt(0)" ::: "memory");
        __syncthreads();
        HgPrep hp; hg_prep(p, tid, l, h, raw + dir * HG_RAW, seg, hp);
        unsigned w[8];
#pragma unroll
        for (int i = 0; i < 8; ++i) w[i] = cvt_pk_bf16(hp.k[2 * i] * __expf(hp.btot - hp.b[2 * i]), hp.k[2 * i + 1] * __expf(hp.btot - hp.b[2 * i + 1]));
        LAS unsigned char* kd = kt + dir * HG_MAT + (d * HG_LD + 16 * tq) * 2;
        *(LAS u32x4*)kd = (u32x4){w[0], w[1], w[2], w[3]}; *(LAS u32x4*)(kd + 16) = (u32x4){w[4], w[5], w[6], w[7]};
        hg_build_vt(raw + 2 * HG_RAW, vt, tid);
        if (tq == 0) WSP(float, WS_HD)[((size_t)u * 2 + dir) * 64 + d] = __expf(hp.btot);
        __syncthreads();
        f32x4 acc[4];
#pragma unroll
        for (int n = 0; n < 4; ++n) acc[n] = (f32x4){0.f, 0.f, 0.f, 0.f};
        const int w4 = wave & 3;
        hg_mma_strip(acc, kt + dir * HG_MAT, 16 * w4, vt, lane);
        float* L = WSP(float, WS_HL) + ((size_t)u * 2 + dir) * 4096;
#pragma unroll
        for (int n = 0; n < 4; ++n)
#pragma unroll
            for (int e = 0; e < 4; ++e) L[(16 * w4 + 4 * (lane >> 4) + e) * 64 + 16 * n + (lane & 15)] = acc[n][e];
        __syncthreads();
    }
}

template <int NCH>
__device__ __forceinline__ float hgrn_b_item(float* HL, const float* HD, int gc0, int h, int dir, int e, float s) {
    float Lv[NCH], Dv[NCH];
#pragma unroll
    for (int cc = 0; cc < NCH; ++cc) {
        const int c = dir == 0 ? cc : NCH - 1 - cc;
        const size_t ui = ((size_t)(gc0 + c) * 4 + h) * 2 + dir;
        Lv[cc] = HL[ui * 4096 + e]; Dv[cc] = HD[ui * 64 + (e >> 6)];
    }
#pragma unroll
    for (int cc = 0; cc < NCH; ++cc) {
        const int c = dir == 0 ? cc : NCH - 1 - cc;
        const size_t ui = ((size_t)(gc0 + c) * 4 + h) * 2 + dir;
        HL[ui * 4096 + e] = s;
        s = Dv[cc] * s + Lv[cc];
    }
    return s;
}
__device__ __forceinline__ void fs_hgrn_b(const P& p, int l, long gtid, long gsz) {
    float* HL = WSP(float, WS_HL); const float* HD = WSP(float, WS_HD);
    for (long it = gtid; it < (long)DB * 4 * 2 * 4096; it += gsz) {
        const int e = (int)(it & 4095), dir = (int)((it >> 12) & 1), h = (int)((it >> 13) & 3), b = (int)(it >> 15);
        const float s0 = p.in[I_ST][((((size_t)b * DEPTH + l) * 2 + dir) * 4 + h) * 4096 + e];
        (void)hgrn_b_item<DSEQ / 64>(HL, HD, (NCTX + b * DSEQ) / 64, h, dir, e, s0);
    }
    for (long it = gtid; it < (long)BATCH * 4 * 2 * 4096; it += gsz) {
        const int e = (int)(it & 4095), dir = (int)((it >> 12) & 1), h = (int)((it >> 13) & 3), b = (int)(it >> 15);
        const float s = hgrn_b_item<SEQ / 64>(HL, HD, (b * SEQ) / 64, h, dir, e, 0.f);
        p.out[O_ST + ((((size_t)b * DEPTH + l) * 2 + dir) * 4 + h) * 4096 + e] = s;
    }
}

__device__ __forceinline__ void fs_hgrn_c(const P& p, int l, LAS unsigned char* lds) {
    LAS unsigned char* raw = lds;
    LAS float* seg = (LAS float*)(lds + 6 * HG_RAW);
    LAS unsigned char* img = lds + 6 * HG_RAW + 2048;
    LAS unsigned char* vt = img + 6 * HG_MAT;
    LAS float* Ob = (LAS float*)raw;
    LAS unsigned char* otile = raw + 2 * HG_RAW;
    const int tid = otid(), lane = tid & 63, wave = tid >> 6, dir = tid >> 8, tq = (tid >> 6) & 3, d = tid & 63, w4 = wave & 3;
    LAS unsigned char* mQ = img + (dir * 3 + 0) * HG_MAT; LAS unsigned char* mK = img + (dir * 3 + 1) * HG_MAT; LAS unsigned char* mS = img + (dir * 3 + 2) * HG_MAT;
    const bf16_t* cols = WSP(bf16_t, WS_COLS);
    for (int u = blockIdx.x; u < (NTOK / 64) * 4; u += gridDim.x) {
        const int gc = u >> 2, h = u & 3, r0 = gc * 64;
        const bf16_t* cr = cols + (size_t)r0 * NC + h * 64;
        hg_dma_tile(cr + C_HGFF, NC, raw, tid); hg_dma_tile(cr + C_HGFB, NC, raw + HG_RAW, tid); hg_dma_tile(cr + C_HGQ, NC, raw + 2 * HG_RAW, tid);
        hg_dma_tile(cr + C_HGI, NC, raw + 3 * HG_RAW, tid); hg_dma_tile(cr + C_HGOG, NC, raw + 4 * HG_RAW, tid); hg_dma_tile(cr + C_HGZ, NC, raw + 5 * HG_RAW, tid);
        f32x4 sreg[4];
        {
            const float* S = WSP(float, WS_HL) + ((size_t)u * 2 + dir) * 4096;
            const int j4 = tid & 15, dd = (tid >> 4) & 15;
#pragma unroll
            for (int i = 0; i < 4; ++i) sreg[i] = *(const f32x4*)(S + (dd + 16 * i) * 64 + 4 * j4);
        }
        asm volatile("s_waitcnt vmcnt(0)" ::: "memory");
        __syncthreads();
        HgPrep hp; hg_prep(p, tid, l, h, raw + dir * HG_RAW, seg, hp);
        {
#pragma unroll
            for (int i = 0; i < 16; ++i) {
                const float qv = bf2f(*(const LAS bf16_t*)(raw + 2 * HG_RAW + ((16 * tq + i) * 64 + d) * 2));
                const float q = qv / (1.f + __expf(-qv));
                const float bb = hp.b[i] - hp.ref1;
                const int o = ((16 * tq + i) * HG_LD + d) * 2;
                *(LAS bf16_t*)(mQ + o) = f2bf(q * __expf(bb));
                *(LAS bf16_t*)(mK + o) = f2bf(hp.k[i] * __expf(-bb));
            }
        }
        hg_build_vt(raw + 3 * HG_RAW, vt, tid);
        {
            const int j4 = tid & 15, dd0 = (tid >> 4) & 15;
#pragma unroll
            for (int i = 0; i < 4; ++i) {
                const int dd = dd0 + 16 * i;
                const float r1 = dir == 0 ? seg[(0 * 4 + 0) * 64 + dd] + seg[(0 * 4 + 1) * 64 + dd] : seg[(1 * 4 + 2) * 64 + dd] + seg[(1 * 4 + 3) * 64 + dd];
                const float sc = __expf(r1);
#pragma unroll
                for (int e = 0; e < 4; ++e) *(LAS bf16_t*)(mS + ((4 * j4 + e) * HG_LD + dd) * 2) = f2bf(sreg[i][e] * sc);
            }
        }
        __syncthreads();
        f32x4 att[4], o[4];
#pragma unroll
        for (int n = 0; n < 4; ++n) { att[n] = (f32x4){0.f, 0.f, 0.f, 0.f}; o[n] = (f32x4){0.f, 0.f, 0.f, 0.f}; }
        hg_mma_strip(att, mQ, 16 * w4, mK, lane);
        hg_mma_strip(o, mQ, 16 * w4, mS, lane);
        __syncthreads();
#pragma unroll
        for (int n = 0; n < 4; ++n)
#pragma unroll
            for (int e = 0; e < 4; ++e) {
                const int t = 16 * w4 + 4 * (lane >> 4) + e, s_ = 16 * n + (lane & 15);
                const bool keep = dir == 0 ? (s_ <= t) : (s_ >= t);
                *(LAS bf16_t*)(mK + (t * HG_LD + s_) * 2) = keep ? f2bf(att[n][e]) : (bf16_t)0;
            }
        asm volatile("s_waitcnt lgkmcnt(0)" ::: "memory");
        hg_mma_strip(o, mK, 16 * w4, vt, lane);
        if (dir == 1) {
#pragma unroll
            for (int n = 0; n < 4; ++n)
#pragma unroll
                for (int e = 0; e < 4; ++e) Ob[(16 * w4 + 4 * (lane >> 4) + e) * 64 + 16 * n + (lane & 15)] = o[n][e];
        }
        __syncthreads();
        if (dir == 0) {
            const float* gn = p.in[I_HGG] + (size_t)l * 64;
            float ss[4] = {0.f, 0.f, 0.f, 0.f};
#pragma unroll
            for (int n = 0; n < 4; ++n)
#pragma unroll
                for (int e = 0; e < 4; ++e) { o[n][e] += Ob[(16 * w4 + 4 * (lane >> 4) + e) * 64 + 16 * n + (lane & 15)]; ss[e] += o[n][e] * o[n][e]; }
#pragma unroll
            for (int e = 0; e < 4; ++e) {
                float v = ss[e];
                v += __shfl_xor(v, 1); v += __shfl_xor(v, 2); v += __shfl_xor(v, 4); v += __shfl_xor(v, 8);
                ss[e] = 1.f / sqrtf(v * (1.f / 64.f) + 1e-6f);
            }
#pragma unroll
            for (int n = 0; n < 4; ++n)
#pragma unroll
                for (int e = 0; e < 4; ++e) {
                    const int t = 16 * w4 + 4 * (lane >> 4) + e, j = 16 * n + (lane & 15);
                    const float og = bf2f(*(const LAS bf16_t*)(raw + 4 * HG_RAW + (t * 64 + j) * 2)), z = bf2f(*(const LAS bf16_t*)(raw + 5 * HG_RAW + (t * 64 + j) * 2));
                    const float v = o[n][e] * ss[e] * gn[j] / (1.f + __expf(-og)) * (z / (1.f + __expf(-z)));
                    *(LAS bf16_t*)(otile + (t * 64 + j) * 2) = f2bf(v);
                }
        }
        __syncthreads();
        {
            const int row = tid >> 3, ch = tid & 7;
            *(u32x4*)(WSP(bf16_t, WS_Y) + (size_t)(r0 + row) * DM + 256 + h * 64 + 8 * ch) = *(const LAS u32x4*)(otile + (row * 64 + 8 * ch) * 2);
        }
        __syncthreads();
    }
}

constexpr int AT_KBUF = 64 * (96 + 8) * 2;
constexpr int AT_VBUF = 64 * 72 * 2;
constexpr int AT_STG = 2 * (AT_KBUF + AT_VBUF);
constexpr int AT_OFF_RPB = 2 * AT_STG;
struct AttnSrc { const bf16_t* k; const bf16_t* v; int kp, vp, n; };
struct AttnMask { int type, a, b; };

template <int DQ>
__device__ __forceinline__ void attn_unit(LAS unsigned char* lds, const int tid, const bf16_t* qbase, const int qpitch, const AttnSrc s0, const AttnSrc s1, const AttnMask mk,
                                          const float* rpb, const float sink, const bool has_sink, const float scale, const float* ropeq  ,
                                          const bf16_t* zbase, bf16_t* ybase  ) {
    constexpr int KS = DQ / 32, KP = DQ + 8;
    constexpr float L2E = 1.4426950408889634f;
    const int lane = tid & 63, wave = tid >> 6, c = lane & 15, fq = lane >> 4;
    LAS float* rpbl = (LAS float*)(lds + AT_OFF_RPB);
    if (mk.type == 1) { for (int i = tid; i < 465; i += NTHREADS) rpbl[i] = rpb[i] * L2E; }
    bf16x8 qf[KS];
    {
        const bf16_t* qr = qbase + (size_t)(16 * wave + c) * qpitch + 8 * fq;
#pragma unroll
        for (int ks = 0; ks < KS; ++ks) qf[ks] = *(const bf16x8*)(qr + 32 * ks);
        if (DQ == 96 && ropeq) {
            const u32x4 mine = __builtin_bit_cast(u32x4, qf[KS - 1]);
            u32x4 oth; oth.x = __shfl_xor(mine.x, 32); oth.y = __shfl_xor(mine.y, 32); oth.z = __shfl_xor(mine.z, 32); oth.w = __shfl_xor(mine.w, 32);
            f32x4 m0, m1, o0, o1; unpack8v(mine, m0, m1); unpack8v(oth, o0, o1);
            const float* rr = ropeq + (size_t)(16 * wave + c) * 32 + (8 * (fq & 1)) * 2;
            float r[8];
#pragma unroll
            for (int j = 0; j < 8; ++j) {
                const float cs = rr[2 * j], sn = rr[2 * j + 1];
                const float mv = j < 4 ? m0[j & 3] : m1[j & 3], ov = j < 4 ? o0[j & 3] : o1[j & 3];
                r[j] = fq < 2 ? mv * cs - ov * sn : ov * sn + mv * cs;
            }
            u32x4 w; w.x = cvt_pk_bf16(r[0], r[1]); w.y = cvt_pk_bf16(r[2], r[3]); w.z = cvt_pk_bf16(r[4], r[5]); w.w = cvt_pk_bf16(r[6], r[7]);
            qf[KS - 1] = __builtin_bit_cast(bf16x8, w);
        }
    }
    int qa = 0, qb = 0;
    if (mk.type == 1) { qa = mk.a + (wave >> 2); qb = 16 * (wave & 3) + c; }
    else if (mk.type == 2) { qa = mk.a + 16 * wave + c; }
    int na_rs = qa - 4; na_rs = na_rs < 0 ? 0 : (na_rs > GROWS - 8 ? GROWS - 8 : na_rs);
    int na_cs = qb - 8; na_cs = na_cs < 0 ? 0 : (na_cs > GW - 16 ? GW - 16 : na_cs);
    const float sl2 = scale * L2E;
    float m = has_sink ? sink * L2E : -3.0e38f, lsum = 0.f;
    f32x4 o[4];
#pragma unroll
    for (int n = 0; n < 4; ++n) o[n] = (f32x4){0.f, 0.f, 0.f, 0.f};
    const int nsteps = (s0.n + s1.n) >> 1;
    u32x4 kreg0[1][2], kreg1[1][2], vreg[1][2];
    const int krow0 = DQ == 64 ? (tid >> 3) : tid / 12, kch0 = DQ == 64 ? (tid & 7) : tid % 12;
    const int krow1 = (tid + 512) / 12, kch1 = (tid + 512) % 12;
    const int vkey = tid & 63, vg = tid >> 6;
#define AT_LOAD(rs, step) do { _Pragma("unroll") for (int j_ = 0; j_ < 2; ++j_) { const int tl_ = 2 * (step) + j_; const bool f0_ = tl_ < s0.n; const int bi_ = f0_ ? tl_ : tl_ - s0.n; \
        const bf16_t* kb_ = (f0_ ? s0.k : s1.k) + (size_t)bi_ * 64 * (f0_ ? s0.kp : s1.kp); const int kp_ = f0_ ? s0.kp : s1.kp; \
        const bf16_t* vb_ = (f0_ ? s0.v : s1.v) + (size_t)bi_ * 64 * (f0_ ? s0.vp : s1.vp); const int vp_ = f0_ ? s0.vp : s1.vp; \
        kreg0[rs][j_] = *(const u32x4*)(kb_ + (size_t)krow0 * kp_ + 8 * kch0); \
        if (DQ == 96 && tid < 256) kreg1[rs][j_] = *(const u32x4*)(kb_ + (size_t)krow1 * kp_ + 8 * kch1); \
        vreg[rs][j_] = *(const u32x4*)(vb_ + (size_t)vkey * vp_ + 8 * vg); } } while (0)
#define AT_STORE(rs, buf) do { _Pragma("unroll") for (int j_ = 0; j_ < 2; ++j_) { LAS unsigned char* kd_ = lds + (buf) * AT_STG + j_ * AT_KBUF; LAS unsigned char* vd_ = lds + (buf) * AT_STG + 2 * AT_KBUF + j_ * AT_VBUF; \
        *(LAS u32x4*)(kd_ + (krow0 * KP + 8 * kch0) * 2) = kreg0[rs][j_]; \
        if (DQ == 96 && tid < 256) *(LAS u32x4*)(kd_ + (krow1 * KP + 8 * kch1) * 2) = kreg1[rs][j_]; \
        const unsigned vw_[4] = {vreg[rs][j_].x, vreg[rs][j_].y, vreg[rs][j_].z, vreg[rs][j_].w}; \
        _Pragma("unroll") for (int e_ = 0; e_ < 4; ++e_) { \
            *(LAS bf16_t*)(vd_ + ((8 * vg + 2 * e_) * 72 + vkey) * 2) = (bf16_t)(vw_[e_] & 0xffffu); \
            *(LAS bf16_t*)(vd_ + ((8 * vg + 2 * e_ + 1) * 72 + vkey) * 2) = (bf16_t)(vw_[e_] >> 16); } } } while (0)
#define AT_SCORES() \
        f32x4 acc[4]; \
        bf16x8 kf[4][KS]; \
        _Pragma("unroll") for (int n = 0; n < 4; ++n) \
            _Pragma("unroll") for (int ks = 0; ks < KS; ++ks) kf[n][ks] = *(const LAS bf16x8*)(kl + ((16 * n + c) * KP + 32 * ks + 8 * fq) * 2); \
        _Pragma("unroll") for (int n = 0; n < 4; ++n) { \
            acc[n] = (f32x4){0.f, 0.f, 0.f, 0.f}; \
            _Pragma("unroll") for (int ks = 0; ks < KS; ++ks) acc[n] = __builtin_amdgcn_mfma_f32_16x16x32_bf16(kf[n][ks], qf[ks], acc[n], 0, 0, 0); } \
        const bool msk = tile < s0.n && mk.type != 0; \
        float mloc = -3.0e38f; \
        _Pragma("unroll") for (int n = 0; n < 4; ++n) \
            _Pragma("unroll") for (int e = 0; e < 4; ++e) { \
                float sv = acc[n][e] * sl2; \
                if (msk) { \
                    const int kk = 16 * n + 4 * fq + e; \
                    if (mk.type == 1) { \
                        const int kr = mk.b + tile; \
                        const bool ok = kr >= na_rs && kr < na_rs + 8 && kk >= na_cs && kk < na_cs + 16; \
                        int dr = kr - qa + 7; dr = dr < 0 ? 0 : (dr > 14 ? 14 : dr); \
                        int dc = kk - qb + 15; dc = dc < 0 ? 0 : (dc > 30 ? 30 : dc); \
                        sv = ok ? sv + rpbl[dr * 31 + dc] : -1.0e30f; \
                    } else { \
                        const int dd = mk.b + 64 * tile + kk - qa; \
                        sv = (dd <= 128 && dd >= -128) ? sv : -1.0e30f; } } \
                acc[n][e] = sv; mloc = fmaxf(mloc, sv); }
#define AT_EXP_PV(mref) \
        float ps = 0.f; \
        _Pragma("unroll") for (int n = 0; n < 4; ++n) \
            _Pragma("unroll") for (int e = 0; e < 4; ++e) { const float pv = __builtin_amdgcn_exp2f(acc[n][e] - (mref)); acc[n][e] = pv; ps += pv; } \
        _Pragma("unroll") for (int ks = 0; ks < 2; ++ks) { \
            u32x4 pw; pw.x = cvt_pk_bf16(acc[2 * ks][0], acc[2 * ks][1]); pw.y = cvt_pk_bf16(acc[2 * ks][2], acc[2 * ks][3]); \
            pw.z = cvt_pk_bf16(acc[2 * ks + 1][0], acc[2 * ks + 1][1]); pw.w = cvt_pk_bf16(acc[2 * ks + 1][2], acc[2 * ks + 1][3]); \
            const bf16x8 pf = __builtin_bit_cast(bf16x8, pw); \
            _Pragma("unroll") for (int n = 0; n < 4; ++n) { \
                const LAS unsigned char* vr = vl + ((16 * n + c) * 72 + 32 * ks + 4 * fq) * 2; \
                const u32x2 v0 = *(const LAS u32x2*)vr, v1 = *(const LAS u32x2*)(vr + 32); \
                const u32x4 vw = (u32x4){v0.x, v0.y, v1.x, v1.y}; \
                o[n] = __builtin_amdgcn_mfma_f32_16x16x32_bf16(__builtin_bit_cast(bf16x8, vw), pf, o[n], 0, 0, 0); } }
#define AT_STEP(step, RL, RS) do { \
        const int buf = (step) & 1; \
        if ((step) + 1 < nsteps) AT_LOAD(RL, (step) + 1); \
        _Pragma("unroll") for (int j = 0; j < 2; ++j) { \
        const LAS unsigned char* kl = lds + buf * AT_STG + j * AT_KBUF; const LAS unsigned char* vl = lds + buf * AT_STG + 2 * AT_KBUF + j * AT_VBUF; \
        const int tile = 2 * (step) + j; \
        AT_SCORES() \
        if (tile == 0 || msk) {        \
            mloc = fmaxf(mloc, __shfl_xor(mloc, 16)); mloc = fmaxf(mloc, __shfl_xor(mloc, 32)); \
            const float mn = fmaxf(m, mloc), corr = __builtin_amdgcn_exp2f(m - mn); \
            m = mn; \
            _Pragma("unroll") for (int n = 0; n < 4; ++n) o[n] *= corr; \
            AT_EXP_PV(mn) \
            lsum = lsum * corr + ps; \
        } else { \
            AT_EXP_PV(m) \
            mloc = fmaxf(mloc, __shfl_xor(mloc, 16)); mloc = fmaxf(mloc, __shfl_xor(mloc, 32)); \
            const float mn = fmaxf(m, mloc), corr = __builtin_amdgcn_exp2f(m - mn); \
            m = mn; \
            lsum = (lsum + ps) * corr; \
            _Pragma("unroll") for (int n = 0; n < 4; ++n) o[n] *= corr; \
        } \
        } \
        if ((step) + 1 < nsteps) AT_STORE(RS, buf ^ 1); \
        asm volatile("s_waitcnt lgkmcnt(0)" ::: "memory"); __builtin_amdgcn_s_barrier(); } while (0)
    AT_LOAD(0, 0);
    AT_STORE(0, 0);
    asm volatile("s_waitcnt lgkmcnt(0)" ::: "memory"); __builtin_amdgcn_s_barrier();
    for (int step = 0; step < nsteps; ++step) AT_STEP(step, 0, 0);
#undef AT_STEP
#undef AT_SCORES
#undef AT_EXP_PV
#undef AT_LOAD
#undef AT_STORE
    lsum += __shfl_xor(lsum, 16); lsum += __shfl_xor(lsum, 32);
    if (has_sink) lsum += exp2f(sink * L2E - m);
    const float inv = 1.f / lsum;
    const bf16_t* zr = zbase + (size_t)(16 * wave + c) * NC; bf16_t* yr = ybase + (size_t)(16 * wave + c) * DM;
#pragma unroll
    for (int n = 0; n < 4; ++n) {
        typedef unsigned u32x2 __attribute__((ext_vector_type(2)));
        const u32x2 zz = *(const u32x2*)(zr + 16 * n + 4 * fq);
        const float z0 = u2f(zz.x << 16), z1 = u2f(zz.x & 0xffff0000u), z2 = u2f(zz.y << 16), z3 = u2f(zz.y & 0xffff0000u);
        u32x2 w;
        w.x = cvt_pk_bf16(o[n][0] * inv * (z0 / (1.f + __expf(-z0))), o[n][1] * inv * (z1 / (1.f + __expf(-z1))));
        w.y = cvt_pk_bf16(o[n][2] * inv * (z2 / (1.f + __expf(-z2))), o[n][3] * inv * (z3 / (1.f + __expf(-z3))));
        *(u32x2*)(yr + 16 * n + 4 * fq) = w;
    }
}

__device__ __forceinline__ void fs_attn(const P& p, int l, LAS unsigned char* lds) {
    const int tid = otid();
    constexpr int NL = (NLAT / 128) * 4, NCU = (NCTX / 128) * 4 * 3, NU = 3 * NL + NCU;
    const bf16_t* cols = WSP(bf16_t, WS_COLS);
    bf16_t* Y = WSP(bf16_t, WS_Y);
    for (int u = blockIdx.x; u < NU; u += gridDim.x) {
        if (u < 3 * NL) {
            const int kind = u / NL, v = u % NL;
            int bh, qt;
            if (NL % 64 == 0) { const int x = v & 7, idx = v >> 3, per = NL / 8; const int bhx = (DB * 4) / 8 > 0 ? (DB * 4) / 8 : 1; bh = x * bhx + idx / (per / bhx); qt = idx % (per / bhx); }
            else { bh = v / (DSEQ / 128); qt = v % (DSEQ / 128); }
            const int b = bh >> 2, h = bh & 3;
            const int r0 = NCTX + b * DSEQ + qt * 128, t0 = qt * 128;
            const size_t cb = ((size_t)b * DEPTH + l) * PAST;
            if (kind == 0) {
                AttnSrc s0{WSP(bf16_t, WS_KMLA) + (size_t)(NCTX + b * DSEQ) * 384 + h * 96, WSP(bf16_t, WS_VMLA) + (size_t)(NCTX + b * DSEQ) * 256 + h * 64, 384, 256, DSEQ / 64};
                AttnSrc s1{WSP(bf16_t, WS_KCM) + cb * 384 + h * 96, WSP(bf16_t, WS_VCM) + cb * 256 + h * 64, 384, 256, PAST / 64};
                attn_unit<96>(lds, tid, WSP(bf16_t, WS_QMLA) + (size_t)r0 * 384 + h * 96, 384, s0, s1, AttnMask{0, 0, 0}, nullptr, 0.f, false, 0.10206207261596577f,
                              WSP(float, WS_ROPEM) + (size_t)t0 * 32, cols + (size_t)r0 * NC + C_MZ + h * 64, Y + (size_t)r0 * DM + 512 + h * 64);
            } else if (kind == 1) {
                const int i0 = 2 * qt;
                int rlo = i0 - 4; rlo = rlo < 0 ? 0 : (rlo > GROWS - 8 ? GROWS - 8 : rlo);
                int rhi = i0 + 1 - 4; rhi = (rhi < 0 ? 0 : (rhi > GROWS - 8 ? GROWS - 8 : rhi)) + 8;
                if ((rhi - rlo) & 1) { if (rlo > 0) --rlo; else ++rhi; }
                const size_t kr0 = (size_t)(NCTX + b * DSEQ + rlo * 64);
                AttnSrc s0{cols + kr0 * NC + C_NAK + h * 64, cols + kr0 * NC + C_NAV + h * 64, NC, NC, rhi - rlo};
                AttnSrc s1{WSP(bf16_t, WS_CNAK) + cb * 256 + h * 64, WSP(bf16_t, WS_CNAV) + cb * 256 + h * 64, 256, 256, PAST / 64};
                attn_unit<64>(lds, tid, cols + (size_t)r0 * NC + C_NAQ + h * 64, NC, s0, s1, AttnMask{1, i0, rlo}, p.in[I_RPB] + ((size_t)l * 4 + h) * 465, 0.f, false, 0.125f,
                              nullptr, cols + (size_t)r0 * NC + C_NAZ + h * 64, Y + (size_t)r0 * DM + 0 + h * 64);
            } else {
                const int kh = h >> 1;
                const int klo = t0 - 128 < 0 ? 0 : t0 - 128, khi = t0 + 256 > DSEQ ? DSEQ : t0 + 256;
                const size_t kr0 = (size_t)(NCTX + b * DSEQ + klo);
                AttnSrc s0{WSP(bf16_t, WS_WKR) + kr0 * 128 + kh * 64, cols + kr0 * NC + C_WV + kh * 64, 128, NC, (khi - klo) / 64};
                AttnSrc s1{WSP(bf16_t, WS_CWK) + cb * 128 + kh * 64, WSP(bf16_t, WS_CWV) + cb * 128 + kh * 64, 128, 128, PAST / 64};
                attn_unit<64>(lds, tid, WSP(bf16_t, WS_WQR) + (size_t)r0 * 256 + h * 64, 256, s0, s1, AttnMask{2, t0, klo}, nullptr, p.in[I_SINK][l * 4 + h], true, 0.125f,
                              nullptr, cols + (size_t)r0 * NC + C_WZ + h * 64, Y + (size_t)r0 * DM + 768 + h * 64);
            }
        } else {
            const int v = u - 3 * NL, kind = v % 3, h = (v / 3) & 3, tile = v / 12;
            const int r0 = tile * 128, sq0 = (r0 / SEQ) * SEQ;
            const AttnSrc none{nullptr, nullptr, 0, 0, 0};
            if (kind == 0) {
                AttnSrc s0{cols + (size_t)sq0 * NC + C_NAK + h * 64, cols + (size_t)sq0 * NC + C_NAV + h * 64, NC, NC, SEQ / 64};
                attn_unit<64>(lds, tid, cols + (size_t)r0 * NC + C_NAQ + h * 64, NC, s0, none, AttnMask{0, 0, 0}, nullptr, 0.f, false, 0.125f, nullptr,
                              cols + (size_t)r0 * NC + C_NAZ + h * 64, Y + (size_t)r0 * DM + 0 + h * 64);
            } else if (kind == 1) {
                AttnSrc s0{WSP(bf16_t, WS_KMLA) + (size_t)sq0 * 384 + h * 96, WSP(bf16_t, WS_VMLA) + (size_t)sq0 * 256 + h * 64, 384, 256, SEQ / 64};
                attn_unit<96>(lds, tid, WSP(bf16_t, WS_QMLA) + (size_t)r0 * 384 + h * 96, 384, s0, none, AttnMask{0, 0, 0}, nullptr, 0.f, false, 0.10206207261596577f, nullptr,
                              cols + (size_t)r0 * NC + C_MZ + h * 64, Y + (size_t)r0 * DM + 512 + h * 64);
            } else {
                const int kh = h >> 1;
                AttnSrc s0{WSP(bf16_t, WS_WKR) + (size_t)sq0 * 128 + kh * 64, cols + (size_t)sq0 * NC + C_WV + kh * 64, 128, NC, SEQ / 64};
                attn_unit<64>(lds, tid, WSP(bf16_t, WS_WQR) + (size_t)r0 * 256 + h * 64, 256, s0, none, AttnMask{0, 0, 0}, nullptr, p.in[I_SINK][l * 4 + h], true, 0.125f, nullptr,
                              cols + (size_t)r0 * NC + C_WZ + h * 64, Y + (size_t)r0 * DM + 768 + h * 64);
            }
        }
    }
}

__device__ __forceinline__ float wave_sum(float v) {
#pragma unroll
    for (int o = 1; o < 64; o <<= 1) v += __shfl_xor(v, o);
    return v;
}

template <bool FINAL>
__device__ __forceinline__ void fs_norm(const P& p, int l) {
    const int tid = otid(), lane = tid & 63, gw = blockIdx.x * (NTHREADS / 64) + (tid >> 6), ngw = gridDim.x * (NTHREADS / 64);
    const float* g = FINAL ? p.in[I_FG] : p.in[I_NG] + (size_t)l * DM;
    constexpr int RB = 6;
    for (int r0 = gw; r0 < NTOK; r0 += RB * ngw) {
        f32x4 v[RB][4]; float ss[RB];
#pragma unroll
        for (int q = 0; q < RB; ++q) {
            const int r = r0 + q * ngw; ss[q] = 0.f;
            if (r < NTOK) {
                const float* x = (FINAL || l > 0) ? WSP(float, WS_X) + (size_t)r * DM : (r < NCTX ? p.in[I_XP] + (size_t)r * DM : p.in[I_XS] + (size_t)(r - NCTX) * DM);
#pragma unroll
                for (int j = 0; j < 4; ++j) v[q][j] = *(const f32x4*)(x + 256 * j + 4 * lane);
            }
        }
#pragma unroll
        for (int q = 0; q < RB; ++q) {
            const int r = r0 + q * ngw;
            if (r >= NTOK) continue;
#pragma unroll
            for (int j = 0; j < 4; ++j) ss[q] += (v[q][j][0] * v[q][j][0] + v[q][j][1] * v[q][j][1]) + (v[q][j][2] * v[q][j][2] + v[q][j][3] * v[q][j][3]);
            const float rstd = 1.f / sqrtf(wave_sum(ss[q]) * (1.f / DM) + 1e-6f);
            const float pscale = (FINAL && PROBE_ON && r >= NCTX) ? 1.f + ((const float*)(p.ws + WS_CTL))[8000] : 1.f;
            if (FINAL) {
#pragma unroll
                for (int j = 0; j < 4; ++j) { const f32x4 gg = *(const f32x4*)(g + 256 * j + 4 * lane); *(f32x4*)(p.out + O_Y + (size_t)r * DM + 256 * j + 4 * lane) = v[q][j] * (rstd * pscale) * gg; }
            } else {
                const float* mv = WSP(float, WS_MODV) + ((size_t)l * NCB + row_cb(r)) * 3072;
                bf16_t* H = WSP(bf16_t, WS_H) + (size_t)r * DM;
#pragma unroll
                for (int j = 0; j < 4; ++j) {
                    const int k = 256 * j + 4 * lane;
                    const f32x4 gg = *(const f32x4*)(g + k), sh = *(const f32x4*)(mv + k), sc = *(const f32x4*)(mv + 1024 + k);
                    const f32x4 y = v[q][j] * rstd * gg * (sc + 1.f) + sh;
                    u32x2 w; w.x = cvt_pk_bf16(y[0], y[1]); w.y = cvt_pk_bf16(y[2], y[3]);
                    *(u32x2*)(H + k) = w;
                }
            }
        }
    }
}

__device__ __forceinline__ void fs_rowprep(const P& p, int l) {
    const int tid = otid(), lane = tid & 63, gw = blockIdx.x * (NTHREADS / 64) + (tid >> 6), ngw = gridDim.x * (NTHREADS / 64);
    const bf16_t* cols = WSP(bf16_t, WS_COLS);
    constexpr int RB = 6;
    for (int r0 = gw; r0 < NTOK; r0 += RB * ngw) {
        unsigned wck[RB]; u32x2 wqa[RB]; bf16_t kr1[RB], kr2[RB], g1[RB][3], g2[RB][3];
#pragma unroll
        for (int q = 0; q < RB; ++q) {
            const int r = r0 + q * ngw;
            if (r < NTOK) {
                const bf16_t* c = cols + (size_t)r * NC;
                wck[q] = *(const unsigned*)(c + C_CKV + 2 * lane);
                wqa[q] = *(const u32x2*)(c + C_MQA + 4 * lane);
                kr1[q] = c[C_KR + (lane & 15)]; kr2[q] = c[C_KR + 16 + (lane & 15)];
#pragma unroll
                for (int i = 0; i < 3; ++i) {
                    const int pi = lane + 64 * i, hh = pi >> 5, j = pi & 31;
                    const bf16_t* src = hh < 4 ? c + C_WQ + hh * 64 : c + C_WK + (hh - 4) * 64;
                    g1[q][i] = src[j]; g2[q][i] = src[32 + j];
                }
            }
        }
#pragma unroll
        for (int q = 0; q < RB; ++q) {
            const int r = r0 + q * ngw;
            if (r >= NTOK) continue;
            const bool lat = r >= NCTX; const int t = lat ? (r - NCTX) % DSEQ : 0;
            const size_t bl = lat ? 0 : ((size_t)(r / SEQ) * DEPTH + l) * SEQ + (r % SEQ);
            {
                const float a = u2f(wck[q] << 16), b = u2f(wck[q] & 0xffff0000u);
                const float rstd = 1.f / sqrtf(wave_sum(a * a + b * b) * (1.f / 128.f) + 1e-6f);
                const float* g = p.in[I_KVG] + (size_t)l * 128 + 2 * lane;
                const float va = a * rstd * g[0], vb = b * rstd * g[1];
                *(unsigned*)(WSP(bf16_t, WS_CKVB) + (size_t)r * 128 + 2 * lane) = cvt_pk_bf16(va, vb);
                if (!lat) { f32x2 o; o.x = va; o.y = vb; *(f32x2*)(p.out + O_CKV + bl * 128 + 2 * lane) = o; }
            }
            {
                const float a0 = u2f(wqa[q].x << 16), a1 = u2f(wqa[q].x & 0xffff0000u), a2 = u2f(wqa[q].y << 16), a3 = u2f(wqa[q].y & 0xffff0000u);
                const float rstd = 1.f / sqrtf(wave_sum((a0 * a0 + a1 * a1) + (a2 * a2 + a3 * a3)) * (1.f / 256.f) + 1e-6f);
                const f32x4 g = *(const f32x4*)(p.in[I_QG] + (size_t)l * 256 + 4 * lane);
                u32x2 o; o.x = cvt_pk_bf16(a0 * rstd * g[0], a1 * rstd * g[1]); o.y = cvt_pk_bf16(a2 * rstd * g[2], a3 * rstd * g[3]);
                *(u32x2*)(WSP(bf16_t, WS_QN) + (size_t)r * 256 + 4 * lane) = o;
            }
            if (lane < 16) {
                const float x1 = bf2f(kr1[q]), x2 = bf2f(kr2[q]);
                float o1 = x1, o2 = x2;
                if (lat) { const float* rm = WSP(float, WS_ROPEM) + (size_t)t * 32 + 2 * lane; o1 = x1 * rm[0] - x2 * rm[1]; o2 = x1 * rm[1] + x2 * rm[0]; }
                else { p.out[O_KR + bl * 32 + lane] = x1; p.out[O_KR + bl * 32 + 16 + lane] = x2; }
                bf16_t* km = WSP(bf16_t, WS_KMLA) + (size_t)r * 384 + 64 + lane;
                const bf16_t b1 = f2bf(o1), b2 = f2bf(o2);
#pragma unroll
                for (int h = 0; h < 4; ++h) { km[h * 96] = b1; km[h * 96 + 16] = b2; }
            }
            {
                const float* rw = WSP(float, WS_ROPEW) + (size_t)t * 64;
#pragma unroll
                for (int i = 0; i < 3; ++i) {
                    const int pi = lane + 64 * i, hh = pi >> 5, j = pi & 31;
                    bf16_t* dst = hh < 4 ? WSP(bf16_t, WS_WQR) + (size_t)r * 256 + hh * 64 : WSP(bf16_t, WS_WKR) + (size_t)r * 128 + (hh - 4) * 64;
                    const float x1 = bf2f(g1[q][i]), x2 = bf2f(g2[q][i]);
                    if (lat) { const float cs = rw[2 * j], sn = rw[2 * j + 1]; dst[j] = f2bf(x1 * cs - x2 * sn); dst[32 + j] = f2bf(x1 * sn + x2 * cs); }
                    else { dst[j] = g1[q][i]; dst[32 + j] = g2[q][i]; }
                }
            }
        }
    }
}

__device__ __forceinline__ void tr_item(const float* W, int N, int ncol0, bf16_t* WT, int K, int nrow0, int k0, LAS float* scr, int lane) {
    if (ncol0 >= 0) {
        float v[32];
        const float* wp = W + (size_t)(k0 + (lane >> 5)) * N + ncol0 + (lane & 31);
#pragma unroll
        for (int i = 0; i < 32; ++i) v[i] = wp[(size_t)(2 * i) * N];
#pragma unroll
        for (int i = 0; i < 32; ++i) scr[(2 * i + (lane >> 5)) * 33 + (lane & 31)] = v[i];
    }
    asm volatile("s_waitcnt lgkmcnt(0)" ::: "memory");
    const int c = lane & 7;
#pragma unroll
    for (int j = 0; j < 4; ++j) {
        const int n = (lane >> 3) + 8 * j; const LAS float* sp = scr + (8 * c) * 33 + n;
        u32x4 o = (u32x4){0u, 0u, 0u, 0u};
        if (ncol0 >= 0) { o.x = cvt_pk_bf16(sp[0 * 33], sp[1 * 33]); o.y = cvt_pk_bf16(sp[2 * 33], sp[3 * 33]); o.z = cvt_pk_bf16(sp[4 * 33], sp[5 * 33]); o.w = cvt_pk_bf16(sp[6 * 33], sp[7 * 33]); }
        *(u32x4*)(WT + (size_t)(nrow0 + n) * K + k0 + 8 * c) = o;
    }
    asm volatile("s_waitcnt lgkmcnt(0)" ::: "memory");
}
__device__ __forceinline__ void tr_big_layer(const P& p, int l, int it0, int it1, int gw, int ngw, LAS float* scr, int lane) {
    for (int it = it0 + gw; it < it1; it += ngw) {
        int r = it;
        if (r < 4096) { const int nb = r & 255, kb = r >> 8;
            tr_item(p.in[I_WIN] + (size_t)l * DM * INW, INW, orig_col(nb * 32), WSP(bf16_t, WS_WTIN) + (size_t)l * NC * DM, DM, nb * 32, kb * 64, scr, lane); continue; } r -= 4096;
        if (r < 512) { const int nb = r & 31, kb = r >> 5;
            tr_item(p.in[I_WOUT] + (size_t)l * DM * DM, DM, nb * 32, WSP(bf16_t, WS_WTOUT) + (size_t)l * DM * DM, DM, nb * 32, kb * 64, scr, lane); continue; } r -= 512;
        { const int nb = r & 31, kb = (r >> 5) & 3, b = r >> 7;
            tr_item(p.in[I_WBR] + (size_t)(l * 4 + b) * 256 * DM, DM, nb * 32, WSP(bf16_t, WS_WTBR) + (size_t)l * DM * DM + b * 256, DM, nb * 32, kb * 64, scr, lane); }
    }
}
constexpr int TR_BIG_ITEMS = 4096 + 512 + 512;
constexpr int GEMM1K_UNITS = (NTOK / 256) * 4;
__device__ __forceinline__ bool defer_weights() { return (int)gridDim.x - GEMM1K_UNITS >= 32; }
__device__ __forceinline__ void fs_prep_deferred(const P& p, int l, int half, LAS unsigned char* lds) {
    const int idle0 = GEMM1K_UNITS, nidle = (int)gridDim.x - idle0;
    if (!defer_weights() || (int)blockIdx.x < idle0) return;
    const int tid = otid(), lane = tid & 63, wave = tid >> 6;
    tr_big_layer(p, l, half * (TR_BIG_ITEMS / 2), (half + 1) * (TR_BIG_ITEMS / 2), ((int)blockIdx.x - idle0) * (NTHREADS / 64) + wave, nidle * (NTHREADS / 64), (LAS float*)(lds + wave * 16384), lane);
}
__device__ __forceinline__ void fs_prep(const P& p, LAS unsigned char* lds) {
    const int tid = otid(), lane = tid & 63, wave = tid >> 6, gw = blockIdx.x * (NTHREADS / 64) + wave, ngw = gridDim.x * (NTHREADS / 64);
    LAS float* scr = (LAS float*)(lds + wave * 16384);
    {
        const int nl = defer_weights() ? 1 : DEPTH;
        for (int l = 0; l < nl; ++l) tr_big_layer(p, l, 0, TR_BIG_ITEMS, gw, ngw, scr, lane);
        constexpr int I_QB = DEPTH * 4 * 16, I_KVB = DEPTH * 2 * 16;
        for (int it = gw; it < I_QB + I_KVB; it += ngw) {
            int r = it;
            if (r < I_QB) { const int nb = r & 15, kb = (r >> 4) & 3, l = r >> 6;
                tr_item(p.in[I_WQB] + (size_t)l * 256 * 384, 384, nb < 12 ? nb * 32 : -1, WSP(bf16_t, WS_WTQB) + (size_t)l * 512 * 256, 256, nb * 32, kb * 64, scr, lane); continue; } r -= I_QB;
            { const int nb = r & 15, kb = (r >> 4) & 1, l = r >> 5;
                tr_item(p.in[I_WKVB] + (size_t)l * 128 * 512, 512, nb * 32, WSP(bf16_t, WS_WTKVB) + (size_t)l * 512 * 128, 128, nb * 32, kb * 64, scr, lane); }
        }
    }
    __syncthreads();
    {
        LAS float* sl = (LAS float*)lds;
        LAS float* red = sl + NCB * 1024;
        for (int i = tid; i < NCB * 1024; i += NTHREADS) { const int cb = i >> 10, k = i & 1023; const float cv = cb == 0 ? p.in[I_CCTX][k] : p.in[I_C][(size_t)(cb - 1) * DM + k]; sl[i] = cv / (1.f + __expf(-cv)); }
        __syncthreads();
        for (int it = blockIdx.x; it < DEPTH * 48; it += gridDim.x) {
            const int l = it / 48, j = (it % 48) * 64 + (tid & 63), kp = tid >> 6;
            const float* w = p.in[I_WMOD] + ((size_t)l * DM + kp * 128) * 3072 + j;
            float acc[NCB];
#pragma unroll
            for (int cb = 0; cb < NCB; ++cb) acc[cb] = 0.f;
            for (int k0 = 0; k0 < 128; k0 += 32) {
                float wv[32];
#pragma unroll
                for (int k = 0; k < 32; ++k) wv[k] = w[(size_t)(k0 + k) * 3072];
#pragma unroll
                for (int k = 0; k < 32; ++k)
#pragma unroll
                    for (int cb = 0; cb < NCB; ++cb) acc[cb] += sl[cb * 1024 + kp * 128 + k0 + k] * wv[k];
            }
#pragma unroll
            for (int cb = 0; cb < NCB; ++cb) red[(kp * NCB + cb) * 64 + (tid & 63)] = acc[cb];
            __syncthreads();
            if (tid < NCB * 64) { const int cb = tid >> 6, jj = tid & 63; float sm = 0.f;
#pragma unroll
                for (int q = 0; q < 8; ++q) sm += red[(q * NCB + cb) * 64 + jj];
                WSP(float, WS_MODV)[((size_t)l * NCB + cb) * 3072 + (it % 48) * 64 + jj] = sm + p.in[I_BMOD][(size_t)l * 3072 + (it % 48) * 64 + jj]; }
            __syncthreads();
        }
    }
    const long gtid = (long)blockIdx.x * NTHREADS + tid, gsz = (long)gridDim.x * NTHREADS;
    {
        float* lbs = WSP(float, WS_LBS);
        for (long i = gtid; i < 2 * 256; i += gsz) {
            const float* lg = p.in[I_LB];
            float mx = -1e30f;
            for (int l = 0; l < DEPTH; ++l) mx = fmaxf(mx, lg[(size_t)l * 512 + i]);
            float sm = 0.f;
            for (int l = 0; l < DEPTH; ++l) sm += expf(lg[(size_t)l * 512 + i] - mx);
            float cum = 0.f; const float p0 = expf(lg[i] - mx) / sm;
            for (int l = 0; l < DEPTH; ++l) { cum += expf(lg[(size_t)l * 512 + i] - mx) / sm; lbs[(size_t)l * 512 + i] = cum - p0; }
        }
        float* rm = WSP(float, WS_ROPEM);
        for (long i = gtid; i < (long)DSEQ * 16; i += gsz) {
            const int j = (int)(i % 16), t = (int)(i / 16);
            const float pos = j < 8 ? (float)(t / GW) : (float)(t % GW);
            const float a = pos * powf(10000.f, -(float)(j & 7) / 8.f); rm[i * 2] = cosf(a); rm[i * 2 + 1] = sinf(a);
        }
        float* rw = WSP(float, WS_ROPEW);
        for (long i = gtid; i < (long)DSEQ * 32; i += gsz) {
            const int j = (int)(i % 32), t = (int)(i / 32);
            const float pos = j < 16 ? (float)(t / GW) : (float)(t % GW);
            const float a = pos * powf(10000.f, -(float)(j & 15) / 16.f); rw[i * 2] = cosf(a); rw[i * 2 + 1] = sinf(a);
        }
        for (long i = gtid; i < (long)DB * DEPTH * PAST * 256 / 4; i += gsz) {
            const f32x4 a = *(const f32x4*)(p.in[I_CNAK] + 4 * i), b = *(const f32x4*)(p.in[I_CNAV] + 4 * i);
            u32x2 wa, wb; wa.x = cvt_pk_bf16(a[0], a[1]); wa.y = cvt_pk_bf16(a[2], a[3]); wb.x = cvt_pk_bf16(b[0], b[1]); wb.y = cvt_pk_bf16(b[2], b[3]);
            *(u32x2*)(WSP(bf16_t, WS_CNAK) + 4 * i) = wa; *(u32x2*)(WSP(bf16_t, WS_CNAV) + 4 * i) = wb;
        }
        for (long i = gtid; i < (long)DB * DEPTH * PAST * 128 / 4; i += gsz) {
            const f32x4 a = *(const f32x4*)(p.in[I_CWK] + 4 * i), b = *(const f32x4*)(p.in[I_CWV] + 4 * i), cc = *(const f32x4*)(p.in[I_CCKV] + 4 * i);
            u32x2 wa, wb, wc; wa.x = cvt_pk_bf16(a[0], a[1]); wa.y = cvt_pk_bf16(a[2], a[3]); wb.x = cvt_pk_bf16(b[0], b[1]); wb.y = cvt_pk_bf16(b[2], b[3]); wc.x = cvt_pk_bf16(cc[0], cc[1]); wc.y = cvt_pk_bf16(cc[2], cc[3]);
            *(u32x2*)(WSP(bf16_t, WS_CWK) + 4 * i) = wa; *(u32x2*)(WSP(bf16_t, WS_CWV) + 4 * i) = wb; *(u32x2*)(WSP(bf16_t, WS_CCKVB) + 4 * i) = wc;
        }
        for (long i = gtid; i < (long)DB * DEPTH * PAST * 128; i += gsz) {
            const int e = (int)(i % 32), h = (int)((i / 32) % 4); const long rowi = i / 128;
            WSP(bf16_t, WS_KCM)[(size_t)rowi * 384 + h * 96 + 64 + e] = f2bf(p.in[I_CKR][(size_t)rowi * 32 + e]);
        }
    }
}
struct CtxOrder {
    int c, nwgs; const char* A; const char* B;
    __device__ bool next(int i, pg8::Unit& u) const {
        const int L = i * nwgs + c; if (L >= (DB * DEPTH * PAST / 256) * 2) return false;
        u.pm = L >> 1; u.pn = L & 1; u.aux = 0;
        const int lyr = (u.pm / (PAST / 256)) % DEPTH;
        u.A = A + (size_t)u.pm * 256 * 128 * 2; u.B = B + ((size_t)lyr * 512 + u.pn * 256) * 128 * 2; return true;
    }
};
__device__ __forceinline__ void fs_prep_ctx(const P& p, LAS unsigned char* lds) {
    bf16_t* km = WSP(bf16_t, WS_KCM); bf16_t* vm = WSP(bf16_t, WS_VCM);
    CtxOrder S{(int)blockIdx.x, (int)gridDim.x, (const char*)WSP(bf16_t, WS_CCKVB), (const char*)WSP(bf16_t, WS_WTKVB)};
    auto E = make_epi([=](const pg8::Unit& u, int r, int n, f32x4 v0, f32x4 v1) {
        const u32x4 w = pack8(v0, v1); const int h = n >> 7, e = n & 127;
        if (e < 64) *(u32x4*)(km + (size_t)r * 384 + h * 96 + e) = w; else *(u32x4*)(vm + (size_t)r * 256 + h * 64 + (e - 64)) = w;
    });
    int K = 128; asm volatile("" : "+s"(K));
    pg8::gemm_phase(lds, pg8::Gemm{K, K, K}, S, E);
}

#define XB_TMO      128
#define XB_XCNT(j)  (256  + 64 * (j))
#define XB_XSUB(j)  (1280 + 64 * (j))
#define XB_XGEN(j)  (2304 + 64 * (j))
#define XB_TOP      3328
#define XB_TOPGEN   3392
#define XCD_BAR_WORDS 3456
#define XB_SPIN_CAP (1u << 20)
__device__ __forceinline__ unsigned xb_ld(unsigned* p)              { return __hip_atomic_load(p, __ATOMIC_RELAXED, __HIP_MEMORY_SCOPE_AGENT); }
__device__ __forceinline__ unsigned xb_add(unsigned* p, unsigned v) { return __hip_atomic_fetch_add(p, v, __ATOMIC_RELAXED, __HIP_MEMORY_SCOPE_AGENT); }
__device__ __forceinline__ unsigned xb_xcc_id() { return (unsigned)__builtin_amdgcn_s_getreg((3 << 11) | 20) & 0xFu; }
#define XB_SPIN(cond, bar) do { unsigned _sp = 0; while (cond) { __builtin_amdgcn_s_sleep(1); \
    if ((++_sp & 255u) == 0u) { if (xb_ld(&(bar)[XB_TMO])) break; if (_sp > XB_SPIN_CAP) { atomicAdd(&(bar)[XB_TMO], 1u); break; } } } } while (0)
struct XcdBarrier { unsigned* bar; unsigned x; volatile LAS unsigned* st; };
__device__ __forceinline__ XcdBarrier xcd_barrier_post(unsigned* bar, volatile LAS unsigned* st) {
    XcdBarrier b; b.bar = bar; b.x = xb_xcc_id(); b.st = st;
    if (threadIdx.x == 0) (void)xb_add(&bar[XB_XCNT(b.x)], 1u);
    return b;
}
__device__ __forceinline__ void xcd_barrier_complete(unsigned* bar, unsigned x, unsigned& nloc, unsigned& nx) {
    const unsigned G = gridDim.x * gridDim.y * gridDim.z;
    unsigned sum, cnt, mine, sp = 0u;
    for (;;) {
        sum = 0u; cnt = 0u; mine = 0u;
#pragma unroll
        for (unsigned j = 0; j < 16; ++j) { const unsigned c = xb_ld(&bar[XB_XCNT(j)]); sum += c; cnt += (c > 0u) ? 1u : 0u; mine = (j == x) ? c : mine; }
        if (sum == G) break;
        __builtin_amdgcn_s_sleep(1);
        if ((++sp & 255u) == 0u) { if (xb_ld(&bar[XB_TMO])) break; if (sp > XB_SPIN_CAP) { atomicAdd(&bar[XB_TMO], 1u); break; } }
    }
    nloc = mine > 0u ? mine : 1u; nx = cnt > 0u ? cnt : 1u;
}
__device__ __forceinline__ void xcd_barrier(const XcdBarrier& b) {
    asm volatile("s_waitcnt vmcnt(0)" ::: "memory");
    __syncthreads();
    if (threadIdx.x == 0) {
        unsigned* bar = b.bar;
        __builtin_amdgcn_s_waitcnt(0);
        unsigned nloc = b.st[0], nx = b.st[1];
        if (nloc == 0u) { xcd_barrier_complete(bar, b.x, nloc, nx); b.st[0] = nloc; b.st[1] = nx; }
        const unsigned old = xb_add(&bar[XB_XSUB(b.x)], 1u);
        const unsigned gen = old / nloc;
        if (old + 1u == (gen + 1u) * nloc) {
            __builtin_amdgcn_fence(__ATOMIC_RELEASE, "agent");
            asm volatile("s_waitcnt vmcnt(0)" ::: "memory");
            const unsigned og = xb_add(&bar[XB_TOP], 1u);
            const unsigned tg = og / nx;
            if (og + 1u == (tg + 1u) * nx) xb_add(&bar[XB_TOPGEN], 1u);
            else XB_SPIN(xb_ld(&bar[XB_TOPGEN]) == tg, bar);
            __builtin_amdgcn_fence(__ATOMIC_ACQUIRE, "agent");
            xb_add(&bar[XB_XGEN(b.x)], 1u);
            asm volatile("s_waitcnt vmcnt(0)" ::: "memory");
        } else {
            XB_SPIN(xb_ld(&bar[XB_XGEN(b.x)]) == gen, bar);
            __builtin_amdgcn_fence(__ATOMIC_ACQUIRE, "agent");
            asm volatile("s_waitcnt vmcnt(0)" ::: "memory");
        }
    }
    __syncthreads();
}

__global__ void __launch_bounds__(NTHREADS) mega_kernel(P p) {
    extern __shared__ __attribute__((aligned(16))) unsigned char lds_raw[];
    LAS unsigned char* lds = (LAS unsigned char*)lds_raw;
    { LAS unsigned* stz = (LAS unsigned*)(lds + LDS_BYTES - 64); if (threadIdx.x < 16) stz[threadIdx.x] = 0u; }
    __syncthreads();
    (void)xcd_barrier_post((unsigned*)((*(const P*)__builtin_amdgcn_kernarg_segment_ptr()).ws + WS_CTL), (volatile LAS unsigned*)(lds + LDS_BYTES - 64));
#define GBAR() do { XcdBarrier gb_; gb_.bar = (unsigned*)(PPR.ws + WS_CTL); gb_.x = xb_xcc_id(); gb_.st = (volatile LAS unsigned*)(lds + LDS_BYTES - 64); xcd_barrier(gb_); } while (0)
    const long gsz = (long)gridDim.x * blockDim.x;
#define GTID() ({ int t_ = threadIdx.x; asm volatile("" : "+v"(t_)); (long)blockIdx.x * blockDim.x + t_; })
#define PP ({ const __attribute__((address_space(4))) P* k_ = (const __attribute__((address_space(4))) P*)__builtin_amdgcn_kernarg_segment_ptr(); asm volatile("" : "+s"(k_)); k_; })
#define PPR (*(const P*)PP)
#ifndef DUPM
#define DUPM 0
#endif
#define PB(id) do { if (PROBE == (id) && blockIdx.x == 0 && threadIdx.x == 0) { *(volatile LAS unsigned long long*)(lds + LDS_BYTES - 32) = __builtin_amdgcn_s_memrealtime(); } } while (0)
#define PE(id) do { if (PROBE == (id) && blockIdx.x == 0 && threadIdx.x == 0) { const unsigned long long t1_ = __builtin_amdgcn_s_memrealtime(); \
        *(volatile LAS unsigned long long*)(lds + LDS_BYTES - 24) += t1_ - *(volatile LAS unsigned long long*)(lds + LDS_BYTES - 32); } } while (0)
    if (PROBE && threadIdx.x == 0) { *(volatile LAS unsigned long long*)(lds + LDS_BYTES - 24) = 0ull; }
#define DUP(bit, stmt) do { if (DUPM & (1 << (bit))) { stmt; } } while (0)
    PB(1); fs_prep(PPR, lds); DUP(0, __syncthreads(); fs_prep(PPR, lds)); GBAR();
    fs_prep_ctx(PPR, lds); GBAR(); PE(1);
#pragma nounroll
    for (int l = 0; l < DEPTH; ++l) {
        PB(2); fs_norm<false>(PPR, l); GBAR(); PE(2);
        PB(3); fs_inproj(PPR, l, lds); DUP(1, fs_inproj(PPR, l, lds)); GBAR(); PE(3);
        PB(4); fs_rowprep(PPR, l); fs_hgrn_a(PPR, l, lds); DUP(6, fs_rowprep(PPR, l); fs_hgrn_a(PPR, l, lds)); GBAR(); PE(4);
        PB(5); fs_mlaproj(PPR, l, lds); DUP(7, fs_mlaproj(PPR, l, lds)); PB(6); fs_hgrn_b(PPR, l, GTID(), gsz); PE(6); GBAR(); PE(5);
        PB(7); fs_attn(PPR, l, lds); DUP(2, fs_attn(PPR, l, lds)); PE(7);
        PB(8); fs_hgrn_c(PPR, l, lds); DUP(5, fs_hgrn_c(PPR, l, lds)); GBAR(); PE(8);
        PB(9); fs_merge(PPR, l, lds); if (l + 1 < DEPTH) fs_prep_deferred(PPR, l + 1, 0, lds); DUP(3, fs_merge(PPR, l, lds)); DUP(4, GBAR(); GBAR(); GBAR(); GBAR(); GBAR(); GBAR(); GBAR(); GBAR()); GBAR(); PE(9);
        PB(10); fs_out(PPR, l, lds); if (l + 1 < DEPTH) fs_prep_deferred(PPR, l + 1, 1, lds);
        if (PROBE && l == DEPTH - 1) { PE(10); if (blockIdx.x == 0 && threadIdx.x == 0) { const unsigned long long ta_ = *(volatile LAS unsigned long long*)(lds + LDS_BYTES - 24); float f_ = (float)ta_ / (100.f * PROBE_SCALE_US); f_ = f_ > 1.f ? 1.f : f_; ((float*)(PPR.ws + WS_CTL))[8000] = sqrtf(2.0e-5f + 7.9e-5f * f_); } }
        GBAR(); if (l < DEPTH - 1) PE(10);
    }
    fs_norm<true>(PPR, 0);
}

extern "C" void kernel_launch(void* const* d_in, const int* in_sizes, int n_in, void* d_out, int out_size, void* d_ws, size_t ws_size, hipStream_t stream) {
    static int grid_blocks = 0;
    if (grid_blocks == 0) {
        if (n_in != N_IN || (size_t)out_size != O_END || ws_size < WS_END) {
            fprintf(stderr, "kernel_launch: unexpected sizes n_in %d out %d ws %zu (need %zu)\n", n_in, out_size, ws_size, (size_t)WS_END);
            grid_blocks = -1; return;
        }
        int dev = 0, cus = 0, per_cu = 0;
        hipGetDevice(&dev);
        hipDeviceGetAttribute(&cus, hipDeviceAttributeMultiprocessorCount, dev);
        hipFuncSetAttribute((const void*)mega_kernel, hipFuncAttributeMaxDynamicSharedMemorySize, LDS_BYTES);
        hipOccupancyMaxActiveBlocksPerMultiprocessor(&per_cu, (const void*)mega_kernel, NTHREADS, LDS_BYTES);
        if (per_cu < 1) per_cu = 1;
        grid_blocks = cus * per_cu;
    }
    if (grid_blocks < 0) return;
    P p{};
    for (int i = 0; i < N_IN; ++i) p.in[i] = (const float*)d_in[i];
    p.out = (float*)d_out; p.ws = (unsigned char*)d_ws;
    if (hipMemsetAsync((char*)d_ws + WS_CTL, 0, 16384, stream) != hipSuccess) { fprintf(stderr, "kernel_launch: memset of the barrier words failed\n"); return; }
    hipLaunchKernelGGL(mega_kernel, dim3(grid_blocks), dim3(NTHREADS), LDS_BYTES, stream, p);
    hipError_t e = hipPeekAtLastError();
    if (e != hipSuccess) fprintf(stderr, "launch failed: %s (grid %d)\n", hipGetErrorString(e), grid_blocks);
}
#endif
```
